# Optimizing an MI355X kernel written in HIP

```python
import jax, jax.numpy as jnp
from jax import lax
import numpy as np

D_MODEL = 1024
BATCH = 8
SEQ = 2048
DEPTH = 1

RWKV_HEADS = 8
RWKV_HEAD_DIM = 64
RWKV_WIDTH = RWKV_HEADS * RWKV_HEAD_DIM
DECAY_LORA = 64
ICLR_LORA = 64
GATE_LORA = 128
GN_EPS = 64e-5
N_DIR = 2
GMLP_GROUPS = 8
GMLP_WIDTH = 512
GMLP_GROUP_DIM = GMLP_WIDTH // GMLP_GROUPS
CHUNK = 128
N_BRANCH = 2
MEM_LEN = 256
XATTN_HEADS = 4
XATTN_HEAD_DIM = D_MODEL // XATTN_HEADS
PEER_HEADS = 8
N_KEYS = 128
N_EXPERTS = N_KEYS * N_KEYS
PEER_QDIM = 256
PEER_HALF = PEER_QDIM // 2
PEER_TOPK = 16
PEER_TOKEN_BLOCK = 128
LN_EPS = 1e-5
ALPHA = (2.0 * DEPTH) ** 0.25
BETA = (8.0 * DEPTH) ** -0.25

RWKV_SPLITS = [int(c) for c in np.cumsum([RWKV_WIDTH, RWKV_WIDTH, RWKV_WIDTH,
                                          N_DIR * DECAY_LORA, N_DIR * ICLR_LORA])]
RWKV_COLS = 3 * RWKV_WIDTH + N_DIR * DECAY_LORA + N_DIR * ICLR_LORA + GATE_LORA
GMLP_COLS = 2 * GMLP_WIDTH
GATE_COLS = N_BRANCH * D_MODEL
IN_COLS = RWKV_COLS + GMLP_COLS + GATE_COLS

kernel_name = "hybrid_rwkv7_gmlp_peer_deepnorm_encoder"


def layer_norm(x, g, b, eps=LN_EPS):
    xf = x.astype(jnp.float32)
    mu = jnp.mean(xf, -1, keepdims=True)
    var = jnp.mean(jnp.square(xf - mu), -1, keepdims=True)
    return ((xf - mu) * lax.rsqrt(var + eps) * g.astype(jnp.float32) + b.astype(jnp.float32)).astype(x.dtype)


def centred_shift(p):
    zero = jnp.zeros_like(p[:, :1])
    prev = jnp.concatenate([zero, p[:, :-1]], axis=1)
    nxt = jnp.concatenate([p[:, 1:], zero], axis=1)
    return 0.5 * (prev + nxt)


def dir_time_major(fwd, bwd):
    t = jnp.stack([fwd, jnp.flip(bwd, axis=1)], axis=0)
    return jnp.moveaxis(t, 2, 0)


def rwkv7_scan(r, w, k, v, a, b):
    n_dir, bsz, nh, n = r.shape[1:]
    s0 = jnp.zeros((n_dir, bsz, nh, n, n), jnp.float32)

    def step(s, inp):
        r_t, w_t, k_t, v_t, a_t, b_t = inp
        sa = jnp.einsum('zbhij,zbhj->zbhi', s, a_t)
        s = s * w_t[..., None, :] + sa[..., :, None] * b_t[..., None, :] + v_t[..., :, None] * k_t[..., None, :]
        y = jnp.einsum('zbhij,zbhj->zbhi', s, r_t)
        return s, y

    _, y = lax.scan(step, s0, (r, w, k, v, a, b))
    return y


def rwkv7_branch(p, mu, w0, w2, a0, a2, g2, k_k, k_a, r_k, gn_g, gn_b):
    bsz, s, _ = p.shape
    f32 = jnp.float32
    p = p + mu * (centred_shift(p) - p)
    r, k, v, wd, ad, gd = jnp.split(p.astype(f32), RWKV_SPLITS, axis=-1)
    wd = wd.reshape(bsz, s, N_DIR, DECAY_LORA)
    ad = ad.reshape(bsz, s, N_DIR, ICLR_LORA)
    w_log = -jax.nn.softplus(-(w0.astype(f32) + jnp.einsum('bszr,zrc->bszc', jnp.tanh(wd), w2.astype(f32)))) - 0.5
    decay = jnp.exp(-jnp.exp(w_log))
    a = jax.nn.sigmoid(a0.astype(f32) + jnp.einsum('bszr,zrc->bszc', ad, a2.astype(f32)))
    g = jnp.einsum('bsr,rc->bsc', jax.nn.sigmoid(gd), g2.astype(f32))
    kk = (k * k_k.astype(f32)).reshape(bsz, s, RWKV_HEADS, RWKV_HEAD_DIM)
    kk = kk / jnp.maximum(jnp.linalg.norm(kk, axis=-1, keepdims=True), 1e-12)
    kk = kk.reshape(bsz, s, RWKV_WIDTH)
    k_dir = k[:, :, None, :] * (1.0 + (a - 1.0) * k_a.astype(f32))
    b_vec = kk[:, :, None, :] * a

    hs = lambda t: t.reshape(bsz, s, RWKV_HEADS, RWKV_HEAD_DIM)
    shared = lambda t: dir_time_major(hs(t), hs(t))
    per_dir = lambda t: dir_time_major(hs(t[:, :, 0]), hs(t[:, :, 1]))
    y = rwkv7_scan(shared(r), per_dir(decay), per_dir(k_dir), shared(v), shared(-kk), per_dir(b_vec))
    y = y[:, 0] + jnp.flip(y[:, 1], axis=0)
    y = jnp.moveaxis(y, 0, 1)
    mu_y = jnp.mean(y, -1, keepdims=True)
    var_y = jnp.mean(jnp.square(y - mu_y), -1, keepdims=True)
    y = ((y - mu_y) * lax.rsqrt(var_y + GN_EPS)).reshape(bsz, s, RWKV_WIDTH) * gn_g.astype(f32) + gn_b.astype(f32)
    rk = jnp.sum((r[:, :, None, :] * k_dir).reshape(bsz, s, N_DIR, RWKV_HEADS, RWKV_HEAD_DIM) * r_k.astype(f32), axis=(2, 4))
    y = y + (rk[..., None] * hs(v)).reshape(bsz, s, RWKV_WIDTH)
    return (y * g).astype(p.dtype)


def gmlp_branch(p, ln_g, ln_b, w_s, b_s):
    bsz, s, _ = p.shape
    u, v = jnp.split(jax.nn.gelu(p, approximate=False), 2, axis=-1)
    v = layer_norm(v, ln_g, ln_b)
    v = v.reshape(bsz, s // CHUNK, CHUNK, GMLP_GROUPS, GMLP_GROUP_DIM)
    sv = jnp.einsum('gpq,bcqgd->bcpgd', w_s, v) + b_s.T[None, None, :, :, None]
    return u * sv.reshape(bsz, s, GMLP_WIDTH)


def hybrid_mixer(h, w_in, rwkv_mu, rwkv_w0, rwkv_w2, rwkv_a0, rwkv_a2, rwkv_g2, rwkv_k_k, rwkv_k_a,
                 rwkv_r_k, rwkv_gn_g, rwkv_gn_b, gmlp_ln_g, gmlp_ln_b, gmlp_w_s, gmlp_b_s, w_branch, w_mix_out):
    bsz, s, d = h.shape
    p = jnp.einsum('bsd,dc->bsc', h, w_in)
    p_a, p_b, p_g = jnp.split(p, [RWKV_COLS, RWKV_COLS + GMLP_COLS], axis=-1)
    y_a = rwkv7_branch(p_a, rwkv_mu, rwkv_w0, rwkv_w2, rwkv_a0, rwkv_a2, rwkv_g2, rwkv_k_k, rwkv_k_a,
                       rwkv_r_k, rwkv_gn_g, rwkv_gn_b)
    y_b = gmlp_branch(p_b, gmlp_ln_g, gmlp_ln_b, gmlp_w_s, gmlp_b_s)
    y = jnp.stack([y_a, y_b], axis=2)
    branch = jnp.einsum('bsnc,ncd->bsnd', y, w_branch)
    gates = jax.nn.sigmoid(p_g.reshape(bsz, s, N_BRANCH, d))
    merged = jnp.sum(gates * branch, axis=2)
    return jnp.einsum('bsd,de->bse', merged, w_mix_out)


def memory_xattn(h, mem_n, w_q, w_kv, w_o):
    bsz, s, d = h.shape
    m = mem_n.shape[1]
    q = jnp.einsum('bsd,de->bse', h, w_q).reshape(bsz, s, XATTN_HEADS, XATTN_HEAD_DIM)
    k, v = jnp.split(jnp.einsum('bmd,de->bme', mem_n, w_kv), 2, axis=-1)
    k = k.reshape(bsz, m, XATTN_HEADS, XATTN_HEAD_DIM)
    v = v.reshape(bsz, m, XATTN_HEADS, XATTN_HEAD_DIM)
    scores = jnp.einsum('bshd,bmhd->bhsm', q, k).astype(jnp.float32) * (XATTN_HEAD_DIM ** -0.5)
    prob = jax.nn.softmax(scores, axis=-1).astype(h.dtype)
    o = jnp.einsum('bhsm,bmhd->bshd', prob, v).reshape(bsz, s, d)
    return jnp.einsum('bsd,de->bse', o, w_o)


def peer(h, w_query, sub_keys, u_table, v_table):
    bsz, s, d = h.shape
    q = jnp.einsum('bsd,dq->bsq', h, w_query).reshape(bsz, s, PEER_HEADS, 2, PEER_HALF)
    sc = jnp.einsum('bshzc,zkc->bshzk', q, sub_keys).astype(jnp.float32)
    top_s, top_i = lax.top_k(sc, PEER_TOPK)
    cand_s = top_s[..., 0, :, None] + top_s[..., 1, None, :]
    cand_i = top_i[..., 0, :, None] * N_KEYS + top_i[..., 1, None, :]
    cand_s = cand_s.reshape(bsz, s, PEER_HEADS, PEER_TOPK * PEER_TOPK)
    cand_i = cand_i.reshape(bsz, s, PEER_HEADS, PEER_TOPK * PEER_TOPK)
    best_s, best_pos = lax.top_k(cand_s, PEER_TOPK)
    expert = jnp.take_along_axis(cand_i, best_pos, axis=-1)
    gate = jax.nn.softmax(best_s, axis=-1).astype(h.dtype)
    n_blk = (bsz * s) // PEER_TOKEN_BLOCK
    xb = h.reshape(n_blk, PEER_TOKEN_BLOCK, d)
    eb = expert.reshape(n_blk, PEER_TOKEN_BLOCK, PEER_HEADS, PEER_TOPK)
    gb = gate.reshape(n_blk, PEER_TOKEN_BLOCK, PEER_HEADS, PEER_TOPK)

    def token_block(args):
        xt, et, gt = args
        u = jnp.take(u_table, et, axis=0)
        act = jax.nn.gelu(jnp.einsum('thkd,td->thk', u, xt), approximate=False)
        vv = jnp.take(v_table, et, axis=0)
        return jnp.einsum('thk,thkd->td', gt * act, vv)

    y = lax.map(token_block, (xb, eb, gb))
    return y.reshape(bsz, s, d)


def setup_inputs(seed: int = 0) -> dict:
    key = jax.random.key(seed)
    keys = list(jax.random.split(key, 64))

    def nk():
        return keys.pop()

    def nrm(shape, scale):
        return jax.random.normal(nk(), shape, jnp.float32) * scale

    def gain(shape):
        return 1.0 + nrm(shape, 0.02)

    L, D = DEPTH, D_MODEL
    col_scale = jnp.ones((IN_COLS,), jnp.float32).at[2 * RWKV_WIDTH:3 * RWKV_WIDTH].set(BETA)
    kv_scale = jnp.ones((2 * D,), jnp.float32).at[D:].set(BETA)
    return {
        "x": nrm((BATCH, SEQ, D), 1.0),
        "mem": nrm((BATCH, MEM_LEN, D), 1.0),
        "ln_emb_g": gain((D,)),
        "ln_emb_b": nrm((D,), 0.02),
        "w_in": nrm((L, D, IN_COLS), D ** -0.5) * col_scale,
        "rwkv_mu": jax.random.uniform(nk(), (L, RWKV_COLS), jnp.float32, 0.0, 1.0),
        "rwkv_w0": jax.random.uniform(nk(), (L, N_DIR, RWKV_WIDTH), jnp.float32, -6.0, -1.0),
        "rwkv_w2": nrm((L, N_DIR, DECAY_LORA, RWKV_WIDTH), 0.1),
        "rwkv_a0": nrm((L, N_DIR, RWKV_WIDTH), 0.1),
        "rwkv_a2": nrm((L, N_DIR, ICLR_LORA, RWKV_WIDTH), 0.1),
        "rwkv_g2": nrm((L, GATE_LORA, RWKV_WIDTH), GATE_LORA ** -0.5),
        "rwkv_k_k": 0.85 + nrm((L, RWKV_WIDTH), 0.02),
        "rwkv_k_a": gain((L, RWKV_WIDTH)),
        "rwkv_r_k": nrm((L, RWKV_HEADS, RWKV_HEAD_DIM), 0.1),
        "rwkv_gn_g": gain((L, RWKV_WIDTH)),
        "rwkv_gn_b": nrm((L, RWKV_WIDTH), 0.02),
        "gmlp_ln_g": gain((L, GMLP_WIDTH)),
        "gmlp_ln_b": nrm((L, GMLP_WIDTH), 0.02),
        "gmlp_w_s": nrm((L, GMLP_GROUPS, CHUNK, CHUNK), CHUNK ** -0.5),
        "gmlp_b_s": gain((L, GMLP_GROUPS, CHUNK)),
        "w_branch": nrm((L, N_BRANCH, RWKV_WIDTH, D), RWKV_WIDTH ** -0.5),
        "w_mix_out": nrm((L, D, D), D ** -0.5) * BETA,
        "ln1_g": gain((L, D)),
        "ln1_b": nrm((L, D), 0.02),
        "mem_ln_g": gain((L, D)),
        "mem_ln_b": nrm((L, D), 0.02),
        "xattn_w_q": nrm((L, D, D), D ** -0.5),
        "xattn_w_kv": nrm((L, D, 2 * D), D ** -0.5) * kv_scale,
        "xattn_w_o": nrm((L, D, D), D ** -0.5) * BETA,
        "ln2_g": gain((L, D)),
        "ln2_b": nrm((L, D), 0.02),
        "peer_w_query": nrm((L, D, PEER_HEADS * PEER_QDIM), D ** -0.5),
        "peer_sub_keys": nrm((L, 2, N_KEYS, PEER_HALF), PEER_HALF ** -0.5),
        "peer_u": nrm((L, N_EXPERTS, D), D ** -0.5),
        "peer_v": nrm((L, N_EXPERTS, D), BETA * PEER_HEADS ** -0.5),
        "ln3_g": gain((L, D)),
        "ln3_b": nrm((L, D), 0.02),
    }


def reference(x, mem, ln_emb_g, ln_emb_b, w_in, rwkv_mu, rwkv_w0, rwkv_w2, rwkv_a0, rwkv_a2, rwkv_g2,
              rwkv_k_k, rwkv_k_a, rwkv_r_k, rwkv_gn_g, rwkv_gn_b, gmlp_ln_g, gmlp_ln_b, gmlp_w_s, gmlp_b_s,
              w_branch, w_mix_out, ln1_g, ln1_b, mem_ln_g, mem_ln_b, xattn_w_q, xattn_w_kv, xattn_w_o,
              ln2_g, ln2_b, peer_w_query, peer_sub_keys, peer_u, peer_v, ln3_g, ln3_b):
    h = layer_norm(x, ln_emb_g, ln_emb_b)
    for l in range(DEPTH):
        mix = hybrid_mixer(h, w_in[l], rwkv_mu[l], rwkv_w0[l], rwkv_w2[l], rwkv_a0[l], rwkv_a2[l], rwkv_g2[l],
                           rwkv_k_k[l], rwkv_k_a[l], rwkv_r_k[l], rwkv_gn_g[l], rwkv_gn_b[l],
                           gmlp_ln_g[l], gmlp_ln_b[l], gmlp_w_s[l], gmlp_b_s[l], w_branch[l], w_mix_out[l])
        h = layer_norm(ALPHA * h + mix, ln1_g[l], ln1_b[l])
        mem_n = layer_norm(mem, mem_ln_g[l], mem_ln_b[l])
        h = layer_norm(ALPHA * h + memory_xattn(h, mem_n, xattn_w_q[l], xattn_w_kv[l], xattn_w_o[l]),
                       ln2_g[l], ln2_b[l])
        h = layer_norm(ALPHA * h + peer(h, peer_w_query[l], peer_sub_keys[l], peer_u[l], peer_v[l]),
                       ln3_g[l], ln3_b[l])
    return h
```

```cpp
#ifdef HOST_EMU
#include "emu.h"
#else
#include <hip/hip_runtime.h>
#define LAUNCH(k, grid, block, stream, ...) k<<<dim3((unsigned)(grid)), dim3((unsigned)(block)), 0, stream>>>(__VA_ARGS__)
#endif

#ifndef BATCH
#define BATCH 8
#endif
#ifndef SEQ
#define SEQ 2048
#endif
#define DM 1024
#define TOK (BATCH * SEQ)
#define IN_COLS 4992
#define RW_COLS 1920
#define MEM_LEN 256
#define ALPHA_F 1.189207115002721f

__device__ __forceinline__ float sigmoidf_(float x) { return 1.0f / (1.0f + expf(-x)); }
__device__ __forceinline__ float geluf_(float x) { return 0.5f * x * (1.0f + erff(x * 0.7071067811865476f)); }

__global__ void k_ln_rows(const float* __restrict__ in, int in_stride, const float* __restrict__ g,
                          const float* __restrict__ b, float* __restrict__ out, int out_stride, int rows, int width,
                          float eps) {
    int row = blockIdx.x * blockDim.x + threadIdx.x;
    if (row >= rows) return;
    const float* x = in + (size_t)row * in_stride;
    float s = 0.f;
    for (int i = 0; i < width; ++i) s += x[i];
    float mu = s / width;
    float q = 0.f;
    for (int i = 0; i < width; ++i) { float d = x[i] - mu; q += d * d; }
    float rs = 1.0f / sqrtf(q / width + eps);
    float* o = out + (size_t)row * out_stride;
    for (int i = 0; i < width; ++i) o[i] = (x[i] - mu) * rs * g[i] + b[i];
}

__global__ void k_resid_ln(const float* __restrict__ h, const float* __restrict__ y, const float* __restrict__ g,
                           const float* __restrict__ b, float* __restrict__ out, int rows) {
    int row = blockIdx.x * blockDim.x + threadIdx.x;
    if (row >= rows) return;
    const float* hr = h + (size_t)row * DM;
    const float* yr = y + (size_t)row * DM;
    float s = 0.f;
    for (int i = 0; i < DM; ++i) s += ALPHA_F * hr[i] + yr[i];
    float mu = s / DM;
    float q = 0.f;
    for (int i = 0; i < DM; ++i) { float d = ALPHA_F * hr[i] + yr[i] - mu; q += d * d; }
    float rs = 1.0f / sqrtf(q / DM + 1e-5f);
    float* o = out + (size_t)row * DM;
    for (int i = 0; i < DM; ++i) o[i] = (ALPHA_F * hr[i] + yr[i] - mu) * rs * g[i] + b[i];
}

__global__ void __launch_bounds__(256) k_gemm(const float* __restrict__ A, int lda, const float* __restrict__ B, int ldb,
                                              float* __restrict__ C, int ldc, int M, int N, int K) {
    int nbn = N / 64;
    int bm = blockIdx.x / nbn, bn = blockIdx.x % nbn;
    int tx = threadIdx.x % 16, ty = threadIdx.x / 16;
    int m0 = bm * 64 + ty * 4, n0 = bn * 64 + tx * 4;
    float c00 = 0, c01 = 0, c02 = 0, c03 = 0, c10 = 0, c11 = 0, c12 = 0, c13 = 0;
    float c20 = 0, c21 = 0, c22 = 0, c23 = 0, c30 = 0, c31 = 0, c32 = 0, c33 = 0;
    const float* a0 = A + (size_t)(m0 + 0) * lda;
    const float* a1 = A + (size_t)(m0 + 1) * lda;
    const float* a2 = A + (size_t)(m0 + 2) * lda;
    const float* a3 = A + (size_t)(m0 + 3) * lda;
    for (int k = 0; k < K; ++k) {
        const float* br = B + (size_t)k * ldb + n0;
        float b0 = br[0], b1 = br[1], b2 = br[2], b3 = br[3];
        float x0 = a0[k], x1 = a1[k], x2 = a2[k], x3 = a3[k];
        c00 += x0 * b0; c01 += x0 * b1; c02 += x0 * b2; c03 += x0 * b3;
        c10 += x1 * b0; c11 += x1 * b1; c12 += x1 * b2; c13 += x1 * b3;
        c20 += x2 * b0; c21 += x2 * b1; c22 += x2 * b2; c23 += x2 * b3;
        c30 += x3 * b0; c31 += x3 * b1; c32 += x3 * b2; c33 += x3 * b3;
    }
    float* c0 = C + (size_t)(m0 + 0) * ldc + n0;
    float* c1 = C + (size_t)(m0 + 1) * ldc + n0;
    float* c2 = C + (size_t)(m0 + 2) * ldc + n0;
    float* c3 = C + (size_t)(m0 + 3) * ldc + n0;
    c0[0] = c00; c0[1] = c01; c0[2] = c02; c0[3] = c03;
    c1[0] = c10; c1[1] = c11; c1[2] = c12; c1[3] = c13;
    c2[0] = c20; c2[1] = c21; c2[2] = c22; c2[3] = c23;
    c3[0] = c30; c3[1] = c31; c3[2] = c32; c3[3] = c33;
}

__global__ void k_shift_mix(const float* __restrict__ p, const float* __restrict__ mu, float* __restrict__ ps) {
    int idx = blockIdx.x * blockDim.x + threadIdx.x;
    if (idx >= SEQ * RW_COLS) return;
    int t = idx / RW_COLS, c = idx % RW_COLS;
    float cur = p[idx];
    float prev = (t > 0) ? p[idx - RW_COLS] : 0.f;
    float nxt = (t < SEQ - 1) ? p[idx + RW_COLS] : 0.f;
    ps[idx] = cur + mu[c] * (0.5f * (prev + nxt) - cur);
}
__global__ void k_decay_a(const float* __restrict__ ps, const float* __restrict__ w0, const float* __restrict__ w2,
                          const float* __restrict__ a0, const float* __restrict__ a2, float* __restrict__ dec,
                          float* __restrict__ aa) {
    int idx = blockIdx.x * blockDim.x + threadIdx.x;
    if (idx >= SEQ * 2 * 512) return;
    int c = idx % 512, z = (idx / 512) % 2, t = idx / 1024;
    const float* wd = ps + (size_t)t * RW_COLS + 1536 + z * 64;
    const float* ad = ps + (size_t)t * RW_COLS + 1664 + z * 64;
    float sw = w0[z * 512 + c], sa = a0[z * 512 + c];
    for (int r = 0; r < 64; ++r) {
        sw += tanhf(wd[r]) * w2[(z * 64 + r) * 512 + c];
        sa += ad[r] * a2[(z * 64 + r) * 512 + c];
    }
    float y = -sw;
    float sp = fmaxf(y, 0.f) + log1pf(expf(-fabsf(y)));
    float wlog = -sp - 0.5f;
    dec[idx] = expf(-expf(wlog));
    aa[idx] = sigmoidf_(sa);
}
__global__ void k_gate(const float* __restrict__ ps, const float* __restrict__ g2, float* __restrict__ g) {
    int idx = blockIdx.x * blockDim.x + threadIdx.x;
    if (idx >= SEQ * 512) return;
    int c = idx % 512, t = idx / 512;
    const float* gd = ps + (size_t)t * RW_COLS + 1792;
    float s = 0.f;
    for (int r = 0; r < 128; ++r) s += sigmoidf_(gd[r]) * g2[r * 512 + c];
    g[idx] = s;
}
__global__ void k_kk(const float* __restrict__ ps, const float* __restrict__ k_k, float* __restrict__ kk) {
    int idx = blockIdx.x * blockDim.x + threadIdx.x;
    if (idx >= SEQ * 512) return;
    int c = idx % 512, t = idx / 512;
    int hb = (c / 64) * 64;
    const float* k = ps + (size_t)t * RW_COLS + 512;
    float s = 0.f;
    for (int j = 0; j < 64; ++j) { float v = k[hb + j] * k_k[hb + j]; s += v * v; }
    float nrm = fmaxf(sqrtf(s), 1e-12f);
    kk[idx] = k[c] * k_k[c] / nrm;
}
__global__ void k_kdir_b(const float* __restrict__ ps, const float* __restrict__ aa, const float* __restrict__ kk,
                         const float* __restrict__ k_a, float* __restrict__ kdir, float* __restrict__ bvec) {
    int idx = blockIdx.x * blockDim.x + threadIdx.x;
    if (idx >= SEQ * 2 * 512) return;
    int c = idx % 512, t = idx / 1024;
    float k = ps[(size_t)t * RW_COLS + 512 + c];
    float a = aa[idx];
    kdir[idx] = k * (1.0f + (a - 1.0f) * k_a[c]);
    bvec[idx] = kk[t * 512 + c] * a;
}
__global__ void __launch_bounds__(64) k_scan(const float* __restrict__ ps, const float* __restrict__ dec,
                                             const float* __restrict__ kdir, const float* __restrict__ kk,
                                             const float* __restrict__ bvec, float* __restrict__ yz) {
    int z = blockIdx.x / 8, h = blockIdx.x % 8;
    int i = threadIdx.x;
    float S[64];
#pragma unroll
    for (int j = 0; j < 64; ++j) S[j] = 0.f;
    for (int n = 0; n < SEQ; ++n) {
        int t = (z == 0) ? n : (SEQ - 1 - n);
        const float* r = ps + (size_t)t * RW_COLS + h * 64;
        const float* w = dec + ((size_t)t * 2 + z) * 512 + h * 64;
        const float* k = kdir + ((size_t)t * 2 + z) * 512 + h * 64;
        const float* b = bvec + ((size_t)t * 2 + z) * 512 + h * 64;
        const float* a = kk + (size_t)t * 512 + h * 64;
        float v = ps[(size_t)t * RW_COLS + 1024 + h * 64 + i];
        float sa = 0.f;
#pragma unroll
        for (int j = 0; j < 64; ++j) sa += S[j] * (-a[j]);
        float y = 0.f;
#pragma unroll
        for (int j = 0; j < 64; ++j) {
            S[j] = S[j] * w[j] + sa * b[j] + v * k[j];
            y += S[j] * r[j];
        }
        yz[((size_t)z * SEQ + t) * 512 + h * 64 + i] = y;
    }
}
__global__ void k_rwkv_out(const float* __restrict__ yz, const float* __restrict__ ps, const float* __restrict__ kdir,
                           const float* __restrict__ r_k, const float* __restrict__ gn_g, const float* __restrict__ gn_b,
                           const float* __restrict__ g, float* __restrict__ ya) {
    int idx = blockIdx.x * blockDim.x + threadIdx.x;
    if (idx >= SEQ * 512) return;
    int c = idx % 512, t = idx / 512;
    int hb = (c / 64) * 64;
    const float* y0 = yz + (size_t)t * 512 + hb;
    const float* y1 = yz + ((size_t)SEQ + t) * 512 + hb;
    float s = 0.f;
    for (int j = 0; j < 64; ++j) s += y0[j] + y1[j];
    float mu = s / 64.f;
    float q = 0.f;
    for (int j = 0; j < 64; ++j) { float d = y0[j] + y1[j] - mu; q += d * d; }
    float rs = 1.0f / sqrtf(q / 64.f + 64e-5f);
    float yn = (y0[c - hb] + y1[c - hb] - mu) * rs * gn_g[c] + gn_b[c];
    const float* r = ps + (size_t)t * RW_COLS + hb;
    float rk = 0.f;
    for (int z = 0; z < 2; ++z)
        for (int j = 0; j < 64; ++j) rk += r[j] * kdir[((size_t)t * 2 + z) * 512 + hb + j] * r_k[hb + j];
    float v = ps[(size_t)t * RW_COLS + 1024 + c];
    ya[idx] = (yn + rk * v) * g[idx];
}

__global__ void k_gelu(float* __restrict__ p, int n) {
    int idx = blockIdx.x * blockDim.x + threadIdx.x;
    if (idx < n) p[idx] = geluf_(p[idx]);
}
__global__ void k_gmlp_sv(const float* __restrict__ pb, const float* __restrict__ vn, const float* __restrict__ w_s,
                          const float* __restrict__ b_s, float* __restrict__ yb) {
    int idx = blockIdx.x * blockDim.x + threadIdx.x;
    if (idx >= SEQ * 512) return;
    int c = idx % 512, t = idx / 512;
    int g = c / 64, ch = t / 128, p = t % 128;
    const float* ws = w_s + ((size_t)g * 128 + p) * 128;
    float s = 0.f;
    for (int q = 0; q < 128; ++q) s += ws[q] * vn[(size_t)(ch * 128 + q) * 512 + c];
    s += b_s[g * 128 + p];
    yb[idx] = pb[(size_t)t * 1024 + c] * s;
}
__global__ void k_merge(const float* __restrict__ pg, const float* __restrict__ br0, const float* __restrict__ br1,
                        float* __restrict__ merged) {
    int idx = blockIdx.x * blockDim.x + threadIdx.x;
    if (idx >= SEQ * DM) return;
    int n = idx % DM, t = idx / DM;
    merged[idx] = sigmoidf_(pg[(size_t)t * 2048 + n]) * br0[idx] + sigmoidf_(pg[(size_t)t * 2048 + 1024 + n]) * br1[idx];
}

__global__ void k_attn_scores(const float* __restrict__ q, const float* __restrict__ kv, float* __restrict__ sc) {
    int idx = blockIdx.x * blockDim.x + threadIdx.x;
    if (idx >= 4 * SEQ * MEM_LEN) return;
    int m = idx % MEM_LEN, s = (idx / MEM_LEN) % SEQ, h = idx / (MEM_LEN * SEQ);
    const float* qr = q + (size_t)s * DM + h * 256;
    const float* kr = kv + (size_t)m * 2048 + h * 256;
    float a = 0.f;
    for (int d = 0; d < 256; ++d) a += qr[d] * kr[d];
    sc[idx] = a * 0.0625f;
}
__global__ void k_softmax256(float* __restrict__ sc, int rows) {
    int row = blockIdx.x * blockDim.x + threadIdx.x;
    if (row >= rows) return;
    float* x = sc + (size_t)row * 256;
    float mx = x[0];
    for (int i = 1; i < 256; ++i) mx = fmaxf(mx, x[i]);
    float s = 0.f;
    for (int i = 0; i < 256; ++i) s += expf(x[i] - mx);
    float inv = 1.0f / s;
    for (int i = 0; i < 256; ++i) x[i] = expf(x[i] - mx) * inv;
}
__global__ void k_attn_out(const float* __restrict__ sc, const float* __restrict__ kv, float* __restrict__ o) {
    int idx = blockIdx.x * blockDim.x + threadIdx.x;
    if (idx >= SEQ * DM) return;
    int c = idx % DM, s = idx / DM;
    int h = c / 256;
    const float* pr = sc + ((size_t)h * SEQ + s) * 256;
    float a = 0.f;
    for (int m = 0; m < MEM_LEN; ++m) a += pr[m] * kv[(size_t)m * 2048 + 1024 + c];
    o[idx] = a;
}

__global__ void k_peer_scores(const float* __restrict__ q, const float* __restrict__ sk, float* __restrict__ sc) {
    int idx = blockIdx.x * blockDim.x + threadIdx.x;
    if (idx >= SEQ * 2048) return;
    int k = idx % 128, z = (idx / 128) % 2, h = (idx / 256) % 8, t = idx / 2048;
    const float* qr = q + (size_t)t * 2048 + h * 256 + z * 128;
    const float* kr = sk + ((size_t)z * 128 + k) * 128;
    float a = 0.f;
    for (int c = 0; c < 128; ++c) a += qr[c] * kr[c];
    sc[idx] = a;
}
__global__ void k_topk16(const float* __restrict__ sc, float* __restrict__ top_s, int* __restrict__ top_i) {
    int row = blockIdx.x * blockDim.x + threadIdx.x;
    if (row >= SEQ * 16) return;
    const float* x = sc + (size_t)row * 128;
    float pv = 0.f; int pi = -1;
    for (int j = 0; j < 16; ++j) {
        float best = 0.f; int bi = -1;
        for (int i = 0; i < 128; ++i) {
            float v = x[i];
            bool elig = (j == 0) || (v < pv) || (v == pv && i > pi);
            if (elig && (bi < 0 || v > best)) { best = v; bi = i; }
        }
        top_s[(size_t)row * 16 + j] = best; top_i[(size_t)row * 16 + j] = bi;
        pv = best; pi = bi;
    }
}
__global__ void k_cand_topk(const float* __restrict__ top_s, const int* __restrict__ top_i, float* __restrict__ gate,
                            int* __restrict__ expert) {
    int row = blockIdx.x * blockDim.x + threadIdx.x;
    if (row >= SEQ * 8) return;
    const float* s0 = top_s + (size_t)row * 32;
    const float* s1 = s0 + 16;
    const int* i0 = top_i + (size_t)row * 32;
    const int* i1 = i0 + 16;
    float pv = 0.f; int pi = -1;
    float mx = 0.f;
    for (int j = 0; j < 16; ++j) {
        float best = 0.f; int bi = -1;
        for (int c = 0; c < 256; ++c) {
            float v = s0[c / 16] + s1[c % 16];
            bool elig = (j == 0) || (v < pv) || (v == pv && c > pi);
            if (elig && (bi < 0 || v > best)) { best = v; bi = c; }
        }
        if (j == 0) mx = best;
        gate[(size_t)row * 16 + j] = best;
        expert[(size_t)row * 16 + j] = i0[bi / 16] * 128 + i1[bi % 16];
        pv = best; pi = bi;
    }
    float s = 0.f;
    for (int j = 0; j < 16; ++j) s += expf(gate[(size_t)row * 16 + j] - mx);
    float inv = 1.0f / s;
    for (int j = 0; j < 16; ++j) gate[(size_t)row * 16 + j] = expf(gate[(size_t)row * 16 + j] - mx) * inv;
}
__global__ void k_peer_act(const float* __restrict__ h2, const float* __restrict__ u, const int* __restrict__ expert,
                           const float* __restrict__ gate, float* __restrict__ coef) {
    int idx = blockIdx.x * blockDim.x + threadIdx.x;
    if (idx >= SEQ * 128) return;
    int t = idx / 128;
    const float* x = h2 + (size_t)t * DM;
    const float* ur = u + (size_t)expert[idx] * DM;
    float a = 0.f;
    for (int d = 0; d < DM; ++d) a += ur[d] * x[d];
    coef[idx] = gate[idx] * geluf_(a);
}
__global__ void k_peer_out(const float* __restrict__ coef, const int* __restrict__ expert, const float* __restrict__ v,
                           float* __restrict__ y) {
    int idx = blockIdx.x * blockDim.x + threadIdx.x;
    if (idx >= SEQ * DM) return;
    int d = idx % DM, t = idx / DM;
    float a = 0.f;
    for (int j = 0; j < 128; ++j) a += coef[(size_t)t * 128 + j] * v[(size_t)expert[(size_t)t * 128 + j] * DM + d];
    y[idx] = a;
}

static inline unsigned cdiv(size_t a, size_t b) { return (unsigned)((a + b - 1) / b); }
static void gemm(hipStream_t st, const float* A, int lda, const float* B, int ldb, float* C, int ldc, int M, int N, int K) {
    LAUNCH(k_gemm, (M / 64) * (N / 64), 256, st, A, lda, B, ldb, C, ldc, M, N, K);
}

extern "C" void kernel_launch(void* const* d_in, const int* in_sizes, int n_in, void* d_out, int out_size, void* d_ws,
                              size_t ws_size, hipStream_t stream) {
    const float* x = (const float*)d_in[0];
    const float* mem = (const float*)d_in[1];
    const float* ln_emb_g = (const float*)d_in[2];
    const float* ln_emb_b = (const float*)d_in[3];
    const float* w_in = (const float*)d_in[4];
    const float* rwkv_mu = (const float*)d_in[5];
    const float* rwkv_w0 = (const float*)d_in[6];
    const float* rwkv_w2 = (const float*)d_in[7];
    const float* rwkv_a0 = (const float*)d_in[8];
    const float* rwkv_a2 = (const float*)d_in[9];
    const float* rwkv_g2 = (const float*)d_in[10];
    const float* rwkv_k_k = (const float*)d_in[11];
    const float* rwkv_k_a = (const float*)d_in[12];
    const float* rwkv_r_k = (const float*)d_in[13];
    const float* rwkv_gn_g = (const float*)d_in[14];
    const float* rwkv_gn_b = (const float*)d_in[15];
    const float* gmlp_ln_g = (const float*)d_in[16];
    const float* gmlp_ln_b = (const float*)d_in[17];
    const float* gmlp_w_s = (const float*)d_in[18];
    const float* gmlp_b_s = (const float*)d_in[19];
    const float* w_branch = (const float*)d_in[20];
    const float* w_mix_out = (const float*)d_in[21];
    const float* ln1_g = (const float*)d_in[22];
    const float* ln1_b = (const float*)d_in[23];
    const float* mem_ln_g = (const float*)d_in[24];
    const float* mem_ln_b = (const float*)d_in[25];
    const float* w_q = (const float*)d_in[26];
    const float* w_kv = (const float*)d_in[27];
    const float* w_o = (const float*)d_in[28];
    const float* ln2_g = (const float*)d_in[29];
    const float* ln2_b = (const float*)d_in[30];
    const float* w_query = (const float*)d_in[31];
    const float* sub_keys = (const float*)d_in[32];
    const float* peer_u = (const float*)d_in[33];
    const float* peer_v = (const float*)d_in[34];
    const float* ln3_g = (const float*)d_in[35];
    const float* ln3_b = (const float*)d_in[36];
    float* out = (float*)d_out;

    float* ws = (float*)d_ws;
    size_t off = 0;
    auto take = [&](size_t n) { float* p = ws + off; off += (n + 63) / 64 * 64; return p; };
    float* H0 = take((size_t)TOK * DM);
    float* H1 = take((size_t)TOK * DM);
    float* SCB = take((size_t)SEQ * 11008);
    float* YA = SCB;
    float* YB = SCB + (size_t)SEQ * 512;
    float* SC = SCB + (size_t)SEQ * 1024;
    float* MIX = out;

    const int S = SEQ;
    LAUNCH(k_ln_rows, cdiv(TOK, 64), 64, stream, x, DM, ln_emb_g, ln_emb_b, H0, DM, TOK, DM, 1e-5f);

    for (int b = 0; b < BATCH; ++b) {
        const float* h0b = H0 + (size_t)b * S * DM;
        float* pa = SC;
        float* ps = pa + (size_t)S * RW_COLS;
        float* dec = ps + (size_t)S * RW_COLS;
        float* aa = dec + (size_t)S * 1024;
        float* kdir = aa + (size_t)S * 1024;
        float* bvec = kdir + (size_t)S * 1024;
        float* gg = bvec + (size_t)S * 1024;
        float* kk = gg + (size_t)S * 512;
        float* yz = kk + (size_t)S * 512;
        gemm(stream, h0b, DM, w_in, IN_COLS, pa, RW_COLS, S, RW_COLS, DM);
        LAUNCH(k_shift_mix, cdiv((size_t)S * RW_COLS, 256), 256, stream, pa, rwkv_mu, ps);
        LAUNCH(k_decay_a, cdiv((size_t)S * 1024, 256), 256, stream, ps, rwkv_w0, rwkv_w2, rwkv_a0, rwkv_a2, dec, aa);
        LAUNCH(k_gate, cdiv((size_t)S * 512, 256), 256, stream, ps, rwkv_g2, gg);
        LAUNCH(k_kk, cdiv((size_t)S * 512, 256), 256, stream, ps, rwkv_k_k, kk);
        LAUNCH(k_kdir_b, cdiv((size_t)S * 1024, 256), 256, stream, ps, aa, kk, rwkv_k_a, kdir, bvec);
        LAUNCH(k_scan, 16, 64, stream, ps, dec, kdir, kk, bvec, yz);
        LAUNCH(k_rwkv_out, cdiv((size_t)S * 512, 256), 256, stream, yz, ps, kdir, rwkv_r_k, rwkv_gn_g, rwkv_gn_b, gg,
               YA);
        float* pb = SC;
        float* vn = pb + (size_t)S * 1024;
        gemm(stream, h0b, DM, w_in + RW_COLS, IN_COLS, pb, 1024, S, 1024, DM);
        LAUNCH(k_gelu, cdiv((size_t)S * 1024, 256), 256, stream, pb, S * 1024);
        LAUNCH(k_ln_rows, cdiv(S, 64), 64, stream, pb + 512, 1024, gmlp_ln_g, gmlp_ln_b, vn, 512, S, 512, 1e-5f);
        LAUNCH(k_gmlp_sv, cdiv((size_t)S * 512, 256), 256, stream, pb, vn, gmlp_w_s, gmlp_b_s, YB);
        float* pg = SC;
        float* br0 = pg + (size_t)S * 2048;
        float* br1 = br0 + (size_t)S * 1024;
        float* mg = br1 + (size_t)S * 1024;
        gemm(stream, h0b, DM, w_in + RW_COLS + 1024, IN_COLS, pg, 2048, S, 2048, DM);
        gemm(stream, YA, 512, w_branch, DM, br0, DM, S, DM, 512);
        gemm(stream, YB, 512, w_branch + (size_t)512 * DM, DM, br1, DM, S, DM, 512);
        LAUNCH(k_merge, cdiv((size_t)S * DM, 256), 256, stream, pg, br0, br1, mg);
        gemm(stream, mg, DM, w_mix_out, DM, MIX + (size_t)b * S * DM, DM, S, DM, DM);
    }
    LAUNCH(k_resid_ln, cdiv(TOK, 64), 64, stream, H0, MIX, ln1_g, ln1_b, H1, TOK);

    for (int b = 0; b < BATCH; ++b) {
        float* q = SC;
        float* sc = q + (size_t)S * 1024;
        float* o = sc + (size_t)S * 1024;
        float* ao = o + (size_t)S * 1024;
        float* mn = ao + (size_t)S * 1024;
        float* kvb = mn + (size_t)256 * 1024;
        LAUNCH(k_ln_rows, cdiv(MEM_LEN, 64), 64, stream, mem + (size_t)b * MEM_LEN * DM, DM, mem_ln_g, mem_ln_b, mn, DM,
               MEM_LEN, DM, 1e-5f);
        gemm(stream, mn, DM, w_kv, 2048, kvb, 2048, MEM_LEN, 2048, DM);
        gemm(stream, H1 + (size_t)b * S * DM, DM, w_q, DM, q, DM, S, DM, DM);
        LAUNCH(k_attn_scores, cdiv((size_t)4 * S * MEM_LEN, 256), 256, stream, q, kvb, sc);
        LAUNCH(k_softmax256, cdiv((size_t)4 * S, 64), 64, stream, sc, 4 * S);
        LAUNCH(k_attn_out, cdiv((size_t)S * DM, 256), 256, stream, sc, kvb, o);
        gemm(stream, o, DM, w_o, DM, MIX + (size_t)b * S * DM, DM, S, DM, DM);
    }
    float* H2 = H0;
    LAUNCH(k_resid_ln, cdiv(TOK, 64), 64, stream, H1, MIX, ln2_g, ln2_b, H2, TOK);

    for (int b = 0; b < BATCH; ++b) {
        const float* h2b = H2 + (size_t)b * S * DM;
        float* q = SC;
        float* sc = q + (size_t)S * 2048;
        float* top_s = sc + (size_t)S * 2048;
        int* top_i = (int*)(top_s + (size_t)S * 256);
        float* gate = top_s + (size_t)S * 512;
        int* expert = (int*)(gate + (size_t)S * 128);
        float* coef = gate + (size_t)S * 256;
        gemm(stream, h2b, DM, w_query, 2048, q, 2048, S, 2048, DM);
        LAUNCH(k_peer_scores, cdiv((size_t)S * 2048, 256), 256, stream, q, sub_keys, sc);
        LAUNCH(k_topk16, cdiv((size_t)S * 16, 64), 64, stream, sc, top_s, top_i);
        LAUNCH(k_cand_topk, cdiv((size_t)S * 8, 64), 64, stream, top_s, top_i, gate, expert);
        LAUNCH(k_peer_act, cdiv((size_t)S * 128, 256), 256, stream, h2b, peer_u, expert, gate, coef);
        LAUNCH(k_peer_out, cdiv((size_t)S * DM, 256), 256, stream, coef, expert, peer_v, H1 + (size_t)b * S * DM);
    }
    LAUNCH(k_resid_ln, cdiv(TOK, 64), 64, stream, H2, H1, ln3_g, ln3_b, out, TOK);
}
```

```cpp
#ifdef HOST_EMU
#include "emu.h"
#else
#include <hip/hip_runtime.h>
#include <cstdio>
#include <cstdint>
#include <cstring>
#endif

#ifndef BATCH
#define BATCH 8
#endif
#ifndef SEQ
#define SEQ 2048
#endif
#define DM 1024
#define TOK (BATCH * SEQ)
#define IN_COLS 4992
#define MEM_LEN 256
#define ALPHA_F 1.189207115002721f
typedef unsigned short bf16_t;

#ifdef HOST_EMU
static inline float bf2f(bf16_t v) { unsigned u = (unsigned)v << 16; float f; memcpy(&f, &u, 4); return f; }
static inline bf16_t f2bf(float f) { unsigned u; memcpy(&u, &f, 4); return (bf16_t)((u + 0x7fffu + ((u >> 16) & 1u)) >> 16); }
#else
__device__ __forceinline__ float bf2f(bf16_t v) { return __uint_as_float((unsigned)v << 16); }
__device__ __forceinline__ bf16_t f2bf(float f) { unsigned u = __float_as_uint(f); return (bf16_t)((u + 0x7fffu + ((u >> 16) & 1u)) >> 16); }
#endif
__device__ __forceinline__ float sigmoidf_(float x) { return 1.0f / (1.0f + expf(-x)); }
__device__ __forceinline__ float geluf_(float x) { return 0.5f * x * (1.0f + erff(x * 0.7071067811865476f)); }

struct Params {
    const float* in[37];
    float* out;
    unsigned* ctl;
    bf16_t *W_IN_T, *W_BR_T, *W_MIX_T, *W_Q_T, *W_KV_T, *W_O_T, *W_QUERY_T;
    bf16_t *KV, *MEMN, *HB;
    bf16_t *PA, *PB, *VN, *YB;
    bf16_t *WDS, *ADS, *SG;
    bf16_t *R, *V, *KK, *OMW, *KDIR, *BVEC;
    float *Y01;
    bf16_t *YA, *BR, *MG;
    float* Z;
    bf16_t *Q, *O;
    float* SCA;
    bf16_t* QP;
    float* SC; float* TOPS; int* TOPI; float* GATE; int* EXPERT; float* COEF; float* Y;
};
enum { I_X = 0, I_MEM, I_LN_EMB_G, I_LN_EMB_B, I_W_IN, I_MU, I_W0, I_W2, I_A0, I_A2, I_G2, I_K_K, I_K_A, I_R_K, I_GN_G, I_GN_B,
       I_GLN_G, I_GLN_B, I_W_S, I_B_S, I_W_BRANCH, I_W_MIX, I_LN1_G, I_LN1_B, I_MLN_G, I_MLN_B, I_W_Q, I_W_KV, I_W_O, I_LN2_G, I_LN2_B,
       I_W_QUERY, I_SUBKEYS, I_PEER_U, I_PEER_V, I_LN3_G, I_LN3_B };

constexpr size_t MiB = 1u << 20;
constexpr size_t TU = (size_t)TOK * 1024;
constexpr size_t WS_CTL = 0;
constexpr size_t WS_W = 1 * MiB;
constexpr size_t OFF_W_IN = 0, OFF_W_BR = OFF_W_IN + (size_t)5120 * 1024 * 2, OFF_W_MIX = OFF_W_BR + (size_t)2048 * 512 * 2,
                 OFF_W_Q = OFF_W_MIX + (size_t)1024 * 1024 * 2, OFF_W_KV = OFF_W_Q + (size_t)1024 * 1024 * 2,
                 OFF_W_O = OFF_W_KV + (size_t)2048 * 1024 * 2, OFF_W_QUERY = OFF_W_O + (size_t)1024 * 1024 * 2,
                 OFF_W_END = OFF_W_QUERY + (size_t)2048 * 1024 * 2;
static_assert(OFF_W_END <= 27 * MiB, "weights region");
constexpr size_t WS_KV = 28 * MiB;
constexpr size_t WS_MEMN = 36 * MiB;
constexpr size_t WS_ACT = 40 * MiB;
constexpr size_t A_HB = WS_ACT;
constexpr size_t A_R1 = A_HB + 2 * TU;
constexpr size_t A_R2 = A_R1 + 4 * TU;
constexpr size_t WS_NEED = A_R2 + 7 * TU + TU / 2;
#ifndef HOST_EMU
static_assert(WS_NEED <= 256 * MiB, "workspace map exceeds 256 MiB");
#endif

struct EpiP1 { bf16_t* PA; bf16_t* PB; };
struct EpiPlain { bf16_t* O; int ldc; int col_off; };
struct EpiMerge { const bf16_t* BR; bf16_t* MG; };
struct EpiResid { const bf16_t* H; float* Z; };

#ifndef HOST_EMU
namespace pg8 {
#define PG8_LAS __attribute__((address_space(3)))
typedef unsigned short bf16_t;
typedef short bf16x8 __attribute__((ext_vector_type(8)));
typedef float f32x4 __attribute__((ext_vector_type(4)));
typedef unsigned u32x4 __attribute__((ext_vector_type(4)));
constexpr int BM = 256, BK = 64, HALF = 128, HTB = HALF * BK * 2  , STAGE_BYTES = 8 * HTB, NXCD = 8, WGM = 8;

__host__ __device__ __forceinline__ int lds_byte(int r, int c) { const int st = (r >> 4) * 2 + (c >> 5), rr = r & 15, cc = c & 31, ob = rr * 64 + cc * 2; return st * 1024 + (ob ^ (((ob >> 9) & 1) << 5)); }
__host__ __device__ __forceinline__ void stage_rc(int b, int& R, int& C) { const int st = b / 1024, sb = b % 1024, swz = sb ^ (((sb >> 9) & 1) << 5); R = (st >> 1) * 16 + swz / 64; C = (st & 1) * 32 + (swz % 64) / 2; }
__host__ __device__ __forceinline__ int perm32(int rho) { const int n = rho >> 4, i = rho & 15; return 8 * (i >> 2) + 4 * n + (i & 3); }

struct Unit { int pm, pn; };
struct Gemm { const bf16_t* A; const bf16_t* Bt; int M, N, K; };

struct StaticOrder {
    int nM, nN, nwg, G, c;
    __host__ __device__ void init(int M, int N, int G_, int c_) { nM = M / BM; nN = N / BM; nwg = nM * nN; G = G_; c = c_; }
    __host__ __device__ bool next(int i, Unit& u) const {
        const long L = (long)i * G + c; if (L >= nwg) return false;
        int wgid = (int)L; { const int q = nwg / NXCD, r = nwg % NXCD, xcd = wgid % NXCD, off = wgid / NXCD; wgid = (xcd < r ? xcd * (q + 1) : r * (q + 1) + (xcd - r) * q) + off; }
        const int nig = WGM * nN, gid = wgid / nig, fm = gid * WGM, gsz = (nM - fm) < WGM ? (nM - fm) : WGM;
        u.pm = fm + ((wgid % nig) % gsz); u.pn = (wgid % nig) / gsz; return true;
    }
    __device__ __forceinline__ void a_ready(const Unit&) const {}
    __device__ __forceinline__ void done(const Unit&) const {}
};

__device__ __forceinline__ unsigned cvt_pk_bf16(float lo, float hi) { unsigned r; asm volatile("v_cvt_pk_bf16_f32 %0, %1, %2" : "=v"(r) : "v"(lo), "v"(hi)); return r; }
typedef float f32x2 __attribute__((ext_vector_type(2)));
__device__ __forceinline__ f32x2 gelu_pk(f32x2 v) {
    const f32x2 av = __builtin_elementwise_abs(v), d = av * 0.2316418882f + 1.0f;
    f32x2 t; t.x = __builtin_amdgcn_rcpf(d.x); t.y = __builtin_amdgcn_rcpf(d.y);
    f32x2 q = t * 0.5307027145f + (-0.7265760135f); q = q * t + 0.7107068705f; q = q * t + (-0.142248368f); q = q * t + 0.127414796f; q = q * t;
    const f32x2 s = (v * v) * (-0.72134752044f);
    f32x2 e; e.x = __builtin_amdgcn_exp2f(s.x); e.y = __builtin_amdgcn_exp2f(s.y);
    const f32x2 m = v * (q * e), r = v - m;
    f32x2 o; o.x = v.x < 0.f ? m.x : r.x; o.y = v.y < 0.f ? m.y : r.y; return o;
}


template <class Epi, class Sched, bool ALIGN_EPI = false, bool SP2 = false>
__device__ __forceinline__ void gemm_phase(PG8_LAS unsigned char* lds, const Gemm g, const Sched& S, const Epi& E) {
    const int tid = threadIdx.x, wid = __builtin_amdgcn_readfirstlane(tid >> 6), lane = tid & 63, wr = wid >> 2, wc = wid & 3, fr = lane & 15, fq = lane >> 4;
    const int K = g.K, nt = K / BK;
    unsigned voffA[2], voffB[2];
#pragma unroll
    for (int i = 0; i < 2; ++i) { int R, C; stage_rc(tid * 16 + i * 8192, R, C); const int Rb = Epi::PERM ? ((R & ~31) + perm32(R & 31)) : R;
        voffA[i] = (unsigned)(R * K + C) * 2u; voffB[i] = (unsigned)(Rb * K + C) * 2u; }
    const size_t kstep = (size_t)(BK * 2);
    const size_t hstep = (size_t)HALF * K * 2;
    const size_t tstep = 2 * hstep;
    const unsigned ldsw = (unsigned)wid * 1024u;
    const int aoff = lds_byte(wr * 64 + fr, fq * 8), boff = lds_byte(wc * 32 + fr, fq * 8);
#define PG8_SA(b, h) (((b) * 2 + (h)) * HTB)
#define PG8_SB(b, h) ((4 + (b) * 2 + (h)) * HTB)
#define PG8_STAGE(bufoff, gbase, voff) do { _Pragma("unroll") for (int _i = 0; _i < 2; ++_i) \
        __builtin_amdgcn_global_load_lds((const unsigned*)((const char*)(gbase) + (voff)[_i]), (PG8_LAS unsigned*)(lds + (bufoff) + ldsw + _i * 8192), 16, 0, 0); } while (0)
#define PG8_LDA(dst, b, h) do { _Pragma("unroll") for (int m = 0; m < 4; ++m) _Pragma("unroll") for (int k = 0; k < 2; ++k) dst[m][k] = *(const PG8_LAS bf16x8*)(lds + PG8_SA(b, h) + aoff + m * 2048 + k * 1024); } while (0)
#define PG8_LDB(dst, b, h) do { _Pragma("unroll") for (int n = 0; n < 2; ++n) _Pragma("unroll") for (int k = 0; k < 2; ++k) dst[n][k] = *(const PG8_LAS bf16x8*)(lds + PG8_SB(b, h) + boff + n * 2048 + k * 1024); } while (0)
#define PG8_MMA(ai, bj, At, Bt) do { __builtin_amdgcn_s_setprio(1); _Pragma("unroll") for (int m = 0; m < 4; ++m) _Pragma("unroll") for (int n = 0; n < 2; ++n) _Pragma("unroll") for (int k = 0; k < 2; ++k) \
        acc[ai][bj][m][n] = __builtin_amdgcn_mfma_f32_16x16x32_bf16(Bt[n][k], At[m][k], acc[ai][bj][m][n], 0, 0, 0); __builtin_amdgcn_s_setprio(0); } while (0)
#define PG8_WAIT_V(n) asm volatile("s_waitcnt vmcnt(" #n ")" ::: "memory")
#define PG8_WAIT_L(n) asm volatile("s_waitcnt lgkmcnt(" #n ")" ::: "memory")
#define PG8_BAR __builtin_amdgcn_s_barrier()
#define PG8_SCHED __builtin_amdgcn_sched_barrier(0)
    Unit cur, nxt; int ui = 0;
    if (!S.next(0, cur)) return;
    f32x4 acc[2][2][4][2];
#pragma unroll
    for (int a = 0; a < 2; ++a)
#pragma unroll
        for (int b = 0; b < 2; ++b)
#pragma unroll
            for (int m = 0; m < 4; ++m)
#pragma unroll
                for (int n = 0; n < 2; ++n) acc[a][b][m][n] = (f32x4){0.f, 0.f, 0.f, 0.f};
    bf16x8 At[4][2], B0[2][2], B1[2][2];
    const char* cA = (const char*)g.A + (size_t)cur.pm * tstep; const char* cB = (const char*)g.Bt + (size_t)cur.pn * tstep;
    S.a_ready(cur);
    if constexpr (SP2) {
        PG8_STAGE(PG8_SB(0, 0), cB, voffB); PG8_STAGE(PG8_SB(0, 1), cB + hstep, voffB); PG8_STAGE(PG8_SA(0, 0), cA, voffA); PG8_STAGE(PG8_SA(0, 1), cA + hstep, voffA);
        if (wr == 1) PG8_BAR;
        PG8_WAIT_V(2); PG8_BAR;
        PG8_STAGE(PG8_SB(1, 0), cB + kstep, voffB); PG8_STAGE(PG8_SA(1, 0), cA + kstep, voffA); PG8_STAGE(PG8_SB(1, 1), cB + hstep + kstep, voffB);
        PG8_WAIT_V(6); PG8_BAR;
    } else {
        PG8_STAGE(PG8_SB(0, 0), cB, voffB); PG8_STAGE(PG8_SA(0, 0), cA, voffA); PG8_STAGE(PG8_SB(0, 1), cB + hstep, voffB); PG8_STAGE(PG8_SA(0, 1), cA + hstep, voffA);
        if (wr == 1) PG8_BAR;
        PG8_WAIT_V(4); PG8_BAR;
        PG8_STAGE(PG8_SB(1, 0), cB + kstep, voffB); PG8_STAGE(PG8_SA(1, 0), cA + kstep, voffA); PG8_STAGE(PG8_SB(1, 1), cB + hstep + kstep, voffB);
        PG8_WAIT_V(6); PG8_BAR;
    }
    for (;;) {
        const bool has_next = S.next(ui + 1, nxt);
        const char* nA = has_next ? (const char*)g.A + (size_t)nxt.pm * tstep : cA; const char* nB = has_next ? (const char*)g.Bt + (size_t)nxt.pn * tstep : cB;
        for (int t = 0; t < nt; t += 2) {
            const bool last = (t == nt - 2);
            const char* a1 = cA + (size_t)(t + 1) * kstep;
            const char* a2 = last ? nA : cA + (size_t)(t + 2) * kstep; const char* b2 = last ? nB : cB + (size_t)(t + 2) * kstep;
            const char* a3 = a2 + kstep; const char* b3 = b2 + kstep;
            if (last && has_next) S.a_ready(nxt);
            if constexpr (SP2) {
            PG8_LDB(B0, 0, 0); PG8_LDB(B1, 0, 1); PG8_SCHED; PG8_LDA(At, 0, 0); PG8_STAGE(PG8_SA(1, 1), a1 + hstep, voffA);
            PG8_WAIT_V(8); PG8_WAIT_L(0); PG8_BAR; PG8_MMA(0, 0, At, B0); PG8_MMA(0, 1, At, B1); PG8_BAR; PG8_SCHED;
            PG8_LDA(At, 0, 1); PG8_STAGE(PG8_SB(0, 0), b2, voffB); PG8_STAGE(PG8_SB(0, 1), b2 + hstep, voffB); PG8_STAGE(PG8_SA(0, 0), a2, voffA);
            PG8_WAIT_V(8); PG8_WAIT_L(0); PG8_BAR; PG8_MMA(1, 0, At, B0); PG8_MMA(1, 1, At, B1); PG8_BAR; PG8_SCHED;
            PG8_LDB(B0, 1, 0); PG8_LDB(B1, 1, 1); PG8_SCHED; PG8_LDA(At, 1, 0); PG8_STAGE(PG8_SA(0, 1), a2 + hstep, voffA);
            PG8_WAIT_V(8); PG8_WAIT_L(0); PG8_BAR; PG8_MMA(0, 0, At, B0); PG8_MMA(0, 1, At, B1); PG8_BAR; PG8_SCHED;
            PG8_LDA(At, 1, 1); PG8_STAGE(PG8_SB(1, 0), b3, voffB); PG8_STAGE(PG8_SB(1, 1), b3 + hstep, voffB); PG8_STAGE(PG8_SA(1, 0), a3, voffA);
            PG8_WAIT_V(8); PG8_WAIT_L(0); PG8_BAR; PG8_MMA(1, 0, At, B0); PG8_MMA(1, 1, At, B1); PG8_BAR; PG8_SCHED;
            } else {
            PG8_LDB(B0, 0, 0); PG8_SCHED; PG8_LDA(At, 0, 0); PG8_STAGE(PG8_SA(1, 1), a1 + hstep, voffA);
            PG8_WAIT_L(8); PG8_BAR; PG8_WAIT_L(0); PG8_MMA(0, 0, At, B0); PG8_BAR; PG8_SCHED;
            PG8_LDB(B1, 0, 1); PG8_STAGE(PG8_SB(0, 0), b2, voffB);
            PG8_BAR; PG8_WAIT_L(0); PG8_MMA(0, 1, At, B1); PG8_BAR;
            PG8_LDA(At, 0, 1); PG8_STAGE(PG8_SA(0, 0), a2, voffA);
            PG8_BAR; PG8_WAIT_L(0); PG8_MMA(1, 0, At, B0); PG8_BAR; PG8_SCHED;
            PG8_STAGE(PG8_SB(0, 1), b2 + hstep, voffB);
            PG8_WAIT_V(6); PG8_BAR; PG8_MMA(1, 1, At, B1); PG8_BAR;
            PG8_LDB(B0, 1, 0); PG8_SCHED; PG8_LDA(At, 1, 0); PG8_STAGE(PG8_SA(0, 1), a2 + hstep, voffA);
            PG8_WAIT_L(8); PG8_BAR; PG8_WAIT_L(0); PG8_MMA(0, 0, At, B0); PG8_BAR; PG8_SCHED;
            PG8_LDB(B1, 1, 1); PG8_STAGE(PG8_SB(1, 0), b3, voffB);
            PG8_BAR; PG8_WAIT_L(0); PG8_MMA(0, 1, At, B1); PG8_BAR;
            PG8_LDA(At, 1, 1); PG8_STAGE(PG8_SA(1, 0), a3, voffA);
            PG8_BAR; PG8_WAIT_L(0); PG8_MMA(1, 0, At, B0); PG8_BAR; PG8_SCHED;
            PG8_STAGE(PG8_SB(1, 1), b3 + hstep, voffB);
            PG8_WAIT_V(6); PG8_BAR; PG8_MMA(1, 1, At, B1); PG8_BAR;
            }
        }
        if constexpr (ALIGN_EPI) { if (wr == 0) PG8_BAR; }
        if constexpr (!Epi::AFTER_DRAIN) { E(acc, cur, wr, wc, fr, fq); S.done(cur); }
        if (!has_next) break;
#pragma unroll
        for (int a = 0; a < 2; ++a)
#pragma unroll
            for (int b = 0; b < 2; ++b)
#pragma unroll
                for (int m = 0; m < 4; ++m)
#pragma unroll
                    for (int n = 0; n < 2; ++n) acc[a][b][m][n] = (f32x4){0.f, 0.f, 0.f, 0.f};
        cur = nxt; cA = nA; cB = nB; ++ui;
        if constexpr (ALIGN_EPI) { if (wr == 1) PG8_BAR; }
    }
    PG8_WAIT_V(0);
    if constexpr (!ALIGN_EPI) { if (wr == 0) PG8_BAR; }
    PG8_BAR;
    if constexpr (Epi::AFTER_DRAIN) { E.fused(acc, cur, wr, wc, fr, fq, lds, wid, lane); S.done(cur); }
#undef PG8_SA
#undef PG8_SB
#undef PG8_STAGE
#undef PG8_LDA
#undef PG8_LDB
#undef PG8_MMA
#undef PG8_WAIT_V
#undef PG8_WAIT_L
#undef PG8_BAR
#undef PG8_SCHED
}
}

namespace pg8 {
__device__ __forceinline__ u32x4 pack8(const f32x4& v0, const f32x4& v1) { u32x4 w; w.x = cvt_pk_bf16(v0[0], v0[1]); w.y = cvt_pk_bf16(v0[2], v0[3]); w.z = cvt_pk_bf16(v1[0], v1[1]); w.w = cvt_pk_bf16(v1[2], v1[3]); return w; }
__device__ __forceinline__ f32x4 gelu4(const f32x4& v) { f32x2 a = gelu_pk((f32x2){v[0], v[1]}), b = gelu_pk((f32x2){v[2], v[3]}); return (f32x4){a.x, a.y, b.x, b.y}; }
struct DEpiP1 {
    static constexpr bool PERM = true, AFTER_DRAIN = false; EpiP1 e;
    __device__ __forceinline__ void operator()(const f32x4 (&acc)[2][2][4][2], const Unit& u, int wr, int wc, int fr, int fq) const {
        const int row0 = u.pm * BM + wr * 64 + fr; const bool isb = (u.pn >= 8);
        bf16_t* base = isb ? e.PB : e.PA; const int ldc = isb ? 1024 : 2048; const int col0 = (isb ? (u.pn - 8) : u.pn) * BM + wc * 32 + 8 * fq;
#pragma unroll
        for (int ai = 0; ai < 2; ++ai)
#pragma unroll
            for (int m = 0; m < 4; ++m) { bf16_t* rowp = base + (size_t)(row0 + ai * HALF + m * 16) * ldc + col0;
#pragma unroll
                for (int bj = 0; bj < 2; ++bj) { f32x4 v0 = acc[ai][bj][m][0], v1 = acc[ai][bj][m][1];
                    if (isb) { v0 = gelu4(v0); v1 = gelu4(v1); }
                    *(u32x4*)(rowp + bj * HALF) = pack8(v0, v1); } }
    }
};
struct DEpiPlain {
    static constexpr bool PERM = true, AFTER_DRAIN = false; EpiPlain e;
    __device__ __forceinline__ void operator()(const f32x4 (&acc)[2][2][4][2], const Unit& u, int wr, int wc, int fr, int fq) const {
        const int row0 = u.pm * BM + wr * 64 + fr; const int col0 = e.col_off + u.pn * BM + wc * 32 + 8 * fq;
#pragma unroll
        for (int ai = 0; ai < 2; ++ai)
#pragma unroll
            for (int m = 0; m < 4; ++m) { bf16_t* rowp = e.O + (size_t)(row0 + ai * HALF + m * 16) * e.ldc + col0;
#pragma unroll
                for (int bj = 0; bj < 2; ++bj) *(u32x4*)(rowp + bj * HALF) = pack8(acc[ai][bj][m][0], acc[ai][bj][m][1]); }
    }
};
__device__ __forceinline__ float sig_fast(float x) { return __builtin_amdgcn_rcpf(1.0f + __expf(-x)); }
__device__ __forceinline__ float bflo(unsigned w) { return __uint_as_float(w << 16); }
__device__ __forceinline__ float bfhi(unsigned w) { return __uint_as_float(w & 0xffff0000u); }
struct DEpiMerge {
    static constexpr bool PERM = true, AFTER_DRAIN = false; EpiMerge e;
    __device__ __forceinline__ void operator()(const f32x4 (&acc)[2][2][4][2], const Unit& u, int wr, int wc, int fr, int fq) const {
        const int row0 = u.pm * BM + wr * 64 + fr; const int n0 = u.pn * HALF + wc * 32 + 8 * fq;
#pragma unroll
        for (int ai = 0; ai < 2; ++ai)
#pragma unroll
            for (int m = 0; m < 4; ++m) { const size_t row = (size_t)(row0 + ai * HALF + m * 16);
                const u32x4 b0 = *(const u32x4*)(e.BR + row * 2048 + n0), b1 = *(const u32x4*)(e.BR + row * 2048 + 1024 + n0);
                const f32x4 g00 = acc[ai][0][m][0], g01 = acc[ai][0][m][1], g10 = acc[ai][1][m][0], g11 = acc[ai][1][m][1];
                f32x4 o0, o1;
                o0[0] = sig_fast(g00[0]) * bflo(b0.x) + sig_fast(g10[0]) * bflo(b1.x); o0[1] = sig_fast(g00[1]) * bfhi(b0.x) + sig_fast(g10[1]) * bfhi(b1.x);
                o0[2] = sig_fast(g00[2]) * bflo(b0.y) + sig_fast(g10[2]) * bflo(b1.y); o0[3] = sig_fast(g00[3]) * bfhi(b0.y) + sig_fast(g10[3]) * bfhi(b1.y);
                o1[0] = sig_fast(g01[0]) * bflo(b0.z) + sig_fast(g11[0]) * bflo(b1.z); o1[1] = sig_fast(g01[1]) * bfhi(b0.z) + sig_fast(g11[1]) * bfhi(b1.z);
                o1[2] = sig_fast(g01[2]) * bflo(b0.w) + sig_fast(g11[2]) * bflo(b1.w); o1[3] = sig_fast(g01[3]) * bfhi(b0.w) + sig_fast(g11[3]) * bfhi(b1.w);
                *(u32x4*)(e.MG + row * 1024 + n0) = pack8(o0, o1); }
    }
};
struct DEpiResid {
    static constexpr bool PERM = false, AFTER_DRAIN = false; EpiResid e;
    __device__ __forceinline__ void operator()(const f32x4 (&acc)[2][2][4][2], const Unit& u, int wr, int wc, int fr, int fq) const {
        const int row0 = u.pm * BM + wr * 64 + fr, col0 = u.pn * BM + wc * 32 + 4 * fq;
        typedef unsigned u32x2 __attribute__((ext_vector_type(2)));
#pragma unroll
        for (int ai = 0; ai < 2; ++ai)
#pragma unroll
            for (int m = 0; m < 4; ++m) { const size_t ro = (size_t)(row0 + ai * HALF + m * 16) * 1024 + col0;
#pragma unroll
                for (int bj = 0; bj < 2; ++bj)
#pragma unroll
                    for (int n = 0; n < 2; ++n) { const u32x2 h = *(const u32x2*)(e.H + ro + bj * HALF + n * 16); const f32x4 a = acc[ai][bj][m][n];
                        f32x4 o; o[0] = ALPHA_F * bflo(h.x) + a[0]; o[1] = ALPHA_F * bfhi(h.x) + a[1]; o[2] = ALPHA_F * bflo(h.y) + a[2]; o[3] = ALPHA_F * bfhi(h.y) + a[3];
                        *(f32x4*)(e.Z + ro + bj * HALF + n * 16) = o; } }
    }
};
}
#define LAS __attribute__((address_space(3)))
#define XB_TMO      128
#define XB_XCNT(j)  (256  + 64 * (j))
#define XB_XSUB(j)  (1280 + 64 * (j))
#define XB_XGEN(j)  (2304 + 64 * (j))
#define XB_TOP      3328
#define XB_TOPGEN   3392
#define XCD_BAR_WORDS 3456
#define XB_SPIN_CAP (1u << 18)

__device__ __forceinline__ unsigned xb_ld(unsigned* p)              { return __hip_atomic_load(p, __ATOMIC_RELAXED, __HIP_MEMORY_SCOPE_AGENT); }
__device__ __forceinline__ unsigned xb_add(unsigned* p, unsigned v) { return __hip_atomic_fetch_add(p, v, __ATOMIC_RELAXED, __HIP_MEMORY_SCOPE_AGENT); }
__device__ __forceinline__ unsigned xb_xcc_id() { return (unsigned)__builtin_amdgcn_s_getreg((3 << 11) | 20) & 0xFu; }
#define XB_SPIN(cond, bar) do { unsigned _sp = 0; while (cond) { __builtin_amdgcn_s_sleep(1); \
    if ((++_sp & 255u) == 0u) { if (xb_ld(&(bar)[XB_TMO])) break; if (_sp > XB_SPIN_CAP) { atomicAdd(&(bar)[XB_TMO], 1u); break; } } } } while (0)

struct XcdBarrier {
    unsigned* bar; unsigned x;
    volatile LAS unsigned* st;
};

__device__ __forceinline__ XcdBarrier xcd_barrier_post(unsigned* bar, volatile LAS unsigned* st) {
    XcdBarrier b; b.bar = bar; b.x = xb_xcc_id(); b.st = st;
    if (threadIdx.x == 0) (void)xb_add(&bar[XB_XCNT(b.x)], 1u);
    return b;
}
__device__ __forceinline__ void xcd_barrier_complete(unsigned* bar, unsigned x, unsigned& nloc, unsigned& nx) {
    const unsigned G = gridDim.x * gridDim.y * gridDim.z;
    unsigned sum, cnt, mine, sp = 0u;
    for (;;) {
        sum = 0u; cnt = 0u; mine = 0u;
#pragma unroll
        for (unsigned j = 0; j < 16; ++j) { const unsigned c = xb_ld(&bar[XB_XCNT(j)]); sum += c; cnt += (c > 0u) ? 1u : 0u; mine = (j == x) ? c : mine; }
        if (sum == G) break;
        __builtin_amdgcn_s_sleep(1);
        if ((++sp & 255u) == 0u) { if (xb_ld(&bar[XB_TMO])) break; if (sp > XB_SPIN_CAP) { atomicAdd(&bar[XB_TMO], 1u); break; } }
    }
    nloc = mine > 0u ? mine : 1u; nx = cnt > 0u ? cnt : 1u;
}

__device__ __forceinline__ void xcd_barrier(const XcdBarrier& b) {
    asm volatile("s_waitcnt vmcnt(0)" ::: "memory");
    __syncthreads();
    if (threadIdx.x == 0) {
        unsigned* bar = b.bar;
        __builtin_amdgcn_s_waitcnt(0);
        unsigned nloc = b.st[0], nx = b.st[1];
        if (nloc == 0u) { xcd_barrier_complete(bar, b.x, nloc, nx); b.st[0] = nloc; b.st[1] = nx; }
        const unsigned old = xb_add(&bar[XB_XSUB(b.x)], 1u);
        const unsigned gen = old / nloc;
        if (old + 1u == (gen + 1u) * nloc) {
            __builtin_amdgcn_fence(__ATOMIC_RELEASE, "agent");
            asm volatile("s_waitcnt vmcnt(0)" ::: "memory");
            const unsigned og = xb_add(&bar[XB_TOP], 1u);
            const unsigned tg = og / nx;
            if (og + 1u == (tg + 1u) * nx) xb_add(&bar[XB_TOPGEN], 1u);
            else XB_SPIN(xb_ld(&bar[XB_TOPGEN]) == tg, bar);
            __builtin_amdgcn_fence(__ATOMIC_ACQUIRE, "agent");
            xb_add(&bar[XB_XGEN(b.x)], 1u);
            asm volatile("s_waitcnt vmcnt(0)" ::: "memory");
        } else {
            XB_SPIN(xb_ld(&bar[XB_XGEN(b.x)]) == gen, bar);
            __builtin_amdgcn_fence(__ATOMIC_ACQUIRE, "agent");
            asm volatile("s_waitcnt vmcnt(0)" ::: "memory");
        }
    }
    __syncthreads();
}

#endif

#ifdef HOST_EMU
template <class F> static void emu_gemm(const bf16_t* A, const bf16_t* Bt, int M, int N, int K, F f) {
#pragma omp parallel for schedule(static)
    for (int r = 0; r < M; ++r)
        for (int c = 0; c < N; ++c) { float a = 0.f; for (int k = 0; k < K; ++k) a += bf2f(A[(size_t)r * K + k]) * bf2f(Bt[(size_t)c * K + k]); f(r, c, a); }
}
#endif

#define GS_LOOP(idx, n) for (long idx = gtid; idx < (long)(n); idx += nthr)

__device__ __forceinline__ int win_src_col(int n) {
    if (n < 1920) return n;
    if (n < 2048) return -1;
    if (n < 3072) return 1920 + (n - 2048);
    const int m = n - 3072, j = m / 256, i = m % 256;
    return (i < 128) ? (2944 + 128 * j + i) : (2944 + 1024 + 128 * j + (i - 128));
}
__device__ __forceinline__ void ph0_weights(const Params& P, long gtid, long nthr) {
    GS_LOOP(idx, (size_t)5120 * 1024) { const int n = (int)(idx / 1024), k = (int)(idx % 1024); const int c = win_src_col(n);
        P.W_IN_T[idx] = (c < 0) ? (bf16_t)0 : f2bf(P.in[I_W_IN][(size_t)k * IN_COLS + c]); }
    GS_LOOP(idx, (size_t)2048 * 512) { const int n = (int)(idx / 512), k = (int)(idx % 512); const int br = n / 1024, nn = n % 1024;
        P.W_BR_T[idx] = f2bf(P.in[I_W_BRANCH][((size_t)br * 512 + k) * 1024 + nn]); }
    GS_LOOP(idx, (size_t)1024 * 1024) { const int n = (int)(idx / 1024), k = (int)(idx % 1024);
        P.W_MIX_T[idx] = f2bf(P.in[I_W_MIX][(size_t)k * 1024 + n]);
        P.W_Q_T[idx] = f2bf(P.in[I_W_Q][(size_t)k * 1024 + n]);
        P.W_O_T[idx] = f2bf(P.in[I_W_O][(size_t)k * 1024 + n]); }
    GS_LOOP(idx, (size_t)2048 * 1024) { const int n = (int)(idx / 1024), k = (int)(idx % 1024);
        P.W_KV_T[idx] = f2bf(P.in[I_W_KV][(size_t)k * 2048 + n]);
        P.W_QUERY_T[idx] = f2bf(P.in[I_W_QUERY][(size_t)k * 2048 + n]); }
}
__device__ __forceinline__ void ln_rows_bf16(const float* in, const float* g, const float* b, bf16_t* out, int rows, int width, long gtid, long nthr) {
    GS_LOOP(row, rows) { const float* x = in + (size_t)row * width; float s = 0.f;
        for (int i = 0; i < width; ++i) s += x[i];
        const float mu = s / width; float q = 0.f;
        for (int i = 0; i < width; ++i) { const float d = x[i] - mu; q += d * d; }
        const float rs = 1.0f / sqrtf(q / width + 1e-5f); bf16_t* o = out + (size_t)row * width;
        for (int i = 0; i < width; ++i) o[i] = f2bf((x[i] - mu) * rs * g[i] + b[i]); }
}
__device__ __forceinline__ void ph2a_vn(const Params& P, long gtid, long nthr) {
    GS_LOOP(row, TOK) { const bf16_t* x = P.PB + (size_t)row * 1024 + 512; float s = 0.f;
        for (int i = 0; i < 512; ++i) s += bf2f(x[i]);
        const float mu = s / 512.f; float q = 0.f;
        for (int i = 0; i < 512; ++i) { const float d = bf2f(x[i]) - mu; q += d * d; }
        const float rs = 1.0f / sqrtf(q / 512.f + 1e-5f); bf16_t* o = P.VN + (size_t)row * 512;
        for (int i = 0; i < 512; ++i) o[i] = f2bf((bf2f(x[i]) - mu) * rs * P.in[I_GLN_G][i] + P.in[I_GLN_B][i]); }
}
__device__ __forceinline__ void ph2b_gmlp(const Params& P, long gtid, long nthr) {
    GS_LOOP(idx, (size_t)TOK * 512) { const int c = (int)(idx % 512); const long t = idx / 512; const int g = c / 64; const long ch = t / 128; const int p = (int)(t % 128);
        const float* ws = P.in[I_W_S] + ((size_t)g * 128 + p) * 128; float s = 0.f;
        for (int q = 0; q < 128; ++q) s += ws[q] * bf2f(P.VN[(size_t)(ch * 128 + q) * 512 + c]);
        s += P.in[I_B_S][g * 128 + p];
        P.YB[idx] = f2bf(bf2f(P.PB[(size_t)t * 1024 + c]) * s); }
}
__device__ __forceinline__ float pa_shift(const Params& P, long t, int c) {
    const int s = (int)(t % SEQ); const float cur = bf2f(P.PA[(size_t)t * 2048 + c]);
    const float prev = (s > 0) ? bf2f(P.PA[(size_t)(t - 1) * 2048 + c]) : 0.f;
    const float nxt = (s < SEQ - 1) ? bf2f(P.PA[(size_t)(t + 1) * 2048 + c]) : 0.f;
    return cur + P.in[I_MU][c] * (0.5f * (prev + nxt) - cur);
}
__device__ __forceinline__ void ph3a_lora_in(const Params& P, long gtid, long nthr) {
    GS_LOOP(idx, (size_t)TOK * 128) { const int r = (int)(idx % 128); const long t = idx / 128;
        P.WDS[idx] = f2bf(tanhf(pa_shift(P, t, 1536 + r)));
        P.ADS[idx] = f2bf(pa_shift(P, t, 1664 + r));
        P.SG[idx] = f2bf(sigmoidf_(pa_shift(P, t, 1792 + r))); }
}
__device__ __forceinline__ void ph3b_prep(const Params& P, long gtid, long nthr) {
    GS_LOOP(idx, (size_t)TOK * 8) { const int h = (int)(idx % 8); const long t = idx / 8; const int hb = h * 64;
        float ss = 0.f;
        for (int j = 0; j < 64; ++j) { const float v = pa_shift(P, t, 512 + hb + j) * P.in[I_K_K][hb + j]; ss += v * v; }
        const float inv = 1.0f / fmaxf(sqrtf(ss), 1e-12f);
        for (int j = 0; j < 64; ++j) { const int c = hb + j;
            const float k = pa_shift(P, t, 512 + c); const float kk = k * P.in[I_K_K][c] * inv;
            P.R[(size_t)t * 512 + c] = f2bf(pa_shift(P, t, c));
            P.V[(size_t)t * 512 + c] = f2bf(pa_shift(P, t, 1024 + c));
            P.KK[(size_t)t * 512 + c] = f2bf(kk);
            for (int z = 0; z < 2; ++z) {
                float sw = P.in[I_W0][z * 512 + c], sa = P.in[I_A0][z * 512 + c];
                for (int r = 0; r < 64; ++r) { sw += bf2f(P.WDS[(size_t)t * 128 + z * 64 + r]) * P.in[I_W2][((size_t)z * 64 + r) * 512 + c];
                                               sa += bf2f(P.ADS[(size_t)t * 128 + z * 64 + r]) * P.in[I_A2][((size_t)z * 64 + r) * 512 + c]; }
                const float y = -sw; const float sp = fmaxf(y, 0.f) + log1pf(expf(-fabsf(y))); const float wlog = -sp - 0.5f;
                const float ew = expf(wlog);
                const float a = sigmoidf_(sa); const size_t o = ((size_t)t * 2 + z) * 512 + c;
                P.OMW[o] = f2bf(-expm1f(-ew));
                P.KDIR[o] = f2bf(k * (1.0f + (a - 1.0f) * P.in[I_K_A][c]));
                P.BVEC[o] = f2bf(kk * a); } } }
}
__device__ __forceinline__ void scan_item(const Params& P, int chain, int i) {
    const int h = chain % 8, b = (chain / 8) % BATCH, z = chain / (8 * BATCH);
    float S[64];
#pragma unroll
    for (int j = 0; j < 64; ++j) S[j] = 0.f;
    for (int n = 0; n < SEQ; ++n) {
        const long t = (long)b * SEQ + ((z == 0) ? n : (SEQ - 1 - n));
        const bf16_t* r = P.R + (size_t)t * 512 + h * 64; const bf16_t* a = P.KK + (size_t)t * 512 + h * 64;
        const bf16_t* w = P.OMW + ((size_t)t * 2 + z) * 512 + h * 64; const bf16_t* k = P.KDIR + ((size_t)t * 2 + z) * 512 + h * 64;
        const bf16_t* bv = P.BVEC + ((size_t)t * 2 + z) * 512 + h * 64;
        const float v = bf2f(P.V[(size_t)t * 512 + h * 64 + i]);
        float sa = 0.f;
#pragma unroll
        for (int j = 0; j < 64; ++j) sa -= S[j] * bf2f(a[j]);
        float y = 0.f;
#pragma unroll
        for (int j = 0; j < 64; ++j) { S[j] = S[j] * (1.0f - bf2f(w[j])) + sa * bf2f(bv[j]) + v * bf2f(k[j]); y += S[j] * bf2f(r[j]); }
        P.Y01[((size_t)z * TOK + t) * 512 + h * 64 + i] = y;
    }
}
__device__ __forceinline__ void ph5_rwkv_out(const Params& P, long gtid, long nthr) {
    GS_LOOP(idx, (size_t)TOK * 512) { const int c = (int)(idx % 512); const long t = idx / 512; const int hb = (c / 64) * 64;
        const float* y0 = P.Y01 + (size_t)t * 512 + hb; const float* y1 = P.Y01 + ((size_t)TOK + t) * 512 + hb;
        float s = 0.f;
        for (int j = 0; j < 64; ++j) s += y0[j] + y1[j];
        const float mu = s / 64.f; float q = 0.f;
        for (int j = 0; j < 64; ++j) { const float d = y0[j] + y1[j] - mu; q += d * d; }
        const float rs = 1.0f / sqrtf(q / 64.f + 64e-5f);
        const float yn = (y0[c - hb] + y1[c - hb] - mu) * rs * P.in[I_GN_G][c] + P.in[I_GN_B][c];
        float rk = 0.f;
        for (int z = 0; z < 2; ++z)
            for (int j = 0; j < 64; ++j) rk += bf2f(P.R[(size_t)t * 512 + hb + j]) * bf2f(P.KDIR[((size_t)t * 2 + z) * 512 + hb + j]) * P.in[I_R_K][hb + j];
        float g = 0.f;
        for (int r = 0; r < 128; ++r) g += bf2f(P.SG[(size_t)t * 128 + r]) * P.in[I_G2][(size_t)r * 512 + c];
        P.YA[idx] = f2bf((yn + rk * bf2f(P.V[(size_t)t * 512 + c])) * g); }
}
__device__ __forceinline__ void ph_ln_z(const Params& P, const float* g, const float* b, long gtid, long nthr) { ln_rows_bf16(P.Z, g, b, P.HB, TOK, 1024, gtid, nthr); }
__device__ __forceinline__ void ph10a_scores(const Params& P, long gtid, long nthr) {
    GS_LOOP(idx, (size_t)TOK * 4 * 256) { const int m = (int)(idx % 256); const long rowi = idx / 256; const int s = (int)(rowi % SEQ); const int bh = (int)(rowi / SEQ); const int b = bh / 4, h = bh % 4;
        const bf16_t* q = P.Q + ((size_t)b * SEQ + s) * 1024 + h * 256; const bf16_t* k = P.KV + ((size_t)b * 256 + m) * 2048 + h * 256; float a = 0.f;
        for (int d = 0; d < 256; ++d) a += bf2f(q[d]) * bf2f(k[d]);
        P.SCA[idx] = a * 0.0625f; }
}
__device__ __forceinline__ void ph10b_softmax(const Params& P, long gtid, long nthr) {
    GS_LOOP(row, (size_t)TOK * 4) { float* x = P.SCA + (size_t)row * 256; float mx = x[0];
        for (int i = 1; i < 256; ++i) mx = fmaxf(mx, x[i]);
        float s = 0.f;
        for (int i = 0; i < 256; ++i) s += expf(x[i] - mx);
        const float inv = 1.0f / s;
        for (int i = 0; i < 256; ++i) x[i] = expf(x[i] - mx) * inv; }
}
__device__ __forceinline__ void ph10c_out(const Params& P, long gtid, long nthr) {
    GS_LOOP(idx, (size_t)TOK * 1024) { const int c = (int)(idx % 1024); const long t = idx / 1024; const int b = (int)(t / SEQ), s = (int)(t % SEQ), h = c / 256;
        const float* pr = P.SCA + (((size_t)b * 4 + h) * SEQ + s) * 256; float a = 0.f;
        for (int m = 0; m < 256; ++m) a += pr[m] * bf2f(P.KV[((size_t)b * 256 + m) * 2048 + 1024 + c]);
        P.O[idx] = f2bf(a); }
}
__device__ __forceinline__ void ph13a_scores(const Params& P, long gtid, long nthr) {
    GS_LOOP(idx, (size_t)TOK * 2048) { const int k = (int)(idx % 128), z = (int)((idx / 128) % 2), h = (int)((idx / 256) % 8); const long t = idx / 2048;
        const bf16_t* q = P.QP + (size_t)t * 2048 + h * 256 + z * 128; const float* kr = P.in[I_SUBKEYS] + ((size_t)z * 128 + k) * 128; float a = 0.f;
        for (int c = 0; c < 128; ++c) a += bf2f(q[c]) * kr[c];
        P.SC[idx] = a; }
}
__device__ __forceinline__ void ph13b_topk(const Params& P, long gtid, long nthr) {
    GS_LOOP(row, (size_t)TOK * 16) { const float* x = P.SC + (size_t)row * 128; float pv = 0.f; int pi = -1;
        for (int j = 0; j < 16; ++j) { float best = 0.f; int bi = -1;
            for (int i = 0; i < 128; ++i) { const float v = x[i]; const bool elig = (j == 0) || (v < pv) || (v == pv && i > pi);
                if (elig && (bi < 0 || v > best)) { best = v; bi = i; } }
            P.TOPS[(size_t)row * 16 + j] = best; P.TOPI[(size_t)row * 16 + j] = bi; pv = best; pi = bi; } }
}
__device__ __forceinline__ void ph13c_cand(const Params& P, long gtid, long nthr) {
    GS_LOOP(row, (size_t)TOK * 8) { const float* s0 = P.TOPS + (size_t)row * 32; const float* s1 = s0 + 16; const int* i0 = P.TOPI + (size_t)row * 32; const int* i1 = i0 + 16;
        float pv = 0.f; int pi = -1; float mx = 0.f;
        for (int j = 0; j < 16; ++j) { float best = 0.f; int bi = -1;
            for (int c = 0; c < 256; ++c) { const float v = s0[c / 16] + s1[c % 16]; const bool elig = (j == 0) || (v < pv) || (v == pv && c > pi);
                if (elig && (bi < 0 || v > best)) { best = v; bi = c; } }
            if (j == 0) mx = best;
            P.GATE[(size_t)row * 16 + j] = best; P.EXPERT[(size_t)row * 16 + j] = i0[bi / 16] * 128 + i1[bi % 16]; pv = best; pi = bi; }
        float s = 0.f;
        for (int j = 0; j < 16; ++j) s += expf(P.GATE[(size_t)row * 16 + j] - mx);
        const float inv = 1.0f / s;
        for (int j = 0; j < 16; ++j) P.GATE[(size_t)row * 16 + j] = expf(P.GATE[(size_t)row * 16 + j] - mx) * inv; }
}
__device__ __forceinline__ void ph14a_act(const Params& P, long gtid, long nthr) {
    GS_LOOP(idx, (size_t)TOK * 128) { const long t = idx / 128; const bf16_t* x = P.HB + (size_t)t * 1024; const float* ur = P.in[I_PEER_U] + (size_t)P.EXPERT[idx] * 1024; float a = 0.f;
        for (int d = 0; d < 1024; ++d) a += ur[d] * bf2f(x[d]);
        P.COEF[idx] = P.GATE[idx] * geluf_(a); }
}
__device__ __forceinline__ void ph14b_out(const Params& P, long gtid, long nthr) {
    GS_LOOP(idx, (size_t)TOK * 1024) { const int d = (int)(idx % 1024); const long t = idx / 1024; float a = 0.f;
        for (int j = 0; j < 128; ++j) a += P.COEF[(size_t)t * 128 + j] * P.in[I_PEER_V][(size_t)P.EXPERT[(size_t)t * 128 + j] * 1024 + d];
        P.Y[idx] = a; }
}
__device__ __forceinline__ void ph14c_final(const Params& P, long gtid, long nthr) {
    GS_LOOP(row, TOK) { const bf16_t* hr = P.HB + (size_t)row * 1024; const float* yr = P.Y + (size_t)row * 1024; float s = 0.f;
        for (int i = 0; i < 1024; ++i) s += ALPHA_F * bf2f(hr[i]) + yr[i];
        const float mu = s / 1024.f; float q = 0.f;
        for (int i = 0; i < 1024; ++i) { const float d = ALPHA_F * bf2f(hr[i]) + yr[i] - mu; q += d * d; }
        const float rs = 1.0f / sqrtf(q / 1024.f + 1e-5f); float* o = P.out + (size_t)row * 1024;
        for (int i = 0; i < 1024; ++i) o[i] = (ALPHA_F * bf2f(hr[i]) + yr[i] - mu) * rs * P.in[I_LN3_G][i] + P.in[I_LN3_B][i]; }
}

static void make_params(Params& P, void* const* d_in, void* d_out, void* d_ws) {
    memset(&P, 0, sizeof(P));
    for (int i = 0; i < 37; ++i) P.in[i] = (const float*)d_in[i];
    P.out = (float*)d_out; unsigned char* ws = (unsigned char*)d_ws; unsigned char* ob = (unsigned char*)d_out;
    unsigned char* r1 = ws + A_R1; unsigned char* r2 = ws + A_R2;
    P.ctl = (unsigned*)(ws + WS_CTL);
    P.W_IN_T = (bf16_t*)(ws + WS_W + OFF_W_IN); P.W_BR_T = (bf16_t*)(ws + WS_W + OFF_W_BR); P.W_MIX_T = (bf16_t*)(ws + WS_W + OFF_W_MIX);
    P.W_Q_T = (bf16_t*)(ws + WS_W + OFF_W_Q); P.W_KV_T = (bf16_t*)(ws + WS_W + OFF_W_KV); P.W_O_T = (bf16_t*)(ws + WS_W + OFF_W_O); P.W_QUERY_T = (bf16_t*)(ws + WS_W + OFF_W_QUERY);
    P.KV = (bf16_t*)(ws + WS_KV); P.MEMN = (bf16_t*)(ws + WS_MEMN); P.HB = (bf16_t*)(ws + A_HB);
    P.PA = (bf16_t*)r1; P.PB = (bf16_t*)r2; P.VN = (bf16_t*)(r2 + 2 * TU);
    P.YB = (bf16_t*)ob; P.WDS = (bf16_t*)(ob + TU); P.ADS = (bf16_t*)(ob + TU + TU / 4); P.SG = (bf16_t*)(ob + TU + TU / 2);
    P.R = (bf16_t*)(ob + 2 * TU); P.KK = (bf16_t*)(ob + 3 * TU);
    P.V = (bf16_t*)r2; P.OMW = (bf16_t*)(r2 + TU); P.KDIR = (bf16_t*)(r2 + 3 * TU); P.BVEC = (bf16_t*)(r2 + 5 * TU);
    P.Y01 = (float*)r1; P.YA = (bf16_t*)(r2 + TU); P.BR = (bf16_t*)r1; P.MG = (bf16_t*)r2; P.Z = (float*)ob;
    P.Q = (bf16_t*)r1; P.O = (bf16_t*)(r1 + 2 * TU); P.SCA = (float*)r2; P.QP = (bf16_t*)ob;
    P.SC = (float*)r1; P.TOPS = (float*)(r2 + 4 * TU); P.TOPI = (int*)(r2 + 5 * TU); P.GATE = (float*)(r2 + 6 * TU); P.EXPERT = (int*)(r2 + 6 * TU + TU / 2);
    P.COEF = (float*)(r2 + 7 * TU); P.Y = (float*)r1;
}

#define N_PHASES 25
__device__ __forceinline__ void run_simt_phase(const Params& P, int ph, long gtid, long nthr) {
    switch (ph) {
    case 0: ph0_weights(P, gtid, nthr);
            ln_rows_bf16(P.in[I_X], P.in[I_LN_EMB_G], P.in[I_LN_EMB_B], P.HB, TOK, 1024, gtid, nthr);
            ln_rows_bf16(P.in[I_MEM], P.in[I_MLN_G], P.in[I_MLN_B], P.MEMN, BATCH * MEM_LEN, 1024, gtid, nthr); break;
    case 2: ph2a_vn(P, gtid, nthr); break;
    case 3: ph2b_gmlp(P, gtid, nthr); break;
    case 4: ph3a_lora_in(P, gtid, nthr); break;
    case 5: ph3b_prep(P, gtid, nthr); break;
    case 7: ph5_rwkv_out(P, gtid, nthr); break;
    case 11: ph_ln_z(P, P.in[I_LN1_G], P.in[I_LN1_B], gtid, nthr); break;
    case 13: ph10a_scores(P, gtid, nthr); break;
    case 14: ph10b_softmax(P, gtid, nthr); break;
    case 15: ph10c_out(P, gtid, nthr); break;
    case 17: ph_ln_z(P, P.in[I_LN2_G], P.in[I_LN2_B], gtid, nthr); break;
    case 19: ph13a_scores(P, gtid, nthr); break;
    case 20: ph13b_topk(P, gtid, nthr); break;
    case 21: ph13c_cand(P, gtid, nthr); break;
    case 22: ph14a_act(P, gtid, nthr); break;
    case 23: ph14b_out(P, gtid, nthr); break;
    case 24: ph14c_final(P, gtid, nthr); break;
    default: break;
    }
}

#ifdef HOST_EMU
static void emu_run(const Params& P) {
    for (int ph = 0; ph < N_PHASES; ++ph) {
        switch (ph) {
        case 1:
            emu_gemm(P.HB, P.W_IN_T, TOK, 3072, 1024, [&](int r, int c, float a) { if (c < 2048) P.PA[(size_t)r * 2048 + c] = f2bf(a); else P.PB[(size_t)r * 1024 + c - 2048] = f2bf(geluf_(a)); });
            emu_gemm(P.MEMN, P.W_KV_T, BATCH * MEM_LEN, 2048, 1024, [&](int r, int c, float a) { P.KV[(size_t)r * 2048 + c] = f2bf(a); });
            break;
        case 6:
#pragma omp parallel for schedule(dynamic, 1)
            for (int it = 0; it < 2 * BATCH * 8 * 64; ++it) scan_item(P, it / 64, it % 64);
            break;
        case 8:
            emu_gemm(P.YA, P.W_BR_T, TOK, 1024, 512, [&](int r, int c, float a) { P.BR[(size_t)r * 2048 + c] = f2bf(a); });
            emu_gemm(P.YB, P.W_BR_T + (size_t)1024 * 512, TOK, 1024, 512, [&](int r, int c, float a) { P.BR[(size_t)r * 2048 + 1024 + c] = f2bf(a); });
            break;
        case 9: {
            float* tmp = (float*)malloc((size_t)TOK * 2048 * 4);
            emu_gemm(P.HB, P.W_IN_T + (size_t)3072 * 1024, TOK, 2048, 1024, [&](int r, int c, float a) { tmp[(size_t)r * 2048 + c] = a; });
            for (int r = 0; r < TOK; ++r) for (int n = 0; n < 1024; ++n) { const int j = n / 128, i = n % 128;
                const float g0 = tmp[(size_t)r * 2048 + 256 * j + i], g1 = tmp[(size_t)r * 2048 + 256 * j + 128 + i];
                P.MG[(size_t)r * 1024 + n] = f2bf(sigmoidf_(g0) * bf2f(P.BR[(size_t)r * 2048 + n]) + sigmoidf_(g1) * bf2f(P.BR[(size_t)r * 2048 + 1024 + n])); }
            free(tmp); } break;
        case 10: emu_gemm(P.MG, P.W_MIX_T, TOK, 1024, 1024, [&](int r, int c, float a) { P.Z[(size_t)r * 1024 + c] = ALPHA_F * bf2f(P.HB[(size_t)r * 1024 + c]) + a; }); break;
        case 12: emu_gemm(P.HB, P.W_Q_T, TOK, 1024, 1024, [&](int r, int c, float a) { P.Q[(size_t)r * 1024 + c] = f2bf(a); }); break;
        case 16: emu_gemm(P.O, P.W_O_T, TOK, 1024, 1024, [&](int r, int c, float a) { P.Z[(size_t)r * 1024 + c] = ALPHA_F * bf2f(P.HB[(size_t)r * 1024 + c]) + a; }); break;
        case 18: emu_gemm(P.HB, P.W_QUERY_T, TOK, 2048, 1024, [&](int r, int c, float a) { P.QP[(size_t)r * 2048 + c] = f2bf(a); }); break;
        default: {
            const long NT = 64;
#pragma omp parallel for schedule(static, 1)
            for (long g = 0; g < NT; ++g) run_simt_phase(P, ph, g, NT);
        } break;
        }
    }
}
extern "C" void kernel_launch(void* const* d_in, const int* in_sizes, int n_in, void* d_out, int out_size, void* d_ws, size_t ws_size, hipStream_t stream) {
    Params P; make_params(P, d_in, d_out, d_ws);
    memset(d_ws, 0, 1 << 20);
    emu_run(P);
}
#else
constexpr int RING_BYTES = 131072, LDSCTL_OFF = RING_BYTES, MISC_OFF = LDSCTL_OFF + 320, LDS_BYTES = 147456;
constexpr int CW_BAR = 4096;
#ifndef MK_PER_PHASE
#define MK_PER_PHASE 0
#endif
struct KArgs { Params P; int ph_lo, ph_hi; };
template <class DE> __device__ __forceinline__ void run_gemm(LAS unsigned char* lds, const bf16_t* A, const bf16_t* Bt, int M, int N, int K, const DE& E) {
    pg8::Gemm g{A, Bt, M, N, K}; pg8::StaticOrder S; S.init(M, N, (int)gridDim.x, (int)blockIdx.x);
    pg8::gemm_phase<DE, pg8::StaticOrder, true, true>(lds, g, S, E);
}
__global__ void __launch_bounds__(512, 2) mega_fwd(KArgs a) {
    extern __shared__ __attribute__((aligned(16))) unsigned char lds_raw[];
    LAS unsigned char* lds = (LAS unsigned char*)lds_raw;
    volatile LAS unsigned* MISC = (volatile LAS unsigned*)(lds + MISC_OFF);
    const Params& P = a.P;
    const int tid = threadIdx.x;
    for (int u = tid; u < (LDS_BYTES - LDSCTL_OFF) / 4; u += 512) ((LAS unsigned*)(lds + LDSCTL_OFF))[u] = 0u;
    __syncthreads();
    XcdBarrier bar; bar.bar = P.ctl + CW_BAR; bar.x = 0; bar.st = nullptr;
    if (!MK_PER_PHASE) bar = xcd_barrier_post(P.ctl + CW_BAR, MISC + 8);
    const long gtid = (long)blockIdx.x * 512 + tid, nthr = (long)gridDim.x * 512;
    const int lo = a.ph_lo, hi = a.ph_hi;
#define IN(k) (lo <= (k) && (k) < hi)
#define SEAM(k) do { if ((k) + 1 < hi) xcd_barrier(bar); } while (0)
#define SIMT(k, call) if (IN(k)) { call; SEAM(k); }
    SIMT(0, (ph0_weights(P, gtid, nthr), ln_rows_bf16(P.in[I_X], P.in[I_LN_EMB_G], P.in[I_LN_EMB_B], P.HB, TOK, 1024, gtid, nthr),
             ln_rows_bf16(P.in[I_MEM], P.in[I_MLN_G], P.in[I_MLN_B], P.MEMN, BATCH * MEM_LEN, 1024, gtid, nthr)))
    if (IN(1)) { { pg8::DEpiP1 E{{P.PA, P.PB}}; run_gemm(lds, P.HB, P.W_IN_T, TOK, 3072, 1024, E); }
                 { pg8::DEpiPlain E2{{P.KV, 2048, 0}}; run_gemm(lds, P.MEMN, P.W_KV_T, BATCH * MEM_LEN, 2048, 1024, E2); } SEAM(1); }
    SIMT(2, ph2a_vn(P, gtid, nthr))
    SIMT(3, ph2b_gmlp(P, gtid, nthr))
    SIMT(4, ph3a_lora_in(P, gtid, nthr))
    SIMT(5, ph3b_prep(P, gtid, nthr))
    if (IN(6)) { const int wave = __builtin_amdgcn_readfirstlane(tid >> 6); const int chain = (int)blockIdx.x + (int)gridDim.x * wave;
                 if (chain < 2 * BATCH * 8) scan_item(P, chain, tid & 63); SEAM(6); }
    SIMT(7, ph5_rwkv_out(P, gtid, nthr))
    if (IN(8)) { { pg8::DEpiPlain E{{P.BR, 2048, 0}}; run_gemm(lds, P.YA, P.W_BR_T, TOK, 1024, 512, E); }
                 { pg8::DEpiPlain E2{{P.BR, 2048, 1024}}; run_gemm(lds, P.YB, P.W_BR_T + (size_t)1024 * 512, TOK, 1024, 512, E2); } SEAM(8); }
    if (IN(9)) { pg8::DEpiMerge E{{P.BR, P.MG}}; run_gemm(lds, P.HB, P.W_IN_T + (size_t)3072 * 1024, TOK, 2048, 1024, E); SEAM(9); }
    if (IN(10)) { pg8::DEpiResid E{{P.HB, P.Z}}; run_gemm(lds, P.MG, P.W_MIX_T, TOK, 1024, 1024, E); SEAM(10); }
    SIMT(11, ph_ln_z(P, P.in[I_LN1_G], P.in[I_LN1_B], gtid, nthr))
    if (IN(12)) { pg8::DEpiPlain E{{P.Q, 1024, 0}}; run_gemm(lds, P.HB, P.W_Q_T, TOK, 1024, 1024, E); SEAM(12); }
    SIMT(13, ph10a_scores(P, gtid, nthr))
    SIMT(14, ph10b_softmax(P, gtid, nthr))
    SIMT(15, ph10c_out(P, gtid, nthr))
    if (IN(16)) { pg8::DEpiResid E{{P.HB, P.Z}}; run_gemm(lds, P.O, P.W_O_T, TOK, 1024, 1024, E); SEAM(16); }
    SIMT(17, ph_ln_z(P, P.in[I_LN2_G], P.in[I_LN2_B], gtid, nthr))
    if (IN(18)) { pg8::DEpiPlain E{{P.QP, 2048, 0}}; run_gemm(lds, P.HB, P.W_QUERY_T, TOK, 2048, 1024, E); SEAM(18); }
    SIMT(19, ph13a_scores(P, gtid, nthr))
    SIMT(20, ph13b_topk(P, gtid, nthr))
    SIMT(21, ph13c_cand(P, gtid, nthr))
    SIMT(22, ph14a_act(P, gtid, nthr))
    SIMT(23, ph14b_out(P, gtid, nthr))
    SIMT(24, ph14c_final(P, gtid, nthr))
#undef IN
#undef SEAM
#undef SIMT
}
extern "C" void kernel_launch(void* const* d_in, const int* in_sizes, int n_in, void* d_out, int out_size, void* d_ws, size_t ws_size, hipStream_t stream) {
    static int grid = 0;
    if (grid == 0) {
        int dev = 0, cus = 0;
        if (n_in != 37 || ws_size < WS_NEED || hipGetDevice(&dev) != hipSuccess || hipDeviceGetAttribute(&cus, hipDeviceAttributeMultiprocessorCount, dev) != hipSuccess) {
            fprintf(stderr, "kernel_launch: bad arguments (n_in %d, ws %zu < %zu)\n", n_in, ws_size, (size_t)WS_NEED); grid = -1; return; }
        if (hipFuncSetAttribute((const void*)mega_fwd, hipFuncAttributeMaxDynamicSharedMemorySize, LDS_BYTES) != hipSuccess) { fprintf(stderr, "kernel_launch: hipFuncSetAttribute failed\n"); grid = -1; return; }
        grid = cus;
    }
    if (grid < 0) return;
    (void)hipMemsetAsync((char*)d_ws + WS_CTL, 0, 1 * MiB, stream);
    KArgs a; memset(&a, 0, sizeof(a)); make_params(a.P, d_in, d_out, d_ws);
#if MK_PER_PHASE
    for (int ph = 0; ph < N_PHASES; ++ph) { a.ph_lo = ph; a.ph_hi = ph + 1; hipLaunchKernelGGL(mega_fwd, dim3(grid), dim3(512), LDS_BYTES, stream, a); }
#else
    a.ph_lo = 0; a.ph_hi = N_PHASES; hipLaunchKernelGGL(mega_fwd, dim3(grid), dim3(512), LDS_BYTES, stream, a);
#endif
}
#endif
```

```cpp
#ifdef HOST_EMU
#include "emu.h"
#else
#include <hip/hip_runtime.h>
#include <cstdio>
#include <cstdint>
#include <cstring>
#endif

#ifndef BATCH
#define BATCH 8
#endif
#ifndef SEQ
#define SEQ 2048
#endif
#define DM 1024
#define TOK (BATCH * SEQ)
#define IN_COLS 4992
#define MEM_LEN 256
#define ALPHA_F 1.189207115002721f
typedef unsigned short bf16_t;

#ifdef HOST_EMU
static inline float bf2f(bf16_t v) { unsigned u = (unsigned)v << 16; float f; memcpy(&f, &u, 4); return f; }
static inline bf16_t f2bf(float f) { unsigned u; memcpy(&u, &f, 4); return (bf16_t)((u + 0x7fffu + ((u >> 16) & 1u)) >> 16); }
#else
__device__ __forceinline__ float bf2f(bf16_t v) { return __uint_as_float((unsigned)v << 16); }
__device__ __forceinline__ bf16_t f2bf(float f) { unsigned u = __float_as_uint(f); return (bf16_t)((u + 0x7fffu + ((u >> 16) & 1u)) >> 16); }
#endif
__device__ __forceinline__ float sigmoidf_(float x) { return 1.0f / (1.0f + expf(-x)); }
__device__ __forceinline__ float geluf_(float x) { return 0.5f * x * (1.0f + erff(x * 0.7071067811865476f)); }

struct Params {
    const float* in[37];
    float* out;
    unsigned* ctl;
    bf16_t *W_IN_T, *W_BR_T, *W_MIX_T, *W_Q_T, *W_KV_T, *W_O_T, *W_QUERY_T;
    bf16_t *KV, *MEMN, *HB;
    bf16_t *PA, *PB, *VN, *YB;
    bf16_t *WDS, *ADS, *SG;
    bf16_t *R, *V, *KK, *OMW, *KDIR, *BVEC;
    float *Y01;
    bf16_t *YA, *BR, *MG;
    float* Z;
    bf16_t *Q, *O;
    float* SCA;
    bf16_t* QP;
    float* SC; float* TOPS; int* TOPI; float* GATE; int* EXPERT; float* COEF; float* Y;
    bf16_t *UB, *VB;
    bf16_t *W_LORA_T;
    bf16_t *LIN, *K, *AL, *G;
    bf16_t *KH, *VT, *QH, *PP;
};
enum { I_X = 0, I_MEM, I_LN_EMB_G, I_LN_EMB_B, I_W_IN, I_MU, I_W0, I_W2, I_A0, I_A2, I_G2, I_K_K, I_K_A, I_R_K, I_GN_G, I_GN_B,
       I_GLN_G, I_GLN_B, I_W_S, I_B_S, I_W_BRANCH, I_W_MIX, I_LN1_G, I_LN1_B, I_MLN_G, I_MLN_B, I_W_Q, I_W_KV, I_W_O, I_LN2_G, I_LN2_B,
       I_W_QUERY, I_SUBKEYS, I_PEER_U, I_PEER_V, I_LN3_G, I_LN3_B };

constexpr size_t MiB = 1u << 20;
constexpr size_t TU = (size_t)TOK * 1024;
constexpr size_t WS_CTL = 0;
constexpr size_t WS_W = 1 * MiB;
constexpr size_t OFF_W_IN = 0, OFF_W_BR = OFF_W_IN + (size_t)5120 * 1024 * 2, OFF_W_MIX = OFF_W_BR + (size_t)2048 * 512 * 2,
                 OFF_W_Q = OFF_W_MIX + (size_t)1024 * 1024 * 2, OFF_W_KV = OFF_W_Q + (size_t)1024 * 1024 * 2,
                 OFF_W_O = OFF_W_KV + (size_t)2048 * 1024 * 2, OFF_W_QUERY = OFF_W_O + (size_t)1024 * 1024 * 2,
                 OFF_W_END = OFF_W_QUERY + (size_t)2048 * 1024 * 2;
static_assert(OFF_W_END <= 27 * MiB, "weights region");
constexpr size_t OFF_W_LORA = OFF_W_END, OFF_W_END2 = OFF_W_LORA + (size_t)2560 * 512 * 2;
static_assert(OFF_W_END2 <= 29 * MiB, "weights region 2");
constexpr size_t WS_KV = 30 * MiB;
constexpr size_t WS_MEMN = 38 * MiB;
constexpr size_t WS_ACT = 42 * MiB;
constexpr size_t A_HB = WS_ACT;
constexpr size_t A_R1 = A_HB + 2 * TU;
constexpr size_t A_R2 = A_R1 + 4 * TU;
constexpr size_t WS_NEED = A_R2 + 7 * TU;
#ifndef HOST_EMU
static_assert(WS_NEED <= 256 * MiB, "workspace map exceeds 256 MiB");
#endif

struct EpiP1 { bf16_t* PA; bf16_t* PB; };
struct EpiPlain { bf16_t* O; int ldc; int col_off; };
struct EpiMerge { const bf16_t* BR; bf16_t* MG; };
struct EpiResid { const bf16_t* H; float* Z; };

#ifndef HOST_EMU
namespace pg8 {
#define PG8_LAS __attribute__((address_space(3)))
typedef unsigned short bf16_t;
typedef short bf16x8 __attribute__((ext_vector_type(8)));
typedef float f32x4 __attribute__((ext_vector_type(4)));
typedef unsigned u32x4 __attribute__((ext_vector_type(4)));
constexpr int BM = 256, BK = 64, HALF = 128, HTB = HALF * BK * 2  , STAGE_BYTES = 8 * HTB, NXCD = 8, WGM = 8;

__host__ __device__ __forceinline__ int lds_byte(int r, int c) { const int st = (r >> 4) * 2 + (c >> 5), rr = r & 15, cc = c & 31, ob = rr * 64 + cc * 2; return st * 1024 + (ob ^ (((ob >> 9) & 1) << 5)); }
__host__ __device__ __forceinline__ void stage_rc(int b, int& R, int& C) { const int st = b / 1024, sb = b % 1024, swz = sb ^ (((sb >> 9) & 1) << 5); R = (st >> 1) * 16 + swz / 64; C = (st & 1) * 32 + (swz % 64) / 2; }
__host__ __device__ __forceinline__ int perm32(int rho) { const int n = rho >> 4, i = rho & 15; return 8 * (i >> 2) + 4 * n + (i & 3); }

struct Unit { int pm, pn; };
struct Gemm { const bf16_t* A; const bf16_t* Bt; int M, N, K; int lda, ldb; int bgrp; size_t bgstride; };

struct StaticOrder {
    int nM, nN, nwg, G, c;
    __host__ __device__ void init(int M, int N, int G_, int c_) { nM = M / BM; nN = N / BM; nwg = nM * nN; G = G_; c = c_; }
    __host__ __device__ bool next(int i, Unit& u) const {
        const long L = (long)i * G + c; if (L >= nwg) return false;
        int wgid = (int)L; { const int q = nwg / NXCD, r = nwg % NXCD, xcd = wgid % NXCD, off = wgid / NXCD; wgid = (xcd < r ? xcd * (q + 1) : r * (q + 1) + (xcd - r) * q) + off; }
        const int nig = WGM * nN, gid = wgid / nig, fm = gid * WGM, gsz = (nM - fm) < WGM ? (nM - fm) : WGM;
        u.pm = fm + ((wgid % nig) % gsz); u.pn = (wgid % nig) / gsz; return true;
    }
    __device__ __forceinline__ void a_ready(const Unit&) const {}
    __device__ __forceinline__ void done(const Unit&) const {}
};

typedef float f32x2c __attribute__((ext_vector_type(2))); typedef __bf16 bf16x2c __attribute__((ext_vector_type(2)));
__device__ __forceinline__ unsigned cvt_pk_bf16(float lo, float hi) { const f32x2c v = {lo, hi}; const bf16x2c b = __builtin_convertvector(v, bf16x2c); return __builtin_bit_cast(unsigned, b); }
typedef float f32x2 __attribute__((ext_vector_type(2)));
__device__ __forceinline__ f32x2 gelu_pk(f32x2 v) {
    const f32x2 av = __builtin_elementwise_abs(v), d = av * 0.2316418882f + 1.0f;
    f32x2 t; t.x = __builtin_amdgcn_rcpf(d.x); t.y = __builtin_amdgcn_rcpf(d.y);
    f32x2 q = t * 0.5307027145f + (-0.7265760135f); q = q * t + 0.7107068705f; q = q * t + (-0.142248368f); q = q * t + 0.127414796f; q = q * t;
    const f32x2 s = (v * v) * (-0.72134752044f);
    f32x2 e; e.x = __builtin_amdgcn_exp2f(s.x); e.y = __builtin_amdgcn_exp2f(s.y);
    const f32x2 m = v * (q * e), r = v - m;
    f32x2 o; o.x = v.x < 0.f ? m.x : r.x; o.y = v.y < 0.f ? m.y : r.y; return o;
}


template <class Epi, class Sched, bool ALIGN_EPI = false, bool SP2 = false>
__device__ __forceinline__ void gemm_phase(PG8_LAS unsigned char* lds, const Gemm g, const Sched& S, const Epi& E) {
    const int tid = threadIdx.x, wid = __builtin_amdgcn_readfirstlane(tid >> 6), lane = tid & 63, wr = wid >> 2, wc = wid & 3, fr = lane & 15, fq = lane >> 4;
    const int K = g.K, nt = K / BK;
    unsigned voffA[2], voffB[2];
#pragma unroll
    for (int i = 0; i < 2; ++i) { int R, C; stage_rc(tid * 16 + i * 8192, R, C); const int Rb = Epi::PERM ? ((R & ~31) + perm32(R & 31)) : R;
        voffA[i] = (unsigned)(R * g.lda + C) * 2u; voffB[i] = (unsigned)(Rb * g.ldb + C) * 2u; }
    const size_t kstep = (size_t)(BK * 2);
    const size_t hstepA = (size_t)HALF * g.lda * 2, hstepB = (size_t)HALF * g.ldb * 2;
    const size_t tstepA = 2 * hstepA, tstepB = 2 * hstepB;
    const unsigned ldsw = (unsigned)wid * 1024u;
    const int aoff = lds_byte(wr * 64 + fr, fq * 8), boff = lds_byte(wc * 32 + fr, fq * 8);
#define PG8_SA(b, h) (((b) * 2 + (h)) * HTB)
#define PG8_SB(b, h) ((4 + (b) * 2 + (h)) * HTB)
#define PG8_STAGE(bufoff, gbase, voff) do { _Pragma("unroll") for (int _i = 0; _i < 2; ++_i) \
        __builtin_amdgcn_global_load_lds((const unsigned*)((const char*)(gbase) + (voff)[_i]), (PG8_LAS unsigned*)(lds + (bufoff) + ldsw + _i * 8192), 16, 0, 0); } while (0)
#define PG8_LDA(dst, b, h) do { _Pragma("unroll") for (int m = 0; m < 4; ++m) _Pragma("unroll") for (int k = 0; k < 2; ++k) dst[m][k] = *(const PG8_LAS bf16x8*)(lds + PG8_SA(b, h) + aoff + m * 2048 + k * 1024); } while (0)
#define PG8_LDB(dst, b, h) do { _Pragma("unroll") for (int n = 0; n < 2; ++n) _Pragma("unroll") for (int k = 0; k < 2; ++k) dst[n][k] = *(const PG8_LAS bf16x8*)(lds + PG8_SB(b, h) + boff + n * 2048 + k * 1024); } while (0)
#define PG8_MMA(ai, bj, At, Bt) do { __builtin_amdgcn_s_setprio(1); _Pragma("unroll") for (int m = 0; m < 4; ++m) _Pragma("unroll") for (int n = 0; n < 2; ++n) _Pragma("unroll") for (int k = 0; k < 2; ++k) \
        acc[ai][bj][m][n] = __builtin_amdgcn_mfma_f32_16x16x32_bf16(Bt[n][k], At[m][k], acc[ai][bj][m][n], 0, 0, 0); __builtin_amdgcn_s_setprio(0); } while (0)
#define PG8_WAIT_V(n) asm volatile("s_waitcnt vmcnt(" #n ")" ::: "memory")
#define PG8_WAIT_L(n) asm volatile("s_waitcnt lgkmcnt(" #n ")" ::: "memory")
#define PG8_BAR __builtin_amdgcn_s_barrier()
#define PG8_SCHED __builtin_amdgcn_sched_barrier(0)
    Unit cur, nxt; int ui = 0;
    if (!S.next(0, cur)) return;
    f32x4 acc[2][2][4][2];
#pragma unroll
    for (int a = 0; a < 2; ++a)
#pragma unroll
        for (int b = 0; b < 2; ++b)
#pragma unroll
            for (int m = 0; m < 4; ++m)
#pragma unroll
                for (int n = 0; n < 2; ++n) acc[a][b][m][n] = (f32x4){0.f, 0.f, 0.f, 0.f};
    bf16x8 At[4][2], B0[2][2], B1[2][2];
    const char* cA = (const char*)g.A + (size_t)cur.pm * tstepA; const char* cB = (const char*)g.Bt + (size_t)cur.pn * tstepB + (size_t)(cur.pm / g.bgrp) * g.bgstride;
    S.a_ready(cur);
    if constexpr (SP2) {
        PG8_STAGE(PG8_SB(0, 0), cB, voffB); PG8_STAGE(PG8_SB(0, 1), cB + hstepB, voffB); PG8_STAGE(PG8_SA(0, 0), cA, voffA); PG8_STAGE(PG8_SA(0, 1), cA + hstepA, voffA);
        if (wr == 1) PG8_BAR;
        PG8_WAIT_V(2); PG8_BAR;
        PG8_STAGE(PG8_SB(1, 0), cB + kstep, voffB); PG8_STAGE(PG8_SA(1, 0), cA + kstep, voffA); PG8_STAGE(PG8_SB(1, 1), cB + hstepB + kstep, voffB);
        PG8_WAIT_V(6); PG8_BAR;
    } else {
        PG8_STAGE(PG8_SB(0, 0), cB, voffB); PG8_STAGE(PG8_SA(0, 0), cA, voffA); PG8_STAGE(PG8_SB(0, 1), cB + hstepB, voffB); PG8_STAGE(PG8_SA(0, 1), cA + hstepA, voffA);
        if (wr == 1) PG8_BAR;
        PG8_WAIT_V(4); PG8_BAR;
        PG8_STAGE(PG8_SB(1, 0), cB + kstep, voffB); PG8_STAGE(PG8_SA(1, 0), cA + kstep, voffA); PG8_STAGE(PG8_SB(1, 1), cB + hstepB + kstep, voffB);
        PG8_WAIT_V(6); PG8_BAR;
    }
    for (;;) {
        const bool has_next = S.next(ui + 1, nxt);
        const char* nA = has_next ? (const char*)g.A + (size_t)nxt.pm * tstepA : cA; const char* nB = has_next ? (const char*)g.Bt + (size_t)nxt.pn * tstepB + (size_t)(nxt.pm / g.bgrp) * g.bgstride : cB;
#pragma unroll 1
        for (int t = 0; t < nt; t += 2) {
            const bool last = (t == nt - 2);
            const char* a1 = cA + (size_t)(t + 1) * kstep;
            const char* a2 = last ? nA : cA + (size_t)(t + 2) * kstep; const char* b2 = last ? nB : cB + (size_t)(t + 2) * kstep;
            const char* a3 = a2 + kstep; const char* b3 = b2 + kstep;
            if (last && has_next) S.a_ready(nxt);
            if constexpr (SP2) {
            PG8_LDB(B0, 0, 0); PG8_LDB(B1, 0, 1); PG8_SCHED; PG8_LDA(At, 0, 0); PG8_STAGE(PG8_SA(1, 1), a1 + hstepA, voffA);
            PG8_WAIT_V(8); PG8_WAIT_L(0); PG8_BAR; PG8_MMA(0, 0, At, B0); PG8_MMA(0, 1, At, B1); PG8_BAR; PG8_SCHED;
            PG8_LDA(At, 0, 1); PG8_STAGE(PG8_SB(0, 0), b2, voffB); PG8_STAGE(PG8_SB(0, 1), b2 + hstepB, voffB); PG8_STAGE(PG8_SA(0, 0), a2, voffA);
            PG8_WAIT_V(8); PG8_WAIT_L(0); PG8_BAR; PG8_MMA(1, 0, At, B0); PG8_MMA(1, 1, At, B1); PG8_BAR; PG8_SCHED;
            PG8_LDB(B0, 1, 0); PG8_LDB(B1, 1, 1); PG8_SCHED; PG8_LDA(At, 1, 0); PG8_STAGE(PG8_SA(0, 1), a2 + hstepA, voffA);
            PG8_WAIT_V(8); PG8_WAIT_L(0); PG8_BAR; PG8_MMA(0, 0, At, B0); PG8_MMA(0, 1, At, B1); PG8_BAR; PG8_SCHED;
            PG8_LDA(At, 1, 1); PG8_STAGE(PG8_SB(1, 0), b3, voffB); PG8_STAGE(PG8_SB(1, 1), b3 + hstepB, voffB); PG8_STAGE(PG8_SA(1, 0), a3, voffA);
            PG8_WAIT_V(8); PG8_WAIT_L(0); PG8_BAR; PG8_MMA(1, 0, At, B0); PG8_MMA(1, 1, At, B1); PG8_BAR; PG8_SCHED;
            } else {
            PG8_LDB(B0, 0, 0); PG8_SCHED; PG8_LDA(At, 0, 0); PG8_STAGE(PG8_SA(1, 1), a1 + hstepA, voffA);
            PG8_WAIT_L(8); PG8_BAR; PG8_WAIT_L(0); PG8_MMA(0, 0, At, B0); PG8_BAR; PG8_SCHED;
            PG8_LDB(B1, 0, 1); PG8_STAGE(PG8_SB(0, 0), b2, voffB);
            PG8_BAR; PG8_WAIT_L(0); PG8_MMA(0, 1, At, B1); PG8_BAR;
            PG8_LDA(At, 0, 1); PG8_STAGE(PG8_SA(0, 0), a2, voffA);
            PG8_BAR; PG8_WAIT_L(0); PG8_MMA(1, 0, At, B0); PG8_BAR; PG8_SCHED;
            PG8_STAGE(PG8_SB(0, 1), b2 + hstepB, voffB);
            PG8_WAIT_V(6); PG8_BAR; PG8_MMA(1, 1, At, B1); PG8_BAR;
            PG8_LDB(B0, 1, 0); PG8_SCHED; PG8_LDA(At, 1, 0); PG8_STAGE(PG8_SA(0, 1), a2 + hstepA, voffA);
            PG8_WAIT_L(8); PG8_BAR; PG8_WAIT_L(0); PG8_MMA(0, 0, At, B0); PG8_BAR; PG8_SCHED;
            PG8_LDB(B1, 1, 1); PG8_STAGE(PG8_SB(1, 0), b3, voffB);
            PG8_BAR; PG8_WAIT_L(0); PG8_MMA(0, 1, At, B1); PG8_BAR;
            PG8_LDA(At, 1, 1); PG8_STAGE(PG8_SA(1, 0), a3, voffA);
            PG8_BAR; PG8_WAIT_L(0); PG8_MMA(1, 0, At, B0); PG8_BAR; PG8_SCHED;
            PG8_STAGE(PG8_SB(1, 1), b3 + hstepB, voffB);
            PG8_WAIT_V(6); PG8_BAR; PG8_MMA(1, 1, At, B1); PG8_BAR;
            }
        }
        if constexpr (ALIGN_EPI) { if (wr == 0) PG8_BAR; }
        if constexpr (!Epi::AFTER_DRAIN) { E(acc, cur, wr, wc, fr, fq); S.done(cur); }
        if (!has_next) break;
#pragma unroll
        for (int a = 0; a < 2; ++a)
#pragma unroll
            for (int b = 0; b < 2; ++b)
#pragma unroll
                for (int m = 0; m < 4; ++m)
#pragma unroll
                    for (int n = 0; n < 2; ++n) acc[a][b][m][n] = (f32x4){0.f, 0.f, 0.f, 0.f};
        cur = nxt; cA = nA; cB = nB; ++ui;
        if constexpr (ALIGN_EPI) { if (wr == 1) PG8_BAR; }
    }
    PG8_WAIT_V(0);
    if constexpr (!ALIGN_EPI) { if (wr == 0) PG8_BAR; }
    PG8_BAR;
    if constexpr (Epi::AFTER_DRAIN) { E.fused(acc, cur, wr, wc, fr, fq, lds, wid, lane); S.done(cur); }
#undef PG8_SA
#undef PG8_SB
#undef PG8_STAGE
#undef PG8_LDA
#undef PG8_LDB
#undef PG8_MMA
#undef PG8_WAIT_V
#undef PG8_WAIT_L
#undef PG8_BAR
#undef PG8_SCHED
}
}

namespace pg8 {
__device__ __forceinline__ u32x4 pack8(const f32x4& v0, const f32x4& v1) { u32x4 w; w.x = cvt_pk_bf16(v0[0], v0[1]); w.y = cvt_pk_bf16(v0[2], v0[3]); w.z = cvt_pk_bf16(v1[0], v1[1]); w.w = cvt_pk_bf16(v1[2], v1[3]); return w; }
__device__ __forceinline__ f32x4 gelu4(const f32x4& v) { f32x2 a = gelu_pk((f32x2){v[0], v[1]}), b = gelu_pk((f32x2){v[2], v[3]}); return (f32x4){a.x, a.y, b.x, b.y}; }
struct DEpiP1 {
    static constexpr bool PERM = true, AFTER_DRAIN = false; EpiP1 e;
    __device__ __forceinline__ void operator()(const f32x4 (&acc)[2][2][4][2], const Unit& u, int wr, int wc, int fr, int fq) const {
        const int row0 = u.pm * BM + wr * 64 + fr; const bool isb = (u.pn >= 8);
        bf16_t* base = isb ? e.PB : e.PA; const int ldc = isb ? 1024 : 2048; const int col0 = (isb ? (u.pn - 8) : u.pn) * BM + wc * 32 + 8 * fq;
#pragma unroll
        for (int ai = 0; ai < 2; ++ai)
#pragma unroll
            for (int m = 0; m < 4; ++m) { bf16_t* rowp = base + (size_t)(row0 + ai * HALF + m * 16) * ldc + col0;
#pragma unroll
                for (int bj = 0; bj < 2; ++bj) { f32x4 v0 = acc[ai][bj][m][0], v1 = acc[ai][bj][m][1];
                    if (isb) { v0 = gelu4(v0); v1 = gelu4(v1); }
                    *(u32x4*)(rowp + bj * HALF) = pack8(v0, v1); } }
    }
};
struct DEpiPlain {
    static constexpr bool PERM = true, AFTER_DRAIN = false; EpiPlain e;
    __device__ __forceinline__ void operator()(const f32x4 (&acc)[2][2][4][2], const Unit& u, int wr, int wc, int fr, int fq) const {
        const int row0 = u.pm * BM + wr * 64 + fr; const int col0 = e.col_off + u.pn * BM + wc * 32 + 8 * fq;
#pragma unroll
        for (int ai = 0; ai < 2; ++ai)
#pragma unroll
            for (int m = 0; m < 4; ++m) { bf16_t* rowp = e.O + (size_t)(row0 + ai * HALF + m * 16) * e.ldc + col0;
#pragma unroll
                for (int bj = 0; bj < 2; ++bj) *(u32x4*)(rowp + bj * HALF) = pack8(acc[ai][bj][m][0], acc[ai][bj][m][1]); }
    }
};
__device__ __forceinline__ float sig_fast(float x) { return __builtin_amdgcn_rcpf(1.0f + __expf(-x)); }
__device__ __forceinline__ float bflo(unsigned w) { return __uint_as_float(w << 16); }
__device__ __forceinline__ float bfhi(unsigned w) { return __uint_as_float(w & 0xffff0000u); }
struct DEpiMerge {
    static constexpr bool PERM = true, AFTER_DRAIN = false; EpiMerge e;
    __device__ __forceinline__ void operator()(const f32x4 (&acc)[2][2][4][2], const Unit& u, int wr, int wc, int fr, int fq) const {
        const int row0 = u.pm * BM + wr * 64 + fr; const int n0 = u.pn * HALF + wc * 32 + 8 * fq;
#pragma unroll
        for (int ai = 0; ai < 2; ++ai)
#pragma unroll
            for (int m = 0; m < 4; ++m) { const size_t row = (size_t)(row0 + ai * HALF + m * 16);
                const u32x4 b0 = *(const u32x4*)(e.BR + row * 2048 + n0), b1 = *(const u32x4*)(e.BR + row * 2048 + 1024 + n0);
                const f32x4 g00 = acc[ai][0][m][0], g01 = acc[ai][0][m][1], g10 = acc[ai][1][m][0], g11 = acc[ai][1][m][1];
                f32x4 o0, o1;
                o0[0] = sig_fast(g00[0]) * bflo(b0.x) + sig_fast(g10[0]) * bflo(b1.x); o0[1] = sig_fast(g00[1]) * bfhi(b0.x) + sig_fast(g10[1]) * bfhi(b1.x);
                o0[2] = sig_fast(g00[2]) * bflo(b0.y) + sig_fast(g10[2]) * bflo(b1.y); o0[3] = sig_fast(g00[3]) * bfhi(b0.y) + sig_fast(g10[3]) * bfhi(b1.y);
                o1[0] = sig_fast(g01[0]) * bflo(b0.z) + sig_fast(g11[0]) * bflo(b1.z); o1[1] = sig_fast(g01[1]) * bfhi(b0.z) + sig_fast(g11[1]) * bfhi(b1.z);
                o1[2] = sig_fast(g01[2]) * bflo(b0.w) + sig_fast(g11[2]) * bflo(b1.w); o1[3] = sig_fast(g01[3]) * bfhi(b0.w) + sig_fast(g11[3]) * bfhi(b1.w);
                *(u32x4*)(e.MG + row * 1024 + n0) = pack8(o0, o1); }
    }
};
struct DEpiResid {
    static constexpr bool PERM = false, AFTER_DRAIN = false; EpiResid e;
    __device__ __forceinline__ void operator()(const f32x4 (&acc)[2][2][4][2], const Unit& u, int wr, int wc, int fr, int fq) const {
        const int row0 = u.pm * BM + wr * 64 + fr, col0 = u.pn * BM + wc * 32 + 4 * fq;
        typedef unsigned u32x2 __attribute__((ext_vector_type(2)));
#pragma unroll
        for (int ai = 0; ai < 2; ++ai)
#pragma unroll
            for (int m = 0; m < 4; ++m) { const size_t ro = (size_t)(row0 + ai * HALF + m * 16) * 1024 + col0;
#pragma unroll
                for (int bj = 0; bj < 2; ++bj)
#pragma unroll
                    for (int n = 0; n < 2; ++n) { const u32x2 h = *(const u32x2*)(e.H + ro + bj * HALF + n * 16); const f32x4 a = acc[ai][bj][m][n];
                        f32x4 o; o[0] = ALPHA_F * bflo(h.x) + a[0]; o[1] = ALPHA_F * bfhi(h.x) + a[1]; o[2] = ALPHA_F * bflo(h.y) + a[2]; o[3] = ALPHA_F * bfhi(h.y) + a[3];
                        *(f32x4*)(e.Z + ro + bj * HALF + n * 16) = o; } }
    }
};

struct DEpiTile {
    static constexpr bool PERM = true, AFTER_DRAIN = false; bf16_t* O; int sm, sn; float scale;
    __device__ __forceinline__ void operator()(const f32x4 (&acc)[2][2][4][2], const Unit& u, int wr, int wc, int fr, int fq) const {
        bf16_t* base = O + (size_t)(u.pm * sm + u.pn * sn) * 65536; const int row0 = wr * 64 + fr, col0 = wc * 32 + 8 * fq;
#pragma unroll
        for (int ai = 0; ai < 2; ++ai)
#pragma unroll
            for (int m = 0; m < 4; ++m) { bf16_t* rowp = base + (size_t)(row0 + ai * HALF + m * 16) * 256 + col0;
#pragma unroll
                for (int bj = 0; bj < 2; ++bj) *(u32x4*)(rowp + bj * HALF) = pack8(acc[ai][bj][m][0] * scale, acc[ai][bj][m][1] * scale); }
    }
};
struct DEpiQ { static constexpr bool PERM = true, AFTER_DRAIN = false; DEpiTile t;
    __device__ __forceinline__ void operator()(const f32x4 (&acc)[2][2][4][2], const Unit& u, int wr, int wc, int fr, int fq) const {
        Unit v; v.pm = (u.pm >> 3) * 32 + u.pn * 8 + (u.pm & 7); v.pn = 0; t(acc, v, wr, wc, fr, fq); } };
struct DEpiO {
    static constexpr bool PERM = true, AFTER_DRAIN = false; bf16_t* O;
    __device__ __forceinline__ void operator()(const f32x4 (&acc)[2][2][4][2], const Unit& u, int wr, int wc, int fr, int fq) const {
        const int bh = u.pm >> 3, b = bh >> 2, h = bh & 3; const int s0 = (u.pm & 7) * 256 + wr * 64 + fr;
        bf16_t* base = O + ((size_t)b * SEQ) * 1024 + h * 256 + wc * 32 + 8 * fq;
#pragma unroll
        for (int ai = 0; ai < 2; ++ai)
#pragma unroll
            for (int m = 0; m < 4; ++m) { bf16_t* rowp = base + (size_t)(s0 + ai * HALF + m * 16) * 1024;
#pragma unroll
                for (int bj = 0; bj < 2; ++bj) *(u32x4*)(rowp + bj * HALF) = pack8(acc[ai][bj][m][0], acc[ai][bj][m][1]); }
    }
};
struct DEpiSoftmax {
    static constexpr bool PERM = true, AFTER_DRAIN = true; bf16_t* Pout;
    __device__ __forceinline__ void fused(f32x4 (&acc)[2][2][4][2], const Unit& u, int wr, int wc, int fr, int fq, PG8_LAS unsigned char* lds, int wid, int lane) const {
        PG8_LAS float* PM = (PG8_LAS float*)lds;
        PG8_LAS float* PS = (PG8_LAS float*)(lds + 4096);
#pragma unroll
        for (int ai = 0; ai < 2; ++ai)
#pragma unroll
            for (int m = 0; m < 4; ++m) { float mx = -3.0e38f;
#pragma unroll
                for (int bj = 0; bj < 2; ++bj)
#pragma unroll
                    for (int n = 0; n < 2; ++n) { const f32x4 x = acc[ai][bj][m][n]; mx = fmaxf(mx, fmaxf(fmaxf(x[0], x[1]), fmaxf(x[2], x[3]))); }
                mx = fmaxf(mx, __shfl_xor(mx, 16)); mx = fmaxf(mx, __shfl_xor(mx, 32));
                if (fq == 0) PM[(ai * HALF + wr * 64 + m * 16 + fr) * 4 + wc] = mx; }
        asm volatile("s_waitcnt lgkmcnt(0)" ::: "memory"); __builtin_amdgcn_s_barrier(); asm volatile("" ::: "memory");
#pragma unroll
        for (int ai = 0; ai < 2; ++ai)
#pragma unroll
            for (int m = 0; m < 4; ++m) { const int row = ai * HALF + wr * 64 + m * 16 + fr; const f32x4 p4 = *(const PG8_LAS f32x4*)(PM + row * 4);
                const float gm = fmaxf(fmaxf(p4[0], p4[1]), fmaxf(p4[2], p4[3])); float sum = 0.f;
#pragma unroll
                for (int bj = 0; bj < 2; ++bj)
#pragma unroll
                    for (int n = 0; n < 2; ++n) { f32x4 x = acc[ai][bj][m][n]; x[0] = __expf(x[0] - gm); x[1] = __expf(x[1] - gm); x[2] = __expf(x[2] - gm); x[3] = __expf(x[3] - gm);
                        acc[ai][bj][m][n] = x; sum += (x[0] + x[1]) + (x[2] + x[3]); }
                sum += __shfl_xor(sum, 16); sum += __shfl_xor(sum, 32);
                if (fq == 0) PS[row * 4 + wc] = sum; }
        asm volatile("s_waitcnt lgkmcnt(0)" ::: "memory"); __builtin_amdgcn_s_barrier(); asm volatile("" ::: "memory");
#pragma unroll
        for (int ai = 0; ai < 2; ++ai)
#pragma unroll
            for (int m = 0; m < 4; ++m) { const int row = ai * HALF + wr * 64 + m * 16 + fr; const f32x4 s4 = *(const PG8_LAS f32x4*)(PS + row * 4);
                const float inv = 1.0f / ((s4[0] + s4[1]) + (s4[2] + s4[3])); bf16_t* rowp = Pout + ((size_t)u.pm * 256 + row) * 256 + wc * 32 + 8 * fq;
#pragma unroll
                for (int bj = 0; bj < 2; ++bj) *(u32x4*)(rowp + bj * HALF) = pack8(acc[ai][bj][m][0] * inv, acc[ai][bj][m][1] * inv); }
        asm volatile("s_waitcnt lgkmcnt(0)" ::: "memory"); __builtin_amdgcn_s_barrier(); asm volatile("" ::: "memory");
    }
};
template <int KIND> struct DEpiLora {
    static constexpr bool PERM = true, AFTER_DRAIN = false; const float* bsrc0; bf16_t* O;
    __device__ __forceinline__ static f32x4 act4(f32x4 x) {
        f32x4 o;
#pragma unroll
        for (int i = 0; i < 4; ++i) {
            if (KIND == 0) { const float y = -x[i]; const float sp = fmaxf(y, 0.f) + __logf(1.0f + __expf(-fabsf(y))); const float ew = __expf(-sp - 0.5f); o[i] = 1.0f - __expf(-ew); }
            else if (KIND == 1) o[i] = __builtin_amdgcn_rcpf(1.0f + __expf(-x[i]));
            else o[i] = x[i]; }
        return o;
    }
    __device__ __forceinline__ void operator()(const f32x4 (&acc)[2][2][4][2], const Unit& u, int wr, int wc, int fr, int fq) const {
        const int row0 = u.pm * BM + wr * 64 + fr; const int z = (KIND == 2) ? 0 : (u.pn >> 1); const int cb = ((KIND == 2) ? u.pn : (u.pn & 1)) * 256 + wc * 32 + 8 * fq;
        f32x4 bv[2][2];
#pragma unroll
        for (int bj = 0; bj < 2; ++bj)
#pragma unroll
            for (int n = 0; n < 2; ++n) bv[bj][n] = (KIND == 2) ? (f32x4){0.f, 0.f, 0.f, 0.f} : *(const f32x4*)(bsrc0 + z * 512 + cb + bj * HALF + 4 * n);
#pragma unroll
        for (int ai = 0; ai < 2; ++ai)
#pragma unroll
            for (int m = 0; m < 4; ++m) { const size_t row = (size_t)(row0 + ai * HALF + m * 16);
                bf16_t* dst = (KIND == 2) ? (O + row * 512 + cb) : (O + (row * 2 + z) * 512 + cb);
#pragma unroll
                for (int bj = 0; bj < 2; ++bj) *(u32x4*)(dst + bj * HALF) = pack8(act4(acc[ai][bj][m][0] + bv[bj][0]), act4(acc[ai][bj][m][1] + bv[bj][1])); }
    }
};
}
#define LAS __attribute__((address_space(3)))
#define XB_TMO      128
#define XB_XCNT(j)  (256  + 64 * (j))
#define XB_XSUB(j)  (1280 + 64 * (j))
#define XB_XGEN(j)  (2304 + 64 * (j))
#define XB_TOP      3328
#define XB_TOPGEN   3392
#define XCD_BAR_WORDS 3456
#define XB_SPIN_CAP (1u << 18)

__device__ __forceinline__ unsigned xb_ld(unsigned* p)              { return __hip_atomic_load(p, __ATOMIC_RELAXED, __HIP_MEMORY_SCOPE_AGENT); }
__device__ __forceinline__ unsigned xb_add(unsigned* p, unsigned v) { return __hip_atomic_fetch_add(p, v, __ATOMIC_RELAXED, __HIP_MEMORY_SCOPE_AGENT); }
__device__ __forceinline__ unsigned xb_xcc_id() { return (unsigned)__builtin_amdgcn_s_getreg((3 << 11) | 20) & 0xFu; }
#define XB_SPIN(cond, bar) do { unsigned _sp = 0; while (cond) { __builtin_amdgcn_s_sleep(1); \
    if ((++_sp & 255u) == 0u) { if (xb_ld(&(bar)[XB_TMO])) break; if (_sp > XB_SPIN_CAP) { atomicAdd(&(bar)[XB_TMO], 1u); break; } } } } while (0)

struct XcdBarrier {
    unsigned* bar; unsigned x;
    volatile LAS unsigned* st;
};

__device__ __forceinline__ XcdBarrier xcd_barrier_post(unsigned* bar, volatile LAS unsigned* st) {
    XcdBarrier b; b.bar = bar; b.x = xb_xcc_id(); b.st = st;
    if (threadIdx.x == 0) (void)xb_add(&bar[XB_XCNT(b.x)], 1u);
    return b;
}
__device__ __forceinline__ void xcd_barrier_complete(unsigned* bar, unsigned x, unsigned& nloc, unsigned& nx) {
    const unsigned G = gridDim.x * gridDim.y * gridDim.z;
    unsigned sum, cnt, mine, sp = 0u;
    for (;;) {
        sum = 0u; cnt = 0u; mine = 0u;
#pragma unroll
        for (unsigned j = 0; j < 16; ++j) { const unsigned c = xb_ld(&bar[XB_XCNT(j)]); sum += c; cnt += (c > 0u) ? 1u : 0u; mine = (j == x) ? c : mine; }
        if (sum == G) break;
        __builtin_amdgcn_s_sleep(1);
        if ((++sp & 255u) == 0u) { if (xb_ld(&bar[XB_TMO])) break; if (sp > XB_SPIN_CAP) { atomicAdd(&bar[XB_TMO], 1u); break; } }
    }
    nloc = mine > 0u ? mine : 1u; nx = cnt > 0u ? cnt : 1u;
}

__device__ __forceinline__ void xcd_barrier(const XcdBarrier& b) {
    asm volatile("s_waitcnt vmcnt(0)" ::: "memory");
    __syncthreads();
    if (threadIdx.x == 0) {
        unsigned* bar = b.bar;
        __builtin_amdgcn_s_waitcnt(0);
        unsigned nloc = b.st[0], nx = b.st[1];
        if (nloc == 0u) { xcd_barrier_complete(bar, b.x, nloc, nx); b.st[0] = nloc; b.st[1] = nx; }
        const unsigned old = xb_add(&bar[XB_XSUB(b.x)], 1u);
        const unsigned gen = old / nloc;
        if (old + 1u == (gen + 1u) * nloc) {
            __builtin_amdgcn_fence(__ATOMIC_RELEASE, "agent");
            asm volatile("s_waitcnt vmcnt(0)" ::: "memory");
            const unsigned og = xb_add(&bar[XB_TOP], 1u);
            const unsigned tg = og / nx;
            if (og + 1u == (tg + 1u) * nx) xb_add(&bar[XB_TOPGEN], 1u);
            else XB_SPIN(xb_ld(&bar[XB_TOPGEN]) == tg, bar);
            __builtin_amdgcn_fence(__ATOMIC_ACQUIRE, "agent");
            xb_add(&bar[XB_XGEN(b.x)], 1u);
            asm volatile("s_waitcnt vmcnt(0)" ::: "memory");
        } else {
            XB_SPIN(xb_ld(&bar[XB_XGEN(b.x)]) == gen, bar);
            __builtin_amdgcn_fence(__ATOMIC_ACQUIRE, "agent");
            asm volatile("s_waitcnt vmcnt(0)" ::: "memory");
        }
    }
    __syncthreads();
}

#endif

#ifdef HOST_EMU
template <class F> static void emu_gemm(const bf16_t* A, const bf16_t* Bt, int M, int N, int K, F f) {
#pragma omp parallel for schedule(static)
    for (int r = 0; r < M; ++r)
        for (int c = 0; c < N; ++c) { float a = 0.f; for (int k = 0; k < K; ++k) a += bf2f(A[(size_t)r * K + k]) * bf2f(Bt[(size_t)c * K + k]); f(r, c, a); }
}
#endif

#define GS_LOOP(idx, n) for (long idx = gtid; idx < (long)(n); idx += nthr)

__device__ __forceinline__ int win_src_col(int n) {
    if (n < 1920) return n;
    if (n < 2048) return -1;
    if (n < 3072) return 1920 + (n - 2048);
    const int m = n - 3072, j = m / 256, i = m % 256;
    return (i < 128) ? (2944 + 128 * j + i) : (2944 + 1024 + 128 * j + (i - 128));
}
__device__ __forceinline__ void ph0_weights(const Params& P, long gtid, long nthr) {
    GS_LOOP(idx, (size_t)5120 * 1024) { const int n = (int)(idx / 1024), k = (int)(idx % 1024); const int c = win_src_col(n);
        P.W_IN_T[idx] = (c < 0) ? (bf16_t)0 : f2bf(P.in[I_W_IN][(size_t)k * IN_COLS + c]); }
    GS_LOOP(idx, (size_t)2048 * 512) { const int n = (int)(idx / 512), k = (int)(idx % 512); const int br = n / 1024, nn = n % 1024;
        P.W_BR_T[idx] = f2bf(P.in[I_W_BRANCH][((size_t)br * 512 + k) * 1024 + nn]); }
    GS_LOOP(idx, (size_t)1024 * 1024) { const int n = (int)(idx / 1024), k = (int)(idx % 1024);
        P.W_MIX_T[idx] = f2bf(P.in[I_W_MIX][(size_t)k * 1024 + n]);
        P.W_Q_T[idx] = f2bf(P.in[I_W_Q][(size_t)k * 1024 + n]);
        P.W_O_T[idx] = f2bf(P.in[I_W_O][(size_t)k * 1024 + n]); }
    GS_LOOP(idx, (size_t)2048 * 1024) { const int n = (int)(idx / 1024), k = (int)(idx % 1024);
        P.W_KV_T[idx] = f2bf(P.in[I_W_KV][(size_t)k * 2048 + n]);
        P.W_QUERY_T[idx] = f2bf(P.in[I_W_QUERY][(size_t)k * 2048 + n]); }
}
__device__ __forceinline__ void ln_rows_bf16(const float* in, const float* g, const float* b, bf16_t* out, int rows, int width, long gtid, long nthr) {
    GS_LOOP(row, rows) { const float* x = in + (size_t)row * width; float s = 0.f;
        for (int i = 0; i < width; ++i) s += x[i];
        const float mu = s / width; float q = 0.f;
        for (int i = 0; i < width; ++i) { const float d = x[i] - mu; q += d * d; }
        const float rs = 1.0f / sqrtf(q / width + 1e-5f); bf16_t* o = out + (size_t)row * width;
        for (int i = 0; i < width; ++i) o[i] = f2bf((x[i] - mu) * rs * g[i] + b[i]); }
}
__device__ __forceinline__ void ph2a_vn(const Params& P, long gtid, long nthr) {
    GS_LOOP(row, TOK) { const bf16_t* x = P.PB + (size_t)row * 1024 + 512; float s = 0.f;
        for (int i = 0; i < 512; ++i) s += bf2f(x[i]);
        const float mu = s / 512.f; float q = 0.f;
        for (int i = 0; i < 512; ++i) { const float d = bf2f(x[i]) - mu; q += d * d; }
        const float rs = 1.0f / sqrtf(q / 512.f + 1e-5f); bf16_t* o = P.VN + (size_t)row * 512;
        for (int i = 0; i < 512; ++i) o[i] = f2bf((bf2f(x[i]) - mu) * rs * P.in[I_GLN_G][i] + P.in[I_GLN_B][i]); }
}
__device__ __forceinline__ void ph2b_gmlp(const Params& P, long gtid, long nthr) {
    GS_LOOP(idx, (size_t)TOK * 512) { const int c = (int)(idx % 512); const long t = idx / 512; const int g = c / 64; const long ch = t / 128; const int p = (int)(t % 128);
        const float* ws = P.in[I_W_S] + ((size_t)g * 128 + p) * 128; float s = 0.f;
        for (int q = 0; q < 128; ++q) s += ws[q] * bf2f(P.VN[(size_t)(ch * 128 + q) * 512 + c]);
        s += P.in[I_B_S][g * 128 + p];
        P.YB[idx] = f2bf(bf2f(P.PB[(size_t)t * 1024 + c]) * s); }
}
__device__ __forceinline__ float pa_shift(const Params& P, long t, int c) {
    const int s = (int)(t % SEQ); const float cur = bf2f(P.PA[(size_t)t * 2048 + c]);
    const float prev = (s > 0) ? bf2f(P.PA[(size_t)(t - 1) * 2048 + c]) : 0.f;
    const float nxt = (s < SEQ - 1) ? bf2f(P.PA[(size_t)(t + 1) * 2048 + c]) : 0.f;
    return cur + P.in[I_MU][c] * (0.5f * (prev + nxt) - cur);
}
__device__ __forceinline__ void ph3a_lora_in(const Params& P, long gtid, long nthr) {
    GS_LOOP(idx, (size_t)TOK * 128) { const int r = (int)(idx % 128); const long t = idx / 128;
        P.WDS[idx] = f2bf(tanhf(pa_shift(P, t, 1536 + r)));
        P.ADS[idx] = f2bf(pa_shift(P, t, 1664 + r));
        P.SG[idx] = f2bf(sigmoidf_(pa_shift(P, t, 1792 + r))); }
}
__device__ __forceinline__ void ph3b_prep(const Params& P, long gtid, long nthr) {
    GS_LOOP(idx, (size_t)TOK * 8) { const int h = (int)(idx % 8); const long t = idx / 8; const int hb = h * 64;
        float ss = 0.f;
        for (int j = 0; j < 64; ++j) { const float v = pa_shift(P, t, 512 + hb + j) * P.in[I_K_K][hb + j]; ss += v * v; }
        const float inv = 1.0f / fmaxf(sqrtf(ss), 1e-12f);
        for (int j = 0; j < 64; ++j) { const int c = hb + j;
            const float k = pa_shift(P, t, 512 + c); const float kk = k * P.in[I_K_K][c] * inv;
            P.R[(size_t)t * 512 + c] = f2bf(pa_shift(P, t, c));
            P.V[(size_t)t * 512 + c] = f2bf(pa_shift(P, t, 1024 + c));
            P.KK[(size_t)t * 512 + c] = f2bf(kk);
            for (int z = 0; z < 2; ++z) {
                float sw = P.in[I_W0][z * 512 + c], sa = P.in[I_A0][z * 512 + c];
                for (int r = 0; r < 64; ++r) { sw += bf2f(P.WDS[(size_t)t * 128 + z * 64 + r]) * P.in[I_W2][((size_t)z * 64 + r) * 512 + c];
                                               sa += bf2f(P.ADS[(size_t)t * 128 + z * 64 + r]) * P.in[I_A2][((size_t)z * 64 + r) * 512 + c]; }
                const float y = -sw; const float sp = fmaxf(y, 0.f) + log1pf(expf(-fabsf(y))); const float wlog = -sp - 0.5f;
                const float ew = expf(wlog);
                const float a = sigmoidf_(sa); const size_t o = ((size_t)t * 2 + z) * 512 + c;
                P.OMW[o] = f2bf(-expm1f(-ew));
                P.KDIR[o] = f2bf(k * (1.0f + (a - 1.0f) * P.in[I_K_A][c]));
                P.BVEC[o] = f2bf(kk * a); } } }
}
__device__ __forceinline__ void scan_item(const Params& P, int chain, int i) {
    const int h = chain % 8, b = (chain / 8) % BATCH, z = chain / (8 * BATCH);
    float S[64];
#pragma unroll
    for (int j = 0; j < 64; ++j) S[j] = 0.f;
    for (int n = 0; n < SEQ; ++n) {
        const long t = (long)b * SEQ + ((z == 0) ? n : (SEQ - 1 - n));
        const bf16_t* r = P.R + (size_t)t * 512 + h * 64; const bf16_t* a = P.KK + (size_t)t * 512 + h * 64;
        const bf16_t* w = P.OMW + ((size_t)t * 2 + z) * 512 + h * 64; const bf16_t* k = P.KDIR + ((size_t)t * 2 + z) * 512 + h * 64;
        const bf16_t* bv = P.BVEC + ((size_t)t * 2 + z) * 512 + h * 64;
        const float v = bf2f(P.V[(size_t)t * 512 + h * 64 + i]);
        float sa = 0.f;
#pragma unroll
        for (int j = 0; j < 64; ++j) sa -= S[j] * bf2f(a[j]);
        float y = 0.f;
#pragma unroll
        for (int j = 0; j < 64; ++j) { S[j] = S[j] * (1.0f - bf2f(w[j])) + sa * bf2f(bv[j]) + v * bf2f(k[j]); y += S[j] * bf2f(r[j]); }
        P.Y01[((size_t)z * TOK + t) * 512 + h * 64 + i] = y;
    }
}
__device__ __forceinline__ void ph5_rwkv_out(const Params& P, long gtid, long nthr) {
    GS_LOOP(idx, (size_t)TOK * 512) { const int c = (int)(idx % 512); const long t = idx / 512; const int hb = (c / 64) * 64;
        const float* y0 = P.Y01 + (size_t)t * 512 + hb; const float* y1 = P.Y01 + ((size_t)TOK + t) * 512 + hb;
        float s = 0.f;
        for (int j = 0; j < 64; ++j) s += y0[j] + y1[j];
        const float mu = s / 64.f; float q = 0.f;
        for (int j = 0; j < 64; ++j) { const float d = y0[j] + y1[j] - mu; q += d * d; }
        const float rs = 1.0f / sqrtf(q / 64.f + 64e-5f);
        const float yn = (y0[c - hb] + y1[c - hb] - mu) * rs * P.in[I_GN_G][c] + P.in[I_GN_B][c];
        float rk = 0.f;
        for (int z = 0; z < 2; ++z)
            for (int j = 0; j < 64; ++j) rk += bf2f(P.R[(size_t)t * 512 + hb + j]) * bf2f(P.KDIR[((size_t)t * 2 + z) * 512 + hb + j]) * P.in[I_R_K][hb + j];
        float g = 0.f;
        for (int r = 0; r < 128; ++r) g += bf2f(P.SG[(size_t)t * 128 + r]) * P.in[I_G2][(size_t)r * 512 + c];
        P.YA[idx] = f2bf((yn + rk * bf2f(P.V[(size_t)t * 512 + c])) * g); }
}
__device__ __forceinline__ void ph_ln_z(const Params& P, const float* g, const float* b, long gtid, long nthr) { ln_rows_bf16(P.Z, g, b, P.HB, TOK, 1024, gtid, nthr); }
__device__ __forceinline__ void ph10a_scores(const Params& P, long gtid, long nthr) {
    GS_LOOP(idx, (size_t)TOK * 4 * 256) { const int m = (int)(idx % 256); const long rowi = idx / 256; const int s = (int)(rowi % SEQ); const int bh = (int)(rowi / SEQ); const int b = bh / 4, h = bh % 4;
        const bf16_t* q = P.Q + ((size_t)b * SEQ + s) * 1024 + h * 256; const bf16_t* k = P.KV + ((size_t)b * 256 + m) * 2048 + h * 256; float a = 0.f;
        for (int d = 0; d < 256; ++d) a += bf2f(q[d]) * bf2f(k[d]);
        P.SCA[idx] = a * 0.0625f; }
}
__device__ __forceinline__ void ph10b_softmax(const Params& P, long gtid, long nthr) {
    GS_LOOP(row, (size_t)TOK * 4) { float* x = P.SCA + (size_t)row * 256; float mx = x[0];
        for (int i = 1; i < 256; ++i) mx = fmaxf(mx, x[i]);
        float s = 0.f;
        for (int i = 0; i < 256; ++i) s += expf(x[i] - mx);
        const float inv = 1.0f / s;
        for (int i = 0; i < 256; ++i) x[i] = expf(x[i] - mx) * inv; }
}
__device__ __forceinline__ void ph10c_out(const Params& P, long gtid, long nthr) {
    GS_LOOP(idx, (size_t)TOK * 1024) { const int c = (int)(idx % 1024); const long t = idx / 1024; const int b = (int)(t / SEQ), s = (int)(t % SEQ), h = c / 256;
        const float* pr = P.SCA + (((size_t)b * 4 + h) * SEQ + s) * 256; float a = 0.f;
        for (int m = 0; m < 256; ++m) a += pr[m] * bf2f(P.KV[((size_t)b * 256 + m) * 2048 + 1024 + c]);
        P.O[idx] = f2bf(a); }
}
__device__ __forceinline__ void ph13a_scores(const Params& P, long gtid, long nthr) {
    GS_LOOP(idx, (size_t)TOK * 2048) { const int k = (int)(idx % 128), z = (int)((idx / 128) % 2), h = (int)((idx / 256) % 8); const long t = idx / 2048;
        const bf16_t* q = P.QP + (size_t)t * 2048 + h * 256 + z * 128; const float* kr = P.in[I_SUBKEYS] + ((size_t)z * 128 + k) * 128; float a = 0.f;
        for (int c = 0; c < 128; ++c) a += bf2f(q[c]) * kr[c];
        P.SC[idx] = a; }
}
__device__ __forceinline__ void ph13b_topk(const Params& P, long gtid, long nthr) {
    GS_LOOP(row, (size_t)TOK * 16) { const float* x = P.SC + (size_t)row * 128; float pv = 0.f; int pi = -1;
        for (int j = 0; j < 16; ++j) { float best = 0.f; int bi = -1;
            for (int i = 0; i < 128; ++i) { const float v = x[i]; const bool elig = (j == 0) || (v < pv) || (v == pv && i > pi);
                if (elig && (bi < 0 || v > best)) { best = v; bi = i; } }
            P.TOPS[(size_t)row * 16 + j] = best; P.TOPI[(size_t)row * 16 + j] = bi; pv = best; pi = bi; } }
}
__device__ __forceinline__ void ph13c_cand(const Params& P, long gtid, long nthr) {
    GS_LOOP(row, (size_t)TOK * 8) { const float* s0 = P.TOPS + (size_t)row * 32; const float* s1 = s0 + 16; const int* i0 = P.TOPI + (size_t)row * 32; const int* i1 = i0 + 16;
        float pv = 0.f; int pi = -1; float mx = 0.f;
        for (int j = 0; j < 16; ++j) { float best = 0.f; int bi = -1;
            for (int c = 0; c < 256; ++c) { const float v = s0[c / 16] + s1[c % 16]; const bool elig = (j == 0) || (v < pv) || (v == pv && c > pi);
                if (elig && (bi < 0 || v > best)) { best = v; bi = c; } }
            if (j == 0) mx = best;
            P.GATE[(size_t)row * 16 + j] = best; P.EXPERT[(size_t)row * 16 + j] = i0[bi / 16] * 128 + i1[bi % 16]; pv = best; pi = bi; }
        float s = 0.f;
        for (int j = 0; j < 16; ++j) s += expf(P.GATE[(size_t)row * 16 + j] - mx);
        const float inv = 1.0f / s;
        for (int j = 0; j < 16; ++j) P.GATE[(size_t)row * 16 + j] = expf(P.GATE[(size_t)row * 16 + j] - mx) * inv; }
}
__device__ __forceinline__ void ph14a_act(const Params& P, long gtid, long nthr) {
    GS_LOOP(idx, (size_t)TOK * 128) { const long t = idx / 128; const bf16_t* x = P.HB + (size_t)t * 1024; const float* ur = P.in[I_PEER_U] + (size_t)P.EXPERT[idx] * 1024; float a = 0.f;
        for (int d = 0; d < 1024; ++d) a += ur[d] * bf2f(x[d]);
        P.COEF[idx] = P.GATE[idx] * geluf_(a); }
}
__device__ __forceinline__ void ph14b_out(const Params& P, long gtid, long nthr) {
    GS_LOOP(idx, (size_t)TOK * 1024) { const int d = (int)(idx % 1024); const long t = idx / 1024; float a = 0.f;
        for (int j = 0; j < 128; ++j) a += P.COEF[(size_t)t * 128 + j] * P.in[I_PEER_V][(size_t)P.EXPERT[(size_t)t * 128 + j] * 1024 + d];
        P.Y[idx] = a; }
}
__device__ __forceinline__ void ph14c_final(const Params& P, long gtid, long nthr) {
    GS_LOOP(row, TOK) { const bf16_t* hr = P.HB + (size_t)row * 1024; const float* yr = P.Y + (size_t)row * 1024; float s = 0.f;
        for (int i = 0; i < 1024; ++i) s += ALPHA_F * bf2f(hr[i]) + yr[i];
        const float mu = s / 1024.f; float q = 0.f;
        for (int i = 0; i < 1024; ++i) { const float d = ALPHA_F * bf2f(hr[i]) + yr[i] - mu; q += d * d; }
        const float rs = 1.0f / sqrtf(q / 1024.f + 1e-5f); float* o = P.out + (size_t)row * 1024;
        for (int i = 0; i < 1024; ++i) o[i] = (ALPHA_F * bf2f(hr[i]) + yr[i] - mu) * rs * P.in[I_LN3_G][i] + P.in[I_LN3_B][i]; }
}

static void make_params(Params& P, void* const* d_in, void* d_out, void* d_ws) {
    memset(&P, 0, sizeof(P));
    for (int i = 0; i < 37; ++i) P.in[i] = (const float*)d_in[i];
    P.out = (float*)d_out; unsigned char* ws = (unsigned char*)d_ws; unsigned char* ob = (unsigned char*)d_out;
    unsigned char* r1 = ws + A_R1; unsigned char* r2 = ws + A_R2;
    P.ctl = (unsigned*)(ws + WS_CTL);
    P.W_IN_T = (bf16_t*)(ws + WS_W + OFF_W_IN); P.W_BR_T = (bf16_t*)(ws + WS_W + OFF_W_BR); P.W_MIX_T = (bf16_t*)(ws + WS_W + OFF_W_MIX);
    P.W_Q_T = (bf16_t*)(ws + WS_W + OFF_W_Q); P.W_KV_T = (bf16_t*)(ws + WS_W + OFF_W_KV); P.W_O_T = (bf16_t*)(ws + WS_W + OFF_W_O); P.W_QUERY_T = (bf16_t*)(ws + WS_W + OFF_W_QUERY);
    P.KV = (bf16_t*)(ws + WS_KV); P.MEMN = (bf16_t*)(ws + WS_MEMN); P.HB = (bf16_t*)(ws + A_HB);
    P.PA = (bf16_t*)r1; P.PB = (bf16_t*)r2; P.VN = (bf16_t*)(r2 + 2 * TU);
    P.YB = (bf16_t*)ob; P.WDS = (bf16_t*)(ob + TU); P.ADS = (bf16_t*)(ob + TU + TU / 4); P.SG = (bf16_t*)(ob + TU + TU / 2);
    P.R = (bf16_t*)(ob + 2 * TU); P.KK = (bf16_t*)(ob + 3 * TU);
    P.V = (bf16_t*)r2; P.OMW = (bf16_t*)(r2 + TU); P.KDIR = (bf16_t*)(r2 + 3 * TU); P.BVEC = (bf16_t*)(r2 + 5 * TU);
    P.Y01 = (float*)r1; P.YA = (bf16_t*)(r2 + TU); P.BR = (bf16_t*)r1; P.MG = (bf16_t*)r2; P.Z = (float*)ob;
    P.Q = (bf16_t*)r1; P.O = (bf16_t*)(r1 + 2 * TU); P.SCA = (float*)r2; P.QP = (bf16_t*)ob;
    P.SC = (float*)r1; P.TOPS = (float*)(r2 + 4 * TU); P.TOPI = (int*)(r2 + 5 * TU); P.GATE = (float*)(r2 + 6 * TU); P.EXPERT = (int*)(r2 + 6 * TU + TU / 2);
    P.COEF = (float*)(r2 + 7 * TU); P.Y = (float*)r1;
    P.UB = (bf16_t*)r1; P.VB = (bf16_t*)(r1 + (size_t)16384 * 1024 * 2);
    P.W_LORA_T = (bf16_t*)(ws + WS_W + OFF_W_LORA);
    P.LIN = (bf16_t*)(ob + TU); P.K = (bf16_t*)(r2 + TU); P.OMW = (bf16_t*)(r2 + 2 * TU); P.AL = (bf16_t*)(r2 + 4 * TU); P.G = (bf16_t*)(r2 + 6 * TU);
    P.YA = (bf16_t*)(r2 + 2 * TU);
    P.KH = (bf16_t*)(ws + WS_KV); P.VT = (bf16_t*)(ws + WS_KV + 4 * MiB); P.QH = (bf16_t*)r1; P.PP = (bf16_t*)r2;
    P.GATE = (float*)(r2 + 6 * TU); P.EXPERT = (int*)(r2 + 6 * TU + TU / 2);
}

#ifndef NEW_PEER
#define NEW_PEER 1
#endif
#ifndef USE_DOT2
#define USE_DOT2 0
#endif
#ifndef ATT_OLD
#define ATT_OLD 0
#endif
#define AX (ATT_OLD ? 1 : 0)
#define N_PHASES (23 + AX)
__device__ __forceinline__ void run_simt_phase(const Params& P, int ph, long gtid, long nthr) {
    switch (ph) {
    case 0: ph0_weights(P, gtid, nthr);
            ln_rows_bf16(P.in[I_X], P.in[I_LN_EMB_G], P.in[I_LN_EMB_B], P.HB, TOK, 1024, gtid, nthr);
            ln_rows_bf16(P.in[I_MEM], P.in[I_MLN_G], P.in[I_MLN_B], P.MEMN, BATCH * MEM_LEN, 1024, gtid, nthr); break;
    case 2: ph2a_vn(P, gtid, nthr); break;
    case 3: ph2b_gmlp(P, gtid, nthr); break;
    case 4: ph3a_lora_in(P, gtid, nthr); break;
    case 5: ph3b_prep(P, gtid, nthr); break;
    case 7: ph5_rwkv_out(P, gtid, nthr); break;
    case 11: ph_ln_z(P, P.in[I_LN1_G], P.in[I_LN1_B], gtid, nthr); break;
    case 13: ph10a_scores(P, gtid, nthr); break;
    case 14: ph10b_softmax(P, gtid, nthr); break;
    case 15: ph10c_out(P, gtid, nthr); break;
    case 17: ph_ln_z(P, P.in[I_LN2_G], P.in[I_LN2_B], gtid, nthr); break;
    case 19: ph13a_scores(P, gtid, nthr); break;
    case 20: ph13b_topk(P, gtid, nthr); break;
    case 21: ph13c_cand(P, gtid, nthr); break;
    case 22: ph14a_act(P, gtid, nthr); break;
    case 23: ph14b_out(P, gtid, nthr); break;
    case 24: ph14c_final(P, gtid, nthr); break;
    default: break;
    }
}

#ifdef HOST_EMU
static void emu_run(const Params& P) {
    for (int ph = 0; ph < N_PHASES; ++ph) {
        switch (ph) {
        case 1:
            emu_gemm(P.HB, P.W_IN_T, TOK, 3072, 1024, [&](int r, int c, float a) { if (c < 2048) P.PA[(size_t)r * 2048 + c] = f2bf(a); else P.PB[(size_t)r * 1024 + c - 2048] = f2bf(geluf_(a)); });
            emu_gemm(P.MEMN, P.W_KV_T, BATCH * MEM_LEN, 2048, 1024, [&](int r, int c, float a) { P.KV[(size_t)r * 2048 + c] = f2bf(a); });
            break;
        case 6:
#pragma omp parallel for schedule(dynamic, 1)
            for (int it = 0; it < 2 * BATCH * 8 * 64; ++it) scan_item(P, it / 64, it % 64);
            break;
        case 8:
            emu_gemm(P.YA, P.W_BR_T, TOK, 1024, 512, [&](int r, int c, float a) { P.BR[(size_t)r * 2048 + c] = f2bf(a); });
            emu_gemm(P.YB, P.W_BR_T + (size_t)1024 * 512, TOK, 1024, 512, [&](int r, int c, float a) { P.BR[(size_t)r * 2048 + 1024 + c] = f2bf(a); });
            break;
        case 9: {
            float* tmp = (float*)malloc((size_t)TOK * 2048 * 4);
            emu_gemm(P.HB, P.W_IN_T + (size_t)3072 * 1024, TOK, 2048, 1024, [&](int r, int c, float a) { tmp[(size_t)r * 2048 + c] = a; });
            for (int r = 0; r < TOK; ++r) for (int n = 0; n < 1024; ++n) { const int j = n / 128, i = n % 128;
                const float g0 = tmp[(size_t)r * 2048 + 256 * j + i], g1 = tmp[(size_t)r * 2048 + 256 * j + 128 + i];
                P.MG[(size_t)r * 1024 + n] = f2bf(sigmoidf_(g0) * bf2f(P.BR[(size_t)r * 2048 + n]) + sigmoidf_(g1) * bf2f(P.BR[(size_t)r * 2048 + 1024 + n])); }
            free(tmp); } break;
        case 10: emu_gemm(P.MG, P.W_MIX_T, TOK, 1024, 1024, [&](int r, int c, float a) { P.Z[(size_t)r * 1024 + c] = ALPHA_F * bf2f(P.HB[(size_t)r * 1024 + c]) + a; }); break;
        case 12: emu_gemm(P.HB, P.W_Q_T, TOK, 1024, 1024, [&](int r, int c, float a) { P.Q[(size_t)r * 1024 + c] = f2bf(a); }); break;
        case 16: emu_gemm(P.O, P.W_O_T, TOK, 1024, 1024, [&](int r, int c, float a) { P.Z[(size_t)r * 1024 + c] = ALPHA_F * bf2f(P.HB[(size_t)r * 1024 + c]) + a; }); break;
        case 18: emu_gemm(P.HB, P.W_QUERY_T, TOK, 2048, 1024, [&](int r, int c, float a) { P.QP[(size_t)r * 2048 + c] = f2bf(a); }); break;
        default: {
            const long NT = 64;
#pragma omp parallel for schedule(static, 1)
            for (long g = 0; g < NT; ++g) run_simt_phase(P, ph, g, NT);
        } break;
        }
    }
}
extern "C" void kernel_launch(void* const* d_in, const int* in_sizes, int n_in, void* d_out, int out_size, void* d_ws, size_t ws_size, hipStream_t stream) {
    Params P; make_params(P, d_in, d_out, d_ws);
    memset(d_ws, 0, 1 << 20);
    emu_run(P);
}
#else

typedef float f32x4 __attribute__((ext_vector_type(4)));
typedef unsigned u32x4 __attribute__((ext_vector_type(4)));
typedef unsigned u32x2 __attribute__((ext_vector_type(2)));
typedef __bf16 bf16x2_t __attribute__((ext_vector_type(2)));
__device__ __forceinline__ float wave_sum(float v) {
#pragma unroll
    for (int o = 1; o < 64; o <<= 1) v += __shfl_xor(v, o);
    return v;
}
__device__ __forceinline__ float wave_max(float v) {
#pragma unroll
    for (int o = 1; o < 64; o <<= 1) v = fmaxf(v, __shfl_xor(v, o));
    return v;
}
__device__ __forceinline__ unsigned pk2(float lo, float hi) { return (unsigned)f2bf(lo) | ((unsigned)f2bf(hi) << 16); }
__device__ __forceinline__ float blo(unsigned w) { return __uint_as_float(w << 16); }
__device__ __forceinline__ float bhi(unsigned w) { return __uint_as_float(w & 0xffff0000u); }
__device__ __forceinline__ void wln_f32_bf16(const float* xrow, const float* g, const float* b, bf16_t* orow, int lane) {
    const f32x4* xr = (const f32x4*)xrow + lane; f32x4 v[4]; float s = 0.f;
#pragma unroll
    for (int j = 0; j < 4; ++j) { v[j] = xr[64 * j]; s += (v[j][0] + v[j][1]) + (v[j][2] + v[j][3]); }
    const float mean = wave_sum(s) * (1.f / 1024.f); float s2 = 0.f;
#pragma unroll
    for (int j = 0; j < 4; ++j) { v[j] = v[j] - mean; s2 += (v[j][0] * v[j][0] + v[j][1] * v[j][1]) + (v[j][2] * v[j][2] + v[j][3] * v[j][3]); }
    const float rstd = 1.f / sqrtf(wave_sum(s2) * (1.f / 1024.f) + 1e-5f);
#pragma unroll
    for (int j = 0; j < 4; ++j) { const f32x4 gg = ((const f32x4*)g)[64 * j + lane], bb = ((const f32x4*)b)[64 * j + lane]; const f32x4 o = v[j] * rstd * gg + bb;
        u32x2 w; w.x = pk2(o[0], o[1]); w.y = pk2(o[2], o[3]); *((u32x2*)orow + 64 * j + lane) = w; }
}
__device__ __forceinline__ void d_ln_rows(const float* in, const float* g, const float* b, bf16_t* out, int rows, int gw, int ngw, int lane) {
    for (int m = gw; m < rows; m += ngw) wln_f32_bf16(in + (size_t)m * 1024, g, b, out + (size_t)m * 1024, lane);
}
__device__ __forceinline__ void d_vn(const Params& P, int gw, int ngw, int lane) {
    const f32x4 g0 = ((const f32x4*)P.in[I_GLN_G])[2 * lane], g1 = ((const f32x4*)P.in[I_GLN_G])[2 * lane + 1];
    const f32x4 b0 = ((const f32x4*)P.in[I_GLN_B])[2 * lane], b1 = ((const f32x4*)P.in[I_GLN_B])[2 * lane + 1];
    for (int m = gw; m < TOK; m += ngw) {
        const u32x4 w = *((const u32x4*)(P.PB + (size_t)m * 1024 + 512) + lane);
        float x[8] = {blo(w.x), bhi(w.x), blo(w.y), bhi(w.y), blo(w.z), bhi(w.z), blo(w.w), bhi(w.w)};
        float s = 0.f;
#pragma unroll
        for (int i = 0; i < 8; ++i) s += x[i];
        const float mean = wave_sum(s) * (1.f / 512.f); float s2 = 0.f;
#pragma unroll
        for (int i = 0; i < 8; ++i) { x[i] -= mean; s2 += x[i] * x[i]; }
        const float rstd = 1.f / sqrtf(wave_sum(s2) * (1.f / 512.f) + 1e-5f);
        u32x4 o; o.x = pk2(x[0] * rstd * g0[0] + b0[0], x[1] * rstd * g0[1] + b0[1]); o.y = pk2(x[2] * rstd * g0[2] + b0[2], x[3] * rstd * g0[3] + b0[3]);
        o.z = pk2(x[4] * rstd * g1[0] + b1[0], x[5] * rstd * g1[1] + b1[1]); o.w = pk2(x[6] * rstd * g1[2] + b1[2], x[7] * rstd * g1[3] + b1[3]);
        *((u32x4*)(P.VN + (size_t)m * 512) + lane) = o;
    }
}
__device__ __forceinline__ void d_softmax256(const Params& P, int gw, int ngw, int lane) {
    for (long m = gw; m < (long)TOK * 4; m += ngw) { f32x4* xr = (f32x4*)(P.SCA + (size_t)m * 256) + lane; f32x4 v = *xr;
        const float mx = wave_max(fmaxf(fmaxf(v[0], v[1]), fmaxf(v[2], v[3])));
        v[0] = __expf(v[0] - mx); v[1] = __expf(v[1] - mx); v[2] = __expf(v[2] - mx); v[3] = __expf(v[3] - mx);
        const float inv = 1.0f / wave_sum((v[0] + v[1]) + (v[2] + v[3])); *xr = v * inv; }
}
__device__ __forceinline__ void tr_item(const float* W, int ldw, int src_col0, bf16_t* WT, int K, int dst_row0, int k0, LAS float* scr, int lane) {
    const int c = lane & 7;
    if (src_col0 < 0) {
#pragma unroll
        for (int j = 0; j < 4; ++j) { const int n = (lane >> 3) + 8 * j; *(u32x4*)(WT + (size_t)(dst_row0 + n) * K + k0 + 8 * c) = (u32x4){0u, 0u, 0u, 0u}; }
        return;
    }
#pragma unroll 8
    for (int i = 0; i < 32; ++i) { const int kk = 2 * i + (lane >> 5); scr[kk * 33 + (lane & 31)] = W[(size_t)(k0 + kk) * ldw + src_col0 + (lane & 31)]; }
    asm volatile("s_waitcnt lgkmcnt(0)" ::: "memory");
#pragma unroll
    for (int j = 0; j < 4; ++j) { const int n = (lane >> 3) + 8 * j; const LAS float* sp = scr + (8 * c) * 33 + n;
        u32x4 o; o.x = pk2(sp[0 * 33], sp[1 * 33]); o.y = pk2(sp[2 * 33], sp[3 * 33]); o.z = pk2(sp[4 * 33], sp[5 * 33]); o.w = pk2(sp[6 * 33], sp[7 * 33]);
        *(u32x4*)(WT + (size_t)(dst_row0 + n) * K + k0 + 8 * c) = o; }
    asm volatile("s_waitcnt lgkmcnt(0)" ::: "memory");
}
__device__ __forceinline__ void d_weights(const Params& P, LAS unsigned char* lds, int gw, int ngw, int wave, int lane) {
    LAS float* scr = (LAS float*)(lds + wave * 16384);
    constexpr int I_IN = 160 * 16, I_BR = 2 * 32 * 8, I_SQ = 32 * 16, I_WIDE = 64 * 16;
    constexpr int NITEMS = I_IN + I_BR + 3 * I_SQ + 2 * I_WIDE;
    for (int it = gw; it < NITEMS; it += ngw) {
        int r = it;
        if (r < I_IN) { const int nb = r / 16, kb = r % 16; tr_item(P.in[I_W_IN], IN_COLS, win_src_col(32 * nb), P.W_IN_T, 1024, 32 * nb, 64 * kb, scr, lane); continue; } r -= I_IN;
        if (r < I_BR) { const int br = r / 256, q = r % 256, nb = q / 8, kb = q % 8; tr_item(P.in[I_W_BRANCH] + (size_t)br * 512 * 1024, 1024, 32 * nb, P.W_BR_T, 512, br * 1024 + 32 * nb, 64 * kb, scr, lane); continue; } r -= I_BR;
        if (r < 3 * I_SQ) { const int w = r / I_SQ, q = r % I_SQ, nb = q / 16, kb = q % 16;
            const float* src = (w == 0) ? P.in[I_W_MIX] : (w == 1) ? P.in[I_W_Q] : P.in[I_W_O]; bf16_t* dst = (w == 0) ? P.W_MIX_T : (w == 1) ? P.W_Q_T : P.W_O_T;
            tr_item(src, 1024, 32 * nb, dst, 1024, 32 * nb, 64 * kb, scr, lane); continue; } r -= 3 * I_SQ;
        { const int w = r / I_WIDE, q = r % I_WIDE, nb = q / 16, kb = q % 16;
            tr_item(w == 0 ? P.in[I_W_KV] : P.in[I_W_QUERY], 2048, 32 * nb, w == 0 ? P.W_KV_T : P.W_QUERY_T, 1024, 32 * nb, 64 * kb, scr, lane); }
    }
}
__device__ __forceinline__ void d_tables(const Params& P, long gtid, long nthr) {
    const long n8 = (long)16384 * 1024 / 8;
    for (long i = gtid; i < 2 * n8; i += nthr) { const bool isv = (i >= n8); const long j = isv ? i - n8 : i;
        const f32x4* src = (const f32x4*)(isv ? P.in[I_PEER_V] : P.in[I_PEER_U]) + 2 * j; const f32x4 a = src[0], b = src[1];
        u32x4 o; o.x = pk2(a[0], a[1]); o.y = pk2(a[2], a[3]); o.z = pk2(b[0], b[1]); o.w = pk2(b[2], b[3]);
        *((u32x4*)(isv ? P.VB : P.UB) + j) = o; }
}
__device__ __forceinline__ float dot8(const u32x4& a, const u32x4& b, float acc) {
#if USE_DOT2
    acc = __builtin_amdgcn_fdot2_f32_bf16(__builtin_bit_cast(bf16x2_t, a.x), __builtin_bit_cast(bf16x2_t, b.x), acc, false);
    acc = __builtin_amdgcn_fdot2_f32_bf16(__builtin_bit_cast(bf16x2_t, a.y), __builtin_bit_cast(bf16x2_t, b.y), acc, false);
    acc = __builtin_amdgcn_fdot2_f32_bf16(__builtin_bit_cast(bf16x2_t, a.z), __builtin_bit_cast(bf16x2_t, b.z), acc, false);
    acc = __builtin_amdgcn_fdot2_f32_bf16(__builtin_bit_cast(bf16x2_t, a.w), __builtin_bit_cast(bf16x2_t, b.w), acc, false);
#else
    acc += blo(a.x) * blo(b.x); acc += bhi(a.x) * bhi(b.x); acc += blo(a.y) * blo(b.y); acc += bhi(a.y) * bhi(b.y);
    acc += blo(a.z) * blo(b.z); acc += bhi(a.z) * bhi(b.z); acc += blo(a.w) * blo(b.w); acc += bhi(a.w) * bhi(b.w);
#endif
    return acc;
}
__device__ __forceinline__ void axpy8(float* y, float c, const u32x4& v) {
    y[0] += c * blo(v.x); y[1] += c * bhi(v.x); y[2] += c * blo(v.y); y[3] += c * bhi(v.y);
    y[4] += c * blo(v.z); y[5] += c * bhi(v.z); y[6] += c * blo(v.w); y[7] += c * bhi(v.w);
}
__device__ __forceinline__ void d_peer(const Params& P, int gw, int ngw, int lane) {
    for (long t = gw; t < TOK; t += ngw) {
        const u32x4* xr = (const u32x4*)(P.HB + (size_t)t * 1024); const u32x4 x0 = xr[lane], x1 = xr[64 + lane];
        const int e_lo = P.EXPERT[(size_t)t * 128 + lane], e_hi = P.EXPERT[(size_t)t * 128 + 64 + lane];
        const float g_lo = P.GATE[(size_t)t * 128 + lane], g_hi = P.GATE[(size_t)t * 128 + 64 + lane];
        float y[16];
#pragma unroll
        for (int i = 0; i < 16; ++i) y[i] = 0.f;
#pragma unroll 1
        for (int half = 0; half < 2; ++half) {
            const int ev = half ? e_hi : e_lo; const float gv = half ? g_hi : g_lo;
#pragma unroll 1
            for (int k0 = 0; k0 < 64; k0 += 4) {
                int e[4]; float gt[4]; u32x4 u0[4], u1[4], v0[4], v1[4];
#pragma unroll
                for (int q = 0; q < 4; ++q) { e[q] = __builtin_amdgcn_readlane(ev, k0 + q); gt[q] = __uint_as_float(__builtin_amdgcn_readlane(__float_as_uint(gv), k0 + q)); }
#pragma unroll
                for (int q = 0; q < 4; ++q) { const u32x4* ur = (const u32x4*)(P.UB + (size_t)e[q] * 1024); u0[q] = ur[lane]; u1[q] = ur[64 + lane]; }
#pragma unroll
                for (int q = 0; q < 4; ++q) { const u32x4* vr = (const u32x4*)(P.VB + (size_t)e[q] * 1024); v0[q] = vr[lane]; v1[q] = vr[64 + lane]; }
                float d[4];
#pragma unroll
                for (int q = 0; q < 4; ++q) d[q] = dot8(u1[q], x1, dot8(u0[q], x0, 0.f));
#pragma unroll
                for (int o = 1; o < 64; o <<= 1) {
#pragma unroll
                    for (int q = 0; q < 4; ++q) d[q] += __shfl_xor(d[q], o); }
#pragma unroll
                for (int q = 0; q < 4; ++q) { const float a = d[q]; const float c = gt[q] * 0.5f * a * (1.0f + erff(a * 0.7071067811865476f)); axpy8(y, c, v0[q]); axpy8(y + 8, c, v1[q]); }
            }
        }
        float z[16];
        z[0] = ALPHA_F * blo(x0.x) + y[0]; z[1] = ALPHA_F * bhi(x0.x) + y[1]; z[2] = ALPHA_F * blo(x0.y) + y[2]; z[3] = ALPHA_F * bhi(x0.y) + y[3];
        z[4] = ALPHA_F * blo(x0.z) + y[4]; z[5] = ALPHA_F * bhi(x0.z) + y[5]; z[6] = ALPHA_F * blo(x0.w) + y[6]; z[7] = ALPHA_F * bhi(x0.w) + y[7];
        z[8] = ALPHA_F * blo(x1.x) + y[8]; z[9] = ALPHA_F * bhi(x1.x) + y[9]; z[10] = ALPHA_F * blo(x1.y) + y[10]; z[11] = ALPHA_F * bhi(x1.y) + y[11];
        z[12] = ALPHA_F * blo(x1.z) + y[12]; z[13] = ALPHA_F * bhi(x1.z) + y[13]; z[14] = ALPHA_F * blo(x1.w) + y[14]; z[15] = ALPHA_F * bhi(x1.w) + y[15];
        float s = 0.f;
#pragma unroll
        for (int i = 0; i < 16; ++i) s += z[i];
        const float mean = wave_sum(s) * (1.f / 1024.f); float s2 = 0.f;
#pragma unroll
        for (int i = 0; i < 16; ++i) { z[i] -= mean; s2 += z[i] * z[i]; }
        const float rstd = 1.f / sqrtf(wave_sum(s2) * (1.f / 1024.f) + 1e-5f);
        const float* g = P.in[I_LN3_G]; const float* b = P.in[I_LN3_B]; float* orow = P.out + (size_t)t * 1024;
#pragma unroll
        for (int hh = 0; hh < 2; ++hh)
#pragma unroll
            for (int q = 0; q < 2; ++q) { const int col = hh * 512 + lane * 8 + q * 4; const f32x4 gg = *(const f32x4*)(g + col), bb = *(const f32x4*)(b + col);
                f32x4 o; o[0] = z[hh * 8 + q * 4 + 0] * rstd * gg[0] + bb[0]; o[1] = z[hh * 8 + q * 4 + 1] * rstd * gg[1] + bb[1];
                o[2] = z[hh * 8 + q * 4 + 2] * rstd * gg[2] + bb[2]; o[3] = z[hh * 8 + q * 4 + 3] * rstd * gg[3] + bb[3];
                *(f32x4*)(orow + col) = o; }
    }
}

__device__ __forceinline__ void d_lora_weights(const Params& P, long gtid, long nthr) {
    for (long idx = gtid; idx < (long)2560 * 512; idx += nthr) { const int n = (int)(idx / 512), k = (int)(idx % 512); float v = 0.f;
        if (n < 1024) { const int z = n >> 9, c = n & 511; if (k >= z * 64 && k < z * 64 + 64) v = P.in[I_W2][((size_t)z * 64 + (k - z * 64)) * 512 + c]; }
        else if (n < 2048) { const int z = (n - 1024) >> 9, c = n & 511; const int kk = k - 128; if (kk >= z * 64 && kk < z * 64 + 64) v = P.in[I_A2][((size_t)z * 64 + (kk - z * 64)) * 512 + c]; }
        else { const int c = n - 2048; if (k >= 256 && k < 384) v = P.in[I_G2][(size_t)(k - 256) * 512 + c]; }
        P.W_LORA_T[idx] = f2bf(v); }
}
__device__ __forceinline__ void shift8(const bf16_t* PA, long t, int s, int col, const float* mu, float* o) {
    const u32x4 c = *(const u32x4*)(PA + (size_t)t * 2048 + col);
    u32x4 p = (u32x4){0u, 0u, 0u, 0u}, n = (u32x4){0u, 0u, 0u, 0u};
    if (s > 0) p = *(const u32x4*)(PA + (size_t)(t - 1) * 2048 + col);
    if (s < SEQ - 1) n = *(const u32x4*)(PA + (size_t)(t + 1) * 2048 + col);
    const f32x4 m0 = *(const f32x4*)(mu + col), m1 = *(const f32x4*)(mu + col + 4);
    const float cc[8] = {blo(c.x), bhi(c.x), blo(c.y), bhi(c.y), blo(c.z), bhi(c.z), blo(c.w), bhi(c.w)};
    const float pp[8] = {blo(p.x), bhi(p.x), blo(p.y), bhi(p.y), blo(p.z), bhi(p.z), blo(p.w), bhi(p.w)};
    const float nn[8] = {blo(n.x), bhi(n.x), blo(n.y), bhi(n.y), blo(n.z), bhi(n.z), blo(n.w), bhi(n.w)};
#pragma unroll
    for (int i = 0; i < 8; ++i) { const float m = (i < 4) ? m0[i] : m1[i - 4]; o[i] = cc[i] + m * (0.5f * (pp[i] + nn[i]) - cc[i]); }
}
__device__ __forceinline__ u32x4 pack8f(const float* v) { u32x4 w; w.x = pk2(v[0], v[1]); w.y = pk2(v[2], v[3]); w.z = pk2(v[4], v[5]); w.w = pk2(v[6], v[7]); return w; }
__device__ __forceinline__ void d_prep_e1(const Params& P, int gw, int ngw, int lane) {
    const float* mu = P.in[I_MU];
    const f32x4 kk0 = *(const f32x4*)(P.in[I_K_K] + 8 * lane), kk1 = *(const f32x4*)(P.in[I_K_K] + 8 * lane + 4);
    for (long t = gw; t < TOK; t += ngw) { const int s = (int)(t % SEQ); float r[8], k[8], v[8];
        shift8(P.PA, t, s, 8 * lane, mu, r); shift8(P.PA, t, s, 512 + 8 * lane, mu, k); shift8(P.PA, t, s, 1024 + 8 * lane, mu, v);
        float q[8]; float ss = 0.f;
#pragma unroll
        for (int i = 0; i < 8; ++i) { q[i] = k[i] * ((i < 4) ? kk0[i] : kk1[i - 4]); ss += q[i] * q[i]; }
        ss += __shfl_xor(ss, 1); ss += __shfl_xor(ss, 2); ss += __shfl_xor(ss, 4);
        const float inv = 1.0f / fmaxf(sqrtf(ss), 1e-12f);
#pragma unroll
        for (int i = 0; i < 8; ++i) q[i] *= inv;
        *(u32x4*)(P.R + (size_t)t * 512 + 8 * lane) = pack8f(r); *(u32x4*)(P.K + (size_t)t * 512 + 8 * lane) = pack8f(k);
        *(u32x4*)(P.V + (size_t)t * 512 + 8 * lane) = pack8f(v); *(u32x4*)(P.KK + (size_t)t * 512 + 8 * lane) = pack8f(q);
        if (lane < 48) { float x[8]; shift8(P.PA, t, s, 1536 + 8 * lane, mu, x);
#pragma unroll
            for (int i = 0; i < 8; ++i) x[i] = (lane < 16) ? tanhf(x[i]) : (lane < 32) ? x[i] : 1.0f / (1.0f + expf(-x[i]));
            *(u32x4*)(P.LIN + (size_t)t * 512 + 8 * lane) = pack8f(x); }
        else *(u32x4*)(P.LIN + (size_t)t * 512 + 8 * lane) = (u32x4){0u, 0u, 0u, 0u};
    }
}
__device__ __forceinline__ void scan_item3(const Params& P, int chain, int i) {
    const int h = chain % 8, b = (chain / 8) % BATCH, z = chain / (8 * BATCH);
    float S[64];
#pragma unroll
    for (int j = 0; j < 64; ++j) S[j] = 0.f;
    const float* ka = P.in[I_K_A] + h * 64;
    for (int n = 0; n < SEQ; ++n) {
        const long t = (long)b * SEQ + ((z == 0) ? n : (SEQ - 1 - n)); const size_t o1 = (size_t)t * 512 + h * 64, o2 = ((size_t)t * 2 + z) * 512 + h * 64;
        const float v = bf2f(P.V[o1 + i]);
        float sa = 0.f;
#pragma unroll
        for (int j = 0; j < 64; ++j) sa -= S[j] * bf2f(P.KK[o1 + j]);
        float y = 0.f;
#pragma unroll
        for (int j = 0; j < 64; ++j) { const float al = bf2f(P.AL[o2 + j]), k = bf2f(P.K[o1 + j]);
            S[j] = S[j] * (1.0f - bf2f(P.OMW[o2 + j])) + sa * (bf2f(P.KK[o1 + j]) * al) + v * (k * (1.0f + (al - 1.0f) * ka[j])); y += S[j] * bf2f(P.R[o1 + j]); }
        P.Y01[((size_t)z * TOK + t) * 512 + h * 64 + i] = y;
    }
}
__device__ __forceinline__ void d_rwkv_out(const Params& P, int gw, int ngw, int lane) {
    for (long it = gw; it < (long)TOK * 8; it += ngw) { const long t = it >> 3; const int c = (int)(it & 7) * 64 + lane;
        const float y = P.Y01[(size_t)t * 512 + c] + P.Y01[((size_t)TOK + t) * 512 + c];
        const float mu = wave_sum(y) * (1.f / 64.f); const float d = y - mu; const float rs = 1.0f / sqrtf(wave_sum(d * d) * (1.f / 64.f) + 64e-5f);
        const float yn = d * rs * P.in[I_GN_G][c] + P.in[I_GN_B][c];
        const float r = bf2f(P.R[(size_t)t * 512 + c]), k = bf2f(P.K[(size_t)t * 512 + c]), ka = P.in[I_K_A][c];
        const float a0 = bf2f(P.AL[((size_t)t * 2) * 512 + c]), a1 = bf2f(P.AL[((size_t)t * 2 + 1) * 512 + c]);
        const float kd = k * (1.0f + (a0 - 1.0f) * ka) + k * (1.0f + (a1 - 1.0f) * ka);
        const float rk = wave_sum(r * kd * P.in[I_R_K][c]);
        P.YA[(size_t)t * 512 + c] = f2bf((yn + rk * bf2f(P.V[(size_t)t * 512 + c])) * bf2f(P.G[(size_t)t * 512 + c])); }
}
constexpr int RING_BYTES = 131072, LDSCTL_OFF = RING_BYTES, MISC_OFF = LDSCTL_OFF + 320, LDS_BYTES = 147456;
constexpr int CW_BAR = 4096;
#ifndef MK_PER_PHASE
#define MK_PER_PHASE 0
#endif
struct KArgs { Params P; int ph_lo, ph_hi; };
template <class DE, bool ALIGN = true> __device__ __forceinline__ void run_gemm(LAS unsigned char* lds, const bf16_t* A, const bf16_t* Bt, int M, int N, int K, const DE& E,
                                                                     int bgrp = 1 << 30, size_t bgstride = 0) {
    pg8::Gemm g{A, Bt, M, N, K, K, K, bgrp, bgstride}; pg8::StaticOrder S; S.init(M, N, (int)gridDim.x, (int)blockIdx.x);
    pg8::gemm_phase<DE, pg8::StaticOrder, ALIGN, true>(lds, g, S, E);
}
__global__ void __launch_bounds__(512, 2) mega_fwd(KArgs a) {
    extern __shared__ __attribute__((aligned(16))) unsigned char lds_raw[];
    LAS unsigned char* lds = (LAS unsigned char*)lds_raw;
    volatile LAS unsigned* MISC = (volatile LAS unsigned*)(lds + MISC_OFF);
    const Params& P = a.P;
    const int tid = threadIdx.x;
    for (int u = tid; u < (LDS_BYTES - LDSCTL_OFF) / 4; u += 512) ((LAS unsigned*)(lds + LDSCTL_OFF))[u] = 0u;
    __syncthreads();
    XcdBarrier bar; bar.bar = P.ctl + CW_BAR; bar.x = 0; bar.st = nullptr;
    if (!MK_PER_PHASE) bar = xcd_barrier_post(P.ctl + CW_BAR, MISC + 8);
    const long gtid = (long)blockIdx.x * 512 + tid, nthr = (long)gridDim.x * 512;
    const int lane = tid & 63, wave = __builtin_amdgcn_readfirstlane(tid >> 6), gw = (int)blockIdx.x * 8 + wave, ngw = (int)gridDim.x * 8;
    const int lo = a.ph_lo, hi = a.ph_hi;
#define IN(k) (lo <= (k) && (k) < hi)
#define SEAM(k) do { if ((k) + 1 < hi) xcd_barrier(bar); } while (0)
#define SIMT(k, call) if (IN(k)) { call; SEAM(k); }
    SIMT(0, (d_weights(P, lds, gw, ngw, wave, lane), d_lora_weights(P, gtid, nthr), d_ln_rows(P.in[I_X], P.in[I_LN_EMB_G], P.in[I_LN_EMB_B], P.HB, TOK, gw, ngw, lane),
             d_ln_rows(P.in[I_MEM], P.in[I_MLN_G], P.in[I_MLN_B], P.MEMN, BATCH * MEM_LEN, gw, ngw, lane)))
    if (IN(1)) { { pg8::DEpiP1 E{{P.PA, P.PB}}; run_gemm(lds, P.HB, P.W_IN_T, TOK, 3072, 1024, E); }
#if ATT_OLD
                 { pg8::DEpiPlain E2{{P.KV, 2048, 0}}; run_gemm(lds, P.MEMN, P.W_KV_T, BATCH * MEM_LEN, 2048, 1024, E2); } SEAM(1); }
#else
                 { pg8::DEpiTile E2{P.KH, 4, 1, 1.0f}; run_gemm(lds, P.MEMN, P.W_KV_T, BATCH * MEM_LEN, 1024, 1024, E2); }
                 { pg8::DEpiTile E3{P.VT, 1, 4, 1.0f}; run_gemm(lds, P.W_KV_T + (size_t)1024 * 1024, P.MEMN, 1024, BATCH * MEM_LEN, 1024, E3); } SEAM(1); }
#endif
    SIMT(2, d_vn(P, gw, ngw, lane))
    SIMT(3, ph2b_gmlp(P, gtid, nthr))
    SIMT(4, d_prep_e1(P, gw, ngw, lane))
    if (IN(5)) { { pg8::DEpiLora<0> E{P.in[I_W0], P.OMW}; run_gemm(lds, P.LIN, P.W_LORA_T, TOK, 1024, 512, E); }
                 { pg8::DEpiLora<1> E{P.in[I_A0], P.AL}; run_gemm(lds, P.LIN, P.W_LORA_T + (size_t)1024 * 512, TOK, 1024, 512, E); }
                 { pg8::DEpiLora<2> E{nullptr, P.G}; run_gemm(lds, P.LIN, P.W_LORA_T + (size_t)2048 * 512, TOK, 512, 512, E); } SEAM(5); }
    if (IN(6)) { const int chain = (int)blockIdx.x + (int)gridDim.x * wave; if (chain < 2 * BATCH * 8) scan_item3(P, chain, lane); SEAM(6); }
    SIMT(7, d_rwkv_out(P, gw, ngw, lane))
    if (IN(8)) { { pg8::DEpiPlain E{{P.BR, 2048, 0}}; run_gemm(lds, P.YA, P.W_BR_T, TOK, 1024, 512, E); }
                 { pg8::DEpiPlain E2{{P.BR, 2048, 1024}}; run_gemm(lds, P.YB, P.W_BR_T + (size_t)1024 * 512, TOK, 1024, 512, E2); } SEAM(8); }
    if (IN(9)) { pg8::DEpiMerge E{{P.BR, P.MG}}; run_gemm(lds, P.HB, P.W_IN_T + (size_t)3072 * 1024, TOK, 2048, 1024, E); SEAM(9); }
    if (IN(10)) { pg8::DEpiResid E{{P.HB, P.Z}}; run_gemm(lds, P.MG, P.W_MIX_T, TOK, 1024, 1024, E); SEAM(10); }
    SIMT(11, d_ln_rows(P.Z, P.in[I_LN1_G], P.in[I_LN1_B], P.HB, TOK, gw, ngw, lane))
#if ATT_OLD
    if (IN(12)) { pg8::DEpiPlain E{{P.Q, 1024, 0}}; run_gemm(lds, P.HB, P.W_Q_T, TOK, 1024, 1024, E); SEAM(12); }
    SIMT(13, ph10a_scores(P, gtid, nthr))
    SIMT(14, d_softmax256(P, gw, ngw, lane))
    SIMT(15, ph10c_out(P, gtid, nthr))
#else
    if (IN(12)) { pg8::DEpiQ EQ{{P.QH, 1, 0, 0.0625f}}; run_gemm(lds, P.HB, P.W_Q_T, TOK, 1024, 1024, EQ); SEAM(12); }
    if (IN(13)) { pg8::DEpiSoftmax E{P.PP}; run_gemm<pg8::DEpiSoftmax, false>(lds, P.QH, P.KH, TOK * 4, 256, 256, E, 8, (size_t)256 * 256 * 2); SEAM(13); }
    if (IN(14)) { pg8::DEpiO E{P.O}; run_gemm(lds, P.PP, P.VT, TOK * 4, 256, 256, E, 8, (size_t)256 * 256 * 2); SEAM(14); }
#endif
    if (IN(15 + AX)) { pg8::DEpiResid E{{P.HB, P.Z}}; run_gemm(lds, P.O, P.W_O_T, TOK, 1024, 1024, E); SEAM(15 + AX); }
    SIMT(16 + AX, d_ln_rows(P.Z, P.in[I_LN2_G], P.in[I_LN2_B], P.HB, TOK, gw, ngw, lane))
    if (IN(17 + AX)) { pg8::DEpiPlain E{{P.QP, 2048, 0}}; run_gemm(lds, P.HB, P.W_QUERY_T, TOK, 2048, 1024, E); SEAM(17 + AX); }
    SIMT(18 + AX, ph13a_scores(P, gtid, nthr))
    SIMT(19 + AX, ph13b_topk(P, gtid, nthr))
    SIMT(20 + AX, ph13c_cand(P, gtid, nthr))
    SIMT(21 + AX, d_tables(P, gtid, nthr))
    SIMT(22 + AX, d_peer(P, gw, ngw, lane))
#undef IN
#undef SEAM
#undef SIMT
}
extern "C" void kernel_launch(void* const* d_in, const int* in_sizes, int n_in, void* d_out, int out_size, void* d_ws, size_t ws_size, hipStream_t stream) {
    static int grid = 0;
    if (grid == 0) {
        int dev = 0, cus = 0;
        if (n_in != 37 || ws_size < WS_NEED || hipGetDevice(&dev) != hipSuccess || hipDeviceGetAttribute(&cus, hipDeviceAttributeMultiprocessorCount, dev) != hipSuccess) {
            fprintf(stderr, "kernel_launch: bad arguments (n_in %d, ws %zu < %zu)\n", n_in, ws_size, (size_t)WS_NEED); grid = -1; return; }
        if (hipFuncSetAttribute((const void*)mega_fwd, hipFuncAttributeMaxDynamicSharedMemorySize, LDS_BYTES) != hipSuccess) { fprintf(stderr, "kernel_launch: hipFuncSetAttribute failed\n"); grid = -1; return; }
        grid = cus;
    }
    if (grid < 0) return;
    (void)hipMemsetAsync((char*)d_ws + WS_CTL, 0, 1 * MiB, stream);
    KArgs a; memset(&a, 0, sizeof(a)); make_params(a.P, d_in, d_out, d_ws);
#if MK_PER_PHASE
    for (int ph = 0; ph < N_PHASES; ++ph) { a.ph_lo = ph; a.ph_hi = ph + 1; hipLaunchKernelGGL(mega_fwd, dim3(grid), dim3(512), LDS_BYTES, stream, a); }
#else
    a.ph_lo = 0; a.ph_hi = N_PHASES; hipLaunchKernelGGL(mega_fwd, dim3(grid), dim3(512), LDS_BYTES, stream, a);
#endif
}
#endif
```

```cpp
#ifdef HOST_EMU
#include "emu.h"
#else
#include <hip/hip_runtime.h>
#include <cstdio>
#include <cstdint>
#include <cstring>
#endif

#ifndef BATCH
#define BATCH 8
#endif
#ifndef SEQ
#define SEQ 2048
#endif
#define DM 1024
#define TOK (BATCH * SEQ)
#define IN_COLS 4992
#define MEM_LEN 256
#define ALPHA_F 1.189207115002721f
typedef unsigned short bf16_t;

#ifdef HOST_EMU
static inline float bf2f(bf16_t v) { unsigned u = (unsigned)v << 16; float f; memcpy(&f, &u, 4); return f; }
static inline bf16_t f2bf(float f) { unsigned u; memcpy(&u, &f, 4); return (bf16_t)((u + 0x7fffu + ((u >> 16) & 1u)) >> 16); }
#else
__device__ __forceinline__ float bf2f(bf16_t v) { return __uint_as_float((unsigned)v << 16); }
__device__ __forceinline__ bf16_t f2bf(float f) { unsigned u = __float_as_uint(f); return (bf16_t)((u + 0x7fffu + ((u >> 16) & 1u)) >> 16); }
#endif
__device__ __forceinline__ float sigmoidf_(float x) { return 1.0f / (1.0f + expf(-x)); }
__device__ __forceinline__ float geluf_(float x) { return 0.5f * x * (1.0f + erff(x * 0.7071067811865476f)); }

struct Params {
    const float* in[37];
    float* out;
    unsigned* ctl;
    bf16_t *W_IN_T, *W_BR_T, *W_MIX_T, *W_Q_T, *W_KV_T, *W_O_T, *W_QUERY_T;
    bf16_t *KV, *MEMN, *HB;
    bf16_t *PA, *PB, *VN, *YB;
    bf16_t *WDS, *ADS, *SG;
    bf16_t *R, *V, *KK, *OMW, *KDIR, *BVEC;
    float *Y01;
    bf16_t *YA, *BR, *MG;
    float* Z;
    bf16_t *Q, *O;
    float* SCA;
    bf16_t* QP;
    float* SC; float* TOPS; int* TOPI; float* GATE; int* EXPERT; float* COEF; float* Y;
    bf16_t *UB, *VB;
    bf16_t *W_LORA_T;
    bf16_t *LIN, *K, *AL, *G;
    bf16_t *KH, *VT, *QH, *PP;
};
enum { I_X = 0, I_MEM, I_LN_EMB_G, I_LN_EMB_B, I_W_IN, I_MU, I_W0, I_W2, I_A0, I_A2, I_G2, I_K_K, I_K_A, I_R_K, I_GN_G, I_GN_B,
       I_GLN_G, I_GLN_B, I_W_S, I_B_S, I_W_BRANCH, I_W_MIX, I_LN1_G, I_LN1_B, I_MLN_G, I_MLN_B, I_W_Q, I_W_KV, I_W_O, I_LN2_G, I_LN2_B,
       I_W_QUERY, I_SUBKEYS, I_PEER_U, I_PEER_V, I_LN3_G, I_LN3_B };

constexpr size_t MiB = 1u << 20;
constexpr size_t TU = (size_t)TOK * 1024;
constexpr size_t WS_CTL = 0;
constexpr size_t WS_W = 1 * MiB;
constexpr size_t OFF_W_IN = 0, OFF_W_BR = OFF_W_IN + (size_t)5120 * 1024 * 2, OFF_W_MIX = OFF_W_BR + (size_t)2048 * 512 * 2,
                 OFF_W_Q = OFF_W_MIX + (size_t)1024 * 1024 * 2, OFF_W_KV = OFF_W_Q + (size_t)1024 * 1024 * 2,
                 OFF_W_O = OFF_W_KV + (size_t)2048 * 1024 * 2, OFF_W_QUERY = OFF_W_O + (size_t)1024 * 1024 * 2,
                 OFF_W_END = OFF_W_QUERY + (size_t)2048 * 1024 * 2;
static_assert(OFF_W_END <= 27 * MiB, "weights region");
constexpr size_t OFF_W_LORA = OFF_W_END, OFF_W_END2 = OFF_W_LORA + (size_t)2560 * 512 * 2;
static_assert(OFF_W_END2 <= 29 * MiB, "weights region 2");
constexpr size_t WS_KV = 30 * MiB;
constexpr size_t WS_MEMN = 38 * MiB;
constexpr size_t WS_ACT = 42 * MiB;
constexpr size_t A_HB = WS_ACT;
constexpr size_t A_R1 = A_HB + 2 * TU;
constexpr size_t A_R2 = A_R1 + 4 * TU;
constexpr size_t WS_NEED = A_R2 + 7 * TU;
#ifndef HOST_EMU
static_assert(WS_NEED <= 256 * MiB, "workspace map exceeds 256 MiB");
#endif

struct EpiP1 { bf16_t* PA; bf16_t* PB; };
struct EpiPlain { bf16_t* O; int ldc; int col_off; };
struct EpiMerge { const bf16_t* BR; bf16_t* MG; };
struct EpiResid { const bf16_t* H; float* Z; };

#ifndef HOST_EMU
namespace pg8 {
#define PG8_LAS __attribute__((address_space(3)))
typedef unsigned short bf16_t;
typedef short bf16x8 __attribute__((ext_vector_type(8)));
typedef float f32x4 __attribute__((ext_vector_type(4)));
typedef unsigned u32x4 __attribute__((ext_vector_type(4)));
constexpr int BM = 256, BK = 64, HALF = 128, HTB = HALF * BK * 2  , STAGE_BYTES = 8 * HTB, NXCD = 8, WGM = 8;

__host__ __device__ __forceinline__ int lds_byte(int r, int c) { const int st = (r >> 4) * 2 + (c >> 5), rr = r & 15, cc = c & 31, ob = rr * 64 + cc * 2; return st * 1024 + (ob ^ (((ob >> 9) & 1) << 5)); }
__host__ __device__ __forceinline__ void stage_rc(int b, int& R, int& C) { const int st = b / 1024, sb = b % 1024, swz = sb ^ (((sb >> 9) & 1) << 5); R = (st >> 1) * 16 + swz / 64; C = (st & 1) * 32 + (swz % 64) / 2; }
__host__ __device__ __forceinline__ int perm32(int rho) { const int n = rho >> 4, i = rho & 15; return 8 * (i >> 2) + 4 * n + (i & 3); }

struct Unit { int pm, pn; };
struct Gemm { const bf16_t* A; const bf16_t* Bt; int M, N, K; int lda, ldb; int bgrp; size_t bgstride; };

struct StaticOrder {
    int nM, nN, nwg, G, c;
    __host__ __device__ void init(int M, int N, int G_, int c_) { nM = M / BM; nN = N / BM; nwg = nM * nN; G = G_; c = c_; }
    __host__ __device__ bool next(int i, Unit& u) const {
        const long L = (long)i * G + c; if (L >= nwg) return false;
        int wgid = (int)L; { const int q = nwg / NXCD, r = nwg % NXCD, xcd = wgid % NXCD, off = wgid / NXCD; wgid = (xcd < r ? xcd * (q + 1) : r * (q + 1) + (xcd - r) * q) + off; }
        const int nig = WGM * nN, gid = wgid / nig, fm = gid * WGM, gsz = (nM - fm) < WGM ? (nM - fm) : WGM;
        u.pm = fm + ((wgid % nig) % gsz); u.pn = (wgid % nig) / gsz; return true;
    }
    __device__ __forceinline__ void a_ready(const Unit&) const {}
    __device__ __forceinline__ void done(const Unit&) const {}
};

typedef float f32x2c __attribute__((ext_vector_type(2))); typedef __bf16 bf16x2c __attribute__((ext_vector_type(2)));
__device__ __forceinline__ unsigned cvt_pk_bf16(float lo, float hi) { const f32x2c v = {lo, hi}; const bf16x2c b = __builtin_convertvector(v, bf16x2c); return __builtin_bit_cast(unsigned, b); }
typedef float f32x2 __attribute__((ext_vector_type(2)));
__device__ __forceinline__ f32x2 gelu_pk(f32x2 v) {
    const f32x2 av = __builtin_elementwise_abs(v), d = av * 0.2316418882f + 1.0f;
    f32x2 t; t.x = __builtin_amdgcn_rcpf(d.x); t.y = __builtin_amdgcn_rcpf(d.y);
    f32x2 q = t * 0.5307027145f + (-0.7265760135f); q = q * t + 0.7107068705f; q = q * t + (-0.142248368f); q = q * t + 0.127414796f; q = q * t;
    const f32x2 s = (v * v) * (-0.72134752044f);
    f32x2 e; e.x = __builtin_amdgcn_exp2f(s.x); e.y = __builtin_amdgcn_exp2f(s.y);
    const f32x2 m = v * (q * e), r = v - m;
    f32x2 o; o.x = v.x < 0.f ? m.x : r.x; o.y = v.y < 0.f ? m.y : r.y; return o;
}


template <class Epi, class Sched, bool ALIGN_EPI = false, bool SP2 = false>
__device__ __forceinline__ void gemm_phase(PG8_LAS unsigned char* lds, const Gemm g, const Sched& S, const Epi& E) {
    const int tid = threadIdx.x, wid = __builtin_amdgcn_readfirstlane(tid >> 6), lane = tid & 63, wr = wid >> 2, wc = wid & 3, fr = lane & 15, fq = lane >> 4;
    const int K = g.K, nt = K / BK;
    unsigned voffA[2], voffB[2];
#pragma unroll
    for (int i = 0; i < 2; ++i) { int R, C; stage_rc(tid * 16 + i * 8192, R, C); const int Rb = Epi::PERM ? ((R & ~31) + perm32(R & 31)) : R;
        voffA[i] = (unsigned)(R * g.lda + C) * 2u; voffB[i] = (unsigned)(Rb * g.ldb + C) * 2u; }
    const size_t kstep = (size_t)(BK * 2);
    const size_t hstepA = (size_t)HALF * g.lda * 2, hstepB = (size_t)HALF * g.ldb * 2;
    const size_t tstepA = 2 * hstepA, tstepB = 2 * hstepB;
    const unsigned ldsw = (unsigned)wid * 1024u;
    const int aoff = lds_byte(wr * 64 + fr, fq * 8), boff = lds_byte(wc * 32 + fr, fq * 8);
#define PG8_SA(b, h) (((b) * 2 + (h)) * HTB)
#define PG8_SB(b, h) ((4 + (b) * 2 + (h)) * HTB)
#define PG8_STAGE(bufoff, gbase, voff) do { _Pragma("unroll") for (int _i = 0; _i < 2; ++_i) \
        __builtin_amdgcn_global_load_lds((const unsigned*)((const char*)(gbase) + (voff)[_i]), (PG8_LAS unsigned*)(lds + (bufoff) + ldsw + _i * 8192), 16, 0, 0); } while (0)
#define PG8_LDA(dst, b, h) do { _Pragma("unroll") for (int m = 0; m < 4; ++m) _Pragma("unroll") for (int k = 0; k < 2; ++k) dst[m][k] = *(const PG8_LAS bf16x8*)(lds + PG8_SA(b, h) + aoff + m * 2048 + k * 1024); } while (0)
#define PG8_LDB(dst, b, h) do { _Pragma("unroll") for (int n = 0; n < 2; ++n) _Pragma("unroll") for (int k = 0; k < 2; ++k) dst[n][k] = *(const PG8_LAS bf16x8*)(lds + PG8_SB(b, h) + boff + n * 2048 + k * 1024); } while (0)
#define PG8_MMA(ai, bj, At, Bt) do { __builtin_amdgcn_s_setprio(1); _Pragma("unroll") for (int m = 0; m < 4; ++m) _Pragma("unroll") for (int n = 0; n < 2; ++n) _Pragma("unroll") for (int k = 0; k < 2; ++k) \
        acc[ai][bj][m][n] = __builtin_amdgcn_mfma_f32_16x16x32_bf16(Bt[n][k], At[m][k], acc[ai][bj][m][n], 0, 0, 0); __builtin_amdgcn_s_setprio(0); } while (0)
#define PG8_WAIT_V(n) asm volatile("s_waitcnt vmcnt(" #n ")" ::: "memory")
#define PG8_WAIT_L(n) asm volatile("s_waitcnt lgkmcnt(" #n ")" ::: "memory")
#define PG8_BAR __builtin_amdgcn_s_barrier()
#define PG8_SCHED __builtin_amdgcn_sched_barrier(0)
    Unit cur, nxt; int ui = 0;
    if (!S.next(0, cur)) return;
    f32x4 acc[2][2][4][2];
#pragma unroll
    for (int a = 0; a < 2; ++a)
#pragma unroll
        for (int b = 0; b < 2; ++b)
#pragma unroll
            for (int m = 0; m < 4; ++m)
#pragma unroll
                for (int n = 0; n < 2; ++n) acc[a][b][m][n] = (f32x4){0.f, 0.f, 0.f, 0.f};
    bf16x8 At[4][2], B0[2][2], B1[2][2];
    const char* cA = (const char*)g.A + (size_t)cur.pm * tstepA; const char* cB = (const char*)g.Bt + (size_t)cur.pn * tstepB + (size_t)(cur.pm / g.bgrp) * g.bgstride;
    S.a_ready(cur);
    if constexpr (SP2) {
        PG8_STAGE(PG8_SB(0, 0), cB, voffB); PG8_STAGE(PG8_SB(0, 1), cB + hstepB, voffB); PG8_STAGE(PG8_SA(0, 0), cA, voffA); PG8_STAGE(PG8_SA(0, 1), cA + hstepA, voffA);
        if (wr == 1) PG8_BAR;
        PG8_WAIT_V(2); PG8_BAR;
        PG8_STAGE(PG8_SB(1, 0), cB + kstep, voffB); PG8_STAGE(PG8_SA(1, 0), cA + kstep, voffA); PG8_STAGE(PG8_SB(1, 1), cB + hstepB + kstep, voffB);
        PG8_WAIT_V(6); PG8_BAR;
    } else {
        PG8_STAGE(PG8_SB(0, 0), cB, voffB); PG8_STAGE(PG8_SA(0, 0), cA, voffA); PG8_STAGE(PG8_SB(0, 1), cB + hstepB, voffB); PG8_STAGE(PG8_SA(0, 1), cA + hstepA, voffA);
        if (wr == 1) PG8_BAR;
        PG8_WAIT_V(4); PG8_BAR;
        PG8_STAGE(PG8_SB(1, 0), cB + kstep, voffB); PG8_STAGE(PG8_SA(1, 0), cA + kstep, voffA); PG8_STAGE(PG8_SB(1, 1), cB + hstepB + kstep, voffB);
        PG8_WAIT_V(6); PG8_BAR;
    }
    for (;;) {
        const bool has_next = S.next(ui + 1, nxt);
        const char* nA = has_next ? (const char*)g.A + (size_t)nxt.pm * tstepA : cA; const char* nB = has_next ? (const char*)g.Bt + (size_t)nxt.pn * tstepB + (size_t)(nxt.pm / g.bgrp) * g.bgstride : cB;
#pragma unroll 1
        for (int t = 0; t < nt; t += 2) {
            const bool last = (t == nt - 2);
            const char* a1 = cA + (size_t)(t + 1) * kstep;
            const char* a2 = last ? nA : cA + (size_t)(t + 2) * kstep; const char* b2 = last ? nB : cB + (size_t)(t + 2) * kstep;
            const char* a3 = a2 + kstep; const char* b3 = b2 + kstep;
            if (last && has_next) S.a_ready(nxt);
            if constexpr (SP2) {
            PG8_LDB(B0, 0, 0); PG8_LDB(B1, 0, 1); PG8_SCHED; PG8_LDA(At, 0, 0); PG8_STAGE(PG8_SA(1, 1), a1 + hstepA, voffA);
            PG8_WAIT_V(8); PG8_WAIT_L(0); PG8_BAR; PG8_MMA(0, 0, At, B0); PG8_MMA(0, 1, At, B1); PG8_BAR; PG8_SCHED;
            PG8_LDA(At, 0, 1); PG8_STAGE(PG8_SB(0, 0), b2, voffB); PG8_STAGE(PG8_SB(0, 1), b2 + hstepB, voffB); PG8_STAGE(PG8_SA(0, 0), a2, voffA);
            PG8_WAIT_V(8); PG8_WAIT_L(0); PG8_BAR; PG8_MMA(1, 0, At, B0); PG8_MMA(1, 1, At, B1); PG8_BAR; PG8_SCHED;
            PG8_LDB(B0, 1, 0); PG8_LDB(B1, 1, 1); PG8_SCHED; PG8_LDA(At, 1, 0); PG8_STAGE(PG8_SA(0, 1), a2 + hstepA, voffA);
            PG8_WAIT_V(8); PG8_WAIT_L(0); PG8_BAR; PG8_MMA(0, 0, At, B0); PG8_MMA(0, 1, At, B1); PG8_BAR; PG8_SCHED;
            PG8_LDA(At, 1, 1); PG8_STAGE(PG8_SB(1, 0), b3, voffB); PG8_STAGE(PG8_SB(1, 1), b3 + hstepB, voffB); PG8_STAGE(PG8_SA(1, 0), a3, voffA);
            PG8_WAIT_V(8); PG8_WAIT_L(0); PG8_BAR; PG8_MMA(1, 0, At, B0); PG8_MMA(1, 1, At, B1); PG8_BAR; PG8_SCHED;
            } else {
            PG8_LDB(B0, 0, 0); PG8_SCHED; PG8_LDA(At, 0, 0); PG8_STAGE(PG8_SA(1, 1), a1 + hstepA, voffA);
            PG8_WAIT_L(8); PG8_BAR; PG8_WAIT_L(0); PG8_MMA(0, 0, At, B0); PG8_BAR; PG8_SCHED;
            PG8_LDB(B1, 0, 1); PG8_STAGE(PG8_SB(0, 0), b2, voffB);
            PG8_BAR; PG8_WAIT_L(0); PG8_MMA(0, 1, At, B1); PG8_BAR;
            PG8_LDA(At, 0, 1); PG8_STAGE(PG8_SA(0, 0), a2, voffA);
            PG8_BAR; PG8_WAIT_L(0); PG8_MMA(1, 0, At, B0); PG8_BAR; PG8_SCHED;
            PG8_STAGE(PG8_SB(0, 1), b2 + hstepB, voffB);
            PG8_WAIT_V(6); PG8_BAR; PG8_MMA(1, 1, At, B1); PG8_BAR;
            PG8_LDB(B0, 1, 0); PG8_SCHED; PG8_LDA(At, 1, 0); PG8_STAGE(PG8_SA(0, 1), a2 + hstepA, voffA);
            PG8_WAIT_L(8); PG8_BAR; PG8_WAIT_L(0); PG8_MMA(0, 0, At, B0); PG8_BAR; PG8_SCHED;
            PG8_LDB(B1, 1, 1); PG8_STAGE(PG8_SB(1, 0), b3, voffB);
            PG8_BAR; PG8_WAIT_L(0); PG8_MMA(0, 1, At, B1); PG8_BAR;
            PG8_LDA(At, 1, 1); PG8_STAGE(PG8_SA(1, 0), a3, voffA);
            PG8_BAR; PG8_WAIT_L(0); PG8_MMA(1, 0, At, B0); PG8_BAR; PG8_SCHED;
            PG8_STAGE(PG8_SB(1, 1), b3 + hstepB, voffB);
            PG8_WAIT_V(6); PG8_BAR; PG8_MMA(1, 1, At, B1); PG8_BAR;
            }
        }
        if constexpr (ALIGN_EPI) { if (wr == 0) PG8_BAR; }
        if constexpr (!Epi::AFTER_DRAIN) { E(acc, cur, wr, wc, fr, fq); S.done(cur); }
        if (!has_next) break;
#pragma unroll
        for (int a = 0; a < 2; ++a)
#pragma unroll
            for (int b = 0; b < 2; ++b)
#pragma unroll
                for (int m = 0; m < 4; ++m)
#pragma unroll
                    for (int n = 0; n < 2; ++n) acc[a][b][m][n] = (f32x4){0.f, 0.f, 0.f, 0.f};
        cur = nxt; cA = nA; cB = nB; ++ui;
        if constexpr (ALIGN_EPI) { if (wr == 1) PG8_BAR; }
    }
    PG8_WAIT_V(0);
    if constexpr (!ALIGN_EPI) { if (wr == 0) PG8_BAR; }
    PG8_BAR;
    if constexpr (Epi::AFTER_DRAIN) { E.fused(acc, cur, wr, wc, fr, fq, lds, wid, lane); S.done(cur); }
#undef PG8_SA
#undef PG8_SB
#undef PG8_STAGE
#undef PG8_LDA
#undef PG8_LDB
#undef PG8_MMA
#undef PG8_WAIT_V
#undef PG8_WAIT_L
#undef PG8_BAR
#undef PG8_SCHED
}
}

namespace pg8 {
__device__ __forceinline__ u32x4 pack8(const f32x4& v0, const f32x4& v1) { u32x4 w; w.x = cvt_pk_bf16(v0[0], v0[1]); w.y = cvt_pk_bf16(v0[2], v0[3]); w.z = cvt_pk_bf16(v1[0], v1[1]); w.w = cvt_pk_bf16(v1[2], v1[3]); return w; }
__device__ __forceinline__ f32x4 gelu4(const f32x4& v) { f32x2 a = gelu_pk((f32x2){v[0], v[1]}), b = gelu_pk((f32x2){v[2], v[3]}); return (f32x4){a.x, a.y, b.x, b.y}; }
struct DEpiP1 {
    static constexpr bool PERM = true, AFTER_DRAIN = false; EpiP1 e;
    __device__ __forceinline__ void operator()(const f32x4 (&acc)[2][2][4][2], const Unit& u, int wr, int wc, int fr, int fq) const {
        const int row0 = u.pm * BM + wr * 64 + fr; const bool isb = (u.pn >= 8);
        bf16_t* base = isb ? e.PB : e.PA; const int ldc = isb ? 1024 : 2048; const int col0 = (isb ? (u.pn - 8) : u.pn) * BM + wc * 32 + 8 * fq;
#pragma unroll
        for (int ai = 0; ai < 2; ++ai)
#pragma unroll
            for (int m = 0; m < 4; ++m) { bf16_t* rowp = base + (size_t)(row0 + ai * HALF + m * 16) * ldc + col0;
#pragma unroll
                for (int bj = 0; bj < 2; ++bj) { f32x4 v0 = acc[ai][bj][m][0], v1 = acc[ai][bj][m][1];
                    if (isb) { v0 = gelu4(v0); v1 = gelu4(v1); }
                    *(u32x4*)(rowp + bj * HALF) = pack8(v0, v1); } }
    }
};
struct DEpiPlain {
    static constexpr bool PERM = true, AFTER_DRAIN = false; EpiPlain e;
    __device__ __forceinline__ void operator()(const f32x4 (&acc)[2][2][4][2], const Unit& u, int wr, int wc, int fr, int fq) const {
        const int row0 = u.pm * BM + wr * 64 + fr; const int col0 = e.col_off + u.pn * BM + wc * 32 + 8 * fq;
#pragma unroll
        for (int ai = 0; ai < 2; ++ai)
#pragma unroll
            for (int m = 0; m < 4; ++m) { bf16_t* rowp = e.O + (size_t)(row0 + ai * HALF + m * 16) * e.ldc + col0;
#pragma unroll
                for (int bj = 0; bj < 2; ++bj) *(u32x4*)(rowp + bj * HALF) = pack8(acc[ai][bj][m][0], acc[ai][bj][m][1]); }
    }
};
__device__ __forceinline__ float sig_fast(float x) { return __builtin_amdgcn_rcpf(1.0f + __expf(-x)); }
__device__ __forceinline__ float bflo(unsigned w) { return __uint_as_float(w << 16); }
__device__ __forceinline__ float bfhi(unsigned w) { return __uint_as_float(w & 0xffff0000u); }
struct DEpiMerge {
    static constexpr bool PERM = true, AFTER_DRAIN = false; EpiMerge e;
    __device__ __forceinline__ void operator()(const f32x4 (&acc)[2][2][4][2], const Unit& u, int wr, int wc, int fr, int fq) const {
        const int row0 = u.pm * BM + wr * 64 + fr; const int n0 = u.pn * HALF + wc * 32 + 8 * fq;
#pragma unroll
        for (int ai = 0; ai < 2; ++ai)
#pragma unroll
            for (int m = 0; m < 4; ++m) { const size_t row = (size_t)(row0 + ai * HALF + m * 16);
                const u32x4 b0 = *(const u32x4*)(e.BR + row * 2048 + n0), b1 = *(const u32x4*)(e.BR + row * 2048 + 1024 + n0);
                const f32x4 g00 = acc[ai][0][m][0], g01 = acc[ai][0][m][1], g10 = acc[ai][1][m][0], g11 = acc[ai][1][m][1];
                f32x4 o0, o1;
                o0[0] = sig_fast(g00[0]) * bflo(b0.x) + sig_fast(g10[0]) * bflo(b1.x); o0[1] = sig_fast(g00[1]) * bfhi(b0.x) + sig_fast(g10[1]) * bfhi(b1.x);
                o0[2] = sig_fast(g00[2]) * bflo(b0.y) + sig_fast(g10[2]) * bflo(b1.y); o0[3] = sig_fast(g00[3]) * bfhi(b0.y) + sig_fast(g10[3]) * bfhi(b1.y);
                o1[0] = sig_fast(g01[0]) * bflo(b0.z) + sig_fast(g11[0]) * bflo(b1.z); o1[1] = sig_fast(g01[1]) * bfhi(b0.z) + sig_fast(g11[1]) * bfhi(b1.z);
                o1[2] = sig_fast(g01[2]) * bflo(b0.w) + sig_fast(g11[2]) * bflo(b1.w); o1[3] = sig_fast(g01[3]) * bfhi(b0.w) + sig_fast(g11[3]) * bfhi(b1.w);
                *(u32x4*)(e.MG + row * 1024 + n0) = pack8(o0, o1); }
    }
};
struct DEpiResid {
    static constexpr bool PERM = false, AFTER_DRAIN = false; EpiResid e;
    __device__ __forceinline__ void operator()(const f32x4 (&acc)[2][2][4][2], const Unit& u, int wr, int wc, int fr, int fq) const {
        const int row0 = u.pm * BM + wr * 64 + fr, col0 = u.pn * BM + wc * 32 + 4 * fq;
        typedef unsigned u32x2 __attribute__((ext_vector_type(2)));
#pragma unroll
        for (int ai = 0; ai < 2; ++ai)
#pragma unroll
            for (int m = 0; m < 4; ++m) { const size_t ro = (size_t)(row0 + ai * HALF + m * 16) * 1024 + col0;
#pragma unroll
                for (int bj = 0; bj < 2; ++bj)
#pragma unroll
                    for (int n = 0; n < 2; ++n) { const u32x2 h = *(const u32x2*)(e.H + ro + bj * HALF + n * 16); const f32x4 a = acc[ai][bj][m][n];
                        f32x4 o; o[0] = ALPHA_F * bflo(h.x) + a[0]; o[1] = ALPHA_F * bfhi(h.x) + a[1]; o[2] = ALPHA_F * bflo(h.y) + a[2]; o[3] = ALPHA_F * bfhi(h.y) + a[3];
                        *(f32x4*)(e.Z + ro + bj * HALF + n * 16) = o; } }
    }
};

struct DEpiTile {
    static constexpr bool PERM = true, AFTER_DRAIN = false; bf16_t* O; int sm, sn; float scale;
    __device__ __forceinline__ void operator()(const f32x4 (&acc)[2][2][4][2], const Unit& u, int wr, int wc, int fr, int fq) const {
        bf16_t* base = O + (size_t)(u.pm * sm + u.pn * sn) * 65536; const int row0 = wr * 64 + fr, col0 = wc * 32 + 8 * fq;
#pragma unroll
        for (int ai = 0; ai < 2; ++ai)
#pragma unroll
            for (int m = 0; m < 4; ++m) { bf16_t* rowp = base + (size_t)(row0 + ai * HALF + m * 16) * 256 + col0;
#pragma unroll
                for (int bj = 0; bj < 2; ++bj) *(u32x4*)(rowp + bj * HALF) = pack8(acc[ai][bj][m][0] * scale, acc[ai][bj][m][1] * scale); }
    }
};
struct DEpiQ { static constexpr bool PERM = true, AFTER_DRAIN = false; DEpiTile t;
    __device__ __forceinline__ void operator()(const f32x4 (&acc)[2][2][4][2], const Unit& u, int wr, int wc, int fr, int fq) const {
        Unit v; v.pm = (u.pm >> 3) * 32 + u.pn * 8 + (u.pm & 7); v.pn = 0; t(acc, v, wr, wc, fr, fq); } };
struct DEpiO {
    static constexpr bool PERM = true, AFTER_DRAIN = false; bf16_t* O;
    __device__ __forceinline__ void operator()(const f32x4 (&acc)[2][2][4][2], const Unit& u, int wr, int wc, int fr, int fq) const {
        const int bh = u.pm >> 3, b = bh >> 2, h = bh & 3; const int s0 = (u.pm & 7) * 256 + wr * 64 + fr;
        bf16_t* base = O + ((size_t)b * SEQ) * 1024 + h * 256 + wc * 32 + 8 * fq;
#pragma unroll
        for (int ai = 0; ai < 2; ++ai)
#pragma unroll
            for (int m = 0; m < 4; ++m) { bf16_t* rowp = base + (size_t)(s0 + ai * HALF + m * 16) * 1024;
#pragma unroll
                for (int bj = 0; bj < 2; ++bj) *(u32x4*)(rowp + bj * HALF) = pack8(acc[ai][bj][m][0], acc[ai][bj][m][1]); }
    }
};
struct DEpiSoftmax {
    static constexpr bool PERM = true, AFTER_DRAIN = true; bf16_t* Pout;
    __device__ __forceinline__ void fused(f32x4 (&acc)[2][2][4][2], const Unit& u, int wr, int wc, int fr, int fq, PG8_LAS unsigned char* lds, int wid, int lane) const {
        PG8_LAS float* PM = (PG8_LAS float*)lds;
        PG8_LAS float* PS = (PG8_LAS float*)(lds + 4096);
#pragma unroll
        for (int ai = 0; ai < 2; ++ai)
#pragma unroll
            for (int m = 0; m < 4; ++m) { float mx = -3.0e38f;
#pragma unroll
                for (int bj = 0; bj < 2; ++bj)
#pragma unroll
                    for (int n = 0; n < 2; ++n) { const f32x4 x = acc[ai][bj][m][n]; mx = fmaxf(mx, fmaxf(fmaxf(x[0], x[1]), fmaxf(x[2], x[3]))); }
                mx = fmaxf(mx, __shfl_xor(mx, 16)); mx = fmaxf(mx, __shfl_xor(mx, 32));
                if (fq == 0) PM[(ai * HALF + wr * 64 + m * 16 + fr) * 4 + wc] = mx; }
        asm volatile("s_waitcnt lgkmcnt(0)" ::: "memory"); __builtin_amdgcn_s_barrier(); asm volatile("" ::: "memory");
#pragma unroll
        for (int ai = 0; ai < 2; ++ai)
#pragma unroll
            for (int m = 0; m < 4; ++m) { const int row = ai * HALF + wr * 64 + m * 16 + fr; const f32x4 p4 = *(const PG8_LAS f32x4*)(PM + row * 4);
                const float gm = fmaxf(fmaxf(p4[0], p4[1]), fmaxf(p4[2], p4[3])); float sum = 0.f;
#pragma unroll
                for (int bj = 0; bj < 2; ++bj)
#pragma unroll
                    for (int n = 0; n < 2; ++n) { f32x4 x = acc[ai][bj][m][n]; x[0] = __expf(x[0] - gm); x[1] = __expf(x[1] - gm); x[2] = __expf(x[2] - gm); x[3] = __expf(x[3] - gm);
                        acc[ai][bj][m][n] = x; sum += (x[0] + x[1]) + (x[2] + x[3]); }
                sum += __shfl_xor(sum, 16); sum += __shfl_xor(sum, 32);
                if (fq == 0) PS[row * 4 + wc] = sum; }
        asm volatile("s_waitcnt lgkmcnt(0)" ::: "memory"); __builtin_amdgcn_s_barrier(); asm volatile("" ::: "memory");
#pragma unroll
        for (int ai = 0; ai < 2; ++ai)
#pragma unroll
            for (int m = 0; m < 4; ++m) { const int row = ai * HALF + wr * 64 + m * 16 + fr; const f32x4 s4 = *(const PG8_LAS f32x4*)(PS + row * 4);
                const float inv = 1.0f / ((s4[0] + s4[1]) + (s4[2] + s4[3])); bf16_t* rowp = Pout + ((size_t)u.pm * 256 + row) * 256 + wc * 32 + 8 * fq;
#pragma unroll
                for (int bj = 0; bj < 2; ++bj) *(u32x4*)(rowp + bj * HALF) = pack8(acc[ai][bj][m][0] * inv, acc[ai][bj][m][1] * inv); }
        asm volatile("s_waitcnt lgkmcnt(0)" ::: "memory"); __builtin_amdgcn_s_barrier(); asm volatile("" ::: "memory");
    }
};
template <int KIND> struct DEpiLora {
    static constexpr bool PERM = true, AFTER_DRAIN = false; const float* bsrc0; bf16_t* O;
    __device__ __forceinline__ static f32x4 act4(f32x4 x) {
        f32x4 o;
#pragma unroll
        for (int i = 0; i < 4; ++i) {
            if (KIND == 0) { const float y = -x[i]; const float sp = fmaxf(y, 0.f) + __logf(1.0f + __expf(-fabsf(y))); const float ew = __expf(-sp - 0.5f); o[i] = 1.0f - __expf(-ew); }
            else if (KIND == 1) o[i] = __builtin_amdgcn_rcpf(1.0f + __expf(-x[i]));
            else o[i] = x[i]; }
        return o;
    }
    __device__ __forceinline__ void operator()(const f32x4 (&acc)[2][2][4][2], const Unit& u, int wr, int wc, int fr, int fq) const {
        const int row0 = u.pm * BM + wr * 64 + fr; const int z = (KIND == 2) ? 0 : (u.pn >> 1); const int cb = ((KIND == 2) ? u.pn : (u.pn & 1)) * 256 + wc * 32 + 8 * fq;
        f32x4 bv[2][2];
#pragma unroll
        for (int bj = 0; bj < 2; ++bj)
#pragma unroll
            for (int n = 0; n < 2; ++n) bv[bj][n] = (KIND == 2) ? (f32x4){0.f, 0.f, 0.f, 0.f} : *(const f32x4*)(bsrc0 + z * 512 + cb + bj * HALF + 4 * n);
#pragma unroll
        for (int ai = 0; ai < 2; ++ai)
#pragma unroll
            for (int m = 0; m < 4; ++m) { const size_t row = (size_t)(row0 + ai * HALF + m * 16);
                bf16_t* dst = (KIND == 2) ? (O + row * 512 + cb) : (O + (row * 2 + z) * 512 + cb);
#pragma unroll
                for (int bj = 0; bj < 2; ++bj) *(u32x4*)(dst + bj * HALF) = pack8(act4(acc[ai][bj][m][0] + bv[bj][0]), act4(acc[ai][bj][m][1] + bv[bj][1])); }
    }
};
}
#define LAS __attribute__((address_space(3)))
#define XB_TMO      128
#define XB_XCNT(j)  (256  + 64 * (j))
#define XB_XSUB(j)  (1280 + 64 * (j))
#define XB_XGEN(j)  (2304 + 64 * (j))
#define XB_TOP      3328
#define XB_TOPGEN   3392
#define XCD_BAR_WORDS 3456
#define XB_SPIN_CAP (1u << 18)

__device__ __forceinline__ unsigned xb_ld(unsigned* p)              { return __hip_atomic_load(p, __ATOMIC_RELAXED, __HIP_MEMORY_SCOPE_AGENT); }
__device__ __forceinline__ unsigned xb_add(unsigned* p, unsigned v) { return __hip_atomic_fetch_add(p, v, __ATOMIC_RELAXED, __HIP_MEMORY_SCOPE_AGENT); }
__device__ __forceinline__ unsigned xb_xcc_id() { return (unsigned)__builtin_amdgcn_s_getreg((3 << 11) | 20) & 0xFu; }
#define XB_SPIN(cond, bar) do { unsigned _sp = 0; while (cond) { __builtin_amdgcn_s_sleep(1); \
    if ((++_sp & 255u) == 0u) { if (xb_ld(&(bar)[XB_TMO])) break; if (_sp > XB_SPIN_CAP) { atomicAdd(&(bar)[XB_TMO], 1u); break; } } } } while (0)

struct XcdBarrier {
    unsigned* bar; unsigned x;
    volatile LAS unsigned* st;
};

__device__ __forceinline__ XcdBarrier xcd_barrier_post(unsigned* bar, volatile LAS unsigned* st) {
    XcdBarrier b; b.bar = bar; b.x = xb_xcc_id(); b.st = st;
    if (threadIdx.x == 0) (void)xb_add(&bar[XB_XCNT(b.x)], 1u);
    return b;
}
__device__ __forceinline__ void xcd_barrier_complete(unsigned* bar, unsigned x, unsigned& nloc, unsigned& nx) {
    const unsigned G = gridDim.x * gridDim.y * gridDim.z;
    unsigned sum, cnt, mine, sp = 0u;
    for (;;) {
        sum = 0u; cnt = 0u; mine = 0u;
#pragma unroll
        for (unsigned j = 0; j < 16; ++j) { const unsigned c = xb_ld(&bar[XB_XCNT(j)]); sum += c; cnt += (c > 0u) ? 1u : 0u; mine = (j == x) ? c : mine; }
        if (sum == G) break;
        __builtin_amdgcn_s_sleep(1);
        if ((++sp & 255u) == 0u) { if (xb_ld(&bar[XB_TMO])) break; if (sp > XB_SPIN_CAP) { atomicAdd(&bar[XB_TMO], 1u); break; } }
    }
    nloc = mine > 0u ? mine : 1u; nx = cnt > 0u ? cnt : 1u;
}

__device__ __forceinline__ void xcd_barrier(const XcdBarrier& b) {
    asm volatile("s_waitcnt vmcnt(0)" ::: "memory");
    __syncthreads();
    if (threadIdx.x == 0) {
        unsigned* bar = b.bar;
        __builtin_amdgcn_s_waitcnt(0);
        unsigned nloc = b.st[0], nx = b.st[1];
        if (nloc == 0u) { xcd_barrier_complete(bar, b.x, nloc, nx); b.st[0] = nloc; b.st[1] = nx; }
        const unsigned old = xb_add(&bar[XB_XSUB(b.x)], 1u);
        const unsigned gen = old / nloc;
        if (old + 1u == (gen + 1u) * nloc) {
            __builtin_amdgcn_fence(__ATOMIC_RELEASE, "agent");
            asm volatile("s_waitcnt vmcnt(0)" ::: "memory");
            const unsigned og = xb_add(&bar[XB_TOP], 1u);
            const unsigned tg = og / nx;
            if (og + 1u == (tg + 1u) * nx) xb_add(&bar[XB_TOPGEN], 1u);
            else XB_SPIN(xb_ld(&bar[XB_TOPGEN]) == tg, bar);
            __builtin_amdgcn_fence(__ATOMIC_ACQUIRE, "agent");
            xb_add(&bar[XB_XGEN(b.x)], 1u);
            asm volatile("s_waitcnt vmcnt(0)" ::: "memory");
        } else {
            XB_SPIN(xb_ld(&bar[XB_XGEN(b.x)]) == gen, bar);
            __builtin_amdgcn_fence(__ATOMIC_ACQUIRE, "agent");
            asm volatile("s_waitcnt vmcnt(0)" ::: "memory");
        }
    }
    __syncthreads();
}

#endif

#ifdef HOST_EMU
template <class F> static void emu_gemm(const bf16_t* A, const bf16_t* Bt, int M, int N, int K, F f) {
#pragma omp parallel for schedule(static)
    for (int r = 0; r < M; ++r)
        for (int c = 0; c < N; ++c) { float a = 0.f; for (int k = 0; k < K; ++k) a += bf2f(A[(size_t)r * K + k]) * bf2f(Bt[(size_t)c * K + k]); f(r, c, a); }
}
#endif

#define GS_LOOP(idx, n) for (long idx = gtid; idx < (long)(n); idx += nthr)

__device__ __forceinline__ int win_src_col(int n) {
    if (n < 1920) return n;
    if (n < 2048) return -1;
    if (n < 3072) return 1920 + (n - 2048);
    const int m = n - 3072, j = m / 256, i = m % 256;
    return (i < 128) ? (2944 + 128 * j + i) : (2944 + 1024 + 128 * j + (i - 128));
}
__device__ __forceinline__ void ph0_weights(const Params& P, long gtid, long nthr) {
    GS_LOOP(idx, (size_t)5120 * 1024) { const int n = (int)(idx / 1024), k = (int)(idx % 1024); const int c = win_src_col(n);
        P.W_IN_T[idx] = (c < 0) ? (bf16_t)0 : f2bf(P.in[I_W_IN][(size_t)k * IN_COLS + c]); }
    GS_LOOP(idx, (size_t)2048 * 512) { const int n = (int)(idx / 512), k = (int)(idx % 512); const int br = n / 1024, nn = n % 1024;
        P.W_BR_T[idx] = f2bf(P.in[I_W_BRANCH][((size_t)br * 512 + k) * 1024 + nn]); }
    GS_LOOP(idx, (size_t)1024 * 1024) { const int n = (int)(idx / 1024), k = (int)(idx % 1024);
        P.W_MIX_T[idx] = f2bf(P.in[I_W_MIX][(size_t)k * 1024 + n]);
        P.W_Q_T[idx] = f2bf(P.in[I_W_Q][(size_t)k * 1024 + n]);
        P.W_O_T[idx] = f2bf(P.in[I_W_O][(size_t)k * 1024 + n]); }
    GS_LOOP(idx, (size_t)2048 * 1024) { const int n = (int)(idx / 1024), k = (int)(idx % 1024);
        P.W_KV_T[idx] = f2bf(P.in[I_W_KV][(size_t)k * 2048 + n]);
        P.W_QUERY_T[idx] = f2bf(P.in[I_W_QUERY][(size_t)k * 2048 + n]); }
}
__device__ __forceinline__ void ln_rows_bf16(const float* in, const float* g, const float* b, bf16_t* out, int rows, int width, long gtid, long nthr) {
    GS_LOOP(row, rows) { const float* x = in + (size_t)row * width; float s = 0.f;
        for (int i = 0; i < width; ++i) s += x[i];
        const float mu = s / width; float q = 0.f;
        for (int i = 0; i < width; ++i) { const float d = x[i] - mu; q += d * d; }
        const float rs = 1.0f / sqrtf(q / width + 1e-5f); bf16_t* o = out + (size_t)row * width;
        for (int i = 0; i < width; ++i) o[i] = f2bf((x[i] - mu) * rs * g[i] + b[i]); }
}
__device__ __forceinline__ void ph2a_vn(const Params& P, long gtid, long nthr) {
    GS_LOOP(row, TOK) { const bf16_t* x = P.PB + (size_t)row * 1024 + 512; float s = 0.f;
        for (int i = 0; i < 512; ++i) s += bf2f(x[i]);
        const float mu = s / 512.f; float q = 0.f;
        for (int i = 0; i < 512; ++i) { const float d = bf2f(x[i]) - mu; q += d * d; }
        const float rs = 1.0f / sqrtf(q / 512.f + 1e-5f); bf16_t* o = P.VN + (size_t)row * 512;
        for (int i = 0; i < 512; ++i) o[i] = f2bf((bf2f(x[i]) - mu) * rs * P.in[I_GLN_G][i] + P.in[I_GLN_B][i]); }
}
__device__ __forceinline__ void ph2b_gmlp(const Params& P, long gtid, long nthr) {
    GS_LOOP(idx, (size_t)TOK * 512) { const int c = (int)(idx % 512); const long t = idx / 512; const int g = c / 64; const long ch = t / 128; const int p = (int)(t % 128);
        const float* ws = P.in[I_W_S] + ((size_t)g * 128 + p) * 128; float s = 0.f;
        for (int q = 0; q < 128; ++q) s += ws[q] * bf2f(P.VN[(size_t)(ch * 128 + q) * 512 + c]);
        s += P.in[I_B_S][g * 128 + p];
        P.YB[idx] = f2bf(bf2f(P.PB[(size_t)t * 1024 + c]) * s); }
}
__device__ __forceinline__ float pa_shift(const Params& P, long t, int c) {
    const int s = (int)(t % SEQ); const float cur = bf2f(P.PA[(size_t)t * 2048 + c]);
    const float prev = (s > 0) ? bf2f(P.PA[(size_t)(t - 1) * 2048 + c]) : 0.f;
    const float nxt = (s < SEQ - 1) ? bf2f(P.PA[(size_t)(t + 1) * 2048 + c]) : 0.f;
    return cur + P.in[I_MU][c] * (0.5f * (prev + nxt) - cur);
}
__device__ __forceinline__ void ph3a_lora_in(const Params& P, long gtid, long nthr) {
    GS_LOOP(idx, (size_t)TOK * 128) { const int r = (int)(idx % 128); const long t = idx / 128;
        P.WDS[idx] = f2bf(tanhf(pa_shift(P, t, 1536 + r)));
        P.ADS[idx] = f2bf(pa_shift(P, t, 1664 + r));
        P.SG[idx] = f2bf(sigmoidf_(pa_shift(P, t, 1792 + r))); }
}
__device__ __forceinline__ void ph3b_prep(const Params& P, long gtid, long nthr) {
    GS_LOOP(idx, (size_t)TOK * 8) { const int h = (int)(idx % 8); const long t = idx / 8; const int hb = h * 64;
        float ss = 0.f;
        for (int j = 0; j < 64; ++j) { const float v = pa_shift(P, t, 512 + hb + j) * P.in[I_K_K][hb + j]; ss += v * v; }
        const float inv = 1.0f / fmaxf(sqrtf(ss), 1e-12f);
        for (int j = 0; j < 64; ++j) { const int c = hb + j;
            const float k = pa_shift(P, t, 512 + c); const float kk = k * P.in[I_K_K][c] * inv;
            P.R[(size_t)t * 512 + c] = f2bf(pa_shift(P, t, c));
            P.V[(size_t)t * 512 + c] = f2bf(pa_shift(P, t, 1024 + c));
            P.KK[(size_t)t * 512 + c] = f2bf(kk);
            for (int z = 0; z < 2; ++z) {
                float sw = P.in[I_W0][z * 512 + c], sa = P.in[I_A0][z * 512 + c];
                for (int r = 0; r < 64; ++r) { sw += bf2f(P.WDS[(size_t)t * 128 + z * 64 + r]) * P.in[I_W2][((size_t)z * 64 + r) * 512 + c];
                                               sa += bf2f(P.ADS[(size_t)t * 128 + z * 64 + r]) * P.in[I_A2][((size_t)z * 64 + r) * 512 + c]; }
                const float y = -sw; const float sp = fmaxf(y, 0.f) + log1pf(expf(-fabsf(y))); const float wlog = -sp - 0.5f;
                const float ew = expf(wlog);
                const float a = sigmoidf_(sa); const size_t o = ((size_t)t * 2 + z) * 512 + c;
                P.OMW[o] = f2bf(-expm1f(-ew));
                P.KDIR[o] = f2bf(k * (1.0f + (a - 1.0f) * P.in[I_K_A][c]));
                P.BVEC[o] = f2bf(kk * a); } } }
}
__device__ __forceinline__ void scan_item(const Params& P, int chain, int i) {
    const int h = chain % 8, b = (chain / 8) % BATCH, z = chain / (8 * BATCH);
    float S[64];
#pragma unroll
    for (int j = 0; j < 64; ++j) S[j] = 0.f;
    for (int n = 0; n < SEQ; ++n) {
        const long t = (long)b * SEQ + ((z == 0) ? n : (SEQ - 1 - n));
        const bf16_t* r = P.R + (size_t)t * 512 + h * 64; const bf16_t* a = P.KK + (size_t)t * 512 + h * 64;
        const bf16_t* w = P.OMW + ((size_t)t * 2 + z) * 512 + h * 64; const bf16_t* k = P.KDIR + ((size_t)t * 2 + z) * 512 + h * 64;
        const bf16_t* bv = P.BVEC + ((size_t)t * 2 + z) * 512 + h * 64;
        const float v = bf2f(P.V[(size_t)t * 512 + h * 64 + i]);
        float sa = 0.f;
#pragma unroll
        for (int j = 0; j < 64; ++j) sa -= S[j] * bf2f(a[j]);
        float y = 0.f;
#pragma unroll
        for (int j = 0; j < 64; ++j) { S[j] = S[j] * (1.0f - bf2f(w[j])) + sa * bf2f(bv[j]) + v * bf2f(k[j]); y += S[j] * bf2f(r[j]); }
        P.Y01[((size_t)z * TOK + t) * 512 + h * 64 + i] = y;
    }
}
__device__ __forceinline__ void ph5_rwkv_out(const Params& P, long gtid, long nthr) {
    GS_LOOP(idx, (size_t)TOK * 512) { const int c = (int)(idx % 512); const long t = idx / 512; const int hb = (c / 64) * 64;
        const float* y0 = P.Y01 + (size_t)t * 512 + hb; const float* y1 = P.Y01 + ((size_t)TOK + t) * 512 + hb;
        float s = 0.f;
        for (int j = 0; j < 64; ++j) s += y0[j] + y1[j];
        const float mu = s / 64.f; float q = 0.f;
        for (int j = 0; j < 64; ++j) { const float d = y0[j] + y1[j] - mu; q += d * d; }
        const float rs = 1.0f / sqrtf(q / 64.f + 64e-5f);
        const float yn = (y0[c - hb] + y1[c - hb] - mu) * rs * P.in[I_GN_G][c] + P.in[I_GN_B][c];
        float rk = 0.f;
        for (int z = 0; z < 2; ++z)
            for (int j = 0; j < 64; ++j) rk += bf2f(P.R[(size_t)t * 512 + hb + j]) * bf2f(P.KDIR[((size_t)t * 2 + z) * 512 + hb + j]) * P.in[I_R_K][hb + j];
        float g = 0.f;
        for (int r = 0; r < 128; ++r) g += bf2f(P.SG[(size_t)t * 128 + r]) * P.in[I_G2][(size_t)r * 512 + c];
        P.YA[idx] = f2bf((yn + rk * bf2f(P.V[(size_t)t * 512 + c])) * g); }
}
__device__ __forceinline__ void ph_ln_z(const Params& P, const float* g, const float* b, long gtid, long nthr) { ln_rows_bf16(P.Z, g, b, P.HB, TOK, 1024, gtid, nthr); }
__device__ __forceinline__ void ph10a_scores(const Params& P, long gtid, long nthr) {
    GS_LOOP(idx, (size_t)TOK * 4 * 256) { const int m = (int)(idx % 256); const long rowi = idx / 256; const int s = (int)(rowi % SEQ); const int bh = (int)(rowi / SEQ); const int b = bh / 4, h = bh % 4;
        const bf16_t* q = P.Q + ((size_t)b * SEQ + s) * 1024 + h * 256; const bf16_t* k = P.KV + ((size_t)b * 256 + m) * 2048 + h * 256; float a = 0.f;
        for (int d = 0; d < 256; ++d) a += bf2f(q[d]) * bf2f(k[d]);
        P.SCA[idx] = a * 0.0625f; }
}
__device__ __forceinline__ void ph10b_softmax(const Params& P, long gtid, long nthr) {
    GS_LOOP(row, (size_t)TOK * 4) { float* x = P.SCA + (size_t)row * 256; float mx = x[0];
        for (int i = 1; i < 256; ++i) mx = fmaxf(mx, x[i]);
        float s = 0.f;
        for (int i = 0; i < 256; ++i) s += expf(x[i] - mx);
        const float inv = 1.0f / s;
        for (int i = 0; i < 256; ++i) x[i] = expf(x[i] - mx) * inv; }
}
__device__ __forceinline__ void ph10c_out(const Params& P, long gtid, long nthr) {
    GS_LOOP(idx, (size_t)TOK * 1024) { const int c = (int)(idx % 1024); const long t = idx / 1024; const int b = (int)(t / SEQ), s = (int)(t % SEQ), h = c / 256;
        const float* pr = P.SCA + (((size_t)b * 4 + h) * SEQ + s) * 256; float a = 0.f;
        for (int m = 0; m < 256; ++m) a += pr[m] * bf2f(P.KV[((size_t)b * 256 + m) * 2048 + 1024 + c]);
        P.O[idx] = f2bf(a); }
}
__device__ __forceinline__ void ph13a_scores(const Params& P, long gtid, long nthr) {
    GS_LOOP(idx, (size_t)TOK * 2048) { const int k = (int)(idx % 128), z = (int)((idx / 128) % 2), h = (int)((idx / 256) % 8); const long t = idx / 2048;
        const bf16_t* q = P.QP + (size_t)t * 2048 + h * 256 + z * 128; const float* kr = P.in[I_SUBKEYS] + ((size_t)z * 128 + k) * 128; float a = 0.f;
        for (int c = 0; c < 128; ++c) a += bf2f(q[c]) * kr[c];
        P.SC[idx] = a; }
}
__device__ __forceinline__ void ph13b_topk(const Params& P, long gtid, long nthr) {
    GS_LOOP(row, (size_t)TOK * 16) { const float* x = P.SC + (size_t)row * 128; float pv = 0.f; int pi = -1;
        for (int j = 0; j < 16; ++j) { float best = 0.f; int bi = -1;
            for (int i = 0; i < 128; ++i) { const float v = x[i]; const bool elig = (j == 0) || (v < pv) || (v == pv && i > pi);
                if (elig && (bi < 0 || v > best)) { best = v; bi = i; } }
            P.TOPS[(size_t)row * 16 + j] = best; P.TOPI[(size_t)row * 16 + j] = bi; pv = best; pi = bi; } }
}
__device__ __forceinline__ void ph13c_cand(const Params& P, long gtid, long nthr) {
    GS_LOOP(row, (size_t)TOK * 8) { const float* s0 = P.TOPS + (size_t)row * 32; const float* s1 = s0 + 16; const int* i0 = P.TOPI + (size_t)row * 32; const int* i1 = i0 + 16;
        float pv = 0.f; int pi = -1; float mx = 0.f;
        for (int j = 0; j < 16; ++j) { float best = 0.f; int bi = -1;
            for (int c = 0; c < 256; ++c) { const float v = s0[c / 16] + s1[c % 16]; const bool elig = (j == 0) || (v < pv) || (v == pv && c > pi);
                if (elig && (bi < 0 || v > best)) { best = v; bi = c; } }
            if (j == 0) mx = best;
            P.GATE[(size_t)row * 16 + j] = best; P.EXPERT[(size_t)row * 16 + j] = i0[bi / 16] * 128 + i1[bi % 16]; pv = best; pi = bi; }
        float s = 0.f;
        for (int j = 0; j < 16; ++j) s += expf(P.GATE[(size_t)row * 16 + j] - mx);
        const float inv = 1.0f / s;
        for (int j = 0; j < 16; ++j) P.GATE[(size_t)row * 16 + j] = expf(P.GATE[(size_t)row * 16 + j] - mx) * inv; }
}
__device__ __forceinline__ void ph14a_act(const Params& P, long gtid, long nthr) {
    GS_LOOP(idx, (size_t)TOK * 128) { const long t = idx / 128; const bf16_t* x = P.HB + (size_t)t * 1024; const float* ur = P.in[I_PEER_U] + (size_t)P.EXPERT[idx] * 1024; float a = 0.f;
        for (int d = 0; d < 1024; ++d) a += ur[d] * bf2f(x[d]);
        P.COEF[idx] = P.GATE[idx] * geluf_(a); }
}
__device__ __forceinline__ void ph14b_out(const Params& P, long gtid, long nthr) {
    GS_LOOP(idx, (size_t)TOK * 1024) { const int d = (int)(idx % 1024); const long t = idx / 1024; float a = 0.f;
        for (int j = 0; j < 128; ++j) a += P.COEF[(size_t)t * 128 + j] * P.in[I_PEER_V][(size_t)P.EXPERT[(size_t)t * 128 + j] * 1024 + d];
        P.Y[idx] = a; }
}
__device__ __forceinline__ void ph14c_final(const Params& P, long gtid, long nthr) {
    GS_LOOP(row, TOK) { const bf16_t* hr = P.HB + (size_t)row * 1024; const float* yr = P.Y + (size_t)row * 1024; float s = 0.f;
        for (int i = 0; i < 1024; ++i) s += ALPHA_F * bf2f(hr[i]) + yr[i];
        const float mu = s / 1024.f; float q = 0.f;
        for (int i = 0; i < 1024; ++i) { const float d = ALPHA_F * bf2f(hr[i]) + yr[i] - mu; q += d * d; }
        const float rs = 1.0f / sqrtf(q / 1024.f + 1e-5f); float* o = P.out + (size_t)row * 1024;
        for (int i = 0; i < 1024; ++i) o[i] = (ALPHA_F * bf2f(hr[i]) + yr[i] - mu) * rs * P.in[I_LN3_G][i] + P.in[I_LN3_B][i]; }
}

static void make_params(Params& P, void* const* d_in, void* d_out, void* d_ws) {
    memset(&P, 0, sizeof(P));
    for (int i = 0; i < 37; ++i) P.in[i] = (const float*)d_in[i];
    P.out = (float*)d_out; unsigned char* ws = (unsigned char*)d_ws; unsigned char* ob = (unsigned char*)d_out;
    unsigned char* r1 = ws + A_R1; unsigned char* r2 = ws + A_R2;
    P.ctl = (unsigned*)(ws + WS_CTL);
    P.W_IN_T = (bf16_t*)(ws + WS_W + OFF_W_IN); P.W_BR_T = (bf16_t*)(ws + WS_W + OFF_W_BR); P.W_MIX_T = (bf16_t*)(ws + WS_W + OFF_W_MIX);
    P.W_Q_T = (bf16_t*)(ws + WS_W + OFF_W_Q); P.W_KV_T = (bf16_t*)(ws + WS_W + OFF_W_KV); P.W_O_T = (bf16_t*)(ws + WS_W + OFF_W_O); P.W_QUERY_T = (bf16_t*)(ws + WS_W + OFF_W_QUERY);
    P.KV = (bf16_t*)(ws + WS_KV); P.MEMN = (bf16_t*)(ws + WS_MEMN); P.HB = (bf16_t*)(ws + A_HB);
    P.PA = (bf16_t*)r1; P.PB = (bf16_t*)r2; P.VN = (bf16_t*)(r2 + 2 * TU);
    P.YB = (bf16_t*)ob; P.WDS = (bf16_t*)(ob + TU); P.ADS = (bf16_t*)(ob + TU + TU / 4); P.SG = (bf16_t*)(ob + TU + TU / 2);
    P.R = (bf16_t*)(ob + 2 * TU); P.KK = (bf16_t*)(ob + 3 * TU);
    P.V = (bf16_t*)r2; P.OMW = (bf16_t*)(r2 + TU); P.KDIR = (bf16_t*)(r2 + 3 * TU); P.BVEC = (bf16_t*)(r2 + 5 * TU);
    P.Y01 = (float*)r1; P.YA = (bf16_t*)(r2 + TU); P.BR = (bf16_t*)r1; P.MG = (bf16_t*)r2; P.Z = (float*)ob;
    P.Q = (bf16_t*)r1; P.O = (bf16_t*)(r1 + 2 * TU); P.SCA = (float*)r2; P.QP = (bf16_t*)ob;
    P.SC = (float*)r1; P.TOPS = (float*)(r2 + 4 * TU); P.TOPI = (int*)(r2 + 5 * TU); P.GATE = (float*)(r2 + 6 * TU); P.EXPERT = (int*)(r2 + 6 * TU + TU / 2);
    P.COEF = (float*)(r2 + 7 * TU); P.Y = (float*)r1;
    P.UB = (bf16_t*)r1; P.VB = (bf16_t*)(r1 + (size_t)16384 * 1024 * 2);
    P.W_LORA_T = (bf16_t*)(ws + WS_W + OFF_W_LORA);
    P.LIN = (bf16_t*)(ob + TU); P.K = (bf16_t*)(r2 + TU); P.OMW = (bf16_t*)(r2 + 2 * TU); P.AL = (bf16_t*)(r2 + 4 * TU); P.G = (bf16_t*)(r2 + 6 * TU);
    P.YA = (bf16_t*)(r2 + 2 * TU);
    P.KH = (bf16_t*)(ws + WS_KV); P.VT = (bf16_t*)(ws + WS_KV + 4 * MiB); P.QH = (bf16_t*)r1; P.PP = (bf16_t*)r2;
    P.GATE = (float*)(r2 + 6 * TU); P.EXPERT = (int*)(r2 + 6 * TU + TU / 2);
}

#ifndef NEW_PEER
#define NEW_PEER 1
#endif
#ifndef USE_DOT2
#define USE_DOT2 0
#endif
#ifndef ATT_OLD
#define ATT_OLD 0
#endif
#ifndef NEW_SCAN
#define NEW_SCAN 1
#endif
#define AX (ATT_OLD ? 1 : 0)
#define N_PHASES (23 + AX)
__device__ __forceinline__ void run_simt_phase(const Params& P, int ph, long gtid, long nthr) {
    switch (ph) {
    case 0: ph0_weights(P, gtid, nthr);
            ln_rows_bf16(P.in[I_X], P.in[I_LN_EMB_G], P.in[I_LN_EMB_B], P.HB, TOK, 1024, gtid, nthr);
            ln_rows_bf16(P.in[I_MEM], P.in[I_MLN_G], P.in[I_MLN_B], P.MEMN, BATCH * MEM_LEN, 1024, gtid, nthr); break;
    case 2: ph2a_vn(P, gtid, nthr); break;
    case 3: ph2b_gmlp(P, gtid, nthr); break;
    case 4: ph3a_lora_in(P, gtid, nthr); break;
    case 5: ph3b_prep(P, gtid, nthr); break;
    case 7: ph5_rwkv_out(P, gtid, nthr); break;
    case 11: ph_ln_z(P, P.in[I_LN1_G], P.in[I_LN1_B], gtid, nthr); break;
    case 13: ph10a_scores(P, gtid, nthr); break;
    case 14: ph10b_softmax(P, gtid, nthr); break;
    case 15: ph10c_out(P, gtid, nthr); break;
    case 17: ph_ln_z(P, P.in[I_LN2_G], P.in[I_LN2_B], gtid, nthr); break;
    case 19: ph13a_scores(P, gtid, nthr); break;
    case 20: ph13b_topk(P, gtid, nthr); break;
    case 21: ph13c_cand(P, gtid, nthr); break;
    case 22: ph14a_act(P, gtid, nthr); break;
    case 23: ph14b_out(P, gtid, nthr); break;
    case 24: ph14c_final(P, gtid, nthr); break;
    default: break;
    }
}

#ifdef HOST_EMU
static void emu_run(const Params& P) {
    for (int ph = 0; ph < N_PHASES; ++ph) {
        switch (ph) {
        case 1:
            emu_gemm(P.HB, P.W_IN_T, TOK, 3072, 1024, [&](int r, int c, float a) { if (c < 2048) P.PA[(size_t)r * 2048 + c] = f2bf(a); else P.PB[(size_t)r * 1024 + c - 2048] = f2bf(geluf_(a)); });
            emu_gemm(P.MEMN, P.W_KV_T, BATCH * MEM_LEN, 2048, 1024, [&](int r, int c, float a) { P.KV[(size_t)r * 2048 + c] = f2bf(a); });
            break;
        case 6:
#pragma omp parallel for schedule(dynamic, 1)
            for (int it = 0; it < 2 * BATCH * 8 * 64; ++it) scan_item(P, it / 64, it % 64);
            break;
        case 8:
            emu_gemm(P.YA, P.W_BR_T, TOK, 1024, 512, [&](int r, int c, float a) { P.BR[(size_t)r * 2048 + c] = f2bf(a); });
            emu_gemm(P.YB, P.W_BR_T + (size_t)1024 * 512, TOK, 1024, 512, [&](int r, int c, float a) { P.BR[(size_t)r * 2048 + 1024 + c] = f2bf(a); });
            break;
        case 9: {
            float* tmp = (float*)malloc((size_t)TOK * 2048 * 4);
            emu_gemm(P.HB, P.W_IN_T + (size_t)3072 * 1024, TOK, 2048, 1024, [&](int r, int c, float a) { tmp[(size_t)r * 2048 + c] = a; });
            for (int r = 0; r < TOK; ++r) for (int n = 0; n < 1024; ++n) { const int j = n / 128, i = n % 128;
                const float g0 = tmp[(size_t)r * 2048 + 256 * j + i], g1 = tmp[(size_t)r * 2048 + 256 * j + 128 + i];
                P.MG[(size_t)r * 1024 + n] = f2bf(sigmoidf_(g0) * bf2f(P.BR[(size_t)r * 2048 + n]) + sigmoidf_(g1) * bf2f(P.BR[(size_t)r * 2048 + 1024 + n])); }
            free(tmp); } break;
        case 10: emu_gemm(P.MG, P.W_MIX_T, TOK, 1024, 1024, [&](int r, int c, float a) { P.Z[(size_t)r * 1024 + c] = ALPHA_F * bf2f(P.HB[(size_t)r * 1024 + c]) + a; }); break;
        case 12: emu_gemm(P.HB, P.W_Q_T, TOK, 1024, 1024, [&](int r, int c, float a) { P.Q[(size_t)r * 1024 + c] = f2bf(a); }); break;
        case 16: emu_gemm(P.O, P.W_O_T, TOK, 1024, 1024, [&](int r, int c, float a) { P.Z[(size_t)r * 1024 + c] = ALPHA_F * bf2f(P.HB[(size_t)r * 1024 + c]) + a; }); break;
        case 18: emu_gemm(P.HB, P.W_QUERY_T, TOK, 2048, 1024, [&](int r, int c, float a) { P.QP[(size_t)r * 2048 + c] = f2bf(a); }); break;
        default: {
            const long NT = 64;
#pragma omp parallel for schedule(static, 1)
            for (long g = 0; g < NT; ++g) run_simt_phase(P, ph, g, NT);
        } break;
        }
    }
}
extern "C" void kernel_launch(void* const* d_in, const int* in_sizes, int n_in, void* d_out, int out_size, void* d_ws, size_t ws_size, hipStream_t stream) {
    Params P; make_params(P, d_in, d_out, d_ws);
    memset(d_ws, 0, 1 << 20);
    emu_run(P);
}
#else

typedef float f32x4 __attribute__((ext_vector_type(4)));
typedef unsigned u32x4 __attribute__((ext_vector_type(4)));
typedef unsigned u32x2 __attribute__((ext_vector_type(2)));
typedef __bf16 bf16x2_t __attribute__((ext_vector_type(2)));
__device__ __forceinline__ float wave_sum(float v) {
#pragma unroll
    for (int o = 1; o < 64; o <<= 1) v += __shfl_xor(v, o);
    return v;
}
__device__ __forceinline__ float wave_max(float v) {
#pragma unroll
    for (int o = 1; o < 64; o <<= 1) v = fmaxf(v, __shfl_xor(v, o));
    return v;
}
__device__ __forceinline__ unsigned pk2(float lo, float hi) { return (unsigned)f2bf(lo) | ((unsigned)f2bf(hi) << 16); }
__device__ __forceinline__ float blo(unsigned w) { return __uint_as_float(w << 16); }
__device__ __forceinline__ float bhi(unsigned w) { return __uint_as_float(w & 0xffff0000u); }
__device__ __forceinline__ void wln_f32_bf16(const float* xrow, const float* g, const float* b, bf16_t* orow, int lane) {
    const f32x4* xr = (const f32x4*)xrow + lane; f32x4 v[4]; float s = 0.f;
#pragma unroll
    for (int j = 0; j < 4; ++j) { v[j] = xr[64 * j]; s += (v[j][0] + v[j][1]) + (v[j][2] + v[j][3]); }
    const float mean = wave_sum(s) * (1.f / 1024.f); float s2 = 0.f;
#pragma unroll
    for (int j = 0; j < 4; ++j) { v[j] = v[j] - mean; s2 += (v[j][0] * v[j][0] + v[j][1] * v[j][1]) + (v[j][2] * v[j][2] + v[j][3] * v[j][3]); }
    const float rstd = 1.f / sqrtf(wave_sum(s2) * (1.f / 1024.f) + 1e-5f);
#pragma unroll
    for (int j = 0; j < 4; ++j) { const f32x4 gg = ((const f32x4*)g)[64 * j + lane], bb = ((const f32x4*)b)[64 * j + lane]; const f32x4 o = v[j] * rstd * gg + bb;
        u32x2 w; w.x = pk2(o[0], o[1]); w.y = pk2(o[2], o[3]); *((u32x2*)orow + 64 * j + lane) = w; }
}
__device__ __forceinline__ void d_ln_rows(const float* in, const float* g, const float* b, bf16_t* out, int rows, int gw, int ngw, int lane) {
    for (int m = gw; m < rows; m += ngw) wln_f32_bf16(in + (size_t)m * 1024, g, b, out + (size_t)m * 1024, lane);
}
__device__ __forceinline__ void d_vn(const Params& P, int gw, int ngw, int lane) {
    const f32x4 g0 = ((const f32x4*)P.in[I_GLN_G])[2 * lane], g1 = ((const f32x4*)P.in[I_GLN_G])[2 * lane + 1];
    const f32x4 b0 = ((const f32x4*)P.in[I_GLN_B])[2 * lane], b1 = ((const f32x4*)P.in[I_GLN_B])[2 * lane + 1];
    for (int m = gw; m < TOK; m += ngw) {
        const u32x4 w = *((const u32x4*)(P.PB + (size_t)m * 1024 + 512) + lane);
        float x[8] = {blo(w.x), bhi(w.x), blo(w.y), bhi(w.y), blo(w.z), bhi(w.z), blo(w.w), bhi(w.w)};
        float s = 0.f;
#pragma unroll
        for (int i = 0; i < 8; ++i) s += x[i];
        const float mean = wave_sum(s) * (1.f / 512.f); float s2 = 0.f;
#pragma unroll
        for (int i = 0; i < 8; ++i) { x[i] -= mean; s2 += x[i] * x[i]; }
        const float rstd = 1.f / sqrtf(wave_sum(s2) * (1.f / 512.f) + 1e-5f);
        u32x4 o; o.x = pk2(x[0] * rstd * g0[0] + b0[0], x[1] * rstd * g0[1] + b0[1]); o.y = pk2(x[2] * rstd * g0[2] + b0[2], x[3] * rstd * g0[3] + b0[3]);
        o.z = pk2(x[4] * rstd * g1[0] + b1[0], x[5] * rstd * g1[1] + b1[1]); o.w = pk2(x[6] * rstd * g1[2] + b1[2], x[7] * rstd * g1[3] + b1[3]);
        *((u32x4*)(P.VN + (size_t)m * 512) + lane) = o;
    }
}
__device__ __forceinline__ void d_softmax256(const Params& P, int gw, int ngw, int lane) {
    for (long m = gw; m < (long)TOK * 4; m += ngw) { f32x4* xr = (f32x4*)(P.SCA + (size_t)m * 256) + lane; f32x4 v = *xr;
        const float mx = wave_max(fmaxf(fmaxf(v[0], v[1]), fmaxf(v[2], v[3])));
        v[0] = __expf(v[0] - mx); v[1] = __expf(v[1] - mx); v[2] = __expf(v[2] - mx); v[3] = __expf(v[3] - mx);
        const float inv = 1.0f / wave_sum((v[0] + v[1]) + (v[2] + v[3])); *xr = v * inv; }
}
__device__ __forceinline__ void tr_item(const float* W, int ldw, int src_col0, bf16_t* WT, int K, int dst_row0, int k0, LAS float* scr, int lane) {
    const int c = lane & 7;
    if (src_col0 < 0) {
#pragma unroll
        for (int j = 0; j < 4; ++j) { const int n = (lane >> 3) + 8 * j; *(u32x4*)(WT + (size_t)(dst_row0 + n) * K + k0 + 8 * c) = (u32x4){0u, 0u, 0u, 0u}; }
        return;
    }
#pragma unroll 8
    for (int i = 0; i < 32; ++i) { const int kk = 2 * i + (lane >> 5); scr[kk * 33 + (lane & 31)] = W[(size_t)(k0 + kk) * ldw + src_col0 + (lane & 31)]; }
    asm volatile("s_waitcnt lgkmcnt(0)" ::: "memory");
#pragma unroll
    for (int j = 0; j < 4; ++j) { const int n = (lane >> 3) + 8 * j; const LAS float* sp = scr + (8 * c) * 33 + n;
        u32x4 o; o.x = pk2(sp[0 * 33], sp[1 * 33]); o.y = pk2(sp[2 * 33], sp[3 * 33]); o.z = pk2(sp[4 * 33], sp[5 * 33]); o.w = pk2(sp[6 * 33], sp[7 * 33]);
        *(u32x4*)(WT + (size_t)(dst_row0 + n) * K + k0 + 8 * c) = o; }
    asm volatile("s_waitcnt lgkmcnt(0)" ::: "memory");
}
__device__ __forceinline__ void d_weights(const Params& P, LAS unsigned char* lds, int gw, int ngw, int wave, int lane) {
    LAS float* scr = (LAS float*)(lds + wave * 16384);
    constexpr int I_IN = 160 * 16, I_BR = 2 * 32 * 8, I_SQ = 32 * 16, I_WIDE = 64 * 16;
    constexpr int NITEMS = I_IN + I_BR + 3 * I_SQ + 2 * I_WIDE;
    for (int it = gw; it < NITEMS; it += ngw) {
        int r = it;
        if (r < I_IN) { const int nb = r / 16, kb = r % 16; tr_item(P.in[I_W_IN], IN_COLS, win_src_col(32 * nb), P.W_IN_T, 1024, 32 * nb, 64 * kb, scr, lane); continue; } r -= I_IN;
        if (r < I_BR) { const int br = r / 256, q = r % 256, nb = q / 8, kb = q % 8; tr_item(P.in[I_W_BRANCH] + (size_t)br * 512 * 1024, 1024, 32 * nb, P.W_BR_T, 512, br * 1024 + 32 * nb, 64 * kb, scr, lane); continue; } r -= I_BR;
        if (r < 3 * I_SQ) { const int w = r / I_SQ, q = r % I_SQ, nb = q / 16, kb = q % 16;
            const float* src = (w == 0) ? P.in[I_W_MIX] : (w == 1) ? P.in[I_W_Q] : P.in[I_W_O]; bf16_t* dst = (w == 0) ? P.W_MIX_T : (w == 1) ? P.W_Q_T : P.W_O_T;
            tr_item(src, 1024, 32 * nb, dst, 1024, 32 * nb, 64 * kb, scr, lane); continue; } r -= 3 * I_SQ;
        { const int w = r / I_WIDE, q = r % I_WIDE, nb = q / 16, kb = q % 16;
            tr_item(w == 0 ? P.in[I_W_KV] : P.in[I_W_QUERY], 2048, 32 * nb, w == 0 ? P.W_KV_T : P.W_QUERY_T, 1024, 32 * nb, 64 * kb, scr, lane); }
    }
}
__device__ __forceinline__ void d_tables(const Params& P, long gtid, long nthr) {
    const long n8 = (long)16384 * 1024 / 8;
    for (long i = gtid; i < 2 * n8; i += nthr) { const bool isv = (i >= n8); const long j = isv ? i - n8 : i;
        const f32x4* src = (const f32x4*)(isv ? P.in[I_PEER_V] : P.in[I_PEER_U]) + 2 * j; const f32x4 a = src[0], b = src[1];
        u32x4 o; o.x = pk2(a[0], a[1]); o.y = pk2(a[2], a[3]); o.z = pk2(b[0], b[1]); o.w = pk2(b[2], b[3]);
        *((u32x4*)(isv ? P.VB : P.UB) + j) = o; }
}
__device__ __forceinline__ float dot8(const u32x4& a, const u32x4& b, float acc) {
#if USE_DOT2
    acc = __builtin_amdgcn_fdot2_f32_bf16(__builtin_bit_cast(bf16x2_t, a.x), __builtin_bit_cast(bf16x2_t, b.x), acc, false);
    acc = __builtin_amdgcn_fdot2_f32_bf16(__builtin_bit_cast(bf16x2_t, a.y), __builtin_bit_cast(bf16x2_t, b.y), acc, false);
    acc = __builtin_amdgcn_fdot2_f32_bf16(__builtin_bit_cast(bf16x2_t, a.z), __builtin_bit_cast(bf16x2_t, b.z), acc, false);
    acc = __builtin_amdgcn_fdot2_f32_bf16(__builtin_bit_cast(bf16x2_t, a.w), __builtin_bit_cast(bf16x2_t, b.w), acc, false);
#else
    acc += blo(a.x) * blo(b.x); acc += bhi(a.x) * bhi(b.x); acc += blo(a.y) * blo(b.y); acc += bhi(a.y) * bhi(b.y);
    acc += blo(a.z) * blo(b.z); acc += bhi(a.z) * bhi(b.z); acc += blo(a.w) * blo(b.w); acc += bhi(a.w) * bhi(b.w);
#endif
    return acc;
}
__device__ __forceinline__ void axpy8(float* y, float c, const u32x4& v) {
    y[0] += c * blo(v.x); y[1] += c * bhi(v.x); y[2] += c * blo(v.y); y[3] += c * bhi(v.y);
    y[4] += c * blo(v.z); y[5] += c * bhi(v.z); y[6] += c * blo(v.w); y[7] += c * bhi(v.w);
}
__device__ __forceinline__ void d_peer(const Params& P, int gw, int ngw, int lane) {
    for (long t = gw; t < TOK; t += ngw) {
        const u32x4* xr = (const u32x4*)(P.HB + (size_t)t * 1024); const u32x4 x0 = xr[lane], x1 = xr[64 + lane];
        const int e_lo = P.EXPERT[(size_t)t * 128 + lane], e_hi = P.EXPERT[(size_t)t * 128 + 64 + lane];
        const float g_lo = P.GATE[(size_t)t * 128 + lane], g_hi = P.GATE[(size_t)t * 128 + 64 + lane];
        float y[16];
#pragma unroll
        for (int i = 0; i < 16; ++i) y[i] = 0.f;
#pragma unroll 1
        for (int half = 0; half < 2; ++half) {
            const int ev = half ? e_hi : e_lo; const float gv = half ? g_hi : g_lo;
#pragma unroll 1
            for (int k0 = 0; k0 < 64; k0 += 4) {
                int e[4]; float gt[4]; u32x4 u0[4], u1[4], v0[4], v1[4];
#pragma unroll
                for (int q = 0; q < 4; ++q) { e[q] = __builtin_amdgcn_readlane(ev, k0 + q); gt[q] = __uint_as_float(__builtin_amdgcn_readlane(__float_as_uint(gv), k0 + q)); }
#pragma unroll
                for (int q = 0; q < 4; ++q) { const u32x4* ur = (const u32x4*)(P.UB + (size_t)e[q] * 1024); u0[q] = ur[lane]; u1[q] = ur[64 + lane]; }
#pragma unroll
                for (int q = 0; q < 4; ++q) { const u32x4* vr = (const u32x4*)(P.VB + (size_t)e[q] * 1024); v0[q] = vr[lane]; v1[q] = vr[64 + lane]; }
                float d[4];
#pragma unroll
                for (int q = 0; q < 4; ++q) d[q] = dot8(u1[q], x1, dot8(u0[q], x0, 0.f));
#pragma unroll
                for (int o = 1; o < 64; o <<= 1) {
#pragma unroll
                    for (int q = 0; q < 4; ++q) d[q] += __shfl_xor(d[q], o); }
#pragma unroll
                for (int q = 0; q < 4; ++q) { const float a = d[q]; const float c = gt[q] * 0.5f * a * (1.0f + erff(a * 0.7071067811865476f)); axpy8(y, c, v0[q]); axpy8(y + 8, c, v1[q]); }
            }
        }
        float z[16];
        z[0] = ALPHA_F * blo(x0.x) + y[0]; z[1] = ALPHA_F * bhi(x0.x) + y[1]; z[2] = ALPHA_F * blo(x0.y) + y[2]; z[3] = ALPHA_F * bhi(x0.y) + y[3];
        z[4] = ALPHA_F * blo(x0.z) + y[4]; z[5] = ALPHA_F * bhi(x0.z) + y[5]; z[6] = ALPHA_F * blo(x0.w) + y[6]; z[7] = ALPHA_F * bhi(x0.w) + y[7];
        z[8] = ALPHA_F * blo(x1.x) + y[8]; z[9] = ALPHA_F * bhi(x1.x) + y[9]; z[10] = ALPHA_F * blo(x1.y) + y[10]; z[11] = ALPHA_F * bhi(x1.y) + y[11];
        z[12] = ALPHA_F * blo(x1.z) + y[12]; z[13] = ALPHA_F * bhi(x1.z) + y[13]; z[14] = ALPHA_F * blo(x1.w) + y[14]; z[15] = ALPHA_F * bhi(x1.w) + y[15];
        float s = 0.f;
#pragma unroll
        for (int i = 0; i < 16; ++i) s += z[i];
        const float mean = wave_sum(s) * (1.f / 1024.f); float s2 = 0.f;
#pragma unroll
        for (int i = 0; i < 16; ++i) { z[i] -= mean; s2 += z[i] * z[i]; }
        const float rstd = 1.f / sqrtf(wave_sum(s2) * (1.f / 1024.f) + 1e-5f);
        const float* g = P.in[I_LN3_G]; const float* b = P.in[I_LN3_B]; float* orow = P.out + (size_t)t * 1024;
#pragma unroll
        for (int hh = 0; hh < 2; ++hh)
#pragma unroll
            for (int q = 0; q < 2; ++q) { const int col = hh * 512 + lane * 8 + q * 4; const f32x4 gg = *(const f32x4*)(g + col), bb = *(const f32x4*)(b + col);
                f32x4 o; o[0] = z[hh * 8 + q * 4 + 0] * rstd * gg[0] + bb[0]; o[1] = z[hh * 8 + q * 4 + 1] * rstd * gg[1] + bb[1];
                o[2] = z[hh * 8 + q * 4 + 2] * rstd * gg[2] + bb[2]; o[3] = z[hh * 8 + q * 4 + 3] * rstd * gg[3] + bb[3];
                *(f32x4*)(orow + col) = o; }
    }
}

__device__ __forceinline__ void d_lora_weights(const Params& P, long gtid, long nthr) {
    for (long idx = gtid; idx < (long)2560 * 512; idx += nthr) { const int n = (int)(idx / 512), k = (int)(idx % 512); float v = 0.f;
        if (n < 1024) { const int z = n >> 9, c = n & 511; if (k >= z * 64 && k < z * 64 + 64) v = P.in[I_W2][((size_t)z * 64 + (k - z * 64)) * 512 + c]; }
        else if (n < 2048) { const int z = (n - 1024) >> 9, c = n & 511; const int kk = k - 128; if (kk >= z * 64 && kk < z * 64 + 64) v = P.in[I_A2][((size_t)z * 64 + (kk - z * 64)) * 512 + c]; }
        else { const int c = n - 2048; if (k >= 256 && k < 384) v = P.in[I_G2][(size_t)(k - 256) * 512 + c]; }
        P.W_LORA_T[idx] = f2bf(v); }
}
__device__ __forceinline__ void shift8(const bf16_t* PA, long t, int s, int col, const float* mu, float* o) {
    const u32x4 c = *(const u32x4*)(PA + (size_t)t * 2048 + col);
    u32x4 p = (u32x4){0u, 0u, 0u, 0u}, n = (u32x4){0u, 0u, 0u, 0u};
    if (s > 0) p = *(const u32x4*)(PA + (size_t)(t - 1) * 2048 + col);
    if (s < SEQ - 1) n = *(const u32x4*)(PA + (size_t)(t + 1) * 2048 + col);
    const f32x4 m0 = *(const f32x4*)(mu + col), m1 = *(const f32x4*)(mu + col + 4);
    const float cc[8] = {blo(c.x), bhi(c.x), blo(c.y), bhi(c.y), blo(c.z), bhi(c.z), blo(c.w), bhi(c.w)};
    const float pp[8] = {blo(p.x), bhi(p.x), blo(p.y), bhi(p.y), blo(p.z), bhi(p.z), blo(p.w), bhi(p.w)};
    const float nn[8] = {blo(n.x), bhi(n.x), blo(n.y), bhi(n.y), blo(n.z), bhi(n.z), blo(n.w), bhi(n.w)};
#pragma unroll
    for (int i = 0; i < 8; ++i) { const float m = (i < 4) ? m0[i] : m1[i - 4]; o[i] = cc[i] + m * (0.5f * (pp[i] + nn[i]) - cc[i]); }
}
__device__ __forceinline__ u32x4 pack8f(const float* v) { u32x4 w; w.x = pk2(v[0], v[1]); w.y = pk2(v[2], v[3]); w.z = pk2(v[4], v[5]); w.w = pk2(v[6], v[7]); return w; }
__device__ __forceinline__ void d_prep_e1(const Params& P, int gw, int ngw, int lane) {
    const float* mu = P.in[I_MU];
    const f32x4 kk0 = *(const f32x4*)(P.in[I_K_K] + 8 * lane), kk1 = *(const f32x4*)(P.in[I_K_K] + 8 * lane + 4);
    for (long t = gw; t < TOK; t += ngw) { const int s = (int)(t % SEQ); float r[8], k[8], v[8];
        shift8(P.PA, t, s, 8 * lane, mu, r); shift8(P.PA, t, s, 512 + 8 * lane, mu, k); shift8(P.PA, t, s, 1024 + 8 * lane, mu, v);
        float q[8]; float ss = 0.f;
#pragma unroll
        for (int i = 0; i < 8; ++i) { q[i] = k[i] * ((i < 4) ? kk0[i] : kk1[i - 4]); ss += q[i] * q[i]; }
        ss += __shfl_xor(ss, 1); ss += __shfl_xor(ss, 2); ss += __shfl_xor(ss, 4);
        const float inv = 1.0f / fmaxf(sqrtf(ss), 1e-12f);
#pragma unroll
        for (int i = 0; i < 8; ++i) q[i] *= inv;
        *(u32x4*)(P.R + (size_t)t * 512 + 8 * lane) = pack8f(r); *(u32x4*)(P.K + (size_t)t * 512 + 8 * lane) = pack8f(k);
        *(u32x4*)(P.V + (size_t)t * 512 + 8 * lane) = pack8f(v); *(u32x4*)(P.KK + (size_t)t * 512 + 8 * lane) = pack8f(q);
        if (lane < 48) { float x[8]; shift8(P.PA, t, s, 1536 + 8 * lane, mu, x);
#pragma unroll
            for (int i = 0; i < 8; ++i) x[i] = (lane < 16) ? tanhf(x[i]) : (lane < 32) ? x[i] : 1.0f / (1.0f + expf(-x[i]));
            *(u32x4*)(P.LIN + (size_t)t * 512 + 8 * lane) = pack8f(x); }
        else *(u32x4*)(P.LIN + (size_t)t * 512 + 8 * lane) = (u32x4){0u, 0u, 0u, 0u};
    }
}
__device__ __forceinline__ void scan_item3(const Params& P, int chain, int i) {
    const int h = chain % 8, b = (chain / 8) % BATCH, z = chain / (8 * BATCH);
    float S[64];
#pragma unroll
    for (int j = 0; j < 64; ++j) S[j] = 0.f;
    const float* ka = P.in[I_K_A] + h * 64;
    for (int n = 0; n < SEQ; ++n) {
        const long t = (long)b * SEQ + ((z == 0) ? n : (SEQ - 1 - n)); const size_t o1 = (size_t)t * 512 + h * 64, o2 = ((size_t)t * 2 + z) * 512 + h * 64;
        const float v = bf2f(P.V[o1 + i]);
        float sa = 0.f;
#pragma unroll
        for (int j = 0; j < 64; ++j) sa -= S[j] * bf2f(P.KK[o1 + j]);
        float y = 0.f;
#pragma unroll
        for (int j = 0; j < 64; ++j) { const float al = bf2f(P.AL[o2 + j]), k = bf2f(P.K[o1 + j]);
            S[j] = S[j] * (1.0f - bf2f(P.OMW[o2 + j])) + sa * (bf2f(P.KK[o1 + j]) * al) + v * (k * (1.0f + (al - 1.0f) * ka[j])); y += S[j] * bf2f(P.R[o1 + j]); }
        P.Y01[((size_t)z * TOK + t) * 512 + h * 64 + i] = y;
    }
}

#define SC_CH 32
#define SC_REC 352
template <int CTRL> __device__ __forceinline__ float dpp_add(float x) {
    return x + __uint_as_float((unsigned)__builtin_amdgcn_update_dpp(0, (int)__float_as_uint(x), CTRL, 0xf, 0xf, false));
}
__device__ __forceinline__ float allsum16(float x) { x = dpp_add<0xB1>(x); x = dpp_add<0x4E>(x); x = dpp_add<0x141>(x); x = dpp_add<0x140>(x); return x; }
__device__ __forceinline__ void d_scan(const Params& P, LAS unsigned char* lds, int tid) {
    const int lane = tid & 63, wave = __builtin_amdgcn_readfirstlane(tid >> 6);
    const int chain = (int)blockIdx.x >> 1, half = (int)blockIdx.x & 1;
    if (chain >= 2 * BATCH * 8) return;
    const int h = chain % 8, b = (chain / 8) % BATCH, z = chain / (8 * BATCH);
    LAS float* buf = (LAS float*)lds;
    const float ka = P.in[I_K_A][h * 64 + lane];
    const long tb = (long)b * SEQ;
    unsigned short gr[4], gk[4], gkk[4], gom[4], gal[4], gv[2];
    auto g_load = [&](int c) {
#pragma unroll
        for (int q = 0; q < 4; ++q) { const int n = c * SC_CH + wave + 8 * q; const long t = tb + ((z == 0) ? n : (SEQ - 1 - n));
            const size_t o1 = (size_t)t * 512 + h * 64 + lane, o2 = ((size_t)t * 2 + z) * 512 + h * 64 + lane;
            gr[q] = P.R[o1]; gk[q] = P.K[o1]; gkk[q] = P.KK[o1]; gom[q] = P.OMW[o2]; gal[q] = P.AL[o2]; }
#pragma unroll
        for (int q = 0; q < 2; ++q) { const int p = tid + 512 * q; const int n = c * SC_CH + (p >> 5); const long t = tb + ((z == 0) ? n : (SEQ - 1 - n));
            gv[q] = P.V[(size_t)t * 512 + h * 64 + half * 32 + (p & 31)]; }
    };
    auto s_write = [&](int c) {
        LAS float* bb = buf + (c & 1) * (SC_CH * SC_REC);
#pragma unroll
        for (int q = 0; q < 4; ++q) { LAS float* rec = bb + (wave + 8 * q) * SC_REC + lane;
            const float k = bf2f(gk[q]), kk = bf2f(gkk[q]), al = bf2f(gal[q]);
            rec[0] = 1.0f - bf2f(gom[q]); rec[64] = k * (1.0f + (al - 1.0f) * ka); rec[128] = -kk; rec[192] = kk * al; rec[256] = bf2f(gr[q]); }
#pragma unroll
        for (int q = 0; q < 2; ++q) { const int p = tid + 512 * q; bb[(p >> 5) * SC_REC + 320 + (p & 31)] = bf2f(gv[q]); }
    };
    const int rg = lane >> 4, jl = lane & 15, rowl = wave * 4 + rg;
    float S0 = 0.f, S1 = 0.f, S2 = 0.f, S3 = 0.f;
    g_load(0); s_write(0); g_load(1);
    asm volatile("s_waitcnt lgkmcnt(0)" ::: "memory"); __syncthreads();
    float* yout = P.Y01 + (size_t)z * TOK * 512 + h * 64 + half * 32 + rowl;
    constexpr int NCH = SEQ / SC_CH;
#pragma unroll 1
    for (int c = 0; c < NCH; ++c) {
        if (c + 1 < NCH) s_write(c + 1);
        if (c + 2 < NCH) g_load(c + 2);
        const LAS float* bb = buf + (c & 1) * (SC_CH * SC_REC);
#pragma unroll 4
        for (int nl = 0; nl < SC_CH; ++nl) { const LAS float* rec = bb + nl * SC_REC + jl * 4;
            const f32x4 w4 = *(const LAS f32x4*)(rec), kd4 = *(const LAS f32x4*)(rec + 64), a4 = *(const LAS f32x4*)(rec + 128), b4 = *(const LAS f32x4*)(rec + 192), r4 = *(const LAS f32x4*)(rec + 256);
            const float v = bb[nl * SC_REC + 320 + rowl];
            float sa = (S0 * a4[0] + S1 * a4[1]) + (S2 * a4[2] + S3 * a4[3]);
            sa = allsum16(sa);
            S0 = S0 * w4[0] + (sa * b4[0] + v * kd4[0]); S1 = S1 * w4[1] + (sa * b4[1] + v * kd4[1]);
            S2 = S2 * w4[2] + (sa * b4[2] + v * kd4[2]); S3 = S3 * w4[3] + (sa * b4[3] + v * kd4[3]);
            float y = (S0 * r4[0] + S1 * r4[1]) + (S2 * r4[2] + S3 * r4[3]);
            y = allsum16(y);
            const int n = c * SC_CH + nl; const long t = tb + ((z == 0) ? n : (SEQ - 1 - n));
            if (jl == 0) yout[(size_t)t * 512] = y;
        }
        asm volatile("s_waitcnt lgkmcnt(0)" ::: "memory"); __syncthreads();
    }
}
__device__ __forceinline__ void d_rwkv_out(const Params& P, int gw, int ngw, int lane) {
    for (long it = gw; it < (long)TOK * 8; it += ngw) { const long t = it >> 3; const int c = (int)(it & 7) * 64 + lane;
        const float y = P.Y01[(size_t)t * 512 + c] + P.Y01[((size_t)TOK + t) * 512 + c];
        const float mu = wave_sum(y) * (1.f / 64.f); const float d = y - mu; const float rs = 1.0f / sqrtf(wave_sum(d * d) * (1.f / 64.f) + 64e-5f);
        const float yn = d * rs * P.in[I_GN_G][c] + P.in[I_GN_B][c];
        const float r = bf2f(P.R[(size_t)t * 512 + c]), k = bf2f(P.K[(size_t)t * 512 + c]), ka = P.in[I_K_A][c];
        const float a0 = bf2f(P.AL[((size_t)t * 2) * 512 + c]), a1 = bf2f(P.AL[((size_t)t * 2 + 1) * 512 + c]);
        const float kd = k * (1.0f + (a0 - 1.0f) * ka) + k * (1.0f + (a1 - 1.0f) * ka);
        const float rk = wave_sum(r * kd * P.in[I_R_K][c]);
        P.YA[(size_t)t * 512 + c] = f2bf((yn + rk * bf2f(P.V[(size_t)t * 512 + c])) * bf2f(P.G[(size_t)t * 512 + c])); }
}
constexpr int RING_BYTES = 131072, LDSCTL_OFF = RING_BYTES, MISC_OFF = LDSCTL_OFF + 320, LDS_BYTES = 147456;
constexpr int CW_BAR = 4096;
#ifndef MK_PER_PHASE
#define MK_PER_PHASE 0
#endif
struct KArgs { Params P; int ph_lo, ph_hi; };
template <class DE, bool ALIGN = true> __device__ __forceinline__ void run_gemm(LAS unsigned char* lds, const bf16_t* A, const bf16_t* Bt, int M, int N, int K, const DE& E,
                                                                     int bgrp = 1 << 30, size_t bgstride = 0) {
    pg8::Gemm g{A, Bt, M, N, K, K, K, bgrp, bgstride}; pg8::StaticOrder S; S.init(M, N, (int)gridDim.x, (int)blockIdx.x);
    pg8::gemm_phase<DE, pg8::StaticOrder, ALIGN, true>(lds, g, S, E);
}
__global__ void __launch_bounds__(512, 2) mega_fwd(KArgs a) {
    extern __shared__ __attribute__((aligned(16))) unsigned char lds_raw[];
    LAS unsigned char* lds = (LAS unsigned char*)lds_raw;
    volatile LAS unsigned* MISC = (volatile LAS unsigned*)(lds + MISC_OFF);
    const Params& P = a.P;
    const int tid = threadIdx.x;
    for (int u = tid; u < (LDS_BYTES - LDSCTL_OFF) / 4; u += 512) ((LAS unsigned*)(lds + LDSCTL_OFF))[u] = 0u;
    __syncthreads();
    XcdBarrier bar; bar.bar = P.ctl + CW_BAR; bar.x = 0; bar.st = nullptr;
    if (!MK_PER_PHASE) bar = xcd_barrier_post(P.ctl + CW_BAR, MISC + 8);
    const long gtid = (long)blockIdx.x * 512 + tid, nthr = (long)gridDim.x * 512;
    const int lane = tid & 63, wave = __builtin_amdgcn_readfirstlane(tid >> 6), gw = (int)blockIdx.x * 8 + wave, ngw = (int)gridDim.x * 8;
    const int lo = a.ph_lo, hi = a.ph_hi;
#define IN(k) (lo <= (k) && (k) < hi)
#define SEAM(k) do { if ((k) + 1 < hi) xcd_barrier(bar); } while (0)
#define SIMT(k, call) if (IN(k)) { call; SEAM(k); }
    SIMT(0, (d_weights(P, lds, gw, ngw, wave, lane), d_lora_weights(P, gtid, nthr), d_ln_rows(P.in[I_X], P.in[I_LN_EMB_G], P.in[I_LN_EMB_B], P.HB, TOK, gw, ngw, lane),
             d_ln_rows(P.in[I_MEM], P.in[I_MLN_G], P.in[I_MLN_B], P.MEMN, BATCH * MEM_LEN, gw, ngw, lane)))
    if (IN(1)) { { pg8::DEpiP1 E{{P.PA, P.PB}}; run_gemm(lds, P.HB, P.W_IN_T, TOK, 3072, 1024, E); }
#if ATT_OLD
                 { pg8::DEpiPlain E2{{P.KV, 2048, 0}}; run_gemm(lds, P.MEMN, P.W_KV_T, BATCH * MEM_LEN, 2048, 1024, E2); } SEAM(1); }
#else
                 { pg8::DEpiTile E2{P.KH, 4, 1, 1.0f}; run_gemm(lds, P.MEMN, P.W_KV_T, BATCH * MEM_LEN, 1024, 1024, E2); }
                 { pg8::DEpiTile E3{P.VT, 1, 4, 1.0f}; run_gemm(lds, P.W_KV_T + (size_t)1024 * 1024, P.MEMN, 1024, BATCH * MEM_LEN, 1024, E3); } SEAM(1); }
#endif
    SIMT(2, d_vn(P, gw, ngw, lane))
    SIMT(3, ph2b_gmlp(P, gtid, nthr))
    SIMT(4, d_prep_e1(P, gw, ngw, lane))
    if (IN(5)) { { pg8::DEpiLora<0> E{P.in[I_W0], P.OMW}; run_gemm(lds, P.LIN, P.W_LORA_T, TOK, 1024, 512, E); }
                 { pg8::DEpiLora<1> E{P.in[I_A0], P.AL}; run_gemm(lds, P.LIN, P.W_LORA_T + (size_t)1024 * 512, TOK, 1024, 512, E); }
                 { pg8::DEpiLora<2> E{nullptr, P.G}; run_gemm(lds, P.LIN, P.W_LORA_T + (size_t)2048 * 512, TOK, 512, 512, E); } SEAM(5); }
#if NEW_SCAN
    if (IN(6)) { d_scan(P, lds, tid); SEAM(6); }
#else
    if (IN(6)) { const int chain = (int)blockIdx.x + (int)gridDim.x * wave; if (chain < 2 * BATCH * 8) scan_item3(P, chain, lane); SEAM(6); }
#endif
    SIMT(7, d_rwkv_out(P, gw, ngw, lane))
    if (IN(8)) { { pg8::DEpiPlain E{{P.BR, 2048, 0}}; run_gemm(lds, P.YA, P.W_BR_T, TOK, 1024, 512, E); }
                 { pg8::DEpiPlain E2{{P.BR, 2048, 1024}}; run_gemm(lds, P.YB, P.W_BR_T + (size_t)1024 * 512, TOK, 1024, 512, E2); } SEAM(8); }
    if (IN(9)) { pg8::DEpiMerge E{{P.BR, P.MG}}; run_gemm(lds, P.HB, P.W_IN_T + (size_t)3072 * 1024, TOK, 2048, 1024, E); SEAM(9); }
    if (IN(10)) { pg8::DEpiResid E{{P.HB, P.Z}}; run_gemm(lds, P.MG, P.W_MIX_T, TOK, 1024, 1024, E); SEAM(10); }
    SIMT(11, d_ln_rows(P.Z, P.in[I_LN1_G], P.in[I_LN1_B], P.HB, TOK, gw, ngw, lane))
#if ATT_OLD
    if (IN(12)) { pg8::DEpiPlain E{{P.Q, 1024, 0}}; run_gemm(lds, P.HB, P.W_Q_T, TOK, 1024, 1024, E); SEAM(12); }
    SIMT(13, ph10a_scores(P, gtid, nthr))
    SIMT(14, d_softmax256(P, gw, ngw, lane))
    SIMT(15, ph10c_out(P, gtid, nthr))
#else
    if (IN(12)) { pg8::DEpiQ EQ{{P.QH, 1, 0, 0.0625f}}; run_gemm(lds, P.HB, P.W_Q_T, TOK, 1024, 1024, EQ); SEAM(12); }
    if (IN(13)) { pg8::DEpiSoftmax E{P.PP}; run_gemm<pg8::DEpiSoftmax, false>(lds, P.QH, P.KH, TOK * 4, 256, 256, E, 8, (size_t)256 * 256 * 2); SEAM(13); }
    if (IN(14)) { pg8::DEpiO E{P.O}; run_gemm(lds, P.PP, P.VT, TOK * 4, 256, 256, E, 8, (size_t)256 * 256 * 2); SEAM(14); }
#endif
    if (IN(15 + AX)) { pg8::DEpiResid E{{P.HB, P.Z}}; run_gemm(lds, P.O, P.W_O_T, TOK, 1024, 1024, E); SEAM(15 + AX); }
    SIMT(16 + AX, d_ln_rows(P.Z, P.in[I_LN2_G], P.in[I_LN2_B], P.HB, TOK, gw, ngw, lane))
    if (IN(17 + AX)) { pg8::DEpiPlain E{{P.QP, 2048, 0}}; run_gemm(lds, P.HB, P.W_QUERY_T, TOK, 2048, 1024, E); SEAM(17 + AX); }
    SIMT(18 + AX, ph13a_scores(P, gtid, nthr))
    SIMT(19 + AX, ph13b_topk(P, gtid, nthr))
    SIMT(20 + AX, ph13c_cand(P, gtid, nthr))
    SIMT(21 + AX, d_tables(P, gtid, nthr))
    SIMT(22 + AX, d_peer(P, gw, ngw, lane))
#undef IN
#undef SEAM
#undef SIMT
}
extern "C" void kernel_launch(void* const* d_in, const int* in_sizes, int n_in, void* d_out, int out_size, void* d_ws, size_t ws_size, hipStream_t stream) {
    static int grid = 0;
    if (grid == 0) {
        int dev = 0, cus = 0;
        if (n_in != 37 || ws_size < WS_NEED || hipGetDevice(&dev) != hipSuccess || hipDeviceGetAttribute(&cus, hipDeviceAttributeMultiprocessorCount, dev) != hipSuccess) {
            fprintf(stderr, "kernel_launch: bad arguments (n_in %d, ws %zu < %zu)\n", n_in, ws_size, (size_t)WS_NEED); grid = -1; return; }
        if (hipFuncSetAttribute((const void*)mega_fwd, hipFuncAttributeMaxDynamicSharedMemorySize, LDS_BYTES) != hipSuccess) { fprintf(stderr, "kernel_launch: hipFuncSetAttribute failed\n"); grid = -1; return; }
        grid = cus;
    }
    if (grid < 0) return;
    (void)hipMemsetAsync((char*)d_ws + WS_CTL, 0, 1 * MiB, stream);
    KArgs a; memset(&a, 0, sizeof(a)); make_params(a.P, d_in, d_out, d_ws);
#if MK_PER_PHASE
    for (int ph = 0; ph < N_PHASES; ++ph) { a.ph_lo = ph; a.ph_hi = ph + 1; hipLaunchKernelGGL(mega_fwd, dim3(grid), dim3(512), LDS_BYTES, stream, a); }
#else
    a.ph_lo = 0; a.ph_hi = N_PHASES; hipLaunchKernelGGL(mega_fwd, dim3(grid), dim3(512), LDS_BYTES, stream, a);
#endif
}
#endif
```

```cpp
#ifdef HOST_EMU
#include "emu.h"
#else
#include <hip/hip_runtime.h>
#include <cstdio>
#include <cstdint>
#include <cstring>
#endif

#ifndef BATCH
#define BATCH 8
#endif
#ifndef SEQ
#define SEQ 2048
#endif
#define DM 1024
#define TOK (BATCH * SEQ)
#define IN_COLS 4992
#define MEM_LEN 256
#define ALPHA_F 1.189207115002721f
typedef unsigned short bf16_t;

#ifdef HOST_EMU
static inline float bf2f(bf16_t v) { unsigned u = (unsigned)v << 16; float f; memcpy(&f, &u, 4); return f; }
static inline bf16_t f2bf(float f) { unsigned u; memcpy(&u, &f, 4); return (bf16_t)((u + 0x7fffu + ((u >> 16) & 1u)) >> 16); }
#else
__device__ __forceinline__ float bf2f(bf16_t v) { return __uint_as_float((unsigned)v << 16); }
__device__ __forceinline__ bf16_t f2bf(float f) { unsigned u = __float_as_uint(f); return (bf16_t)((u + 0x7fffu + ((u >> 16) & 1u)) >> 16); }
#endif
__device__ __forceinline__ float sigmoidf_(float x) { return 1.0f / (1.0f + expf(-x)); }
__device__ __forceinline__ float geluf_(float x) { return 0.5f * x * (1.0f + erff(x * 0.7071067811865476f)); }

struct Params {
    const float* in[37];
    float* out;
    unsigned* ctl;
    bf16_t *W_IN_T, *W_BR_T, *W_MIX_T, *W_Q_T, *W_KV_T, *W_O_T, *W_QUERY_T;
    bf16_t *KV, *MEMN, *HB;
    bf16_t *PA, *PB, *VN, *YB;
    bf16_t *WDS, *ADS, *SG;
    bf16_t *R, *V, *KK, *OMW, *KDIR, *BVEC;
    float *Y01;
    bf16_t *YA, *BR, *MG;
    float* Z;
    bf16_t *Q, *O;
    float* SCA;
    bf16_t* QP;
    float* SC; float* TOPS; int* TOPI; float* GATE; int* EXPERT; float* COEF; float* Y;
    bf16_t *UB, *VB;
    bf16_t *W_LORA_T;
    bf16_t *LIN, *K, *AL, *G;
    bf16_t *KH, *VT, *QH, *PP;
};
enum { I_X = 0, I_MEM, I_LN_EMB_G, I_LN_EMB_B, I_W_IN, I_MU, I_W0, I_W2, I_A0, I_A2, I_G2, I_K_K, I_K_A, I_R_K, I_GN_G, I_GN_B,
       I_GLN_G, I_GLN_B, I_W_S, I_B_S, I_W_BRANCH, I_W_MIX, I_LN1_G, I_LN1_B, I_MLN_G, I_MLN_B, I_W_Q, I_W_KV, I_W_O, I_LN2_G, I_LN2_B,
       I_W_QUERY, I_SUBKEYS, I_PEER_U, I_PEER_V, I_LN3_G, I_LN3_B };

constexpr size_t MiB = 1u << 20;
constexpr size_t TU = (size_t)TOK * 1024;
constexpr size_t WS_CTL = 0;
constexpr size_t WS_W = 1 * MiB;
constexpr size_t OFF_W_IN = 0, OFF_W_BR = OFF_W_IN + (size_t)5120 * 1024 * 2, OFF_W_MIX = OFF_W_BR + (size_t)2048 * 512 * 2,
                 OFF_W_Q = OFF_W_MIX + (size_t)1024 * 1024 * 2, OFF_W_KV = OFF_W_Q + (size_t)1024 * 1024 * 2,
                 OFF_W_O = OFF_W_KV + (size_t)2048 * 1024 * 2, OFF_W_QUERY = OFF_W_O + (size_t)1024 * 1024 * 2,
                 OFF_W_END = OFF_W_QUERY + (size_t)2048 * 1024 * 2;
static_assert(OFF_W_END <= 27 * MiB, "weights region");
constexpr size_t OFF_W_LORA = OFF_W_END, OFF_W_END2 = OFF_W_LORA + (size_t)2560 * 512 * 2;
static_assert(OFF_W_END2 <= 29 * MiB, "weights region 2");
constexpr size_t WS_KV = 30 * MiB;
constexpr size_t WS_MEMN = 38 * MiB;
constexpr size_t WS_ACT = 42 * MiB;
constexpr size_t A_HB = WS_ACT;
constexpr size_t A_R1 = A_HB + 2 * TU;
constexpr size_t A_R2 = A_R1 + 4 * TU;
constexpr size_t WS_NEED = A_R2 + 7 * TU;
#ifndef HOST_EMU
static_assert(WS_NEED <= 256 * MiB, "workspace map exceeds 256 MiB");
#endif

struct EpiP1 { bf16_t* PA; bf16_t* PB; };
struct EpiPlain { bf16_t* O; int ldc; int col_off; };
struct EpiMerge { const bf16_t* BR; bf16_t* MG; };
struct EpiResid { const bf16_t* H; float* Z; };

#ifndef HOST_EMU
namespace pg8 {
#define PG8_LAS __attribute__((address_space(3)))
typedef unsigned short bf16_t;
typedef short bf16x8 __attribute__((ext_vector_type(8)));
typedef float f32x4 __attribute__((ext_vector_type(4)));
typedef unsigned u32x4 __attribute__((ext_vector_type(4)));
constexpr int BM = 256, BK = 64, HALF = 128, HTB = HALF * BK * 2  , STAGE_BYTES = 8 * HTB, NXCD = 8, WGM = 8;

__host__ __device__ __forceinline__ int lds_byte(int r, int c) { const int st = (r >> 4) * 2 + (c >> 5), rr = r & 15, cc = c & 31, ob = rr * 64 + cc * 2; return st * 1024 + (ob ^ (((ob >> 9) & 1) << 5)); }
__host__ __device__ __forceinline__ void stage_rc(int b, int& R, int& C) { const int st = b / 1024, sb = b % 1024, swz = sb ^ (((sb >> 9) & 1) << 5); R = (st >> 1) * 16 + swz / 64; C = (st & 1) * 32 + (swz % 64) / 2; }
__host__ __device__ __forceinline__ int perm32(int rho) { const int n = rho >> 4, i = rho & 15; return 8 * (i >> 2) + 4 * n + (i & 3); }

struct Unit { int pm, pn; };
struct Gemm { const bf16_t* A; const bf16_t* Bt; int M, N, K; int lda, ldb; int bgrp; size_t bgstride; };

struct StaticOrder {
    int nM, nN, nwg, G, c;
    __host__ __device__ void init(int M, int N, int G_, int c_) { nM = M / BM; nN = N / BM; nwg = nM * nN; G = G_; c = c_; }
    __host__ __device__ bool next(int i, Unit& u) const {
        const long L = (long)i * G + c; if (L >= nwg) return false;
        int wgid = (int)L; { const int q = nwg / NXCD, r = nwg % NXCD, xcd = wgid % NXCD, off = wgid / NXCD; wgid = (xcd < r ? xcd * (q + 1) : r * (q + 1) + (xcd - r) * q) + off; }
        const int nig = WGM * nN, gid = wgid / nig, fm = gid * WGM, gsz = (nM - fm) < WGM ? (nM - fm) : WGM;
        u.pm = fm + ((wgid % nig) % gsz); u.pn = (wgid % nig) / gsz; return true;
    }
    __device__ __forceinline__ void a_ready(const Unit&) const {}
    __device__ __forceinline__ void done(const Unit&) const {}
};

typedef float f32x2c __attribute__((ext_vector_type(2))); typedef __bf16 bf16x2c __attribute__((ext_vector_type(2)));
__device__ __forceinline__ unsigned cvt_pk_bf16(float lo, float hi) { const f32x2c v = {lo, hi}; const bf16x2c b = __builtin_convertvector(v, bf16x2c); return __builtin_bit_cast(unsigned, b); }
typedef float f32x2 __attribute__((ext_vector_type(2)));
__device__ __forceinline__ f32x2 gelu_pk(f32x2 v) {
    const f32x2 av = __builtin_elementwise_abs(v), d = av * 0.2316418882f + 1.0f;
    f32x2 t; t.x = __builtin_amdgcn_rcpf(d.x); t.y = __builtin_amdgcn_rcpf(d.y);
    f32x2 q = t * 0.5307027145f + (-0.7265760135f); q = q * t + 0.7107068705f; q = q * t + (-0.142248368f); q = q * t + 0.127414796f; q = q * t;
    const f32x2 s = (v * v) * (-0.72134752044f);
    f32x2 e; e.x = __builtin_amdgcn_exp2f(s.x); e.y = __builtin_amdgcn_exp2f(s.y);
    const f32x2 m = v * (q * e), r = v - m;
    f32x2 o; o.x = v.x < 0.f ? m.x : r.x; o.y = v.y < 0.f ? m.y : r.y; return o;
}


template <class Epi, class Sched, bool ALIGN_EPI = false, bool SP2 = false>
__device__ __forceinline__ void gemm_phase(PG8_LAS unsigned char* lds, const Gemm g, const Sched& S, const Epi& E) {
    const int tid = threadIdx.x, wid = __builtin_amdgcn_readfirstlane(tid >> 6), lane = tid & 63, wr = wid >> 2, wc = wid & 3, fr = lane & 15, fq = lane >> 4;
    const int K = g.K, nt = K / BK;
    unsigned voffA[2], voffB[2];
#pragma unroll
    for (int i = 0; i < 2; ++i) { int R, C; stage_rc(tid * 16 + i * 8192, R, C); const int Rb = Epi::PERM ? ((R & ~31) + perm32(R & 31)) : R;
        voffA[i] = (unsigned)(R * g.lda + C) * 2u; voffB[i] = (unsigned)(Rb * g.ldb + C) * 2u; }
    const size_t kstep = (size_t)(BK * 2);
    const size_t hstepA = (size_t)HALF * g.lda * 2, hstepB = (size_t)HALF * g.ldb * 2;
    const size_t tstepA = 2 * hstepA, tstepB = 2 * hstepB;
    const unsigned ldsw = (unsigned)wid * 1024u;
    const int aoff = lds_byte(wr * 64 + fr, fq * 8), boff = lds_byte(wc * 32 + fr, fq * 8);
#define PG8_SA(b, h) (((b) * 2 + (h)) * HTB)
#define PG8_SB(b, h) ((4 + (b) * 2 + (h)) * HTB)
#define PG8_STAGE(bufoff, gbase, voff) do { _Pragma("unroll") for (int _i = 0; _i < 2; ++_i) \
        __builtin_amdgcn_global_load_lds((const unsigned*)((const char*)(gbase) + (voff)[_i]), (PG8_LAS unsigned*)(lds + (bufoff) + ldsw + _i * 8192), 16, 0, 0); } while (0)
#define PG8_LDA(dst, b, h) do { _Pragma("unroll") for (int m = 0; m < 4; ++m) _Pragma("unroll") for (int k = 0; k < 2; ++k) dst[m][k] = *(const PG8_LAS bf16x8*)(lds + PG8_SA(b, h) + aoff + m * 2048 + k * 1024); } while (0)
#define PG8_LDB(dst, b, h) do { _Pragma("unroll") for (int n = 0; n < 2; ++n) _Pragma("unroll") for (int k = 0; k < 2; ++k) dst[n][k] = *(const PG8_LAS bf16x8*)(lds + PG8_SB(b, h) + boff + n * 2048 + k * 1024); } while (0)
#define PG8_MMA(ai, bj, At, Bt) do { __builtin_amdgcn_s_setprio(1); _Pragma("unroll") for (int m = 0; m < 4; ++m) _Pragma("unroll") for (int n = 0; n < 2; ++n) _Pragma("unroll") for (int k = 0; k < 2; ++k) \
        acc[ai][bj][m][n] = __builtin_amdgcn_mfma_f32_16x16x32_bf16(Bt[n][k], At[m][k], acc[ai][bj][m][n], 0, 0, 0); __builtin_amdgcn_s_setprio(0); } while (0)
#define PG8_WAIT_V(n) asm volatile("s_waitcnt vmcnt(" #n ")" ::: "memory")
#define PG8_WAIT_L(n) asm volatile("s_waitcnt lgkmcnt(" #n ")" ::: "memory")
#define PG8_BAR __builtin_amdgcn_s_barrier()
#define PG8_SCHED __builtin_amdgcn_sched_barrier(0)
    Unit cur, nxt; int ui = 0;
    if (!S.next(0, cur)) return;
    f32x4 acc[2][2][4][2];
#pragma unroll
    for (int a = 0; a < 2; ++a)
#pragma unroll
        for (int b = 0; b < 2; ++b)
#pragma unroll
            for (int m = 0; m < 4; ++m)
#pragma unroll
                for (int n = 0; n < 2; ++n) acc[a][b][m][n] = (f32x4){0.f, 0.f, 0.f, 0.f};
    bf16x8 At[4][2], B0[2][2], B1[2][2];
    const char* cA = (const char*)g.A + (size_t)cur.pm * tstepA; const char* cB = (const char*)g.Bt + (size_t)cur.pn * tstepB + (size_t)(cur.pm / g.bgrp) * g.bgstride;
    S.a_ready(cur);
    if constexpr (SP2) {
        PG8_STAGE(PG8_SB(0, 0), cB, voffB); PG8_STAGE(PG8_SB(0, 1), cB + hstepB, voffB); PG8_STAGE(PG8_SA(0, 0), cA, voffA); PG8_STAGE(PG8_SA(0, 1), cA + hstepA, voffA);
        if (wr == 1) PG8_BAR;
        PG8_WAIT_V(2); PG8_BAR;
        PG8_STAGE(PG8_SB(1, 0), cB + kstep, voffB); PG8_STAGE(PG8_SA(1, 0), cA + kstep, voffA); PG8_STAGE(PG8_SB(1, 1), cB + hstepB + kstep, voffB);
        PG8_WAIT_V(6); PG8_BAR;
    } else {
        PG8_STAGE(PG8_SB(0, 0), cB, voffB); PG8_STAGE(PG8_SA(0, 0), cA, voffA); PG8_STAGE(PG8_SB(0, 1), cB + hstepB, voffB); PG8_STAGE(PG8_SA(0, 1), cA + hstepA, voffA);
        if (wr == 1) PG8_BAR;
        PG8_WAIT_V(4); PG8_BAR;
        PG8_STAGE(PG8_SB(1, 0), cB + kstep, voffB); PG8_STAGE(PG8_SA(1, 0), cA + kstep, voffA); PG8_STAGE(PG8_SB(1, 1), cB + hstepB + kstep, voffB);
        PG8_WAIT_V(6); PG8_BAR;
    }
    for (;;) {
        const bool has_next = S.next(ui + 1, nxt);
        const char* nA = has_next ? (const char*)g.A + (size_t)nxt.pm * tstepA : cA; const char* nB = has_next ? (const char*)g.Bt + (size_t)nxt.pn * tstepB + (size_t)(nxt.pm / g.bgrp) * g.bgstride : cB;
#pragma unroll 1
        for (int t = 0; t < nt; t += 2) {
            const bool last = (t == nt - 2);
            const char* a1 = cA + (size_t)(t + 1) * kstep;
            const char* a2 = last ? nA : cA + (size_t)(t + 2) * kstep; const char* b2 = last ? nB : cB + (size_t)(t + 2) * kstep;
            const char* a3 = a2 + kstep; const char* b3 = b2 + kstep;
            if (last && has_next) S.a_ready(nxt);
            if constexpr (SP2) {
            PG8_LDB(B0, 0, 0); PG8_LDB(B1, 0, 1); PG8_SCHED; PG8_LDA(At, 0, 0); PG8_STAGE(PG8_SA(1, 1), a1 + hstepA, voffA);
            PG8_WAIT_V(8); PG8_WAIT_L(0); PG8_BAR; PG8_MMA(0, 0, At, B0); PG8_MMA(0, 1, At, B1); PG8_BAR; PG8_SCHED;
            PG8_LDA(At, 0, 1); PG8_STAGE(PG8_SB(0, 0), b2, voffB); PG8_STAGE(PG8_SB(0, 1), b2 + hstepB, voffB); PG8_STAGE(PG8_SA(0, 0), a2, voffA);
            PG8_WAIT_V(8); PG8_WAIT_L(0); PG8_BAR; PG8_MMA(1, 0, At, B0); PG8_MMA(1, 1, At, B1); PG8_BAR; PG8_SCHED;
            PG8_LDB(B0, 1, 0); PG8_LDB(B1, 1, 1); PG8_SCHED; PG8_LDA(At, 1, 0); PG8_STAGE(PG8_SA(0, 1), a2 + hstepA, voffA);
            PG8_WAIT_V(8); PG8_WAIT_L(0); PG8_BAR; PG8_MMA(0, 0, At, B0); PG8_MMA(0, 1, At, B1); PG8_BAR; PG8_SCHED;
            PG8_LDA(At, 1, 1); PG8_STAGE(PG8_SB(1, 0), b3, voffB); PG8_STAGE(PG8_SB(1, 1), b3 + hstepB, voffB); PG8_STAGE(PG8_SA(1, 0), a3, voffA);
            PG8_WAIT_V(8); PG8_WAIT_L(0); PG8_BAR; PG8_MMA(1, 0, At, B0); PG8_MMA(1, 1, At, B1); PG8_BAR; PG8_SCHED;
            } else {
            PG8_LDB(B0, 0, 0); PG8_SCHED; PG8_LDA(At, 0, 0); PG8_STAGE(PG8_SA(1, 1), a1 + hstepA, voffA);
            PG8_WAIT_L(8); PG8_BAR; PG8_WAIT_L(0); PG8_MMA(0, 0, At, B0); PG8_BAR; PG8_SCHED;
            PG8_LDB(B1, 0, 1); PG8_STAGE(PG8_SB(0, 0), b2, voffB);
            PG8_BAR; PG8_WAIT_L(0); PG8_MMA(0, 1, At, B1); PG8_BAR;
            PG8_LDA(At, 0, 1); PG8_STAGE(PG8_SA(0, 0), a2, voffA);
            PG8_BAR; PG8_WAIT_L(0); PG8_MMA(1, 0, At, B0); PG8_BAR; PG8_SCHED;
            PG8_STAGE(PG8_SB(0, 1), b2 + hstepB, voffB);
            PG8_WAIT_V(6); PG8_BAR; PG8_MMA(1, 1, At, B1); PG8_BAR;
            PG8_LDB(B0, 1, 0); PG8_SCHED; PG8_LDA(At, 1, 0); PG8_STAGE(PG8_SA(0, 1), a2 + hstepA, voffA);
            PG8_WAIT_L(8); PG8_BAR; PG8_WAIT_L(0); PG8_MMA(0, 0, At, B0); PG8_BAR; PG8_SCHED;
            PG8_LDB(B1, 1, 1); PG8_STAGE(PG8_SB(1, 0), b3, voffB);
            PG8_BAR; PG8_WAIT_L(0); PG8_MMA(0, 1, At, B1); PG8_BAR;
            PG8_LDA(At, 1, 1); PG8_STAGE(PG8_SA(1, 0), a3, voffA);
            PG8_BAR; PG8_WAIT_L(0); PG8_MMA(1, 0, At, B0); PG8_BAR; PG8_SCHED;
            PG8_STAGE(PG8_SB(1, 1), b3 + hstepB, voffB);
            PG8_WAIT_V(6); PG8_BAR; PG8_MMA(1, 1, At, B1); PG8_BAR;
            }
        }
        if constexpr (ALIGN_EPI) { if (wr == 0) PG8_BAR; }
        if constexpr (!Epi::AFTER_DRAIN) { E(acc, cur, wr, wc, fr, fq); S.done(cur); }
        if (!has_next) break;
#pragma unroll
        for (int a = 0; a < 2; ++a)
#pragma unroll
            for (int b = 0; b < 2; ++b)
#pragma unroll
                for (int m = 0; m < 4; ++m)
#pragma unroll
                    for (int n = 0; n < 2; ++n) acc[a][b][m][n] = (f32x4){0.f, 0.f, 0.f, 0.f};
        cur = nxt; cA = nA; cB = nB; ++ui;
        if constexpr (ALIGN_EPI) { if (wr == 1) PG8_BAR; }
    }
    PG8_WAIT_V(0);
    if constexpr (!ALIGN_EPI) { if (wr == 0) PG8_BAR; }
    PG8_BAR;
    if constexpr (Epi::AFTER_DRAIN) { E.fused(acc, cur, wr, wc, fr, fq, lds, wid, lane); S.done(cur); }
#undef PG8_SA
#undef PG8_SB
#undef PG8_STAGE
#undef PG8_LDA
#undef PG8_LDB
#undef PG8_MMA
#undef PG8_WAIT_V
#undef PG8_WAIT_L
#undef PG8_BAR
#undef PG8_SCHED
}
}

namespace pg8 {
__device__ __forceinline__ u32x4 pack8(const f32x4& v0, const f32x4& v1) { u32x4 w; w.x = cvt_pk_bf16(v0[0], v0[1]); w.y = cvt_pk_bf16(v0[2], v0[3]); w.z = cvt_pk_bf16(v1[0], v1[1]); w.w = cvt_pk_bf16(v1[2], v1[3]); return w; }
__device__ __forceinline__ f32x4 gelu4(const f32x4& v) { f32x2 a = gelu_pk((f32x2){v[0], v[1]}), b = gelu_pk((f32x2){v[2], v[3]}); return (f32x4){a.x, a.y, b.x, b.y}; }
struct DEpiP1 {
    static constexpr bool PERM = true, AFTER_DRAIN = false; EpiP1 e;
    __device__ __forceinline__ void operator()(const f32x4 (&acc)[2][2][4][2], const Unit& u, int wr, int wc, int fr, int fq) const {
        const int row0 = u.pm * BM + wr * 64 + fr; const bool isb = (u.pn >= 8);
        bf16_t* base = isb ? e.PB : e.PA; const int ldc = isb ? 1024 : 2048; const int col0 = (isb ? (u.pn - 8) : u.pn) * BM + wc * 32 + 8 * fq;
#pragma unroll
        for (int ai = 0; ai < 2; ++ai)
#pragma unroll
            for (int m = 0; m < 4; ++m) { bf16_t* rowp = base + (size_t)(row0 + ai * HALF + m * 16) * ldc + col0;
#pragma unroll
                for (int bj = 0; bj < 2; ++bj) { f32x4 v0 = acc[ai][bj][m][0], v1 = acc[ai][bj][m][1];
                    if (isb) { v0 = gelu4(v0); v1 = gelu4(v1); }
                    *(u32x4*)(rowp + bj * HALF) = pack8(v0, v1); } }
    }
};
struct DEpiPlain {
    static constexpr bool PERM = true, AFTER_DRAIN = false; EpiPlain e;
    __device__ __forceinline__ void operator()(const f32x4 (&acc)[2][2][4][2], const Unit& u, int wr, int wc, int fr, int fq) const {
        const int row0 = u.pm * BM + wr * 64 + fr; const int col0 = e.col_off + u.pn * BM + wc * 32 + 8 * fq;
#pragma unroll
        for (int ai = 0; ai < 2; ++ai)
#pragma unroll
            for (int m = 0; m < 4; ++m) { bf16_t* rowp = e.O + (size_t)(row0 + ai * HALF + m * 16) * e.ldc + col0;
#pragma unroll
                for (int bj = 0; bj < 2; ++bj) *(u32x4*)(rowp + bj * HALF) = pack8(acc[ai][bj][m][0], acc[ai][bj][m][1]); }
    }
};
__device__ __forceinline__ float sig_fast(float x) { return __builtin_amdgcn_rcpf(1.0f + __expf(-x)); }
__device__ __forceinline__ float bflo(unsigned w) { return __uint_as_float(w << 16); }
__device__ __forceinline__ float bfhi(unsigned w) { return __uint_as_float(w & 0xffff0000u); }
struct DEpiMerge {
    static constexpr bool PERM = true, AFTER_DRAIN = false; EpiMerge e;
    __device__ __forceinline__ void operator()(const f32x4 (&acc)[2][2][4][2], const Unit& u, int wr, int wc, int fr, int fq) const {
        const int row0 = u.pm * BM + wr * 64 + fr; const int n0 = u.pn * HALF + wc * 32 + 8 * fq;
#pragma unroll
        for (int ai = 0; ai < 2; ++ai)
#pragma unroll
            for (int m = 0; m < 4; ++m) { const size_t row = (size_t)(row0 + ai * HALF + m * 16);
                const u32x4 b0 = *(const u32x4*)(e.BR + row * 2048 + n0), b1 = *(const u32x4*)(e.BR + row * 2048 + 1024 + n0);
                const f32x4 g00 = acc[ai][0][m][0], g01 = acc[ai][0][m][1], g10 = acc[ai][1][m][0], g11 = acc[ai][1][m][1];
                f32x4 o0, o1;
                o0[0] = sig_fast(g00[0]) * bflo(b0.x) + sig_fast(g10[0]) * bflo(b1.x); o0[1] = sig_fast(g00[1]) * bfhi(b0.x) + sig_fast(g10[1]) * bfhi(b1.x);
                o0[2] = sig_fast(g00[2]) * bflo(b0.y) + sig_fast(g10[2]) * bflo(b1.y); o0[3] = sig_fast(g00[3]) * bfhi(b0.y) + sig_fast(g10[3]) * bfhi(b1.y);
                o1[0] = sig_fast(g01[0]) * bflo(b0.z) + sig_fast(g11[0]) * bflo(b1.z); o1[1] = sig_fast(g01[1]) * bfhi(b0.z) + sig_fast(g11[1]) * bfhi(b1.z);
                o1[2] = sig_fast(g01[2]) * bflo(b0.w) + sig_fast(g11[2]) * bflo(b1.w); o1[3] = sig_fast(g01[3]) * bfhi(b0.w) + sig_fast(g11[3]) * bfhi(b1.w);
                *(u32x4*)(e.MG + row * 1024 + n0) = pack8(o0, o1); }
    }
};
struct DEpiResid {
    static constexpr bool PERM = false, AFTER_DRAIN = false; EpiResid e;
    __device__ __forceinline__ void operator()(const f32x4 (&acc)[2][2][4][2], const Unit& u, int wr, int wc, int fr, int fq) const {
        const int row0 = u.pm * BM + wr * 64 + fr, col0 = u.pn * BM + wc * 32 + 4 * fq;
        typedef unsigned u32x2 __attribute__((ext_vector_type(2)));
#pragma unroll
        for (int ai = 0; ai < 2; ++ai)
#pragma unroll
            for (int m = 0; m < 4; ++m) { const size_t ro = (size_t)(row0 + ai * HALF + m * 16) * 1024 + col0;
#pragma unroll
                for (int bj = 0; bj < 2; ++bj)
#pragma unroll
                    for (int n = 0; n < 2; ++n) { const u32x2 h = *(const u32x2*)(e.H + ro + bj * HALF + n * 16); const f32x4 a = acc[ai][bj][m][n];
                        f32x4 o; o[0] = ALPHA_F * bflo(h.x) + a[0]; o[1] = ALPHA_F * bfhi(h.x) + a[1]; o[2] = ALPHA_F * bflo(h.y) + a[2]; o[3] = ALPHA_F * bfhi(h.y) + a[3];
                        *(f32x4*)(e.Z + ro + bj * HALF + n * 16) = o; } }
    }
};

struct DEpiTile {
    static constexpr bool PERM = true, AFTER_DRAIN = false; bf16_t* O; int sm, sn; float scale;
    __device__ __forceinline__ void operator()(const f32x4 (&acc)[2][2][4][2], const Unit& u, int wr, int wc, int fr, int fq) const {
        bf16_t* base = O + (size_t)(u.pm * sm + u.pn * sn) * 65536; const int row0 = wr * 64 + fr, col0 = wc * 32 + 8 * fq;
#pragma unroll
        for (int ai = 0; ai < 2; ++ai)
#pragma unroll
            for (int m = 0; m < 4; ++m) { bf16_t* rowp = base + (size_t)(row0 + ai * HALF + m * 16) * 256 + col0;
#pragma unroll
                for (int bj = 0; bj < 2; ++bj) *(u32x4*)(rowp + bj * HALF) = pack8(acc[ai][bj][m][0] * scale, acc[ai][bj][m][1] * scale); }
    }
};
struct DEpiQ { static constexpr bool PERM = true, AFTER_DRAIN = false; DEpiTile t;
    __device__ __forceinline__ void operator()(const f32x4 (&acc)[2][2][4][2], const Unit& u, int wr, int wc, int fr, int fq) const {
        Unit v; v.pm = (u.pm >> 3) * 32 + u.pn * 8 + (u.pm & 7); v.pn = 0; t(acc, v, wr, wc, fr, fq); } };
struct DEpiO {
    static constexpr bool PERM = true, AFTER_DRAIN = false; bf16_t* O;
    __device__ __forceinline__ void operator()(const f32x4 (&acc)[2][2][4][2], const Unit& u, int wr, int wc, int fr, int fq) const {
        const int bh = u.pm >> 3, b = bh >> 2, h = bh & 3; const int s0 = (u.pm & 7) * 256 + wr * 64 + fr;
        bf16_t* base = O + ((size_t)b * SEQ) * 1024 + h * 256 + wc * 32 + 8 * fq;
#pragma unroll
        for (int ai = 0; ai < 2; ++ai)
#pragma unroll
            for (int m = 0; m < 4; ++m) { bf16_t* rowp = base + (size_t)(s0 + ai * HALF + m * 16) * 1024;
#pragma unroll
                for (int bj = 0; bj < 2; ++bj) *(u32x4*)(rowp + bj * HALF) = pack8(acc[ai][bj][m][0], acc[ai][bj][m][1]); }
    }
};
struct DEpiSoftmax {
    static constexpr bool PERM = true, AFTER_DRAIN = true; bf16_t* Pout;
    __device__ __forceinline__ void fused(f32x4 (&acc)[2][2][4][2], const Unit& u, int wr, int wc, int fr, int fq, PG8_LAS unsigned char* lds, int wid, int lane) const {
        PG8_LAS float* PM = (PG8_LAS float*)lds;
        PG8_LAS float* PS = (PG8_LAS float*)(lds + 4096);
#pragma unroll
        for (int ai = 0; ai < 2; ++ai)
#pragma unroll
            for (int m = 0; m < 4; ++m) { float mx = -3.0e38f;
#pragma unroll
                for (int bj = 0; bj < 2; ++bj)
#pragma unroll
                    for (int n = 0; n < 2; ++n) { const f32x4 x = acc[ai][bj][m][n]; mx = fmaxf(mx, fmaxf(fmaxf(x[0], x[1]), fmaxf(x[2], x[3]))); }
                mx = fmaxf(mx, __shfl_xor(mx, 16)); mx = fmaxf(mx, __shfl_xor(mx, 32));
                if (fq == 0) PM[(ai * HALF + wr * 64 + m * 16 + fr) * 4 + wc] = mx; }
        asm volatile("s_waitcnt lgkmcnt(0)" ::: "memory"); __builtin_amdgcn_s_barrier(); asm volatile("" ::: "memory");
#pragma unroll
        for (int ai = 0; ai < 2; ++ai)
#pragma unroll
            for (int m = 0; m < 4; ++m) { const int row = ai * HALF + wr * 64 + m * 16 + fr; const f32x4 p4 = *(const PG8_LAS f32x4*)(PM + row * 4);
                const float gm = fmaxf(fmaxf(p4[0], p4[1]), fmaxf(p4[2], p4[3])); float sum = 0.f;
#pragma unroll
                for (int bj = 0; bj < 2; ++bj)
#pragma unroll
                    for (int n = 0; n < 2; ++n) { f32x4 x = acc[ai][bj][m][n]; x[0] = __expf(x[0] - gm); x[1] = __expf(x[1] - gm); x[2] = __expf(x[2] - gm); x[3] = __expf(x[3] - gm);
                        acc[ai][bj][m][n] = x; sum += (x[0] + x[1]) + (x[2] + x[3]); }
                sum += __shfl_xor(sum, 16); sum += __shfl_xor(sum, 32);
                if (fq == 0) PS[row * 4 + wc] = sum; }
        asm volatile("s_waitcnt lgkmcnt(0)" ::: "memory"); __builtin_amdgcn_s_barrier(); asm volatile("" ::: "memory");
#pragma unroll
        for (int ai = 0; ai < 2; ++ai)
#pragma unroll
            for (int m = 0; m < 4; ++m) { const int row = ai * HALF + wr * 64 + m * 16 + fr; const f32x4 s4 = *(const PG8_LAS f32x4*)(PS + row * 4);
                const float inv = 1.0f / ((s4[0] + s4[1]) + (s4[2] + s4[3])); bf16_t* rowp = Pout + ((size_t)u.pm * 256 + row) * 256 + wc * 32 + 8 * fq;
#pragma unroll
                for (int bj = 0; bj < 2; ++bj) *(u32x4*)(rowp + bj * HALF) = pack8(acc[ai][bj][m][0] * inv, acc[ai][bj][m][1] * inv); }
        asm volatile("s_waitcnt lgkmcnt(0)" ::: "memory"); __builtin_amdgcn_s_barrier(); asm volatile("" ::: "memory");
    }
};
template <int KIND> struct DEpiLora {
    static constexpr bool PERM = true, AFTER_DRAIN = false; const float* bsrc0; bf16_t* O;
    __device__ __forceinline__ static f32x4 act4(f32x4 x) {
        f32x4 o;
#pragma unroll
        for (int i = 0; i < 4; ++i) {
            if (KIND == 0) { const float y = -x[i]; const float sp = fmaxf(y, 0.f) + __logf(1.0f + __expf(-fabsf(y))); const float ew = __expf(-sp - 0.5f); o[i] = 1.0f - __expf(-ew); }
            else if (KIND == 1) o[i] = __builtin_amdgcn_rcpf(1.0f + __expf(-x[i]));
            else o[i] = x[i]; }
        return o;
    }
    __device__ __forceinline__ void operator()(const f32x4 (&acc)[2][2][4][2], const Unit& u, int wr, int wc, int fr, int fq) const {
        const int row0 = u.pm * BM + wr * 64 + fr; const int z = (KIND == 2) ? 0 : (u.pn >> 1); const int cb = ((KIND == 2) ? u.pn : (u.pn & 1)) * 256 + wc * 32 + 8 * fq;
        f32x4 bv[2][2];
#pragma unroll
        for (int bj = 0; bj < 2; ++bj)
#pragma unroll
            for (int n = 0; n < 2; ++n) bv[bj][n] = (KIND == 2) ? (f32x4){0.f, 0.f, 0.f, 0.f} : *(const f32x4*)(bsrc0 + z * 512 + cb + bj * HALF + 4 * n);
#pragma unroll
        for (int ai = 0; ai < 2; ++ai)
#pragma unroll
            for (int m = 0; m < 4; ++m) { const size_t row = (size_t)(row0 + ai * HALF + m * 16);
                bf16_t* dst = (KIND == 2) ? (O + row * 512 + cb) : (O + (row * 2 + z) * 512 + cb);
#pragma unroll
                for (int bj = 0; bj < 2; ++bj) *(u32x4*)(dst + bj * HALF) = pack8(act4(acc[ai][bj][m][0] + bv[bj][0]), act4(acc[ai][bj][m][1] + bv[bj][1])); }
    }
};
}
#define LAS __attribute__((address_space(3)))
#define XB_TMO      128
#define XB_XCNT(j)  (256  + 64 * (j))
#define XB_XSUB(j)  (1280 + 64 * (j))
#define XB_XGEN(j)  (2304 + 64 * (j))
#define XB_TOP      3328
#define XB_TOPGEN   3392
#define XCD_BAR_WORDS 3456
#define XB_SPIN_CAP (1u << 18)

__device__ __forceinline__ unsigned xb_ld(unsigned* p)              { return __hip_atomic_load(p, __ATOMIC_RELAXED, __HIP_MEMORY_SCOPE_AGENT); }
__device__ __forceinline__ unsigned xb_add(unsigned* p, unsigned v) { return __hip_atomic_fetch_add(p, v, __ATOMIC_RELAXED, __HIP_MEMORY_SCOPE_AGENT); }
__device__ __forceinline__ unsigned xb_xcc_id() { return (unsigned)__builtin_amdgcn_s_getreg((3 << 11) | 20) & 0xFu; }
#define XB_SPIN(cond, bar) do { unsigned _sp = 0; while (cond) { __builtin_amdgcn_s_sleep(1); \
    if ((++_sp & 255u) == 0u) { if (xb_ld(&(bar)[XB_TMO])) break; if (_sp > XB_SPIN_CAP) { atomicAdd(&(bar)[XB_TMO], 1u); break; } } } } while (0)

struct XcdBarrier {
    unsigned* bar; unsigned x;
    volatile LAS unsigned* st;
};

__device__ __forceinline__ XcdBarrier xcd_barrier_post(unsigned* bar, volatile LAS unsigned* st) {
    XcdBarrier b; b.bar = bar; b.x = xb_xcc_id(); b.st = st;
    if (threadIdx.x == 0) (void)xb_add(&bar[XB_XCNT(b.x)], 1u);
    return b;
}
__device__ __forceinline__ void xcd_barrier_complete(unsigned* bar, unsigned x, unsigned& nloc, unsigned& nx) {
    const unsigned G = gridDim.x * gridDim.y * gridDim.z;
    unsigned sum, cnt, mine, sp = 0u;
    for (;;) {
        sum = 0u; cnt = 0u; mine = 0u;
#pragma unroll
        for (unsigned j = 0; j < 16; ++j) { const unsigned c = xb_ld(&bar[XB_XCNT(j)]); sum += c; cnt += (c > 0u) ? 1u : 0u; mine = (j == x) ? c : mine; }
        if (sum == G) break;
        __builtin_amdgcn_s_sleep(1);
        if ((++sp & 255u) == 0u) { if (xb_ld(&bar[XB_TMO])) break; if (sp > XB_SPIN_CAP) { atomicAdd(&bar[XB_TMO], 1u); break; } }
    }
    nloc = mine > 0u ? mine : 1u; nx = cnt > 0u ? cnt : 1u;
}

__device__ __forceinline__ void xcd_barrier(const XcdBarrier& b) {
    asm volatile("s_waitcnt vmcnt(0)" ::: "memory");
    __syncthreads();
    if (threadIdx.x == 0) {
        unsigned* bar = b.bar;
        __builtin_amdgcn_s_waitcnt(0);
        unsigned nloc = b.st[0], nx = b.st[1];
        if (nloc == 0u) { xcd_barrier_complete(bar, b.x, nloc, nx); b.st[0] = nloc; b.st[1] = nx; }
        const unsigned old = xb_add(&bar[XB_XSUB(b.x)], 1u);
        const unsigned gen = old / nloc;
        if (old + 1u == (gen + 1u) * nloc) {
            __builtin_amdgcn_fence(__ATOMIC_RELEASE, "agent");
            asm volatile("s_waitcnt vmcnt(0)" ::: "memory");
            const unsigned og = xb_add(&bar[XB_TOP], 1u);
            const unsigned tg = og / nx;
            if (og + 1u == (tg + 1u) * nx) xb_add(&bar[XB_TOPGEN], 1u);
            else XB_SPIN(xb_ld(&bar[XB_TOPGEN]) == tg, bar);
            __builtin_amdgcn_fence(__ATOMIC_ACQUIRE, "agent");
            xb_add(&bar[XB_XGEN(b.x)], 1u);
            asm volatile("s_waitcnt vmcnt(0)" ::: "memory");
        } else {
            XB_SPIN(xb_ld(&bar[XB_XGEN(b.x)]) == gen, bar);
            __builtin_amdgcn_fence(__ATOMIC_ACQUIRE, "agent");
            asm volatile("s_waitcnt vmcnt(0)" ::: "memory");
        }
    }
    __syncthreads();
}

#endif

#ifdef HOST_EMU
template <class F> static void emu_gemm(const bf16_t* A, const bf16_t* Bt, int M, int N, int K, F f) {
#pragma omp parallel for schedule(static)
    for (int r = 0; r < M; ++r)
        for (int c = 0; c < N; ++c) { float a = 0.f; for (int k = 0; k < K; ++k) a += bf2f(A[(size_t)r * K + k]) * bf2f(Bt[(size_t)c * K + k]); f(r, c, a); }
}
#endif

#define GS_LOOP(idx, n) for (long idx = gtid; idx < (long)(n); idx += nthr)

__device__ __forceinline__ int win_src_col(int n) {
    if (n < 1920) return n;
    if (n < 2048) return -1;
    if (n < 3072) return 1920 + (n - 2048);
    const int m = n - 3072, j = m / 256, i = m % 256;
    return (i < 128) ? (2944 + 128 * j + i) : (2944 + 1024 + 128 * j + (i - 128));
}
__device__ __forceinline__ void ph0_weights(const Params& P, long gtid, long nthr) {
    GS_LOOP(idx, (size_t)5120 * 1024) { const int n = (int)(idx / 1024), k = (int)(idx % 1024); const int c = win_src_col(n);
        P.W_IN_T[idx] = (c < 0) ? (bf16_t)0 : f2bf(P.in[I_W_IN][(size_t)k * IN_COLS + c]); }
    GS_LOOP(idx, (size_t)2048 * 512) { const int n = (int)(idx / 512), k = (int)(idx % 512); const int br = n / 1024, nn = n % 1024;
        P.W_BR_T[idx] = f2bf(P.in[I_W_BRANCH][((size_t)br * 512 + k) * 1024 + nn]); }
    GS_LOOP(idx, (size_t)1024 * 1024) { const int n = (int)(idx / 1024), k = (int)(idx % 1024);
        P.W_MIX_T[idx] = f2bf(P.in[I_W_MIX][(size_t)k * 1024 + n]);
        P.W_Q_T[idx] = f2bf(P.in[I_W_Q][(size_t)k * 1024 + n]);
        P.W_O_T[idx] = f2bf(P.in[I_W_O][(size_t)k * 1024 + n]); }
    GS_LOOP(idx, (size_t)2048 * 1024) { const int n = (int)(idx / 1024), k = (int)(idx % 1024);
        P.W_KV_T[idx] = f2bf(P.in[I_W_KV][(size_t)k * 2048 + n]);
        P.W_QUERY_T[idx] = f2bf(P.in[I_W_QUERY][(size_t)k * 2048 + n]); }
}
__device__ __forceinline__ void ln_rows_bf16(const float* in, const float* g, const float* b, bf16_t* out, int rows, int width, long gtid, long nthr) {
    GS_LOOP(row, rows) { const float* x = in + (size_t)row * width; float s = 0.f;
        for (int i = 0; i < width; ++i) s += x[i];
        const float mu = s / width; float q = 0.f;
        for (int i = 0; i < width; ++i) { const float d = x[i] - mu; q += d * d; }
        const float rs = 1.0f / sqrtf(q / width + 1e-5f); bf16_t* o = out + (size_t)row * width;
        for (int i = 0; i < width; ++i) o[i] = f2bf((x[i] - mu) * rs * g[i] + b[i]); }
}
__device__ __forceinline__ void ph2a_vn(const Params& P, long gtid, long nthr) {
    GS_LOOP(row, TOK) { const bf16_t* x = P.PB + (size_t)row * 1024 + 512; float s = 0.f;
        for (int i = 0; i < 512; ++i) s += bf2f(x[i]);
        const float mu = s / 512.f; float q = 0.f;
        for (int i = 0; i < 512; ++i) { const float d = bf2f(x[i]) - mu; q += d * d; }
        const float rs = 1.0f / sqrtf(q / 512.f + 1e-5f); bf16_t* o = P.VN + (size_t)row * 512;
        for (int i = 0; i < 512; ++i) o[i] = f2bf((bf2f(x[i]) - mu) * rs * P.in[I_GLN_G][i] + P.in[I_GLN_B][i]); }
}
__device__ __forceinline__ void ph2b_gmlp(const Params& P, long gtid, long nthr) {
    GS_LOOP(idx, (size_t)TOK * 512) { const int c = (int)(idx % 512); const long t = idx / 512; const int g = c / 64; const long ch = t / 128; const int p = (int)(t % 128);
        const float* ws = P.in[I_W_S] + ((size_t)g * 128 + p) * 128; float s = 0.f;
        for (int q = 0; q < 128; ++q) s += ws[q] * bf2f(P.VN[(size_t)(ch * 128 + q) * 512 + c]);
        s += P.in[I_B_S][g * 128 + p];
        P.YB[idx] = f2bf(bf2f(P.PB[(size_t)t * 1024 + c]) * s); }
}
__device__ __forceinline__ float pa_shift(const Params& P, long t, int c) {
    const int s = (int)(t % SEQ); const float cur = bf2f(P.PA[(size_t)t * 2048 + c]);
    const float prev = (s > 0) ? bf2f(P.PA[(size_t)(t - 1) * 2048 + c]) : 0.f;
    const float nxt = (s < SEQ - 1) ? bf2f(P.PA[(size_t)(t + 1) * 2048 + c]) : 0.f;
    return cur + P.in[I_MU][c] * (0.5f * (prev + nxt) - cur);
}
__device__ __forceinline__ void ph3a_lora_in(const Params& P, long gtid, long nthr) {
    GS_LOOP(idx, (size_t)TOK * 128) { const int r = (int)(idx % 128); const long t = idx / 128;
        P.WDS[idx] = f2bf(tanhf(pa_shift(P, t, 1536 + r)));
        P.ADS[idx] = f2bf(pa_shift(P, t, 1664 + r));
        P.SG[idx] = f2bf(sigmoidf_(pa_shift(P, t, 1792 + r))); }
}
__device__ __forceinline__ void ph3b_prep(const Params& P, long gtid, long nthr) {
    GS_LOOP(idx, (size_t)TOK * 8) { const int h = (int)(idx % 8); const long t = idx / 8; const int hb = h * 64;
        float ss = 0.f;
        for (int j = 0; j < 64; ++j) { const float v = pa_shift(P, t, 512 + hb + j) * P.in[I_K_K][hb + j]; ss += v * v; }
        const float inv = 1.0f / fmaxf(sqrtf(ss), 1e-12f);
        for (int j = 0; j < 64; ++j) { const int c = hb + j;
            const float k = pa_shift(P, t, 512 + c); const float kk = k * P.in[I_K_K][c] * inv;
            P.R[(size_t)t * 512 + c] = f2bf(pa_shift(P, t, c));
            P.V[(size_t)t * 512 + c] = f2bf(pa_shift(P, t, 1024 + c));
            P.KK[(size_t)t * 512 + c] = f2bf(kk);
            for (int z = 0; z < 2; ++z) {
                float sw = P.in[I_W0][z * 512 + c], sa = P.in[I_A0][z * 512 + c];
                for (int r = 0; r < 64; ++r) { sw += bf2f(P.WDS[(size_t)t * 128 + z * 64 + r]) * P.in[I_W2][((size_t)z * 64 + r) * 512 + c];
                                               sa += bf2f(P.ADS[(size_t)t * 128 + z * 64 + r]) * P.in[I_A2][((size_t)z * 64 + r) * 512 + c]; }
                const float y = -sw; const float sp = fmaxf(y, 0.f) + log1pf(expf(-fabsf(y))); const float wlog = -sp - 0.5f;
                const float ew = expf(wlog);
                const float a = sigmoidf_(sa); const size_t o = ((size_t)t * 2 + z) * 512 + c;
                P.OMW[o] = f2bf(-expm1f(-ew));
                P.KDIR[o] = f2bf(k * (1.0f + (a - 1.0f) * P.in[I_K_A][c]));
                P.BVEC[o] = f2bf(kk * a); } } }
}
__device__ __forceinline__ void scan_item(const Params& P, int chain, int i) {
    const int h = chain % 8, b = (chain / 8) % BATCH, z = chain / (8 * BATCH);
    float S[64];
#pragma unroll
    for (int j = 0; j < 64; ++j) S[j] = 0.f;
    for (int n = 0; n < SEQ; ++n) {
        const long t = (long)b * SEQ + ((z == 0) ? n : (SEQ - 1 - n));
        const bf16_t* r = P.R + (size_t)t * 512 + h * 64; const bf16_t* a = P.KK + (size_t)t * 512 + h * 64;
        const bf16_t* w = P.OMW + ((size_t)t * 2 + z) * 512 + h * 64; const bf16_t* k = P.KDIR + ((size_t)t * 2 + z) * 512 + h * 64;
        const bf16_t* bv = P.BVEC + ((size_t)t * 2 + z) * 512 + h * 64;
        const float v = bf2f(P.V[(size_t)t * 512 + h * 64 + i]);
        float sa = 0.f;
#pragma unroll
        for (int j = 0; j < 64; ++j) sa -= S[j] * bf2f(a[j]);
        float y = 0.f;
#pragma unroll
        for (int j = 0; j < 64; ++j) { S[j] = S[j] * (1.0f - bf2f(w[j])) + sa * bf2f(bv[j]) + v * bf2f(k[j]); y += S[j] * bf2f(r[j]); }
        P.Y01[((size_t)z * TOK + t) * 512 + h * 64 + i] = y;
    }
}
__device__ __forceinline__ void ph5_rwkv_out(const Params& P, long gtid, long nthr) {
    GS_LOOP(idx, (size_t)TOK * 512) { const int c = (int)(idx % 512); const long t = idx / 512; const int hb = (c / 64) * 64;
        const float* y0 = P.Y01 + (size_t)t * 512 + hb; const float* y1 = P.Y01 + ((size_t)TOK + t) * 512 + hb;
        float s = 0.f;
        for (int j = 0; j < 64; ++j) s += y0[j] + y1[j];
        const float mu = s / 64.f; float q = 0.f;
        for (int j = 0; j < 64; ++j) { const float d = y0[j] + y1[j] - mu; q += d * d; }
        const float rs = 1.0f / sqrtf(q / 64.f + 64e-5f);
        const float yn = (y0[c - hb] + y1[c - hb] - mu) * rs * P.in[I_GN_G][c] + P.in[I_GN_B][c];
        float rk = 0.f;
        for (int z = 0; z < 2; ++z)
            for (int j = 0; j < 64; ++j) rk += bf2f(P.R[(size_t)t * 512 + hb + j]) * bf2f(P.KDIR[((size_t)t * 2 + z) * 512 + hb + j]) * P.in[I_R_K][hb + j];
        float g = 0.f;
        for (int r = 0; r < 128; ++r) g += bf2f(P.SG[(size_t)t * 128 + r]) * P.in[I_G2][(size_t)r * 512 + c];
        P.YA[idx] = f2bf((yn + rk * bf2f(P.V[(size_t)t * 512 + c])) * g); }
}
__device__ __forceinline__ void ph_ln_z(const Params& P, const float* g, const float* b, long gtid, long nthr) { ln_rows_bf16(P.Z, g, b, P.HB, TOK, 1024, gtid, nthr); }
__device__ __forceinline__ void ph10a_scores(const Params& P, long gtid, long nthr) {
    GS_LOOP(idx, (size_t)TOK * 4 * 256) { const int m = (int)(idx % 256); const long rowi = idx / 256; const int s = (int)(rowi % SEQ); const int bh = (int)(rowi / SEQ); const int b = bh / 4, h = bh % 4;
        const bf16_t* q = P.Q + ((size_t)b * SEQ + s) * 1024 + h * 256; const bf16_t* k = P.KV + ((size_t)b * 256 + m) * 2048 + h * 256; float a = 0.f;
        for (int d = 0; d < 256; ++d) a += bf2f(q[d]) * bf2f(k[d]);
        P.SCA[idx] = a * 0.0625f; }
}
__device__ __forceinline__ void ph10b_softmax(const Params& P, long gtid, long nthr) {
    GS_LOOP(row, (size_t)TOK * 4) { float* x = P.SCA + (size_t)row * 256; float mx = x[0];
        for (int i = 1; i < 256; ++i) mx = fmaxf(mx, x[i]);
        float s = 0.f;
        for (int i = 0; i < 256; ++i) s += expf(x[i] - mx);
        const float inv = 1.0f / s;
        for (int i = 0; i < 256; ++i) x[i] = expf(x[i] - mx) * inv; }
}
__device__ __forceinline__ void ph10c_out(const Params& P, long gtid, long nthr) {
    GS_LOOP(idx, (size_t)TOK * 1024) { const int c = (int)(idx % 1024); const long t = idx / 1024; const int b = (int)(t / SEQ), s = (int)(t % SEQ), h = c / 256;
        const float* pr = P.SCA + (((size_t)b * 4 + h) * SEQ + s) * 256; float a = 0.f;
        for (int m = 0; m < 256; ++m) a += pr[m] * bf2f(P.KV[((size_t)b * 256 + m) * 2048 + 1024 + c]);
        P.O[idx] = f2bf(a); }
}
__device__ __forceinline__ void ph13a_scores(const Params& P, long gtid, long nthr) {
    GS_LOOP(idx, (size_t)TOK * 2048) { const int k = (int)(idx % 128), z = (int)((idx / 128) % 2), h = (int)((idx / 256) % 8); const long t = idx / 2048;
        const bf16_t* q = P.QP + (size_t)t * 2048 + h * 256 + z * 128; const float* kr = P.in[I_SUBKEYS] + ((size_t)z * 128 + k) * 128; float a = 0.f;
        for (int c = 0; c < 128; ++c) a += bf2f(q[c]) * kr[c];
        P.SC[idx] = a; }
}
__device__ __forceinline__ void ph13b_topk(const Params& P, long gtid, long nthr) {
    GS_LOOP(row, (size_t)TOK * 16) { const float* x = P.SC + (size_t)row * 128; float pv = 0.f; int pi = -1;
        for (int j = 0; j < 16; ++j) { float best = 0.f; int bi = -1;
            for (int i = 0; i < 128; ++i) { const float v = x[i]; const bool elig = (j == 0) || (v < pv) || (v == pv && i > pi);
                if (elig && (bi < 0 || v > best)) { best = v; bi = i; } }
            P.TOPS[(size_t)row * 16 + j] = best; P.TOPI[(size_t)row * 16 + j] = bi; pv = best; pi = bi; } }
}
__device__ __forceinline__ void ph13c_cand(const Params& P, long gtid, long nthr) {
    GS_LOOP(row, (size_t)TOK * 8) { const float* s0 = P.TOPS + (size_t)row * 32; const float* s1 = s0 + 16; const int* i0 = P.TOPI + (size_t)row * 32; const int* i1 = i0 + 16;
        float pv = 0.f; int pi = -1; float mx = 0.f;
        for (int j = 0; j < 16; ++j) { float best = 0.f; int bi = -1;
            for (int c = 0; c < 256; ++c) { const float v = s0[c / 16] + s1[c % 16]; const bool elig = (j == 0) || (v < pv) || (v == pv && c > pi);
                if (elig && (bi < 0 || v > best)) { best = v; bi = c; } }
            if (j == 0) mx = best;
            P.GATE[(size_t)row * 16 + j] = best; P.EXPERT[(size_t)row * 16 + j] = i0[bi / 16] * 128 + i1[bi % 16]; pv = best; pi = bi; }
        float s = 0.f;
        for (int j = 0; j < 16; ++j) s += expf(P.GATE[(size_t)row * 16 + j] - mx);
        const float inv = 1.0f / s;
        for (int j = 0; j < 16; ++j) P.GATE[(size_t)row * 16 + j] = expf(P.GATE[(size_t)row * 16 + j] - mx) * inv; }
}
__device__ __forceinline__ void ph14a_act(const Params& P, long gtid, long nthr) {
    GS_LOOP(idx, (size_t)TOK * 128) { const long t = idx / 128; const bf16_t* x = P.HB + (size_t)t * 1024; const float* ur = P.in[I_PEER_U] + (size_t)P.EXPERT[idx] * 1024; float a = 0.f;
        for (int d = 0; d < 1024; ++d) a += ur[d] * bf2f(x[d]);
        P.COEF[idx] = P.GATE[idx] * geluf_(a); }
}
__device__ __forceinline__ void ph14b_out(const Params& P, long gtid, long nthr) {
    GS_LOOP(idx, (size_t)TOK * 1024) { const int d = (int)(idx % 1024); const long t = idx / 1024; float a = 0.f;
        for (int j = 0; j < 128; ++j) a += P.COEF[(size_t)t * 128 + j] * P.in[I_PEER_V][(size_t)P.EXPERT[(size_t)t * 128 + j] * 1024 + d];
        P.Y[idx] = a; }
}
__device__ __forceinline__ void ph14c_final(const Params& P, long gtid, long nthr) {
    GS_LOOP(row, TOK) { const bf16_t* hr = P.HB + (size_t)row * 1024; const float* yr = P.Y + (size_t)row * 1024; float s = 0.f;
        for (int i = 0; i < 1024; ++i) s += ALPHA_F * bf2f(hr[i]) + yr[i];
        const float mu = s / 1024.f; float q = 0.f;
        for (int i = 0; i < 1024; ++i) { const float d = ALPHA_F * bf2f(hr[i]) + yr[i] - mu; q += d * d; }
        const float rs = 1.0f / sqrtf(q / 1024.f + 1e-5f); float* o = P.out + (size_t)row * 1024;
        for (int i = 0; i < 1024; ++i) o[i] = (ALPHA_F * bf2f(hr[i]) + yr[i] - mu) * rs * P.in[I_LN3_G][i] + P.in[I_LN3_B][i]; }
}

static void make_params(Params& P, void* const* d_in, void* d_out, void* d_ws) {
    memset(&P, 0, sizeof(P));
    for (int i = 0; i < 37; ++i) P.in[i] = (const float*)d_in[i];
    P.out = (float*)d_out; unsigned char* ws = (unsigned char*)d_ws; unsigned char* ob = (unsigned char*)d_out;
    unsigned char* r1 = ws + A_R1; unsigned char* r2 = ws + A_R2;
    P.ctl = (unsigned*)(ws + WS_CTL);
    P.W_IN_T = (bf16_t*)(ws + WS_W + OFF_W_IN); P.W_BR_T = (bf16_t*)(ws + WS_W + OFF_W_BR); P.W_MIX_T = (bf16_t*)(ws + WS_W + OFF_W_MIX);
    P.W_Q_T = (bf16_t*)(ws + WS_W + OFF_W_Q); P.W_KV_T = (bf16_t*)(ws + WS_W + OFF_W_KV); P.W_O_T = (bf16_t*)(ws + WS_W + OFF_W_O); P.W_QUERY_T = (bf16_t*)(ws + WS_W + OFF_W_QUERY);
    P.KV = (bf16_t*)(ws + WS_KV); P.MEMN = (bf16_t*)(ws + WS_MEMN); P.HB = (bf16_t*)(ws + A_HB);
    P.PA = (bf16_t*)r1; P.PB = (bf16_t*)r2; P.VN = (bf16_t*)(r2 + 2 * TU);
    P.YB = (bf16_t*)ob; P.WDS = (bf16_t*)(ob + TU); P.ADS = (bf16_t*)(ob + TU + TU / 4); P.SG = (bf16_t*)(ob + TU + TU / 2);
    P.R = (bf16_t*)(ob + 2 * TU); P.KK = (bf16_t*)(ob + 3 * TU);
    P.V = (bf16_t*)r2; P.OMW = (bf16_t*)(r2 + TU); P.KDIR = (bf16_t*)(r2 + 3 * TU); P.BVEC = (bf16_t*)(r2 + 5 * TU);
    P.Y01 = (float*)r1; P.YA = (bf16_t*)(r2 + TU); P.BR = (bf16_t*)r1; P.MG = (bf16_t*)r2; P.Z = (float*)ob;
    P.Q = (bf16_t*)r1; P.O = (bf16_t*)(r1 + 2 * TU); P.SCA = (float*)r2; P.QP = (bf16_t*)ob;
    P.SC = (float*)r1; P.TOPS = (float*)(r2 + 4 * TU); P.TOPI = (int*)(r2 + 5 * TU); P.GATE = (float*)(r2 + 6 * TU); P.EXPERT = (int*)(r2 + 6 * TU + TU / 2);
    P.COEF = (float*)(r2 + 7 * TU); P.Y = (float*)r1;
    P.UB = (bf16_t*)r1; P.VB = (bf16_t*)(r1 + (size_t)16384 * 1024 * 2);
    P.W_LORA_T = (bf16_t*)(ws + WS_W + OFF_W_LORA);
    P.LIN = (bf16_t*)(ob + TU); P.K = (bf16_t*)(r2 + TU); P.OMW = (bf16_t*)(r2 + 2 * TU); P.AL = (bf16_t*)(r2 + 4 * TU); P.G = (bf16_t*)(r2 + 6 * TU);
    P.YA = (bf16_t*)(r2 + 2 * TU);
    P.KH = (bf16_t*)(ws + WS_KV); P.VT = (bf16_t*)(ws + WS_KV + 4 * MiB); P.QH = (bf16_t*)r1; P.PP = (bf16_t*)r2;
    P.GATE = (float*)(r2 + 6 * TU); P.EXPERT = (int*)(r2 + 6 * TU + TU / 2);
}

#ifndef NEW_PEER
#define NEW_PEER 1
#endif
#ifndef USE_DOT2
#define USE_DOT2 0
#endif
#ifndef ATT_OLD
#define ATT_OLD 0
#endif
#ifndef NEW_SCAN
#define NEW_SCAN 1
#endif
#ifndef NEW_ROUTE
#define NEW_ROUTE 1
#endif
#define AX (ATT_OLD ? 1 : 0)
#define N_PHASES ((NEW_ROUTE ? 20 : 23) + AX)
__device__ __forceinline__ void run_simt_phase(const Params& P, int ph, long gtid, long nthr) {
    switch (ph) {
    case 0: ph0_weights(P, gtid, nthr);
            ln_rows_bf16(P.in[I_X], P.in[I_LN_EMB_G], P.in[I_LN_EMB_B], P.HB, TOK, 1024, gtid, nthr);
            ln_rows_bf16(P.in[I_MEM], P.in[I_MLN_G], P.in[I_MLN_B], P.MEMN, BATCH * MEM_LEN, 1024, gtid, nthr); break;
    case 2: ph2a_vn(P, gtid, nthr); break;
    case 3: ph2b_gmlp(P, gtid, nthr); break;
    case 4: ph3a_lora_in(P, gtid, nthr); break;
    case 5: ph3b_prep(P, gtid, nthr); break;
    case 7: ph5_rwkv_out(P, gtid, nthr); break;
    case 11: ph_ln_z(P, P.in[I_LN1_G], P.in[I_LN1_B], gtid, nthr); break;
    case 13: ph10a_scores(P, gtid, nthr); break;
    case 14: ph10b_softmax(P, gtid, nthr); break;
    case 15: ph10c_out(P, gtid, nthr); break;
    case 17: ph_ln_z(P, P.in[I_LN2_G], P.in[I_LN2_B], gtid, nthr); break;
    case 19: ph13a_scores(P, gtid, nthr); break;
    case 20: ph13b_topk(P, gtid, nthr); break;
    case 21: ph13c_cand(P, gtid, nthr); break;
    case 22: ph14a_act(P, gtid, nthr); break;
    case 23: ph14b_out(P, gtid, nthr); break;
    case 24: ph14c_final(P, gtid, nthr); break;
    default: break;
    }
}

#ifdef HOST_EMU
static void emu_run(const Params& P) {
    for (int ph = 0; ph < N_PHASES; ++ph) {
        switch (ph) {
        case 1:
            emu_gemm(P.HB, P.W_IN_T, TOK, 3072, 1024, [&](int r, int c, float a) { if (c < 2048) P.PA[(size_t)r * 2048 + c] = f2bf(a); else P.PB[(size_t)r * 1024 + c - 2048] = f2bf(geluf_(a)); });
            emu_gemm(P.MEMN, P.W_KV_T, BATCH * MEM_LEN, 2048, 1024, [&](int r, int c, float a) { P.KV[(size_t)r * 2048 + c] = f2bf(a); });
            break;
        case 6:
#pragma omp parallel for schedule(dynamic, 1)
            for (int it = 0; it < 2 * BATCH * 8 * 64; ++it) scan_item(P, it / 64, it % 64);
            break;
        case 8:
            emu_gemm(P.YA, P.W_BR_T, TOK, 1024, 512, [&](int r, int c, float a) { P.BR[(size_t)r * 2048 + c] = f2bf(a); });
            emu_gemm(P.YB, P.W_BR_T + (size_t)1024 * 512, TOK, 1024, 512, [&](int r, int c, float a) { P.BR[(size_t)r * 2048 + 1024 + c] = f2bf(a); });
            break;
        case 9: {
            float* tmp = (float*)malloc((size_t)TOK * 2048 * 4);
            emu_gemm(P.HB, P.W_IN_T + (size_t)3072 * 1024, TOK, 2048, 1024, [&](int r, int c, float a) { tmp[(size_t)r * 2048 + c] = a; });
            for (int r = 0; r < TOK; ++r) for (int n = 0; n < 1024; ++n) { const int j = n / 128, i = n % 128;
                const float g0 = tmp[(size_t)r * 2048 + 256 * j + i], g1 = tmp[(size_t)r * 2048 + 256 * j + 128 + i];
                P.MG[(size_t)r * 1024 + n] = f2bf(sigmoidf_(g0) * bf2f(P.BR[(size_t)r * 2048 + n]) + sigmoidf_(g1) * bf2f(P.BR[(size_t)r * 2048 + 1024 + n])); }
            free(tmp); } break;
        case 10: emu_gemm(P.MG, P.W_MIX_T, TOK, 1024, 1024, [&](int r, int c, float a) { P.Z[(size_t)r * 1024 + c] = ALPHA_F * bf2f(P.HB[(size_t)r * 1024 + c]) + a; }); break;
        case 12: emu_gemm(P.HB, P.W_Q_T, TOK, 1024, 1024, [&](int r, int c, float a) { P.Q[(size_t)r * 1024 + c] = f2bf(a); }); break;
        case 16: emu_gemm(P.O, P.W_O_T, TOK, 1024, 1024, [&](int r, int c, float a) { P.Z[(size_t)r * 1024 + c] = ALPHA_F * bf2f(P.HB[(size_t)r * 1024 + c]) + a; }); break;
        case 18: emu_gemm(P.HB, P.W_QUERY_T, TOK, 2048, 1024, [&](int r, int c, float a) { P.QP[(size_t)r * 2048 + c] = f2bf(a); }); break;
        default: {
            const long NT = 64;
#pragma omp parallel for schedule(static, 1)
            for (long g = 0; g < NT; ++g) run_simt_phase(P, ph, g, NT);
        } break;
        }
    }
}
extern "C" void kernel_launch(void* const* d_in, const int* in_sizes, int n_in, void* d_out, int out_size, void* d_ws, size_t ws_size, hipStream_t stream) {
    Params P; make_params(P, d_in, d_out, d_ws);
    memset(d_ws, 0, 1 << 20);
    emu_run(P);
}
#else

typedef float f32x4 __attribute__((ext_vector_type(4)));
typedef unsigned u32x4 __attribute__((ext_vector_type(4)));
typedef unsigned u32x2 __attribute__((ext_vector_type(2)));
typedef __bf16 bf16x2_t __attribute__((ext_vector_type(2)));
__device__ __forceinline__ float wave_sum(float v) {
#pragma unroll
    for (int o = 1; o < 64; o <<= 1) v += __shfl_xor(v, o);
    return v;
}
__device__ __forceinline__ float wave_max(float v) {
#pragma unroll
    for (int o = 1; o < 64; o <<= 1) v = fmaxf(v, __shfl_xor(v, o));
    return v;
}
__device__ __forceinline__ unsigned pk2(float lo, float hi) { return (unsigned)f2bf(lo) | ((unsigned)f2bf(hi) << 16); }
__device__ __forceinline__ float blo(unsigned w) { return __uint_as_float(w << 16); }
__device__ __forceinline__ float bhi(unsigned w) { return __uint_as_float(w & 0xffff0000u); }
__device__ __forceinline__ void wln_f32_bf16(const float* xrow, const float* g, const float* b, bf16_t* orow, int lane) {
    const f32x4* xr = (const f32x4*)xrow + lane; f32x4 v[4]; float s = 0.f;
#pragma unroll
    for (int j = 0; j < 4; ++j) { v[j] = xr[64 * j]; s += (v[j][0] + v[j][1]) + (v[j][2] + v[j][3]); }
    const float mean = wave_sum(s) * (1.f / 1024.f); float s2 = 0.f;
#pragma unroll
    for (int j = 0; j < 4; ++j) { v[j] = v[j] - mean; s2 += (v[j][0] * v[j][0] + v[j][1] * v[j][1]) + (v[j][2] * v[j][2] + v[j][3] * v[j][3]); }
    const float rstd = 1.f / sqrtf(wave_sum(s2) * (1.f / 1024.f) + 1e-5f);
#pragma unroll
    for (int j = 0; j < 4; ++j) { const f32x4 gg = ((const f32x4*)g)[64 * j + lane], bb = ((const f32x4*)b)[64 * j + lane]; const f32x4 o = v[j] * rstd * gg + bb;
        u32x2 w; w.x = pk2(o[0], o[1]); w.y = pk2(o[2], o[3]); *((u32x2*)orow + 64 * j + lane) = w; }
}
__device__ __forceinline__ void d_ln_rows(const float* in, const float* g, const float* b, bf16_t* out, int rows, int gw, int ngw, int lane) {
    for (int m = gw; m < rows; m += ngw) wln_f32_bf16(in + (size_t)m * 1024, g, b, out + (size_t)m * 1024, lane);
}
__device__ __forceinline__ void d_vn(const Params& P, int gw, int ngw, int lane) {
    const f32x4 g0 = ((const f32x4*)P.in[I_GLN_G])[2 * lane], g1 = ((const f32x4*)P.in[I_GLN_G])[2 * lane + 1];
    const f32x4 b0 = ((const f32x4*)P.in[I_GLN_B])[2 * lane], b1 = ((const f32x4*)P.in[I_GLN_B])[2 * lane + 1];
    for (int m = gw; m < TOK; m += ngw) {
        const u32x4 w = *((const u32x4*)(P.PB + (size_t)m * 1024 + 512) + lane);
        float x[8] = {blo(w.x), bhi(w.x), blo(w.y), bhi(w.y), blo(w.z), bhi(w.z), blo(w.w), bhi(w.w)};
        float s = 0.f;
#pragma unroll
        for (int i = 0; i < 8; ++i) s += x[i];
        const float mean = wave_sum(s) * (1.f / 512.f); float s2 = 0.f;
#pragma unroll
        for (int i = 0; i < 8; ++i) { x[i] -= mean; s2 += x[i] * x[i]; }
        const float rstd = 1.f / sqrtf(wave_sum(s2) * (1.f / 512.f) + 1e-5f);
        u32x4 o; o.x = pk2(x[0] * rstd * g0[0] + b0[0], x[1] * rstd * g0[1] + b0[1]); o.y = pk2(x[2] * rstd * g0[2] + b0[2], x[3] * rstd * g0[3] + b0[3]);
        o.z = pk2(x[4] * rstd * g1[0] + b1[0], x[5] * rstd * g1[1] + b1[1]); o.w = pk2(x[6] * rstd * g1[2] + b1[2], x[7] * rstd * g1[3] + b1[3]);
        *((u32x4*)(P.VN + (size_t)m * 512) + lane) = o;
    }
}
__device__ __forceinline__ void d_softmax256(const Params& P, int gw, int ngw, int lane) {
    for (long m = gw; m < (long)TOK * 4; m += ngw) { f32x4* xr = (f32x4*)(P.SCA + (size_t)m * 256) + lane; f32x4 v = *xr;
        const float mx = wave_max(fmaxf(fmaxf(v[0], v[1]), fmaxf(v[2], v[3])));
        v[0] = __expf(v[0] - mx); v[1] = __expf(v[1] - mx); v[2] = __expf(v[2] - mx); v[3] = __expf(v[3] - mx);
        const float inv = 1.0f / wave_sum((v[0] + v[1]) + (v[2] + v[3])); *xr = v * inv; }
}
__device__ __forceinline__ void tr_item(const float* W, int ldw, int src_col0, bf16_t* WT, int K, int dst_row0, int k0, LAS float* scr, int lane) {
    const int c = lane & 7;
    if (src_col0 < 0) {
#pragma unroll
        for (int j = 0; j < 4; ++j) { const int n = (lane >> 3) + 8 * j; *(u32x4*)(WT + (size_t)(dst_row0 + n) * K + k0 + 8 * c) = (u32x4){0u, 0u, 0u, 0u}; }
        return;
    }
#pragma unroll 8
    for (int i = 0; i < 32; ++i) { const int kk = 2 * i + (lane >> 5); scr[kk * 33 + (lane & 31)] = W[(size_t)(k0 + kk) * ldw + src_col0 + (lane & 31)]; }
    asm volatile("s_waitcnt lgkmcnt(0)" ::: "memory");
#pragma unroll
    for (int j = 0; j < 4; ++j) { const int n = (lane >> 3) + 8 * j; const LAS float* sp = scr + (8 * c) * 33 + n;
        u32x4 o; o.x = pk2(sp[0 * 33], sp[1 * 33]); o.y = pk2(sp[2 * 33], sp[3 * 33]); o.z = pk2(sp[4 * 33], sp[5 * 33]); o.w = pk2(sp[6 * 33], sp[7 * 33]);
        *(u32x4*)(WT + (size_t)(dst_row0 + n) * K + k0 + 8 * c) = o; }
    asm volatile("s_waitcnt lgkmcnt(0)" ::: "memory");
}
__device__ __forceinline__ void d_weights(const Params& P, LAS unsigned char* lds, int gw, int ngw, int wave, int lane) {
    LAS float* scr = (LAS float*)(lds + wave * 16384);
    constexpr int I_IN = 160 * 16, I_BR = 2 * 32 * 8, I_SQ = 32 * 16, I_WIDE = 64 * 16;
    constexpr int NITEMS = I_IN + I_BR + 3 * I_SQ + 2 * I_WIDE;
    for (int it = gw; it < NITEMS; it += ngw) {
        int r = it;
        if (r < I_IN) { const int nb = r / 16, kb = r % 16; tr_item(P.in[I_W_IN], IN_COLS, win_src_col(32 * nb), P.W_IN_T, 1024, 32 * nb, 64 * kb, scr, lane); continue; } r -= I_IN;
        if (r < I_BR) { const int br = r / 256, q = r % 256, nb = q / 8, kb = q % 8; tr_item(P.in[I_W_BRANCH] + (size_t)br * 512 * 1024, 1024, 32 * nb, P.W_BR_T, 512, br * 1024 + 32 * nb, 64 * kb, scr, lane); continue; } r -= I_BR;
        if (r < 3 * I_SQ) { const int w = r / I_SQ, q = r % I_SQ, nb = q / 16, kb = q % 16;
            const float* src = (w == 0) ? P.in[I_W_MIX] : (w == 1) ? P.in[I_W_Q] : P.in[I_W_O]; bf16_t* dst = (w == 0) ? P.W_MIX_T : (w == 1) ? P.W_Q_T : P.W_O_T;
            tr_item(src, 1024, 32 * nb, dst, 1024, 32 * nb, 64 * kb, scr, lane); continue; } r -= 3 * I_SQ;
        { const int w = r / I_WIDE, q = r % I_WIDE, nb = q / 16, kb = q % 16;
            tr_item(w == 0 ? P.in[I_W_KV] : P.in[I_W_QUERY], 2048, 32 * nb, w == 0 ? P.W_KV_T : P.W_QUERY_T, 1024, 32 * nb, 64 * kb, scr, lane); }
    }
}
__device__ __forceinline__ void d_tables(const Params& P, long gtid, long nthr) {
    const long n8 = (long)16384 * 1024 / 8;
    for (long i = gtid; i < 2 * n8; i += nthr) { const bool isv = (i >= n8); const long j = isv ? i - n8 : i;
        const f32x4* src = (const f32x4*)(isv ? P.in[I_PEER_V] : P.in[I_PEER_U]) + 2 * j; const f32x4 a = src[0], b = src[1];
        u32x4 o; o.x = pk2(a[0], a[1]); o.y = pk2(a[2], a[3]); o.z = pk2(b[0], b[1]); o.w = pk2(b[2], b[3]);
        *((u32x4*)(isv ? P.VB : P.UB) + j) = o; }
}
__device__ __forceinline__ float dot8(const u32x4& a, const u32x4& b, float acc) {
#if USE_DOT2
    acc = __builtin_amdgcn_fdot2_f32_bf16(__builtin_bit_cast(bf16x2_t, a.x), __builtin_bit_cast(bf16x2_t, b.x), acc, false);
    acc = __builtin_amdgcn_fdot2_f32_bf16(__builtin_bit_cast(bf16x2_t, a.y), __builtin_bit_cast(bf16x2_t, b.y), acc, false);
    acc = __builtin_amdgcn_fdot2_f32_bf16(__builtin_bit_cast(bf16x2_t, a.z), __builtin_bit_cast(bf16x2_t, b.z), acc, false);
    acc = __builtin_amdgcn_fdot2_f32_bf16(__builtin_bit_cast(bf16x2_t, a.w), __builtin_bit_cast(bf16x2_t, b.w), acc, false);
#else
    acc += blo(a.x) * blo(b.x); acc += bhi(a.x) * bhi(b.x); acc += blo(a.y) * blo(b.y); acc += bhi(a.y) * bhi(b.y);
    acc += blo(a.z) * blo(b.z); acc += bhi(a.z) * bhi(b.z); acc += blo(a.w) * blo(b.w); acc += bhi(a.w) * bhi(b.w);
#endif
    return acc;
}
__device__ __forceinline__ void axpy8(float* y, float c, const u32x4& v) {
    y[0] += c * blo(v.x); y[1] += c * bhi(v.x); y[2] += c * blo(v.y); y[3] += c * bhi(v.y);
    y[4] += c * blo(v.z); y[5] += c * bhi(v.z); y[6] += c * blo(v.w); y[7] += c * bhi(v.w);
}
__device__ __forceinline__ void d_peer(const Params& P, int gw, int ngw, int lane) {
    for (long t = gw; t < TOK; t += ngw) {
        const u32x4* xr = (const u32x4*)(P.HB + (size_t)t * 1024); const u32x4 x0 = xr[lane], x1 = xr[64 + lane];
        const int e_lo = P.EXPERT[(size_t)t * 128 + lane], e_hi = P.EXPERT[(size_t)t * 128 + 64 + lane];
        const float g_lo = P.GATE[(size_t)t * 128 + lane], g_hi = P.GATE[(size_t)t * 128 + 64 + lane];
        float y[16];
#pragma unroll
        for (int i = 0; i < 16; ++i) y[i] = 0.f;
#pragma unroll 1
        for (int half = 0; half < 2; ++half) {
            const int ev = half ? e_hi : e_lo; const float gv = half ? g_hi : g_lo;
#pragma unroll 1
            for (int k0 = 0; k0 < 64; k0 += 4) {
                int e[4]; float gt[4]; u32x4 u0[4], u1[4], v0[4], v1[4];
#pragma unroll
                for (int q = 0; q < 4; ++q) { e[q] = __builtin_amdgcn_readlane(ev, k0 + q); gt[q] = __uint_as_float(__builtin_amdgcn_readlane(__float_as_uint(gv), k0 + q)); }
#pragma unroll
                for (int q = 0; q < 4; ++q) { const u32x4* ur = (const u32x4*)(P.UB + (size_t)e[q] * 1024); u0[q] = ur[lane]; u1[q] = ur[64 + lane]; }
#pragma unroll
                for (int q = 0; q < 4; ++q) { const u32x4* vr = (const u32x4*)(P.VB + (size_t)e[q] * 1024); v0[q] = vr[lane]; v1[q] = vr[64 + lane]; }
                float d[4];
#pragma unroll
                for (int q = 0; q < 4; ++q) d[q] = dot8(u1[q], x1, dot8(u0[q], x0, 0.f));
#pragma unroll
                for (int o = 1; o < 64; o <<= 1) {
#pragma unroll
                    for (int q = 0; q < 4; ++q) d[q] += __shfl_xor(d[q], o); }
#pragma unroll
                for (int q = 0; q < 4; ++q) { const float a = d[q]; const float c = gt[q] * 0.5f * a * (1.0f + erff(a * 0.7071067811865476f)); axpy8(y, c, v0[q]); axpy8(y + 8, c, v1[q]); }
            }
        }
        float z[16];
        z[0] = ALPHA_F * blo(x0.x) + y[0]; z[1] = ALPHA_F * bhi(x0.x) + y[1]; z[2] = ALPHA_F * blo(x0.y) + y[2]; z[3] = ALPHA_F * bhi(x0.y) + y[3];
        z[4] = ALPHA_F * blo(x0.z) + y[4]; z[5] = ALPHA_F * bhi(x0.z) + y[5]; z[6] = ALPHA_F * blo(x0.w) + y[6]; z[7] = ALPHA_F * bhi(x0.w) + y[7];
        z[8] = ALPHA_F * blo(x1.x) + y[8]; z[9] = ALPHA_F * bhi(x1.x) + y[9]; z[10] = ALPHA_F * blo(x1.y) + y[10]; z[11] = ALPHA_F * bhi(x1.y) + y[11];
        z[12] = ALPHA_F * blo(x1.z) + y[12]; z[13] = ALPHA_F * bhi(x1.z) + y[13]; z[14] = ALPHA_F * blo(x1.w) + y[14]; z[15] = ALPHA_F * bhi(x1.w) + y[15];
        float s = 0.f;
#pragma unroll
        for (int i = 0; i < 16; ++i) s += z[i];
        const float mean = wave_sum(s) * (1.f / 1024.f); float s2 = 0.f;
#pragma unroll
        for (int i = 0; i < 16; ++i) { z[i] -= mean; s2 += z[i] * z[i]; }
        const float rstd = 1.f / sqrtf(wave_sum(s2) * (1.f / 1024.f) + 1e-5f);
        const float* g = P.in[I_LN3_G]; const float* b = P.in[I_LN3_B]; float* orow = P.out + (size_t)t * 1024;
#pragma unroll
        for (int hh = 0; hh < 2; ++hh)
#pragma unroll
            for (int q = 0; q < 2; ++q) { const int col = hh * 512 + lane * 8 + q * 4; const f32x4 gg = *(const f32x4*)(g + col), bb = *(const f32x4*)(b + col);
                f32x4 o; o[0] = z[hh * 8 + q * 4 + 0] * rstd * gg[0] + bb[0]; o[1] = z[hh * 8 + q * 4 + 1] * rstd * gg[1] + bb[1];
                o[2] = z[hh * 8 + q * 4 + 2] * rstd * gg[2] + bb[2]; o[3] = z[hh * 8 + q * 4 + 3] * rstd * gg[3] + bb[3];
                *(f32x4*)(orow + col) = o; }
    }
}

__device__ __forceinline__ void d_lora_weights(const Params& P, long gtid, long nthr) {
    for (long idx = gtid; idx < (long)2560 * 512; idx += nthr) { const int n = (int)(idx / 512), k = (int)(idx % 512); float v = 0.f;
        if (n < 1024) { const int z = n >> 9, c = n & 511; if (k >= z * 64 && k < z * 64 + 64) v = P.in[I_W2][((size_t)z * 64 + (k - z * 64)) * 512 + c]; }
        else if (n < 2048) { const int z = (n - 1024) >> 9, c = n & 511; const int kk = k - 128; if (kk >= z * 64 && kk < z * 64 + 64) v = P.in[I_A2][((size_t)z * 64 + (kk - z * 64)) * 512 + c]; }
        else { const int c = n - 2048; if (k >= 256 && k < 384) v = P.in[I_G2][(size_t)(k - 256) * 512 + c]; }
        P.W_LORA_T[idx] = f2bf(v); }
}
__device__ __forceinline__ void shift8(const bf16_t* PA, long t, int s, int col, const float* mu, float* o) {
    const u32x4 c = *(const u32x4*)(PA + (size_t)t * 2048 + col);
    u32x4 p = (u32x4){0u, 0u, 0u, 0u}, n = (u32x4){0u, 0u, 0u, 0u};
    if (s > 0) p = *(const u32x4*)(PA + (size_t)(t - 1) * 2048 + col);
    if (s < SEQ - 1) n = *(const u32x4*)(PA + (size_t)(t + 1) * 2048 + col);
    const f32x4 m0 = *(const f32x4*)(mu + col), m1 = *(const f32x4*)(mu + col + 4);
    const float cc[8] = {blo(c.x), bhi(c.x), blo(c.y), bhi(c.y), blo(c.z), bhi(c.z), blo(c.w), bhi(c.w)};
    const float pp[8] = {blo(p.x), bhi(p.x), blo(p.y), bhi(p.y), blo(p.z), bhi(p.z), blo(p.w), bhi(p.w)};
    const float nn[8] = {blo(n.x), bhi(n.x), blo(n.y), bhi(n.y), blo(n.z), bhi(n.z), blo(n.w), bhi(n.w)};
#pragma unroll
    for (int i = 0; i < 8; ++i) { const float m = (i < 4) ? m0[i] : m1[i - 4]; o[i] = cc[i] + m * (0.5f * (pp[i] + nn[i]) - cc[i]); }
}
__device__ __forceinline__ u32x4 pack8f(const float* v) { u32x4 w; w.x = pk2(v[0], v[1]); w.y = pk2(v[2], v[3]); w.z = pk2(v[4], v[5]); w.w = pk2(v[6], v[7]); return w; }
__device__ __forceinline__ void d_prep_e1(const Params& P, int gw, int ngw, int lane) {
    const float* mu = P.in[I_MU];
    const f32x4 kk0 = *(const f32x4*)(P.in[I_K_K] + 8 * lane), kk1 = *(const f32x4*)(P.in[I_K_K] + 8 * lane + 4);
    for (long t = gw; t < TOK; t += ngw) { const int s = (int)(t % SEQ); float r[8], k[8], v[8];
        shift8(P.PA, t, s, 8 * lane, mu, r); shift8(P.PA, t, s, 512 + 8 * lane, mu, k); shift8(P.PA, t, s, 1024 + 8 * lane, mu, v);
        float q[8]; float ss = 0.f;
#pragma unroll
        for (int i = 0; i < 8; ++i) { q[i] = k[i] * ((i < 4) ? kk0[i] : kk1[i - 4]); ss += q[i] * q[i]; }
        ss += __shfl_xor(ss, 1); ss += __shfl_xor(ss, 2); ss += __shfl_xor(ss, 4);
        const float inv = 1.0f / fmaxf(sqrtf(ss), 1e-12f);
#pragma unroll
        for (int i = 0; i < 8; ++i) q[i] *= inv;
        *(u32x4*)(P.R + (size_t)t * 512 + 8 * lane) = pack8f(r); *(u32x4*)(P.K + (size_t)t * 512 + 8 * lane) = pack8f(k);
        *(u32x4*)(P.V + (size_t)t * 512 + 8 * lane) = pack8f(v); *(u32x4*)(P.KK + (size_t)t * 512 + 8 * lane) = pack8f(q);
        if (lane < 48) { float x[8]; shift8(P.PA, t, s, 1536 + 8 * lane, mu, x);
#pragma unroll
            for (int i = 0; i < 8; ++i) x[i] = (lane < 16) ? tanhf(x[i]) : (lane < 32) ? x[i] : 1.0f / (1.0f + expf(-x[i]));
            *(u32x4*)(P.LIN + (size_t)t * 512 + 8 * lane) = pack8f(x); }
        else *(u32x4*)(P.LIN + (size_t)t * 512 + 8 * lane) = (u32x4){0u, 0u, 0u, 0u};
    }
}
__device__ __forceinline__ void scan_item3(const Params& P, int chain, int i) {
    const int h = chain % 8, b = (chain / 8) % BATCH, z = chain / (8 * BATCH);
    float S[64];
#pragma unroll
    for (int j = 0; j < 64; ++j) S[j] = 0.f;
    const float* ka = P.in[I_K_A] + h * 64;
    for (int n = 0; n < SEQ; ++n) {
        const long t = (long)b * SEQ + ((z == 0) ? n : (SEQ - 1 - n)); const size_t o1 = (size_t)t * 512 + h * 64, o2 = ((size_t)t * 2 + z) * 512 + h * 64;
        const float v = bf2f(P.V[o1 + i]);
        float sa = 0.f;
#pragma unroll
        for (int j = 0; j < 64; ++j) sa -= S[j] * bf2f(P.KK[o1 + j]);
        float y = 0.f;
#pragma unroll
        for (int j = 0; j < 64; ++j) { const float al = bf2f(P.AL[o2 + j]), k = bf2f(P.K[o1 + j]);
            S[j] = S[j] * (1.0f - bf2f(P.OMW[o2 + j])) + sa * (bf2f(P.KK[o1 + j]) * al) + v * (k * (1.0f + (al - 1.0f) * ka[j])); y += S[j] * bf2f(P.R[o1 + j]); }
        P.Y01[((size_t)z * TOK + t) * 512 + h * 64 + i] = y;
    }
}

#define SC_CH 32
#define SC_REC 352
template <int CTRL> __device__ __forceinline__ float dpp_add(float x) {
    return x + __uint_as_float((unsigned)__builtin_amdgcn_update_dpp(0, (int)__float_as_uint(x), CTRL, 0xf, 0xf, false));
}
__device__ __forceinline__ float allsum16(float x) { x = dpp_add<0xB1>(x); x = dpp_add<0x4E>(x); x = dpp_add<0x141>(x); x = dpp_add<0x140>(x); return x; }
__device__ __forceinline__ void d_scan(const Params& P, LAS unsigned char* lds, int tid) {
    const int lane = tid & 63, wave = __builtin_amdgcn_readfirstlane(tid >> 6);
    const int chain = (int)blockIdx.x >> 1, half = (int)blockIdx.x & 1;
    if (chain >= 2 * BATCH * 8) return;
    const int h = chain % 8, b = (chain / 8) % BATCH, z = chain / (8 * BATCH);
    LAS float* buf = (LAS float*)lds;
    const float ka = P.in[I_K_A][h * 64 + lane];
    const long tb = (long)b * SEQ;
    unsigned short gr[4], gk[4], gkk[4], gom[4], gal[4], gv[2];
    auto g_load = [&](int c) {
#pragma unroll
        for (int q = 0; q < 4; ++q) { const int n = c * SC_CH + wave + 8 * q; const long t = tb + ((z == 0) ? n : (SEQ - 1 - n));
            const size_t o1 = (size_t)t * 512 + h * 64 + lane, o2 = ((size_t)t * 2 + z) * 512 + h * 64 + lane;
            gr[q] = P.R[o1]; gk[q] = P.K[o1]; gkk[q] = P.KK[o1]; gom[q] = P.OMW[o2]; gal[q] = P.AL[o2]; }
#pragma unroll
        for (int q = 0; q < 2; ++q) { const int p = tid + 512 * q; const int n = c * SC_CH + (p >> 5); const long t = tb + ((z == 0) ? n : (SEQ - 1 - n));
            gv[q] = P.V[(size_t)t * 512 + h * 64 + half * 32 + (p & 31)]; }
    };
    auto s_write = [&](int c) {
        LAS float* bb = buf + (c & 1) * (SC_CH * SC_REC);
#pragma unroll
        for (int q = 0; q < 4; ++q) { LAS float* rec = bb + (wave + 8 * q) * SC_REC + lane;
            const float k = bf2f(gk[q]), kk = bf2f(gkk[q]), al = bf2f(gal[q]);
            rec[0] = 1.0f - bf2f(gom[q]); rec[64] = k * (1.0f + (al - 1.0f) * ka); rec[128] = -kk; rec[192] = kk * al; rec[256] = bf2f(gr[q]); }
#pragma unroll
        for (int q = 0; q < 2; ++q) { const int p = tid + 512 * q; bb[(p >> 5) * SC_REC + 320 + (p & 31)] = bf2f(gv[q]); }
    };
    const int rg = lane >> 4, jl = lane & 15, rowl = wave * 4 + rg;
    float S0 = 0.f, S1 = 0.f, S2 = 0.f, S3 = 0.f;
    g_load(0); s_write(0); g_load(1);
    asm volatile("s_waitcnt lgkmcnt(0)" ::: "memory"); __syncthreads();
    float* yout = P.Y01 + (size_t)z * TOK * 512 + h * 64 + half * 32 + rowl;
    constexpr int NCH = SEQ / SC_CH;
#pragma unroll 1
    for (int c = 0; c < NCH; ++c) {
        if (c + 1 < NCH) s_write(c + 1);
        if (c + 2 < NCH) g_load(c + 2);
        const LAS float* bb = buf + (c & 1) * (SC_CH * SC_REC);
#pragma unroll 4
        for (int nl = 0; nl < SC_CH; ++nl) { const LAS float* rec = bb + nl * SC_REC + jl * 4;
            const f32x4 w4 = *(const LAS f32x4*)(rec), kd4 = *(const LAS f32x4*)(rec + 64), a4 = *(const LAS f32x4*)(rec + 128), b4 = *(const LAS f32x4*)(rec + 192), r4 = *(const LAS f32x4*)(rec + 256);
            const float v = bb[nl * SC_REC + 320 + rowl];
            float sa = (S0 * a4[0] + S1 * a4[1]) + (S2 * a4[2] + S3 * a4[3]);
            sa = allsum16(sa);
            S0 = S0 * w4[0] + (sa * b4[0] + v * kd4[0]); S1 = S1 * w4[1] + (sa * b4[1] + v * kd4[1]);
            S2 = S2 * w4[2] + (sa * b4[2] + v * kd4[2]); S3 = S3 * w4[3] + (sa * b4[3] + v * kd4[3]);
            float y = (S0 * r4[0] + S1 * r4[1]) + (S2 * r4[2] + S3 * r4[3]);
            y = allsum16(y);
            const int n = c * SC_CH + nl; const long t = tb + ((z == 0) ? n : (SEQ - 1 - n));
            if (jl == 0) yout[(size_t)t * 512] = y;
        }
        asm volatile("s_waitcnt lgkmcnt(0)" ::: "memory"); __syncthreads();
    }
}
__device__ __forceinline__ void d_rwkv_out(const Params& P, int gw, int ngw, int lane) {
    for (long it = gw; it < (long)TOK * 8; it += ngw) { const long t = it >> 3; const int c = (int)(it & 7) * 64 + lane;
        const float y = P.Y01[(size_t)t * 512 + c] + P.Y01[((size_t)TOK + t) * 512 + c];
        const float mu = wave_sum(y) * (1.f / 64.f); const float d = y - mu; const float rs = 1.0f / sqrtf(wave_sum(d * d) * (1.f / 64.f) + 64e-5f);
        const float yn = d * rs * P.in[I_GN_G][c] + P.in[I_GN_B][c];
        const float r = bf2f(P.R[(size_t)t * 512 + c]), k = bf2f(P.K[(size_t)t * 512 + c]), ka = P.in[I_K_A][c];
        const float a0 = bf2f(P.AL[((size_t)t * 2) * 512 + c]), a1 = bf2f(P.AL[((size_t)t * 2 + 1) * 512 + c]);
        const float kd = k * (1.0f + (a0 - 1.0f) * ka) + k * (1.0f + (a1 - 1.0f) * ka);
        const float rk = wave_sum(r * kd * P.in[I_R_K][c]);
        P.YA[(size_t)t * 512 + c] = f2bf((yn + rk * bf2f(P.V[(size_t)t * 512 + c])) * bf2f(P.G[(size_t)t * 512 + c])); }
}

typedef short bf16x8v __attribute__((ext_vector_type(8)));
typedef float f32x16v __attribute__((ext_vector_type(16)));
#define RT_SKROW 272
__device__ __forceinline__ unsigned f2key(float f) { const unsigned u = __float_as_uint(f); return (u & 0x80000000u) ? ~u : (u | 0x80000000u); }
__device__ __forceinline__ float key2f(unsigned k) { const unsigned u = (k & 0x80000000u) ? (k & 0x7fffffffu) : ~k; return __uint_as_float(u); }
#define DECL16(T, P) T P##0, P##1, P##2, P##3, P##4, P##5, P##6, P##7, P##8, P##9, P##10, P##11, P##12, P##13, P##14, P##15
#define CE_D(a, b) do { const unsigned _hi = max(a, b), _lo = min(a, b); a = _hi; b = _lo; } while (0)
#define CE_A(a, b) do { const unsigned _hi = max(a, b), _lo = min(a, b); a = _lo; b = _hi; } while (0)
#define CEP_D(ka, pa, kb, pb) do { const bool _sw = (kb) > (ka); const unsigned _k0 = _sw ? (kb) : (ka), _k1 = _sw ? (ka) : (kb), _p0 = _sw ? (pb) : (pa), _p1 = _sw ? (pa) : (pb); ka = _k0; kb = _k1; pa = _p0; pb = _p1; } while (0)
#define CEP_A(ka, pa, kb, pb) do { const bool _sw = (kb) < (ka); const unsigned _k0 = _sw ? (kb) : (ka), _k1 = _sw ? (ka) : (kb), _p0 = _sw ? (pb) : (pa), _p1 = _sw ? (pa) : (pb); ka = _k0; kb = _k1; pa = _p0; pb = _p1; } while (0)
#define SORT16_DESC(P) do { CE_D(P##0, P##1); CE_A(P##2, P##3); CE_D(P##4, P##5); CE_A(P##6, P##7); CE_D(P##8, P##9); CE_A(P##10, P##11); CE_D(P##12, P##13); CE_A(P##14, P##15); CE_D(P##0, P##2); CE_D(P##1, P##3); CE_A(P##4, P##6); CE_A(P##5, P##7); CE_D(P##8, P##10); CE_D(P##9, P##11); CE_A(P##12, P##14); CE_A(P##13, P##15); CE_D(P##0, P##1); CE_D(P##2, P##3); CE_A(P##4, P##5); CE_A(P##6, P##7); CE_D(P##8, P##9); CE_D(P##10, P##11); CE_A(P##12, P##13); CE_A(P##14, P##15); CE_D(P##0, P##4); CE_D(P##1, P##5); CE_D(P##2, P##6); CE_D(P##3, P##7); CE_A(P##8, P##12); CE_A(P##9, P##13); CE_A(P##10, P##14); CE_A(P##11, P##15); CE_D(P##0, P##2); CE_D(P##1, P##3); CE_D(P##4, P##6); CE_D(P##5, P##7); CE_A(P##8, P##10); CE_A(P##9, P##11); CE_A(P##12, P##14); CE_A(P##13, P##15); CE_D(P##0, P##1); CE_D(P##2, P##3); CE_D(P##4, P##5); CE_D(P##6, P##7); CE_A(P##8, P##9); CE_A(P##10, P##11); CE_A(P##12, P##13); CE_A(P##14, P##15); CE_D(P##0, P##8); CE_D(P##1, P##9); CE_D(P##2, P##10); CE_D(P##3, P##11); CE_D(P##4, P##12); CE_D(P##5, P##13); CE_D(P##6, P##14); CE_D(P##7, P##15); CE_D(P##0, P##4); CE_D(P##1, P##5); CE_D(P##2, P##6); CE_D(P##3, P##7); CE_D(P##8, P##12); CE_D(P##9, P##13); CE_D(P##10, P##14); CE_D(P##11, P##15); CE_D(P##0, P##2); CE_D(P##1, P##3); CE_D(P##4, P##6); CE_D(P##5, P##7); CE_D(P##8, P##10); CE_D(P##9, P##11); CE_D(P##12, P##14); CE_D(P##13, P##15); CE_D(P##0, P##1); CE_D(P##2, P##3); CE_D(P##4, P##5); CE_D(P##6, P##7); CE_D(P##8, P##9); CE_D(P##10, P##11); CE_D(P##12, P##13); CE_D(P##14, P##15); } while (0)
#define SORT16P_DESC(K, Q) do { CEP_D(K##0, Q##0, K##1, Q##1); CEP_A(K##2, Q##2, K##3, Q##3); CEP_D(K##4, Q##4, K##5, Q##5); CEP_A(K##6, Q##6, K##7, Q##7); CEP_D(K##8, Q##8, K##9, Q##9); CEP_A(K##10, Q##10, K##11, Q##11); CEP_D(K##12, Q##12, K##13, Q##13); CEP_A(K##14, Q##14, K##15, Q##15); CEP_D(K##0, Q##0, K##2, Q##2); CEP_D(K##1, Q##1, K##3, Q##3); CEP_A(K##4, Q##4, K##6, Q##6); CEP_A(K##5, Q##5, K##7, Q##7); CEP_D(K##8, Q##8, K##10, Q##10); CEP_D(K##9, Q##9, K##11, Q##11); CEP_A(K##12, Q##12, K##14, Q##14); CEP_A(K##13, Q##13, K##15, Q##15); CEP_D(K##0, Q##0, K##1, Q##1); CEP_D(K##2, Q##2, K##3, Q##3); CEP_A(K##4, Q##4, K##5, Q##5); CEP_A(K##6, Q##6, K##7, Q##7); CEP_D(K##8, Q##8, K##9, Q##9); CEP_D(K##10, Q##10, K##11, Q##11); CEP_A(K##12, Q##12, K##13, Q##13); CEP_A(K##14, Q##14, K##15, Q##15); CEP_D(K##0, Q##0, K##4, Q##4); CEP_D(K##1, Q##1, K##5, Q##5); CEP_D(K##2, Q##2, K##6, Q##6); CEP_D(K##3, Q##3, K##7, Q##7); CEP_A(K##8, Q##8, K##12, Q##12); CEP_A(K##9, Q##9, K##13, Q##13); CEP_A(K##10, Q##10, K##14, Q##14); CEP_A(K##11, Q##11, K##15, Q##15); CEP_D(K##0, Q##0, K##2, Q##2); CEP_D(K##1, Q##1, K##3, Q##3); CEP_D(K##4, Q##4, K##6, Q##6); CEP_D(K##5, Q##5, K##7, Q##7); CEP_A(K##8, Q##8, K##10, Q##10); CEP_A(K##9, Q##9, K##11, Q##11); CEP_A(K##12, Q##12, K##14, Q##14); CEP_A(K##13, Q##13, K##15, Q##15); CEP_D(K##0, Q##0, K##1, Q##1); CEP_D(K##2, Q##2, K##3, Q##3); CEP_D(K##4, Q##4, K##5, Q##5); CEP_D(K##6, Q##6, K##7, Q##7); CEP_A(K##8, Q##8, K##9, Q##9); CEP_A(K##10, Q##10, K##11, Q##11); CEP_A(K##12, Q##12, K##13, Q##13); CEP_A(K##14, Q##14, K##15, Q##15); CEP_D(K##0, Q##0, K##8, Q##8); CEP_D(K##1, Q##1, K##9, Q##9); CEP_D(K##2, Q##2, K##10, Q##10); CEP_D(K##3, Q##3, K##11, Q##11); CEP_D(K##4, Q##4, K##12, Q##12); CEP_D(K##5, Q##5, K##13, Q##13); CEP_D(K##6, Q##6, K##14, Q##14); CEP_D(K##7, Q##7, K##15, Q##15); CEP_D(K##0, Q##0, K##4, Q##4); CEP_D(K##1, Q##1, K##5, Q##5); CEP_D(K##2, Q##2, K##6, Q##6); CEP_D(K##3, Q##3, K##7, Q##7); CEP_D(K##8, Q##8, K##12, Q##12); CEP_D(K##9, Q##9, K##13, Q##13); CEP_D(K##10, Q##10, K##14, Q##14); CEP_D(K##11, Q##11, K##15, Q##15); CEP_D(K##0, Q##0, K##2, Q##2); CEP_D(K##1, Q##1, K##3, Q##3); CEP_D(K##4, Q##4, K##6, Q##6); CEP_D(K##5, Q##5, K##7, Q##7); CEP_D(K##8, Q##8, K##10, Q##10); CEP_D(K##9, Q##9, K##11, Q##11); CEP_D(K##12, Q##12, K##14, Q##14); CEP_D(K##13, Q##13, K##15, Q##15); CEP_D(K##0, Q##0, K##1, Q##1); CEP_D(K##2, Q##2, K##3, Q##3); CEP_D(K##4, Q##4, K##5, Q##5); CEP_D(K##6, Q##6, K##7, Q##7); CEP_D(K##8, Q##8, K##9, Q##9); CEP_D(K##10, Q##10, K##11, Q##11); CEP_D(K##12, Q##12, K##13, Q##13); CEP_D(K##14, Q##14, K##15, Q##15); } while (0)
#define MERGE16_DESC(A, B) do { A##0 = max(A##0, B##15); A##1 = max(A##1, B##14); A##2 = max(A##2, B##13); A##3 = max(A##3, B##12); A##4 = max(A##4, B##11); A##5 = max(A##5, B##10); A##6 = max(A##6, B##9); A##7 = max(A##7, B##8); A##8 = max(A##8, B##7); A##9 = max(A##9, B##6); A##10 = max(A##10, B##5); A##11 = max(A##11, B##4); A##12 = max(A##12, B##3); A##13 = max(A##13, B##2); A##14 = max(A##14, B##1); A##15 = max(A##15, B##0); CE_D(A##0, A##8); CE_D(A##1, A##9); CE_D(A##2, A##10); CE_D(A##3, A##11); CE_D(A##4, A##12); CE_D(A##5, A##13); CE_D(A##6, A##14); CE_D(A##7, A##15); CE_D(A##0, A##4); CE_D(A##1, A##5); CE_D(A##2, A##6); CE_D(A##3, A##7); CE_D(A##8, A##12); CE_D(A##9, A##13); CE_D(A##10, A##14); CE_D(A##11, A##15); CE_D(A##0, A##2); CE_D(A##1, A##3); CE_D(A##4, A##6); CE_D(A##5, A##7); CE_D(A##8, A##10); CE_D(A##9, A##11); CE_D(A##12, A##14); CE_D(A##13, A##15); CE_D(A##0, A##1); CE_D(A##2, A##3); CE_D(A##4, A##5); CE_D(A##6, A##7); CE_D(A##8, A##9); CE_D(A##10, A##11); CE_D(A##12, A##13); CE_D(A##14, A##15); } while (0)
#define MERGE16P_DESC(A, PA, B, PB) do { { const bool _s = B##15 > A##0; PA##0 = _s ? PB##15 : PA##0; A##0 = _s ? B##15 : A##0; } { const bool _s = B##14 > A##1; PA##1 = _s ? PB##14 : PA##1; A##1 = _s ? B##14 : A##1; } { const bool _s = B##13 > A##2; PA##2 = _s ? PB##13 : PA##2; A##2 = _s ? B##13 : A##2; } { const bool _s = B##12 > A##3; PA##3 = _s ? PB##12 : PA##3; A##3 = _s ? B##12 : A##3; } { const bool _s = B##11 > A##4; PA##4 = _s ? PB##11 : PA##4; A##4 = _s ? B##11 : A##4; } { const bool _s = B##10 > A##5; PA##5 = _s ? PB##10 : PA##5; A##5 = _s ? B##10 : A##5; } { const bool _s = B##9 > A##6; PA##6 = _s ? PB##9 : PA##6; A##6 = _s ? B##9 : A##6; } { const bool _s = B##8 > A##7; PA##7 = _s ? PB##8 : PA##7; A##7 = _s ? B##8 : A##7; } { const bool _s = B##7 > A##8; PA##8 = _s ? PB##7 : PA##8; A##8 = _s ? B##7 : A##8; } { const bool _s = B##6 > A##9; PA##9 = _s ? PB##6 : PA##9; A##9 = _s ? B##6 : A##9; } { const bool _s = B##5 > A##10; PA##10 = _s ? PB##5 : PA##10; A##10 = _s ? B##5 : A##10; } { const bool _s = B##4 > A##11; PA##11 = _s ? PB##4 : PA##11; A##11 = _s ? B##4 : A##11; } { const bool _s = B##3 > A##12; PA##12 = _s ? PB##3 : PA##12; A##12 = _s ? B##3 : A##12; } { const bool _s = B##2 > A##13; PA##13 = _s ? PB##2 : PA##13; A##13 = _s ? B##2 : A##13; } { const bool _s = B##1 > A##14; PA##14 = _s ? PB##1 : PA##14; A##14 = _s ? B##1 : A##14; } { const bool _s = B##0 > A##15; PA##15 = _s ? PB##0 : PA##15; A##15 = _s ? B##0 : A##15; } CEP_D(A##0, PA##0, A##8, PA##8); CEP_D(A##1, PA##1, A##9, PA##9); CEP_D(A##2, PA##2, A##10, PA##10); CEP_D(A##3, PA##3, A##11, PA##11); CEP_D(A##4, PA##4, A##12, PA##12); CEP_D(A##5, PA##5, A##13, PA##13); CEP_D(A##6, PA##6, A##14, PA##14); CEP_D(A##7, PA##7, A##15, PA##15); CEP_D(A##0, PA##0, A##4, PA##4); CEP_D(A##1, PA##1, A##5, PA##5); CEP_D(A##2, PA##2, A##6, PA##6); CEP_D(A##3, PA##3, A##7, PA##7); CEP_D(A##8, PA##8, A##12, PA##12); CEP_D(A##9, PA##9, A##13, PA##13); CEP_D(A##10, PA##10, A##14, PA##14); CEP_D(A##11, PA##11, A##15, PA##15); CEP_D(A##0, PA##0, A##2, PA##2); CEP_D(A##1, PA##1, A##3, PA##3); CEP_D(A##4, PA##4, A##6, PA##6); CEP_D(A##5, PA##5, A##7, PA##7); CEP_D(A##8, PA##8, A##10, PA##10); CEP_D(A##9, PA##9, A##11, PA##11); CEP_D(A##12, PA##12, A##14, PA##14); CEP_D(A##13, PA##13, A##15, PA##15); CEP_D(A##0, PA##0, A##1, PA##1); CEP_D(A##2, PA##2, A##3, PA##3); CEP_D(A##4, PA##4, A##5, PA##5); CEP_D(A##6, PA##6, A##7, PA##7); CEP_D(A##8, PA##8, A##9, PA##9); CEP_D(A##10, PA##10, A##11, PA##11); CEP_D(A##12, PA##12, A##13, PA##13); CEP_D(A##14, PA##14, A##15, PA##15); } while (0)
#define FILL_G0(P, ACC, HH) do { P##0 = (f2key(ACC[0]) & ~0x7fu) | (unsigned)(127 - (0 + 4 * (HH))); P##1 = (f2key(ACC[1]) & ~0x7fu) | (unsigned)(127 - (1 + 4 * (HH))); P##2 = (f2key(ACC[2]) & ~0x7fu) | (unsigned)(127 - (2 + 4 * (HH))); P##3 = (f2key(ACC[3]) & ~0x7fu) | (unsigned)(127 - (3 + 4 * (HH))); P##4 = (f2key(ACC[4]) & ~0x7fu) | (unsigned)(127 - (8 + 4 * (HH))); P##5 = (f2key(ACC[5]) & ~0x7fu) | (unsigned)(127 - (9 + 4 * (HH))); P##6 = (f2key(ACC[6]) & ~0x7fu) | (unsigned)(127 - (10 + 4 * (HH))); P##7 = (f2key(ACC[7]) & ~0x7fu) | (unsigned)(127 - (11 + 4 * (HH))); P##8 = (f2key(ACC[8]) & ~0x7fu) | (unsigned)(127 - (16 + 4 * (HH))); P##9 = (f2key(ACC[9]) & ~0x7fu) | (unsigned)(127 - (17 + 4 * (HH))); P##10 = (f2key(ACC[10]) & ~0x7fu) | (unsigned)(127 - (18 + 4 * (HH))); P##11 = (f2key(ACC[11]) & ~0x7fu) | (unsigned)(127 - (19 + 4 * (HH))); P##12 = (f2key(ACC[12]) & ~0x7fu) | (unsigned)(127 - (24 + 4 * (HH))); P##13 = (f2key(ACC[13]) & ~0x7fu) | (unsigned)(127 - (25 + 4 * (HH))); P##14 = (f2key(ACC[14]) & ~0x7fu) | (unsigned)(127 - (26 + 4 * (HH))); P##15 = (f2key(ACC[15]) & ~0x7fu) | (unsigned)(127 - (27 + 4 * (HH))); } while (0)
#define FILL_G1(P, ACC, HH) do { P##0 = (f2key(ACC[0]) & ~0x7fu) | (unsigned)(127 - (32 + 4 * (HH))); P##1 = (f2key(ACC[1]) & ~0x7fu) | (unsigned)(127 - (33 + 4 * (HH))); P##2 = (f2key(ACC[2]) & ~0x7fu) | (unsigned)(127 - (34 + 4 * (HH))); P##3 = (f2key(ACC[3]) & ~0x7fu) | (unsigned)(127 - (35 + 4 * (HH))); P##4 = (f2key(ACC[4]) & ~0x7fu) | (unsigned)(127 - (40 + 4 * (HH))); P##5 = (f2key(ACC[5]) & ~0x7fu) | (unsigned)(127 - (41 + 4 * (HH))); P##6 = (f2key(ACC[6]) & ~0x7fu) | (unsigned)(127 - (42 + 4 * (HH))); P##7 = (f2key(ACC[7]) & ~0x7fu) | (unsigned)(127 - (43 + 4 * (HH))); P##8 = (f2key(ACC[8]) & ~0x7fu) | (unsigned)(127 - (48 + 4 * (HH))); P##9 = (f2key(ACC[9]) & ~0x7fu) | (unsigned)(127 - (49 + 4 * (HH))); P##10 = (f2key(ACC[10]) & ~0x7fu) | (unsigned)(127 - (50 + 4 * (HH))); P##11 = (f2key(ACC[11]) & ~0x7fu) | (unsigned)(127 - (51 + 4 * (HH))); P##12 = (f2key(ACC[12]) & ~0x7fu) | (unsigned)(127 - (56 + 4 * (HH))); P##13 = (f2key(ACC[13]) & ~0x7fu) | (unsigned)(127 - (57 + 4 * (HH))); P##14 = (f2key(ACC[14]) & ~0x7fu) | (unsigned)(127 - (58 + 4 * (HH))); P##15 = (f2key(ACC[15]) & ~0x7fu) | (unsigned)(127 - (59 + 4 * (HH))); } while (0)
#define FILL_G2(P, ACC, HH) do { P##0 = (f2key(ACC[0]) & ~0x7fu) | (unsigned)(127 - (64 + 4 * (HH))); P##1 = (f2key(ACC[1]) & ~0x7fu) | (unsigned)(127 - (65 + 4 * (HH))); P##2 = (f2key(ACC[2]) & ~0x7fu) | (unsigned)(127 - (66 + 4 * (HH))); P##3 = (f2key(ACC[3]) & ~0x7fu) | (unsigned)(127 - (67 + 4 * (HH))); P##4 = (f2key(ACC[4]) & ~0x7fu) | (unsigned)(127 - (72 + 4 * (HH))); P##5 = (f2key(ACC[5]) & ~0x7fu) | (unsigned)(127 - (73 + 4 * (HH))); P##6 = (f2key(ACC[6]) & ~0x7fu) | (unsigned)(127 - (74 + 4 * (HH))); P##7 = (f2key(ACC[7]) & ~0x7fu) | (unsigned)(127 - (75 + 4 * (HH))); P##8 = (f2key(ACC[8]) & ~0x7fu) | (unsigned)(127 - (80 + 4 * (HH))); P##9 = (f2key(ACC[9]) & ~0x7fu) | (unsigned)(127 - (81 + 4 * (HH))); P##10 = (f2key(ACC[10]) & ~0x7fu) | (unsigned)(127 - (82 + 4 * (HH))); P##11 = (f2key(ACC[11]) & ~0x7fu) | (unsigned)(127 - (83 + 4 * (HH))); P##12 = (f2key(ACC[12]) & ~0x7fu) | (unsigned)(127 - (88 + 4 * (HH))); P##13 = (f2key(ACC[13]) & ~0x7fu) | (unsigned)(127 - (89 + 4 * (HH))); P##14 = (f2key(ACC[14]) & ~0x7fu) | (unsigned)(127 - (90 + 4 * (HH))); P##15 = (f2key(ACC[15]) & ~0x7fu) | (unsigned)(127 - (91 + 4 * (HH))); } while (0)
#define FILL_G3(P, ACC, HH) do { P##0 = (f2key(ACC[0]) & ~0x7fu) | (unsigned)(127 - (96 + 4 * (HH))); P##1 = (f2key(ACC[1]) & ~0x7fu) | (unsigned)(127 - (97 + 4 * (HH))); P##2 = (f2key(ACC[2]) & ~0x7fu) | (unsigned)(127 - (98 + 4 * (HH))); P##3 = (f2key(ACC[3]) & ~0x7fu) | (unsigned)(127 - (99 + 4 * (HH))); P##4 = (f2key(ACC[4]) & ~0x7fu) | (unsigned)(127 - (104 + 4 * (HH))); P##5 = (f2key(ACC[5]) & ~0x7fu) | (unsigned)(127 - (105 + 4 * (HH))); P##6 = (f2key(ACC[6]) & ~0x7fu) | (unsigned)(127 - (106 + 4 * (HH))); P##7 = (f2key(ACC[7]) & ~0x7fu) | (unsigned)(127 - (107 + 4 * (HH))); P##8 = (f2key(ACC[8]) & ~0x7fu) | (unsigned)(127 - (112 + 4 * (HH))); P##9 = (f2key(ACC[9]) & ~0x7fu) | (unsigned)(127 - (113 + 4 * (HH))); P##10 = (f2key(ACC[10]) & ~0x7fu) | (unsigned)(127 - (114 + 4 * (HH))); P##11 = (f2key(ACC[11]) & ~0x7fu) | (unsigned)(127 - (115 + 4 * (HH))); P##12 = (f2key(ACC[12]) & ~0x7fu) | (unsigned)(127 - (120 + 4 * (HH))); P##13 = (f2key(ACC[13]) & ~0x7fu) | (unsigned)(127 - (121 + 4 * (HH))); P##14 = (f2key(ACC[14]) & ~0x7fu) | (unsigned)(127 - (122 + 4 * (HH))); P##15 = (f2key(ACC[15]) & ~0x7fu) | (unsigned)(127 - (123 + 4 * (HH))); } while (0)
#define XCHG16(O, A) do { O##0 = (unsigned)__shfl_xor((int)A##0, 32); O##1 = (unsigned)__shfl_xor((int)A##1, 32); O##2 = (unsigned)__shfl_xor((int)A##2, 32); O##3 = (unsigned)__shfl_xor((int)A##3, 32); O##4 = (unsigned)__shfl_xor((int)A##4, 32); O##5 = (unsigned)__shfl_xor((int)A##5, 32); O##6 = (unsigned)__shfl_xor((int)A##6, 32); O##7 = (unsigned)__shfl_xor((int)A##7, 32); O##8 = (unsigned)__shfl_xor((int)A##8, 32); O##9 = (unsigned)__shfl_xor((int)A##9, 32); O##10 = (unsigned)__shfl_xor((int)A##10, 32); O##11 = (unsigned)__shfl_xor((int)A##11, 32); O##12 = (unsigned)__shfl_xor((int)A##12, 32); O##13 = (unsigned)__shfl_xor((int)A##13, 32); O##14 = (unsigned)__shfl_xor((int)A##14, 32); O##15 = (unsigned)__shfl_xor((int)A##15, 32); } while (0)
#define COPY16(D, S) do { D##0 = S##0; D##1 = S##1; D##2 = S##2; D##3 = S##3; D##4 = S##4; D##5 = S##5; D##6 = S##6; D##7 = S##7; D##8 = S##8; D##9 = S##9; D##10 = S##10; D##11 = S##11; D##12 = S##12; D##13 = S##13; D##14 = S##14; D##15 = S##15; } while (0)
#define FILL_CANDS() do { ck0_0 = (f2key(key2f(ta0 & ~0x7fu) + key2f(tb0 & ~0x7fu)) & ~0xffu) | 255u; ck0_1 = (f2key(key2f(ta0 & ~0x7fu) + key2f(tb1 & ~0x7fu)) & ~0xffu) | 254u; ck0_2 = (f2key(key2f(ta0 & ~0x7fu) + key2f(tb2 & ~0x7fu)) & ~0xffu) | 253u; ck0_3 = (f2key(key2f(ta0 & ~0x7fu) + key2f(tb3 & ~0x7fu)) & ~0xffu) | 252u; ck0_4 = (f2key(key2f(ta0 & ~0x7fu) + key2f(tb4 & ~0x7fu)) & ~0xffu) | 251u; ck0_5 = (f2key(key2f(ta0 & ~0x7fu) + key2f(tb5 & ~0x7fu)) & ~0xffu) | 250u; ck0_6 = (f2key(key2f(ta0 & ~0x7fu) + key2f(tb6 & ~0x7fu)) & ~0xffu) | 249u; ck0_7 = (f2key(key2f(ta0 & ~0x7fu) + key2f(tb7 & ~0x7fu)) & ~0xffu) | 248u; ck0_8 = (f2key(key2f(ta0 & ~0x7fu) + key2f(tb8 & ~0x7fu)) & ~0xffu) | 247u; ck0_9 = (f2key(key2f(ta0 & ~0x7fu) + key2f(tb9 & ~0x7fu)) & ~0xffu) | 246u; ck0_10 = (f2key(key2f(ta0 & ~0x7fu) + key2f(tb10 & ~0x7fu)) & ~0xffu) | 245u; ck0_11 = (f2key(key2f(ta0 & ~0x7fu) + key2f(tb11 & ~0x7fu)) & ~0xffu) | 244u; ck0_12 = (f2key(key2f(ta0 & ~0x7fu) + key2f(tb12 & ~0x7fu)) & ~0xffu) | 243u; ck0_13 = (f2key(key2f(ta0 & ~0x7fu) + key2f(tb13 & ~0x7fu)) & ~0xffu) | 242u; ck0_14 = (f2key(key2f(ta0 & ~0x7fu) + key2f(tb14 & ~0x7fu)) & ~0xffu) | 241u; ck0_15 = (f2key(key2f(ta0 & ~0x7fu) + key2f(tb15 & ~0x7fu)) & ~0xffu) | 240u; ck1_0 = (f2key(key2f(ta1 & ~0x7fu) + key2f(tb0 & ~0x7fu)) & ~0xffu) | 239u; ck1_1 = (f2key(key2f(ta1 & ~0x7fu) + key2f(tb1 & ~0x7fu)) & ~0xffu) | 238u; ck1_2 = (f2key(key2f(ta1 & ~0x7fu) + key2f(tb2 & ~0x7fu)) & ~0xffu) | 237u; ck1_3 = (f2key(key2f(ta1 & ~0x7fu) + key2f(tb3 & ~0x7fu)) & ~0xffu) | 236u; ck1_4 = (f2key(key2f(ta1 & ~0x7fu) + key2f(tb4 & ~0x7fu)) & ~0xffu) | 235u; ck1_5 = (f2key(key2f(ta1 & ~0x7fu) + key2f(tb5 & ~0x7fu)) & ~0xffu) | 234u; ck1_6 = (f2key(key2f(ta1 & ~0x7fu) + key2f(tb6 & ~0x7fu)) & ~0xffu) | 233u; ck1_7 = (f2key(key2f(ta1 & ~0x7fu) + key2f(tb7 & ~0x7fu)) & ~0xffu) | 232u; ck1_8 = (f2key(key2f(ta2 & ~0x7fu) + key2f(tb0 & ~0x7fu)) & ~0xffu) | 223u; ck1_9 = (f2key(key2f(ta2 & ~0x7fu) + key2f(tb1 & ~0x7fu)) & ~0xffu) | 222u; ck1_10 = (f2key(key2f(ta2 & ~0x7fu) + key2f(tb2 & ~0x7fu)) & ~0xffu) | 221u; ck1_11 = (f2key(key2f(ta2 & ~0x7fu) + key2f(tb3 & ~0x7fu)) & ~0xffu) | 220u; ck1_12 = (f2key(key2f(ta2 & ~0x7fu) + key2f(tb4 & ~0x7fu)) & ~0xffu) | 219u; ck1_13 = (f2key(key2f(ta3 & ~0x7fu) + key2f(tb0 & ~0x7fu)) & ~0xffu) | 207u; ck1_14 = (f2key(key2f(ta3 & ~0x7fu) + key2f(tb1 & ~0x7fu)) & ~0xffu) | 206u; ck1_15 = (f2key(key2f(ta3 & ~0x7fu) + key2f(tb2 & ~0x7fu)) & ~0xffu) | 205u; ck2_0 = (f2key(key2f(ta3 & ~0x7fu) + key2f(tb3 & ~0x7fu)) & ~0xffu) | 204u; ck2_1 = (f2key(key2f(ta4 & ~0x7fu) + key2f(tb0 & ~0x7fu)) & ~0xffu) | 191u; ck2_2 = (f2key(key2f(ta4 & ~0x7fu) + key2f(tb1 & ~0x7fu)) & ~0xffu) | 190u; ck2_3 = (f2key(key2f(ta4 & ~0x7fu) + key2f(tb2 & ~0x7fu)) & ~0xffu) | 189u; ck2_4 = (f2key(key2f(ta5 & ~0x7fu) + key2f(tb0 & ~0x7fu)) & ~0xffu) | 175u; ck2_5 = (f2key(key2f(ta5 & ~0x7fu) + key2f(tb1 & ~0x7fu)) & ~0xffu) | 174u; ck2_6 = (f2key(key2f(ta6 & ~0x7fu) + key2f(tb0 & ~0x7fu)) & ~0xffu) | 159u; ck2_7 = (f2key(key2f(ta6 & ~0x7fu) + key2f(tb1 & ~0x7fu)) & ~0xffu) | 158u; ck2_8 = (f2key(key2f(ta7 & ~0x7fu) + key2f(tb0 & ~0x7fu)) & ~0xffu) | 143u; ck2_9 = (f2key(key2f(ta7 & ~0x7fu) + key2f(tb1 & ~0x7fu)) & ~0xffu) | 142u; ck2_10 = (f2key(key2f(ta8 & ~0x7fu) + key2f(tb0 & ~0x7fu)) & ~0xffu) | 127u; ck2_11 = (f2key(key2f(ta9 & ~0x7fu) + key2f(tb0 & ~0x7fu)) & ~0xffu) | 111u; ck2_12 = (f2key(key2f(ta10 & ~0x7fu) + key2f(tb0 & ~0x7fu)) & ~0xffu) | 95u; ck2_13 = (f2key(key2f(ta11 & ~0x7fu) + key2f(tb0 & ~0x7fu)) & ~0xffu) | 79u; ck2_14 = (f2key(key2f(ta12 & ~0x7fu) + key2f(tb0 & ~0x7fu)) & ~0xffu) | 63u; ck2_15 = (f2key(key2f(ta13 & ~0x7fu) + key2f(tb0 & ~0x7fu)) & ~0xffu) | 47u; ck3_0 = (f2key(key2f(ta14 & ~0x7fu) + key2f(tb0 & ~0x7fu)) & ~0xffu) | 31u; ck3_1 = (f2key(key2f(ta15 & ~0x7fu) + key2f(tb0 & ~0x7fu)) & ~0xffu) | 15u; ck3_2 = 0u; ck3_3 = 0u; ck3_4 = 0u; ck3_5 = 0u; ck3_6 = 0u; ck3_7 = 0u; ck3_8 = 0u; ck3_9 = 0u; ck3_10 = 0u; ck3_11 = 0u; ck3_12 = 0u; ck3_13 = 0u; ck3_14 = 0u; ck3_15 = 0u; } while (0)
#define WRITE_LUT(LP) do { *(LAS u32x4*)(LP) = (u32x4){((127u - (ta0 & 127u)) << 0) | ((127u - (ta1 & 127u)) << 8) | ((127u - (ta2 & 127u)) << 16) | ((127u - (ta3 & 127u)) << 24), ((127u - (ta4 & 127u)) << 0) | ((127u - (ta5 & 127u)) << 8) | ((127u - (ta6 & 127u)) << 16) | ((127u - (ta7 & 127u)) << 24), ((127u - (ta8 & 127u)) << 0) | ((127u - (ta9 & 127u)) << 8) | ((127u - (ta10 & 127u)) << 16) | ((127u - (ta11 & 127u)) << 24), ((127u - (ta12 & 127u)) << 0) | ((127u - (ta13 & 127u)) << 8) | ((127u - (ta14 & 127u)) << 16) | ((127u - (ta15 & 127u)) << 24)}; *(LAS u32x4*)((LP) + 16) = (u32x4){((127u - (tb0 & 127u)) << 0) | ((127u - (tb1 & 127u)) << 8) | ((127u - (tb2 & 127u)) << 16) | ((127u - (tb3 & 127u)) << 24), ((127u - (tb4 & 127u)) << 0) | ((127u - (tb5 & 127u)) << 8) | ((127u - (tb6 & 127u)) << 16) | ((127u - (tb7 & 127u)) << 24), ((127u - (tb8 & 127u)) << 0) | ((127u - (tb9 & 127u)) << 8) | ((127u - (tb10 & 127u)) << 16) | ((127u - (tb11 & 127u)) << 24), ((127u - (tb12 & 127u)) << 0) | ((127u - (tb13 & 127u)) << 8) | ((127u - (tb14 & 127u)) << 16) | ((127u - (tb15 & 127u)) << 24)}; } while (0)
#define LOOKUP16(PQ, K, LP) do { { const unsigned _f = 255u - (K##0 & 255u); PQ##0 = (unsigned)(LP)[_f >> 4] * 128u + (unsigned)(LP)[16u + (_f & 15u)]; } { const unsigned _f = 255u - (K##1 & 255u); PQ##1 = (unsigned)(LP)[_f >> 4] * 128u + (unsigned)(LP)[16u + (_f & 15u)]; } { const unsigned _f = 255u - (K##2 & 255u); PQ##2 = (unsigned)(LP)[_f >> 4] * 128u + (unsigned)(LP)[16u + (_f & 15u)]; } { const unsigned _f = 255u - (K##3 & 255u); PQ##3 = (unsigned)(LP)[_f >> 4] * 128u + (unsigned)(LP)[16u + (_f & 15u)]; } { const unsigned _f = 255u - (K##4 & 255u); PQ##4 = (unsigned)(LP)[_f >> 4] * 128u + (unsigned)(LP)[16u + (_f & 15u)]; } { const unsigned _f = 255u - (K##5 & 255u); PQ##5 = (unsigned)(LP)[_f >> 4] * 128u + (unsigned)(LP)[16u + (_f & 15u)]; } { const unsigned _f = 255u - (K##6 & 255u); PQ##6 = (unsigned)(LP)[_f >> 4] * 128u + (unsigned)(LP)[16u + (_f & 15u)]; } { const unsigned _f = 255u - (K##7 & 255u); PQ##7 = (unsigned)(LP)[_f >> 4] * 128u + (unsigned)(LP)[16u + (_f & 15u)]; } { const unsigned _f = 255u - (K##8 & 255u); PQ##8 = (unsigned)(LP)[_f >> 4] * 128u + (unsigned)(LP)[16u + (_f & 15u)]; } { const unsigned _f = 255u - (K##9 & 255u); PQ##9 = (unsigned)(LP)[_f >> 4] * 128u + (unsigned)(LP)[16u + (_f & 15u)]; } { const unsigned _f = 255u - (K##10 & 255u); PQ##10 = (unsigned)(LP)[_f >> 4] * 128u + (unsigned)(LP)[16u + (_f & 15u)]; } { const unsigned _f = 255u - (K##11 & 255u); PQ##11 = (unsigned)(LP)[_f >> 4] * 128u + (unsigned)(LP)[16u + (_f & 15u)]; } { const unsigned _f = 255u - (K##12 & 255u); PQ##12 = (unsigned)(LP)[_f >> 4] * 128u + (unsigned)(LP)[16u + (_f & 15u)]; } { const unsigned _f = 255u - (K##13 & 255u); PQ##13 = (unsigned)(LP)[_f >> 4] * 128u + (unsigned)(LP)[16u + (_f & 15u)]; } { const unsigned _f = 255u - (K##14 & 255u); PQ##14 = (unsigned)(LP)[_f >> 4] * 128u + (unsigned)(LP)[16u + (_f & 15u)]; } { const unsigned _f = 255u - (K##15 & 255u); PQ##15 = (unsigned)(LP)[_f >> 4] * 128u + (unsigned)(LP)[16u + (_f & 15u)]; } } while (0)
#define GATES16(E, K, MX, SUM) do { E##0 = __expf(key2f(K##0 & ~0xffu) - (MX)); SUM += E##0; E##1 = __expf(key2f(K##1 & ~0xffu) - (MX)); SUM += E##1; E##2 = __expf(key2f(K##2 & ~0xffu) - (MX)); SUM += E##2; E##3 = __expf(key2f(K##3 & ~0xffu) - (MX)); SUM += E##3; E##4 = __expf(key2f(K##4 & ~0xffu) - (MX)); SUM += E##4; E##5 = __expf(key2f(K##5 & ~0xffu) - (MX)); SUM += E##5; E##6 = __expf(key2f(K##6 & ~0xffu) - (MX)); SUM += E##6; E##7 = __expf(key2f(K##7 & ~0xffu) - (MX)); SUM += E##7; E##8 = __expf(key2f(K##8 & ~0xffu) - (MX)); SUM += E##8; E##9 = __expf(key2f(K##9 & ~0xffu) - (MX)); SUM += E##9; E##10 = __expf(key2f(K##10 & ~0xffu) - (MX)); SUM += E##10; E##11 = __expf(key2f(K##11 & ~0xffu) - (MX)); SUM += E##11; E##12 = __expf(key2f(K##12 & ~0xffu) - (MX)); SUM += E##12; E##13 = __expf(key2f(K##13 & ~0xffu) - (MX)); SUM += E##13; E##14 = __expf(key2f(K##14 & ~0xffu) - (MX)); SUM += E##14; E##15 = __expf(key2f(K##15 & ~0xffu) - (MX)); SUM += E##15; } while (0)
#define STORE_GATES(GP, EP, E, PQ, INV) do { *(f32x4*)((GP) + 0) = (f32x4){E##0 * (INV), E##1 * (INV), E##2 * (INV), E##3 * (INV)}; *(u32x4*)((EP) + 0) = (u32x4){PQ##0, PQ##1, PQ##2, PQ##3}; *(f32x4*)((GP) + 4) = (f32x4){E##4 * (INV), E##5 * (INV), E##6 * (INV), E##7 * (INV)}; *(u32x4*)((EP) + 4) = (u32x4){PQ##4, PQ##5, PQ##6, PQ##7}; *(f32x4*)((GP) + 8) = (f32x4){E##8 * (INV), E##9 * (INV), E##10 * (INV), E##11 * (INV)}; *(u32x4*)((EP) + 8) = (u32x4){PQ##8, PQ##9, PQ##10, PQ##11}; *(f32x4*)((GP) + 12) = (f32x4){E##12 * (INV), E##13 * (INV), E##14 * (INV), E##15 * (INV)}; *(u32x4*)((EP) + 12) = (u32x4){PQ##12, PQ##13, PQ##14, PQ##15}; } while (0)

__device__ __forceinline__ void d_route(const Params& P, LAS unsigned char* lds, int tid, int gw, int ngw) {
    const int lane = tid & 63, wave = __builtin_amdgcn_readfirstlane(tid >> 6);
    for (int idx = tid; idx < 2 * 128 * 128 / 2; idx += 512) { const int e = idx * 2, row = e >> 7, c = e & 127;
        const float a = P.in[I_SUBKEYS][e], b = P.in[I_SUBKEYS][e + 1];
        *(LAS unsigned*)(lds + row * RT_SKROW + c * 2) = pk2(a, b); }
    asm volatile("s_waitcnt lgkmcnt(0)" ::: "memory"); __syncthreads();
    const int hh = lane >> 5, l31 = lane & 31;
#define ROUTE_HALF(QROW, SKZ, T) do { \
        bf16x8v qf[8]; f32x16v acc[4]; \
        _Pragma("unroll") for (int ks = 0; ks < 8; ++ks) qf[ks] = *(const bf16x8v*)((QROW) + ks * 16 + 8 * hh); \
        _Pragma("unroll") for (int kb = 0; kb < 4; ++kb) { \
            _Pragma("unroll") for (int i = 0; i < 16; ++i) acc[kb][i] = 0.f; \
            _Pragma("unroll") for (int ks = 0; ks < 8; ++ks) { const bf16x8v af = *(const LAS bf16x8v*)((SKZ) + (kb * 32 + l31) * RT_SKROW + (ks * 16 + 8 * hh) * 2); \
                acc[kb] = __builtin_amdgcn_mfma_f32_32x32x16_bf16(af, qf[ks], acc[kb], 0, 0, 0); } } \
        DECL16(unsigned, ga); DECL16(unsigned, gb); DECL16(unsigned, gc); DECL16(unsigned, gd); DECL16(unsigned, ob); \
        __builtin_amdgcn_sched_barrier(0); FILL_G0(ga, acc[0], hh); SORT16_DESC(ga); __builtin_amdgcn_sched_barrier(0); FILL_G1(gb, acc[1], hh); SORT16_DESC(gb); __builtin_amdgcn_sched_barrier(0); MERGE16_DESC(ga, gb); __builtin_amdgcn_sched_barrier(0); \
        FILL_G2(gc, acc[2], hh); SORT16_DESC(gc); __builtin_amdgcn_sched_barrier(0); FILL_G3(gd, acc[3], hh); SORT16_DESC(gd); __builtin_amdgcn_sched_barrier(0); MERGE16_DESC(gc, gd); __builtin_amdgcn_sched_barrier(0); MERGE16_DESC(ga, gc); __builtin_amdgcn_sched_barrier(0); \
        XCHG16(ob, ga); MERGE16_DESC(ga, ob); COPY16(T, ga); __builtin_amdgcn_sched_barrier(0); } while (0)
#pragma unroll 1
    for (int task = gw; task < TOK * 8 / 32; task += ngw) {
        const long r0 = (long)task * 32; const bf16_t* qrow = P.QP + (size_t)(r0 + l31) * 256;
        DECL16(unsigned, ta); DECL16(unsigned, tb);
        ROUTE_HALF(qrow, lds, ta);
        ROUTE_HALF(qrow + 128, lds + 128 * RT_SKROW, tb);
        DECL16(unsigned, ck0_); DECL16(unsigned, ck1_); DECL16(unsigned, ck2_); DECL16(unsigned, ck3_);
        LAS unsigned char* lut = lds + 2 * 128 * RT_SKROW + wave * 1024 + l31 * 32;
        WRITE_LUT(lut);
        FILL_CANDS(); __builtin_amdgcn_sched_barrier(0);
        SORT16_DESC(ck0_); __builtin_amdgcn_sched_barrier(0); SORT16_DESC(ck1_); __builtin_amdgcn_sched_barrier(0); MERGE16_DESC(ck0_, ck1_); __builtin_amdgcn_sched_barrier(0);
        SORT16_DESC(ck2_); __builtin_amdgcn_sched_barrier(0); SORT16_DESC(ck3_); __builtin_amdgcn_sched_barrier(0); MERGE16_DESC(ck2_, ck3_); __builtin_amdgcn_sched_barrier(0); MERGE16_DESC(ck0_, ck2_); __builtin_amdgcn_sched_barrier(0);
        DECL16(unsigned, cp0_);
        LOOKUP16(cp0_, ck0_, lut);
        DECL16(float, ee); const float mx = key2f(ck0_0 & ~0xffu); float sum = 0.f;
        GATES16(ee, ck0_, mx, sum);
        const float inv = 1.0f / sum;
        if (lane < 32) { float* gp = P.GATE + (size_t)(r0 + lane) * 16; int* ep = P.EXPERT + (size_t)(r0 + lane) * 16; STORE_GATES(gp, ep, ee, cp0_, inv); }
    }
#undef ROUTE_HALF
}
constexpr int RING_BYTES = 131072, LDSCTL_OFF = RING_BYTES, MISC_OFF = LDSCTL_OFF + 320, LDS_BYTES = 147456;
constexpr int CW_BAR = 4096;
#ifndef MK_PER_PHASE
#define MK_PER_PHASE 0
#endif
struct KArgs { Params P; int ph_lo, ph_hi; };
template <class DE, bool ALIGN = true> __device__ __forceinline__ void run_gemm(LAS unsigned char* lds, const bf16_t* A, const bf16_t* Bt, int M, int N, int K, const DE& E,
                                                                     int bgrp = 1 << 30, size_t bgstride = 0) {
    pg8::Gemm g{A, Bt, M, N, K, K, K, bgrp, bgstride}; pg8::StaticOrder S; S.init(M, N, (int)gridDim.x, (int)blockIdx.x);
    pg8::gemm_phase<DE, pg8::StaticOrder, ALIGN, true>(lds, g, S, E);
}
__global__ void __launch_bounds__(512, 2) mega_fwd(KArgs a) {
    extern __shared__ __attribute__((aligned(16))) unsigned char lds_raw[];
    LAS unsigned char* lds = (LAS unsigned char*)lds_raw;
    volatile LAS unsigned* MISC = (volatile LAS unsigned*)(lds + MISC_OFF);
    const Params& P = a.P;
    const int tid = threadIdx.x;
    for (int u = tid; u < (LDS_BYTES - LDSCTL_OFF) / 4; u += 512) ((LAS unsigned*)(lds + LDSCTL_OFF))[u] = 0u;
    __syncthreads();
    XcdBarrier bar; bar.bar = P.ctl + CW_BAR; bar.x = 0; bar.st = nullptr;
    if (!MK_PER_PHASE) bar = xcd_barrier_post(P.ctl + CW_BAR, MISC + 8);
    const long gtid = (long)blockIdx.x * 512 + tid, nthr = (long)gridDim.x * 512;
    const int lane = tid & 63, wave = __builtin_amdgcn_readfirstlane(tid >> 6), gw = (int)blockIdx.x * 8 + wave, ngw = (int)gridDim.x * 8;
    const int lo = a.ph_lo, hi = a.ph_hi;
#define IN(k) (lo <= (k) && (k) < hi)
#define SEAM(k) do { if ((k) + 1 < hi) xcd_barrier(bar); } while (0)
#define SIMT(k, call) if (IN(k)) { call; SEAM(k); }
    SIMT(0, (d_weights(P, lds, gw, ngw, wave, lane), d_lora_weights(P, gtid, nthr), d_ln_rows(P.in[I_X], P.in[I_LN_EMB_G], P.in[I_LN_EMB_B], P.HB, TOK, gw, ngw, lane),
             d_ln_rows(P.in[I_MEM], P.in[I_MLN_G], P.in[I_MLN_B], P.MEMN, BATCH * MEM_LEN, gw, ngw, lane)))
    if (IN(1)) { { pg8::DEpiP1 E{{P.PA, P.PB}}; run_gemm(lds, P.HB, P.W_IN_T, TOK, 3072, 1024, E); }
#if ATT_OLD
                 { pg8::DEpiPlain E2{{P.KV, 2048, 0}}; run_gemm(lds, P.MEMN, P.W_KV_T, BATCH * MEM_LEN, 2048, 1024, E2); } SEAM(1); }
#else
                 { pg8::DEpiTile E2{P.KH, 4, 1, 1.0f}; run_gemm(lds, P.MEMN, P.W_KV_T, BATCH * MEM_LEN, 1024, 1024, E2); }
                 { pg8::DEpiTile E3{P.VT, 1, 4, 1.0f}; run_gemm(lds, P.W_KV_T + (size_t)1024 * 1024, P.MEMN, 1024, BATCH * MEM_LEN, 1024, E3); } SEAM(1); }
#endif
    SIMT(2, d_vn(P, gw, ngw, lane))
    SIMT(3, ph2b_gmlp(P, gtid, nthr))
    SIMT(4, d_prep_e1(P, gw, ngw, lane))
    if (IN(5)) { { pg8::DEpiLora<0> E{P.in[I_W0], P.OMW}; run_gemm(lds, P.LIN, P.W_LORA_T, TOK, 1024, 512, E); }
                 { pg8::DEpiLora<1> E{P.in[I_A0], P.AL}; run_gemm(lds, P.LIN, P.W_LORA_T + (size_t)1024 * 512, TOK, 1024, 512, E); }
                 { pg8::DEpiLora<2> E{nullptr, P.G}; run_gemm(lds, P.LIN, P.W_LORA_T + (size_t)2048 * 512, TOK, 512, 512, E); } SEAM(5); }
#if NEW_SCAN
    if (IN(6)) { d_scan(P, lds, tid); SEAM(6); }
#else
    if (IN(6)) { const int chain = (int)blockIdx.x + (int)gridDim.x * wave; if (chain < 2 * BATCH * 8) scan_item3(P, chain, lane); SEAM(6); }
#endif
    SIMT(7, d_rwkv_out(P, gw, ngw, lane))
    if (IN(8)) { { pg8::DEpiPlain E{{P.BR, 2048, 0}}; run_gemm(lds, P.YA, P.W_BR_T, TOK, 1024, 512, E); }
                 { pg8::DEpiPlain E2{{P.BR, 2048, 1024}}; run_gemm(lds, P.YB, P.W_BR_T + (size_t)1024 * 512, TOK, 1024, 512, E2); } SEAM(8); }
    if (IN(9)) { pg8::DEpiMerge E{{P.BR, P.MG}}; run_gemm(lds, P.HB, P.W_IN_T + (size_t)3072 * 1024, TOK, 2048, 1024, E); SEAM(9); }
    if (IN(10)) { pg8::DEpiResid E{{P.HB, P.Z}}; run_gemm(lds, P.MG, P.W_MIX_T, TOK, 1024, 1024, E); SEAM(10); }
    SIMT(11, d_ln_rows(P.Z, P.in[I_LN1_G], P.in[I_LN1_B], P.HB, TOK, gw, ngw, lane))
#if ATT_OLD
    if (IN(12)) { pg8::DEpiPlain E{{P.Q, 1024, 0}}; run_gemm(lds, P.HB, P.W_Q_T, TOK, 1024, 1024, E); SEAM(12); }
    SIMT(13, ph10a_scores(P, gtid, nthr))
    SIMT(14, d_softmax256(P, gw, ngw, lane))
    SIMT(15, ph10c_out(P, gtid, nthr))
#else
    if (IN(12)) { pg8::DEpiQ EQ{{P.QH, 1, 0, 0.0625f}}; run_gemm(lds, P.HB, P.W_Q_T, TOK, 1024, 1024, EQ); SEAM(12); }
    if (IN(13)) { pg8::DEpiSoftmax E{P.PP}; run_gemm<pg8::DEpiSoftmax, false>(lds, P.QH, P.KH, TOK * 4, 256, 256, E, 8, (size_t)256 * 256 * 2); SEAM(13); }
    if (IN(14)) { pg8::DEpiO E{P.O}; run_gemm(lds, P.PP, P.VT, TOK * 4, 256, 256, E, 8, (size_t)256 * 256 * 2); SEAM(14); }
#endif
    if (IN(15 + AX)) { pg8::DEpiResid E{{P.HB, P.Z}}; run_gemm(lds, P.O, P.W_O_T, TOK, 1024, 1024, E); SEAM(15 + AX); }
    SIMT(16 + AX, d_ln_rows(P.Z, P.in[I_LN2_G], P.in[I_LN2_B], P.HB, TOK, gw, ngw, lane))
    if (IN(17 + AX)) { pg8::DEpiPlain E{{P.QP, 2048, 0}}; run_gemm(lds, P.HB, P.W_QUERY_T, TOK, 2048, 1024, E); SEAM(17 + AX); }
#if NEW_ROUTE
    SIMT(18 + AX, (d_route(P, lds, tid, gw, ngw), d_tables(P, gtid, nthr)))
    SIMT(19 + AX, d_peer(P, gw, ngw, lane))
#else
    SIMT(18 + AX, ph13a_scores(P, gtid, nthr))
    SIMT(19 + AX, ph13b_topk(P, gtid, nthr))
    SIMT(20 + AX, ph13c_cand(P, gtid, nthr))
    SIMT(21 + AX, d_tables(P, gtid, nthr))
    SIMT(22 + AX, d_peer(P, gw, ngw, lane))
#endif
#undef IN
#undef SEAM
#undef SIMT
}
extern "C" void kernel_launch(void* const* d_in, const int* in_sizes, int n_in, void* d_out, int out_size, void* d_ws, size_t ws_size, hipStream_t stream) {
    static int grid = 0;
    if (grid == 0) {
        int dev = 0, cus = 0;
        if (n_in != 37 || ws_size < WS_NEED || hipGetDevice(&dev) != hipSuccess || hipDeviceGetAttribute(&cus, hipDeviceAttributeMultiprocessorCount, dev) != hipSuccess) {
            fprintf(stderr, "kernel_launch: bad arguments (n_in %d, ws %zu < %zu)\n", n_in, ws_size, (size_t)WS_NEED); grid = -1; return; }
        if (hipFuncSetAttribute((const void*)mega_fwd, hipFuncAttributeMaxDynamicSharedMemorySize, LDS_BYTES) != hipSuccess) { fprintf(stderr, "kernel_launch: hipFuncSetAttribute failed\n"); grid = -1; return; }
        grid = cus;
    }
    if (grid < 0) return;
    (void)hipMemsetAsync((char*)d_ws + WS_CTL, 0, 1 * MiB, stream);
    KArgs a; memset(&a, 0, sizeof(a)); make_params(a.P, d_in, d_out, d_ws);
#if MK_PER_PHASE
    for (int ph = 0; ph < N_PHASES; ++ph) { a.ph_lo = ph; a.ph_hi = ph + 1; hipLaunchKernelGGL(mega_fwd, dim3(grid), dim3(512), LDS_BYTES, stream, a); }
#else
    a.ph_lo = 0; a.ph_hi = N_PHASES; hipLaunchKernelGGL(mega_fwd, dim3(grid), dim3(512), LDS_BYTES, stream, a);
#endif
}
#endif
```

```cpp
#ifdef HOST_EMU
#include "emu.h"
#else
#include <hip/hip_runtime.h>
#include <cstdio>
#include <cstdint>
#include <cstring>
#endif

#ifndef BATCH
#define BATCH 8
#endif
#ifndef SEQ
#define SEQ 2048
#endif
#define DM 1024
#define TOK (BATCH * SEQ)
#define IN_COLS 4992
#define MEM_LEN 256
#define ALPHA_F 1.189207115002721f
typedef unsigned short bf16_t;

#ifdef HOST_EMU
static inline float bf2f(bf16_t v) { unsigned u = (unsigned)v << 16; float f; memcpy(&f, &u, 4); return f; }
static inline bf16_t f2bf(float f) { unsigned u; memcpy(&u, &f, 4); return (bf16_t)((u + 0x7fffu + ((u >> 16) & 1u)) >> 16); }
#else
__device__ __forceinline__ float bf2f(bf16_t v) { return __uint_as_float((unsigned)v << 16); }
__device__ __forceinline__ bf16_t f2bf(float f) { unsigned u = __float_as_uint(f); return (bf16_t)((u + 0x7fffu + ((u >> 16) & 1u)) >> 16); }
#endif
__device__ __forceinline__ float sigmoidf_(float x) { return 1.0f / (1.0f + expf(-x)); }
__device__ __forceinline__ float geluf_(float x) { return 0.5f * x * (1.0f + erff(x * 0.7071067811865476f)); }

struct Params {
    const float* in[37];
    float* out;
    unsigned* ctl;
    bf16_t *W_IN_T, *W_BR_T, *W_MIX_T, *W_Q_T, *W_KV_T, *W_O_T, *W_QUERY_T;
    bf16_t *KV, *MEMN, *HB;
    bf16_t *PA, *PB, *VN, *YB;
    bf16_t *WDS, *ADS, *SG;
    bf16_t *R, *V, *KK, *OMW, *KDIR, *BVEC;
    float *Y01;
    bf16_t *YA, *BR, *MG;
    float* Z;
    bf16_t *Q, *O;
    float* SCA;
    bf16_t* QP;
    float* SC; float* TOPS; int* TOPI; float* GATE; int* EXPERT; float* COEF; float* Y;
    bf16_t *UB, *VB;
    bf16_t *W_LORA_T;
    bf16_t *WSB;
    bf16_t *LIN, *K, *AL, *G;
    bf16_t *KH, *VT, *QH, *PP;
};
enum { I_X = 0, I_MEM, I_LN_EMB_G, I_LN_EMB_B, I_W_IN, I_MU, I_W0, I_W2, I_A0, I_A2, I_G2, I_K_K, I_K_A, I_R_K, I_GN_G, I_GN_B,
       I_GLN_G, I_GLN_B, I_W_S, I_B_S, I_W_BRANCH, I_W_MIX, I_LN1_G, I_LN1_B, I_MLN_G, I_MLN_B, I_W_Q, I_W_KV, I_W_O, I_LN2_G, I_LN2_B,
       I_W_QUERY, I_SUBKEYS, I_PEER_U, I_PEER_V, I_LN3_G, I_LN3_B };

constexpr size_t MiB = 1u << 20;
constexpr size_t TU = (size_t)TOK * 1024;
constexpr size_t WS_CTL = 0;
constexpr size_t WS_W = 1 * MiB;
constexpr size_t OFF_W_IN = 0, OFF_W_BR = OFF_W_IN + (size_t)5120 * 1024 * 2, OFF_W_MIX = OFF_W_BR + (size_t)2048 * 512 * 2,
                 OFF_W_Q = OFF_W_MIX + (size_t)1024 * 1024 * 2, OFF_W_KV = OFF_W_Q + (size_t)1024 * 1024 * 2,
                 OFF_W_O = OFF_W_KV + (size_t)2048 * 1024 * 2, OFF_W_QUERY = OFF_W_O + (size_t)1024 * 1024 * 2,
                 OFF_W_END = OFF_W_QUERY + (size_t)2048 * 1024 * 2;
static_assert(OFF_W_END <= 27 * MiB, "weights region");
constexpr size_t OFF_W_LORA = OFF_W_END, OFF_W_END2 = OFF_W_LORA + (size_t)2560 * 512 * 2;
constexpr size_t OFF_WSB = OFF_W_END2;
static_assert(OFF_WSB + 8 * 128 * 128 * 2 <= 29 * MiB, "weights region 2");
constexpr size_t WS_KV = 30 * MiB;
constexpr size_t WS_MEMN = 38 * MiB;
constexpr size_t WS_ACT = 42 * MiB;
constexpr size_t A_HB = WS_ACT;
constexpr size_t A_R1 = A_HB + 2 * TU;
constexpr size_t A_R2 = A_R1 + 4 * TU;
constexpr size_t WS_NEED = A_R2 + 7 * TU;
#ifndef HOST_EMU
static_assert(WS_NEED <= 256 * MiB, "workspace map exceeds 256 MiB");
#endif

struct EpiP1 { bf16_t* PA; bf16_t* PB; };
struct EpiPlain { bf16_t* O; int ldc; int col_off; };
struct EpiMerge { const bf16_t* BR; bf16_t* MG; };
struct EpiResid { const bf16_t* H; float* Z; };

#ifndef HOST_EMU
namespace pg8 {
#define PG8_LAS __attribute__((address_space(3)))
typedef unsigned short bf16_t;
typedef short bf16x8 __attribute__((ext_vector_type(8)));
typedef float f32x4 __attribute__((ext_vector_type(4)));
typedef unsigned u32x4 __attribute__((ext_vector_type(4)));
constexpr int BM = 256, BK = 64, HALF = 128, HTB = HALF * BK * 2  , STAGE_BYTES = 8 * HTB, NXCD = 8, WGM = 8;

__host__ __device__ __forceinline__ int lds_byte(int r, int c) { const int st = (r >> 4) * 2 + (c >> 5), rr = r & 15, cc = c & 31, ob = rr * 64 + cc * 2; return st * 1024 + (ob ^ (((ob >> 9) & 1) << 5)); }
__host__ __device__ __forceinline__ void stage_rc(int b, int& R, int& C) { const int st = b / 1024, sb = b % 1024, swz = sb ^ (((sb >> 9) & 1) << 5); R = (st >> 1) * 16 + swz / 64; C = (st & 1) * 32 + (swz % 64) / 2; }
__host__ __device__ __forceinline__ int perm32(int rho) { const int n = rho >> 4, i = rho & 15; return 8 * (i >> 2) + 4 * n + (i & 3); }

struct Unit { int pm, pn; };
struct Gemm { const bf16_t* A; const bf16_t* Bt; int M, N, K; int lda, ldb; int bgrp; size_t bgstride; };

struct StaticOrder {
    int nM, nN, nwg, G, c;
    __host__ __device__ void init(int M, int N, int G_, int c_) { nM = M / BM; nN = N / BM; nwg = nM * nN; G = G_; c = c_; }
    __host__ __device__ bool next(int i, Unit& u) const {
        const long L = (long)i * G + c; if (L >= nwg) return false;
        int wgid = (int)L; { const int q = nwg / NXCD, r = nwg % NXCD, xcd = wgid % NXCD, off = wgid / NXCD; wgid = (xcd < r ? xcd * (q + 1) : r * (q + 1) + (xcd - r) * q) + off; }
        const int nig = WGM * nN, gid = wgid / nig, fm = gid * WGM, gsz = (nM - fm) < WGM ? (nM - fm) : WGM;
        u.pm = fm + ((wgid % nig) % gsz); u.pn = (wgid % nig) / gsz; return true;
    }
    __device__ __forceinline__ void a_ready(const Unit&) const {}
    __device__ __forceinline__ void done(const Unit&) const {}
};

typedef float f32x2c __attribute__((ext_vector_type(2))); typedef __bf16 bf16x2c __attribute__((ext_vector_type(2)));
__device__ __forceinline__ unsigned cvt_pk_bf16(float lo, float hi) { const f32x2c v = {lo, hi}; const bf16x2c b = __builtin_convertvector(v, bf16x2c); return __builtin_bit_cast(unsigned, b); }
typedef float f32x2 __attribute__((ext_vector_type(2)));
__device__ __forceinline__ f32x2 gelu_pk(f32x2 v) {
    const f32x2 av = __builtin_elementwise_abs(v), d = av * 0.2316418882f + 1.0f;
    f32x2 t; t.x = __builtin_amdgcn_rcpf(d.x); t.y = __builtin_amdgcn_rcpf(d.y);
    f32x2 q = t * 0.5307027145f + (-0.7265760135f); q = q * t + 0.7107068705f; q = q * t + (-0.142248368f); q = q * t + 0.127414796f; q = q * t;
    const f32x2 s = (v * v) * (-0.72134752044f);
    f32x2 e; e.x = __builtin_amdgcn_exp2f(s.x); e.y = __builtin_amdgcn_exp2f(s.y);
    const f32x2 m = v * (q * e), r = v - m;
    f32x2 o; o.x = v.x < 0.f ? m.x : r.x; o.y = v.y < 0.f ? m.y : r.y; return o;
}


template <class Epi, class Sched, bool ALIGN_EPI = false, bool SP2 = false>
__device__ __forceinline__ void gemm_phase(PG8_LAS unsigned char* lds, const Gemm g, const Sched& S, const Epi& E) {
    int tid_ = threadIdx.x; asm volatile("" : "+v"(tid_));
    const int tid = tid_, wid = __builtin_amdgcn_readfirstlane(tid >> 6), lane = tid & 63, wr = wid >> 2, wc = wid & 3, fr = lane & 15, fq = lane >> 4;
    const int K = g.K, nt = K / BK;
    unsigned voffA[2], voffB[2];
#pragma unroll
    for (int i = 0; i < 2; ++i) { int R, C; stage_rc(tid * 16 + i * 8192, R, C); const int Rb = Epi::PERM ? ((R & ~31) + perm32(R & 31)) : R;
        voffA[i] = (unsigned)(R * g.lda + C) * 2u; voffB[i] = (unsigned)(Rb * g.ldb + C) * 2u; }
    const size_t kstep = (size_t)(BK * 2);
    const size_t hstepA = (size_t)HALF * g.lda * 2, hstepB = (size_t)HALF * g.ldb * 2;
    const size_t tstepA = 2 * hstepA, tstepB = 2 * hstepB;
    const unsigned ldsw = (unsigned)wid * 1024u;
    const int aoff = lds_byte(wr * 64 + fr, fq * 8), boff = lds_byte(wc * 32 + fr, fq * 8);
#define PG8_SA(b, h) (((b) * 2 + (h)) * HTB)
#define PG8_SB(b, h) ((4 + (b) * 2 + (h)) * HTB)
#define PG8_STAGE(bufoff, gbase, voff) do { _Pragma("unroll") for (int _i = 0; _i < 2; ++_i) \
        __builtin_amdgcn_global_load_lds((const unsigned*)((const char*)(gbase) + (voff)[_i]), (PG8_LAS unsigned*)(lds + (bufoff) + ldsw + _i * 8192), 16, 0, 0); } while (0)
#define PG8_LDA(dst, b, h) do { _Pragma("unroll") for (int m = 0; m < 4; ++m) _Pragma("unroll") for (int k = 0; k < 2; ++k) dst[m][k] = *(const PG8_LAS bf16x8*)(lds + PG8_SA(b, h) + aoff + m * 2048 + k * 1024); } while (0)
#define PG8_LDB(dst, b, h) do { _Pragma("unroll") for (int n = 0; n < 2; ++n) _Pragma("unroll") for (int k = 0; k < 2; ++k) dst[n][k] = *(const PG8_LAS bf16x8*)(lds + PG8_SB(b, h) + boff + n * 2048 + k * 1024); } while (0)
#define PG8_MMA(ai, bj, At, Bt) do { __builtin_amdgcn_s_setprio(1); _Pragma("unroll") for (int m = 0; m < 4; ++m) _Pragma("unroll") for (int n = 0; n < 2; ++n) _Pragma("unroll") for (int k = 0; k < 2; ++k) \
        acc[ai][bj][m][n] = __builtin_amdgcn_mfma_f32_16x16x32_bf16(Bt[n][k], At[m][k], acc[ai][bj][m][n], 0, 0, 0); __builtin_amdgcn_s_setprio(0); } while (0)
#define PG8_WAIT_V(n) asm volatile("s_waitcnt vmcnt(" #n ")" ::: "memory")
#define PG8_WAIT_L(n) asm volatile("s_waitcnt lgkmcnt(" #n ")" ::: "memory")
#define PG8_BAR __builtin_amdgcn_s_barrier()
#define PG8_SCHED __builtin_amdgcn_sched_barrier(0)
    Unit cur, nxt; int ui = 0;
    if (!S.next(0, cur)) return;
    f32x4 acc[2][2][4][2];
#pragma unroll
    for (int a = 0; a < 2; ++a)
#pragma unroll
        for (int b = 0; b < 2; ++b)
#pragma unroll
            for (int m = 0; m < 4; ++m)
#pragma unroll
                for (int n = 0; n < 2; ++n) acc[a][b][m][n] = (f32x4){0.f, 0.f, 0.f, 0.f};
    bf16x8 At[4][2], B0[2][2], B1[2][2];
    const char* cA = (const char*)g.A + (size_t)cur.pm * tstepA; const char* cB = (const char*)g.Bt + (size_t)cur.pn * tstepB + (size_t)(cur.pm / g.bgrp) * g.bgstride;
    S.a_ready(cur);
    if constexpr (SP2) {
        PG8_STAGE(PG8_SB(0, 0), cB, voffB); PG8_STAGE(PG8_SB(0, 1), cB + hstepB, voffB); PG8_STAGE(PG8_SA(0, 0), cA, voffA); PG8_STAGE(PG8_SA(0, 1), cA + hstepA, voffA);
        if (wr == 1) PG8_BAR;
        PG8_WAIT_V(2); PG8_BAR;
        PG8_STAGE(PG8_SB(1, 0), cB + kstep, voffB); PG8_STAGE(PG8_SA(1, 0), cA + kstep, voffA); PG8_STAGE(PG8_SB(1, 1), cB + hstepB + kstep, voffB);
        PG8_WAIT_V(6); PG8_BAR;
    } else {
        PG8_STAGE(PG8_SB(0, 0), cB, voffB); PG8_STAGE(PG8_SA(0, 0), cA, voffA); PG8_STAGE(PG8_SB(0, 1), cB + hstepB, voffB); PG8_STAGE(PG8_SA(0, 1), cA + hstepA, voffA);
        if (wr == 1) PG8_BAR;
        PG8_WAIT_V(4); PG8_BAR;
        PG8_STAGE(PG8_SB(1, 0), cB + kstep, voffB); PG8_STAGE(PG8_SA(1, 0), cA + kstep, voffA); PG8_STAGE(PG8_SB(1, 1), cB + hstepB + kstep, voffB);
        PG8_WAIT_V(6); PG8_BAR;
    }
    for (;;) {
        const bool has_next = S.next(ui + 1, nxt);
        const char* nA = has_next ? (const char*)g.A + (size_t)nxt.pm * tstepA : cA; const char* nB = has_next ? (const char*)g.Bt + (size_t)nxt.pn * tstepB + (size_t)(nxt.pm / g.bgrp) * g.bgstride : cB;
#pragma unroll 1
        for (int t = 0; t < nt; t += 2) {
            const bool last = (t == nt - 2);
            const char* a1 = cA + (size_t)(t + 1) * kstep;
            const char* a2 = last ? nA : cA + (size_t)(t + 2) * kstep; const char* b2 = last ? nB : cB + (size_t)(t + 2) * kstep;
            const char* a3 = a2 + kstep; const char* b3 = b2 + kstep;
            if (last && has_next) S.a_ready(nxt);
            if constexpr (SP2) {
            PG8_LDB(B0, 0, 0); PG8_LDB(B1, 0, 1); PG8_SCHED; PG8_LDA(At, 0, 0); PG8_STAGE(PG8_SA(1, 1), a1 + hstepA, voffA);
            PG8_WAIT_V(8); PG8_WAIT_L(0); PG8_BAR; PG8_MMA(0, 0, At, B0); PG8_MMA(0, 1, At, B1); PG8_BAR; PG8_SCHED;
            PG8_LDA(At, 0, 1); PG8_STAGE(PG8_SB(0, 0), b2, voffB); PG8_STAGE(PG8_SB(0, 1), b2 + hstepB, voffB); PG8_STAGE(PG8_SA(0, 0), a2, voffA);
            PG8_WAIT_V(8); PG8_WAIT_L(0); PG8_BAR; PG8_MMA(1, 0, At, B0); PG8_MMA(1, 1, At, B1); PG8_BAR; PG8_SCHED;
            PG8_LDB(B0, 1, 0); PG8_LDB(B1, 1, 1); PG8_SCHED; PG8_LDA(At, 1, 0); PG8_STAGE(PG8_SA(0, 1), a2 + hstepA, voffA);
            PG8_WAIT_V(8); PG8_WAIT_L(0); PG8_BAR; PG8_MMA(0, 0, At, B0); PG8_MMA(0, 1, At, B1); PG8_BAR; PG8_SCHED;
            PG8_LDA(At, 1, 1); PG8_STAGE(PG8_SB(1, 0), b3, voffB); PG8_STAGE(PG8_SB(1, 1), b3 + hstepB, voffB); PG8_STAGE(PG8_SA(1, 0), a3, voffA);
            PG8_WAIT_V(8); PG8_WAIT_L(0); PG8_BAR; PG8_MMA(1, 0, At, B0); PG8_MMA(1, 1, At, B1); PG8_BAR; PG8_SCHED;
            } else {
            PG8_LDB(B0, 0, 0); PG8_SCHED; PG8_LDA(At, 0, 0); PG8_STAGE(PG8_SA(1, 1), a1 + hstepA, voffA);
            PG8_WAIT_L(8); PG8_BAR; PG8_WAIT_L(0); PG8_MMA(0, 0, At, B0); PG8_BAR; PG8_SCHED;
            PG8_LDB(B1, 0, 1); PG8_STAGE(PG8_SB(0, 0), b2, voffB);
            PG8_BAR; PG8_WAIT_L(0); PG8_MMA(0, 1, At, B1); PG8_BAR;
            PG8_LDA(At, 0, 1); PG8_STAGE(PG8_SA(0, 0), a2, voffA);
            PG8_BAR; PG8_WAIT_L(0); PG8_MMA(1, 0, At, B0); PG8_BAR; PG8_SCHED;
            PG8_STAGE(PG8_SB(0, 1), b2 + hstepB, voffB);
            PG8_WAIT_V(6); PG8_BAR; PG8_MMA(1, 1, At, B1); PG8_BAR;
            PG8_LDB(B0, 1, 0); PG8_SCHED; PG8_LDA(At, 1, 0); PG8_STAGE(PG8_SA(0, 1), a2 + hstepA, voffA);
            PG8_WAIT_L(8); PG8_BAR; PG8_WAIT_L(0); PG8_MMA(0, 0, At, B0); PG8_BAR; PG8_SCHED;
            PG8_LDB(B1, 1, 1); PG8_STAGE(PG8_SB(1, 0), b3, voffB);
            PG8_BAR; PG8_WAIT_L(0); PG8_MMA(0, 1, At, B1); PG8_BAR;
            PG8_LDA(At, 1, 1); PG8_STAGE(PG8_SA(1, 0), a3, voffA);
            PG8_BAR; PG8_WAIT_L(0); PG8_MMA(1, 0, At, B0); PG8_BAR; PG8_SCHED;
            PG8_STAGE(PG8_SB(1, 1), b3 + hstepB, voffB);
            PG8_WAIT_V(6); PG8_BAR; PG8_MMA(1, 1, At, B1); PG8_BAR;
            }
        }
        if constexpr (ALIGN_EPI) { if (wr == 0) PG8_BAR; }
        if constexpr (!Epi::AFTER_DRAIN) { E(acc, cur, wr, wc, fr, fq); S.done(cur); }
        if (!has_next) break;
#pragma unroll
        for (int a = 0; a < 2; ++a)
#pragma unroll
            for (int b = 0; b < 2; ++b)
#pragma unroll
                for (int m = 0; m < 4; ++m)
#pragma unroll
                    for (int n = 0; n < 2; ++n) acc[a][b][m][n] = (f32x4){0.f, 0.f, 0.f, 0.f};
        cur = nxt; cA = nA; cB = nB; ++ui;
        if constexpr (ALIGN_EPI) { if (wr == 1) PG8_BAR; }
    }
    PG8_WAIT_V(0);
    if constexpr (!ALIGN_EPI) { if (wr == 0) PG8_BAR; }
    PG8_BAR;
    if constexpr (Epi::AFTER_DRAIN) { E.fused(acc, cur, wr, wc, fr, fq, lds, wid, lane); S.done(cur); }
#undef PG8_SA
#undef PG8_SB
#undef PG8_STAGE
#undef PG8_LDA
#undef PG8_LDB
#undef PG8_MMA
#undef PG8_WAIT_V
#undef PG8_WAIT_L
#undef PG8_BAR
#undef PG8_SCHED
}
}

namespace pg8 {
__device__ __forceinline__ u32x4 pack8(const f32x4& v0, const f32x4& v1) { u32x4 w; w.x = cvt_pk_bf16(v0[0], v0[1]); w.y = cvt_pk_bf16(v0[2], v0[3]); w.z = cvt_pk_bf16(v1[0], v1[1]); w.w = cvt_pk_bf16(v1[2], v1[3]); return w; }
__device__ __forceinline__ f32x4 gelu4(const f32x4& v) { f32x2 a = gelu_pk((f32x2){v[0], v[1]}), b = gelu_pk((f32x2){v[2], v[3]}); return (f32x4){a.x, a.y, b.x, b.y}; }
struct DEpiP1 {
    static constexpr bool PERM = true, AFTER_DRAIN = false; EpiP1 e;
    __device__ __forceinline__ void operator()(const f32x4 (&acc)[2][2][4][2], const Unit& u, int wr, int wc, int fr, int fq) const {
        const int row0 = u.pm * BM + wr * 64 + fr; const bool isb = (u.pn >= 8);
        bf16_t* base = isb ? e.PB : e.PA; const int ldc = isb ? 1024 : 2048; const int col0 = (isb ? (u.pn - 8) : u.pn) * BM + wc * 32 + 8 * fq;
#pragma unroll
        for (int ai = 0; ai < 2; ++ai)
#pragma unroll
            for (int m = 0; m < 4; ++m) { bf16_t* rowp = base + (size_t)(row0 + ai * HALF + m * 16) * ldc + col0;
#pragma unroll
                for (int bj = 0; bj < 2; ++bj) { f32x4 v0 = acc[ai][bj][m][0], v1 = acc[ai][bj][m][1];
                    if (isb) { v0 = gelu4(v0); v1 = gelu4(v1); }
                    *(u32x4*)(rowp + bj * HALF) = pack8(v0, v1); } }
    }
};
struct DEpiPlain {
    static constexpr bool PERM = true, AFTER_DRAIN = false; EpiPlain e;
    __device__ __forceinline__ void operator()(const f32x4 (&acc)[2][2][4][2], const Unit& u, int wr, int wc, int fr, int fq) const {
        const int row0 = u.pm * BM + wr * 64 + fr; const int col0 = e.col_off + u.pn * BM + wc * 32 + 8 * fq;
#pragma unroll
        for (int ai = 0; ai < 2; ++ai)
#pragma unroll
            for (int m = 0; m < 4; ++m) { bf16_t* rowp = e.O + (size_t)(row0 + ai * HALF + m * 16) * e.ldc + col0;
#pragma unroll
                for (int bj = 0; bj < 2; ++bj) *(u32x4*)(rowp + bj * HALF) = pack8(acc[ai][bj][m][0], acc[ai][bj][m][1]); }
    }
};
__device__ __forceinline__ float sig_fast(float x) { return __builtin_amdgcn_rcpf(1.0f + __expf(-x)); }
__device__ __forceinline__ float bflo(unsigned w) { return __uint_as_float(w << 16); }
__device__ __forceinline__ float bfhi(unsigned w) { return __uint_as_float(w & 0xffff0000u); }
struct DEpiMerge {
    static constexpr bool PERM = true, AFTER_DRAIN = false; EpiMerge e;
    __device__ __forceinline__ void operator()(const f32x4 (&acc)[2][2][4][2], const Unit& u, int wr, int wc, int fr, int fq) const {
        const int row0 = u.pm * BM + wr * 64 + fr; const int n0 = u.pn * HALF + wc * 32 + 8 * fq;
#pragma unroll
        for (int ai = 0; ai < 2; ++ai)
#pragma unroll
            for (int m = 0; m < 4; ++m) { const size_t row = (size_t)(row0 + ai * HALF + m * 16);
                const u32x4 b0 = *(const u32x4*)(e.BR + row * 2048 + n0), b1 = *(const u32x4*)(e.BR + row * 2048 + 1024 + n0);
                const f32x4 g00 = acc[ai][0][m][0], g01 = acc[ai][0][m][1], g10 = acc[ai][1][m][0], g11 = acc[ai][1][m][1];
                f32x4 o0, o1;
                o0[0] = sig_fast(g00[0]) * bflo(b0.x) + sig_fast(g10[0]) * bflo(b1.x); o0[1] = sig_fast(g00[1]) * bfhi(b0.x) + sig_fast(g10[1]) * bfhi(b1.x);
                o0[2] = sig_fast(g00[2]) * bflo(b0.y) + sig_fast(g10[2]) * bflo(b1.y); o0[3] = sig_fast(g00[3]) * bfhi(b0.y) + sig_fast(g10[3]) * bfhi(b1.y);
                o1[0] = sig_fast(g01[0]) * bflo(b0.z) + sig_fast(g11[0]) * bflo(b1.z); o1[1] = sig_fast(g01[1]) * bfhi(b0.z) + sig_fast(g11[1]) * bfhi(b1.z);
                o1[2] = sig_fast(g01[2]) * bflo(b0.w) + sig_fast(g11[2]) * bflo(b1.w); o1[3] = sig_fast(g01[3]) * bfhi(b0.w) + sig_fast(g11[3]) * bfhi(b1.w);
                *(u32x4*)(e.MG + row * 1024 + n0) = pack8(o0, o1); }
    }
};
struct DEpiResid {
    static constexpr bool PERM = false, AFTER_DRAIN = false; EpiResid e;
    __device__ __forceinline__ void operator()(const f32x4 (&acc)[2][2][4][2], const Unit& u, int wr, int wc, int fr, int fq) const {
        const int row0 = u.pm * BM + wr * 64 + fr, col0 = u.pn * BM + wc * 32 + 4 * fq;
        typedef unsigned u32x2 __attribute__((ext_vector_type(2)));
#pragma unroll
        for (int ai = 0; ai < 2; ++ai)
#pragma unroll
            for (int m = 0; m < 4; ++m) { const size_t ro = (size_t)(row0 + ai * HALF + m * 16) * 1024 + col0;
#pragma unroll
                for (int bj = 0; bj < 2; ++bj)
#pragma unroll
                    for (int n = 0; n < 2; ++n) { const u32x2 h = *(const u32x2*)(e.H + ro + bj * HALF + n * 16); const f32x4 a = acc[ai][bj][m][n];
                        f32x4 o; o[0] = ALPHA_F * bflo(h.x) + a[0]; o[1] = ALPHA_F * bfhi(h.x) + a[1]; o[2] = ALPHA_F * bflo(h.y) + a[2]; o[3] = ALPHA_F * bfhi(h.y) + a[3];
                        *(f32x4*)(e.Z + ro + bj * HALF + n * 16) = o; } }
    }
};

struct DEpiTile {
    static constexpr bool PERM = true, AFTER_DRAIN = false; bf16_t* O; int sm, sn; float scale;
    __device__ __forceinline__ void operator()(const f32x4 (&acc)[2][2][4][2], const Unit& u, int wr, int wc, int fr, int fq) const {
        bf16_t* base = O + (size_t)(u.pm * sm + u.pn * sn) * 65536; const int row0 = wr * 64 + fr, col0 = wc * 32 + 8 * fq;
#pragma unroll
        for (int ai = 0; ai < 2; ++ai)
#pragma unroll
            for (int m = 0; m < 4; ++m) { bf16_t* rowp = base + (size_t)(row0 + ai * HALF + m * 16) * 256 + col0;
#pragma unroll
                for (int bj = 0; bj < 2; ++bj) *(u32x4*)(rowp + bj * HALF) = pack8(acc[ai][bj][m][0] * scale, acc[ai][bj][m][1] * scale); }
    }
};
struct DEpiQ { static constexpr bool PERM = true, AFTER_DRAIN = false; DEpiTile t;
    __device__ __forceinline__ void operator()(const f32x4 (&acc)[2][2][4][2], const Unit& u, int wr, int wc, int fr, int fq) const {
        Unit v; v.pm = (u.pm >> 3) * 32 + u.pn * 8 + (u.pm & 7); v.pn = 0; t(acc, v, wr, wc, fr, fq); } };
struct DEpiO {
    static constexpr bool PERM = true, AFTER_DRAIN = false; bf16_t* O;
    __device__ __forceinline__ void operator()(const f32x4 (&acc)[2][2][4][2], const Unit& u, int wr, int wc, int fr, int fq) const {
        const int bh = u.pm >> 3, b = bh >> 2, h = bh & 3; const int s0 = (u.pm & 7) * 256 + wr * 64 + fr;
        bf16_t* base = O + ((size_t)b * SEQ) * 1024 + h * 256 + wc * 32 + 8 * fq;
#pragma unroll
        for (int ai = 0; ai < 2; ++ai)
#pragma unroll
            for (int m = 0; m < 4; ++m) { bf16_t* rowp = base + (size_t)(s0 + ai * HALF + m * 16) * 1024;
#pragma unroll
                for (int bj = 0; bj < 2; ++bj) *(u32x4*)(rowp + bj * HALF) = pack8(acc[ai][bj][m][0], acc[ai][bj][m][1]); }
    }
};
struct DEpiSoftmax {
    static constexpr bool PERM = true, AFTER_DRAIN = true; bf16_t* Pout;
    __device__ __forceinline__ void fused(f32x4 (&acc)[2][2][4][2], const Unit& u, int wr, int wc, int fr, int fq, PG8_LAS unsigned char* lds, int wid, int lane) const {
        PG8_LAS float* PM = (PG8_LAS float*)lds;
        PG8_LAS float* PS = (PG8_LAS float*)(lds + 4096);
#pragma unroll
        for (int ai = 0; ai < 2; ++ai)
#pragma unroll
            for (int m = 0; m < 4; ++m) { float mx = -3.0e38f;
#pragma unroll
                for (int bj = 0; bj < 2; ++bj)
#pragma unroll
                    for (int n = 0; n < 2; ++n) { const f32x4 x = acc[ai][bj][m][n]; mx = fmaxf(mx, fmaxf(fmaxf(x[0], x[1]), fmaxf(x[2], x[3]))); }
                mx = fmaxf(mx, __shfl_xor(mx, 16)); mx = fmaxf(mx, __shfl_xor(mx, 32));
                if (fq == 0) PM[(ai * HALF + wr * 64 + m * 16 + fr) * 4 + wc] = mx; }
        asm volatile("s_waitcnt lgkmcnt(0)" ::: "memory"); __builtin_amdgcn_s_barrier(); asm volatile("" ::: "memory");
#pragma unroll
        for (int ai = 0; ai < 2; ++ai)
#pragma unroll
            for (int m = 0; m < 4; ++m) { const int row = ai * HALF + wr * 64 + m * 16 + fr; const f32x4 p4 = *(const PG8_LAS f32x4*)(PM + row * 4);
                const float gm = fmaxf(fmaxf(p4[0], p4[1]), fmaxf(p4[2], p4[3])); float sum = 0.f;
#pragma unroll
                for (int bj = 0; bj < 2; ++bj)
#pragma unroll
                    for (int n = 0; n < 2; ++n) { f32x4 x = acc[ai][bj][m][n]; x[0] = __expf(x[0] - gm); x[1] = __expf(x[1] - gm); x[2] = __expf(x[2] - gm); x[3] = __expf(x[3] - gm);
                        acc[ai][bj][m][n] = x; sum += (x[0] + x[1]) + (x[2] + x[3]); }
                sum += __shfl_xor(sum, 16); sum += __shfl_xor(sum, 32);
                if (fq == 0) PS[row * 4 + wc] = sum; }
        asm volatile("s_waitcnt lgkmcnt(0)" ::: "memory"); __builtin_amdgcn_s_barrier(); asm volatile("" ::: "memory");
#pragma unroll
        for (int ai = 0; ai < 2; ++ai)
#pragma unroll
            for (int m = 0; m < 4; ++m) { const int row = ai * HALF + wr * 64 + m * 16 + fr; const f32x4 s4 = *(const PG8_LAS f32x4*)(PS + row * 4);
                const float inv = 1.0f / ((s4[0] + s4[1]) + (s4[2] + s4[3])); bf16_t* rowp = Pout + ((size_t)u.pm * 256 + row) * 256 + wc * 32 + 8 * fq;
#pragma unroll
                for (int bj = 0; bj < 2; ++bj) *(u32x4*)(rowp + bj * HALF) = pack8(acc[ai][bj][m][0] * inv, acc[ai][bj][m][1] * inv); }
        asm volatile("s_waitcnt lgkmcnt(0)" ::: "memory"); __builtin_amdgcn_s_barrier(); asm volatile("" ::: "memory");
    }
};
template <int KIND> struct DEpiLora {
    static constexpr bool PERM = true, AFTER_DRAIN = false; const float* bsrc0; bf16_t* O;
    __device__ __forceinline__ static f32x4 act4(f32x4 x) {
        f32x4 o;
#pragma unroll
        for (int i = 0; i < 4; ++i) {
            if (KIND == 0) { const float y = -x[i]; const float sp = fmaxf(y, 0.f) + __logf(1.0f + __expf(-fabsf(y))); const float ew = __expf(-sp - 0.5f); o[i] = 1.0f - __expf(-ew); }
            else if (KIND == 1) o[i] = __builtin_amdgcn_rcpf(1.0f + __expf(-x[i]));
            else o[i] = x[i]; }
        return o;
    }
    __device__ __forceinline__ void operator()(const f32x4 (&acc)[2][2][4][2], const Unit& u, int wr, int wc, int fr, int fq) const {
        const int row0 = u.pm * BM + wr * 64 + fr; const int z = (KIND == 2) ? 0 : (u.pn >> 1); const int cb = ((KIND == 2) ? u.pn : (u.pn & 1)) * 256 + wc * 32 + 8 * fq;
        f32x4 bv[2][2];
#pragma unroll
        for (int bj = 0; bj < 2; ++bj)
#pragma unroll
            for (int n = 0; n < 2; ++n) bv[bj][n] = (KIND == 2) ? (f32x4){0.f, 0.f, 0.f, 0.f} : *(const f32x4*)(bsrc0 + z * 512 + cb + bj * HALF + 4 * n);
#pragma unroll
        for (int ai = 0; ai < 2; ++ai)
#pragma unroll
            for (int m = 0; m < 4; ++m) { const size_t row = (size_t)(row0 + ai * HALF + m * 16);
                bf16_t* dst = (KIND == 2) ? (O + row * 512 + cb) : (O + (row * 2 + z) * 512 + cb);
#pragma unroll
                for (int bj = 0; bj < 2; ++bj) *(u32x4*)(dst + bj * HALF) = pack8(act4(acc[ai][bj][m][0] + bv[bj][0]), act4(acc[ai][bj][m][1] + bv[bj][1])); }
    }
};
}
#define LAS __attribute__((address_space(3)))
#define XB_TMO      128
#define XB_XCNT(j)  (256  + 64 * (j))
#define XB_XSUB(j)  (1280 + 64 * (j))
#define XB_XGEN(j)  (2304 + 64 * (j))
#define XB_TOP      3328
#define XB_TOPGEN   3392
#define XCD_BAR_WORDS 3456
#define XB_SPIN_CAP (1u << 18)

__device__ __forceinline__ unsigned xb_ld(unsigned* p)              { return __hip_atomic_load(p, __ATOMIC_RELAXED, __HIP_MEMORY_SCOPE_AGENT); }
__device__ __forceinline__ unsigned xb_add(unsigned* p, unsigned v) { return __hip_atomic_fetch_add(p, v, __ATOMIC_RELAXED, __HIP_MEMORY_SCOPE_AGENT); }
__device__ __forceinline__ unsigned xb_xcc_id() { return (unsigned)__builtin_amdgcn_s_getreg((3 << 11) | 20) & 0xFu; }
#define XB_SPIN(cond, bar) do { unsigned _sp = 0; while (cond) { __builtin_amdgcn_s_sleep(1); \
    if ((++_sp & 255u) == 0u) { if (xb_ld(&(bar)[XB_TMO])) break; if (_sp > XB_SPIN_CAP) { atomicAdd(&(bar)[XB_TMO], 1u); break; } } } } while (0)

struct XcdBarrier {
    unsigned* bar; unsigned x;
    volatile LAS unsigned* st;
};

__device__ __forceinline__ XcdBarrier xcd_barrier_post(unsigned* bar, volatile LAS unsigned* st) {
    XcdBarrier b; b.bar = bar; b.x = xb_xcc_id(); b.st = st;
    if (threadIdx.x == 0) (void)xb_add(&bar[XB_XCNT(b.x)], 1u);
    return b;
}
__device__ __forceinline__ void xcd_barrier_complete(unsigned* bar, unsigned x, unsigned& nloc, unsigned& nx) {
    const unsigned G = gridDim.x * gridDim.y * gridDim.z;
    unsigned sum, cnt, mine, sp = 0u;
    for (;;) {
        sum = 0u; cnt = 0u; mine = 0u;
#pragma unroll
        for (unsigned j = 0; j < 16; ++j) { const unsigned c = xb_ld(&bar[XB_XCNT(j)]); sum += c; cnt += (c > 0u) ? 1u : 0u; mine = (j == x) ? c : mine; }
        if (sum == G) break;
        __builtin_amdgcn_s_sleep(1);
        if ((++sp & 255u) == 0u) { if (xb_ld(&bar[XB_TMO])) break; if (sp > XB_SPIN_CAP) { atomicAdd(&bar[XB_TMO], 1u); break; } }
    }
    nloc = mine > 0u ? mine : 1u; nx = cnt > 0u ? cnt : 1u;
}

__device__ __forceinline__ void xcd_barrier(const XcdBarrier& b) {
    asm volatile("s_waitcnt vmcnt(0)" ::: "memory");
    __syncthreads();
    if (threadIdx.x == 0) {
        unsigned* bar = b.bar;
        __builtin_amdgcn_s_waitcnt(0);
        unsigned nloc = b.st[0], nx = b.st[1];
        if (nloc == 0u) { xcd_barrier_complete(bar, b.x, nloc, nx); b.st[0] = nloc; b.st[1] = nx; }
        const unsigned old = xb_add(&bar[XB_XSUB(b.x)], 1u);
        const unsigned gen = old / nloc;
        if (old + 1u == (gen + 1u) * nloc) {
            __builtin_amdgcn_fence(__ATOMIC_RELEASE, "agent");
            asm volatile("s_waitcnt vmcnt(0)" ::: "memory");
            const unsigned og = xb_add(&bar[XB_TOP], 1u);
            const unsigned tg = og / nx;
            if (og + 1u == (tg + 1u) * nx) xb_add(&bar[XB_TOPGEN], 1u);
            else XB_SPIN(xb_ld(&bar[XB_TOPGEN]) == tg, bar);
            __builtin_amdgcn_fence(__ATOMIC_ACQUIRE, "agent");
            xb_add(&bar[XB_XGEN(b.x)], 1u);
            asm volatile("s_waitcnt vmcnt(0)" ::: "memory");
        } else {
            XB_SPIN(xb_ld(&bar[XB_XGEN(b.x)]) == gen, bar);
            __builtin_amdgcn_fence(__ATOMIC_ACQUIRE, "agent");
            asm volatile("s_waitcnt vmcnt(0)" ::: "memory");
        }
    }
    __syncthreads();
}

#endif

#ifdef HOST_EMU
template <class F> static void emu_gemm(const bf16_t* A, const bf16_t* Bt, int M, int N, int K, F f) {
#pragma omp parallel for schedule(static)
    for (int r = 0; r < M; ++r)
        for (int c = 0; c < N; ++c) { float a = 0.f; for (int k = 0; k < K; ++k) a += bf2f(A[(size_t)r * K + k]) * bf2f(Bt[(size_t)c * K + k]); f(r, c, a); }
}
#endif

#define GS_LOOP(idx, n) for (long idx = gtid; idx < (long)(n); idx += nthr)

__device__ __forceinline__ int win_src_col(int n) {
    if (n < 1920) return n;
    if (n < 2048) return -1;
    if (n < 3072) return 1920 + (n - 2048);
    const int m = n - 3072, j = m / 256, i = m % 256;
    return (i < 128) ? (2944 + 128 * j + i) : (2944 + 1024 + 128 * j + (i - 128));
}
__device__ __forceinline__ void ph0_weights(const Params& P, long gtid, long nthr) {
    GS_LOOP(idx, (size_t)5120 * 1024) { const int n = (int)(idx / 1024), k = (int)(idx % 1024); const int c = win_src_col(n);
        P.W_IN_T[idx] = (c < 0) ? (bf16_t)0 : f2bf(P.in[I_W_IN][(size_t)k * IN_COLS + c]); }
    GS_LOOP(idx, (size_t)2048 * 512) { const int n = (int)(idx / 512), k = (int)(idx % 512); const int br = n / 1024, nn = n % 1024;
        P.W_BR_T[idx] = f2bf(P.in[I_W_BRANCH][((size_t)br * 512 + k) * 1024 + nn]); }
    GS_LOOP(idx, (size_t)1024 * 1024) { const int n = (int)(idx / 1024), k = (int)(idx % 1024);
        P.W_MIX_T[idx] = f2bf(P.in[I_W_MIX][(size_t)k * 1024 + n]);
        P.W_Q_T[idx] = f2bf(P.in[I_W_Q][(size_t)k * 1024 + n]);
        P.W_O_T[idx] = f2bf(P.in[I_W_O][(size_t)k * 1024 + n]); }
    GS_LOOP(idx, (size_t)2048 * 1024) { const int n = (int)(idx / 1024), k = (int)(idx % 1024);
        P.W_KV_T[idx] = f2bf(P.in[I_W_KV][(size_t)k * 2048 + n]);
        P.W_QUERY_T[idx] = f2bf(P.in[I_W_QUERY][(size_t)k * 2048 + n]); }
}
__device__ __forceinline__ void ln_rows_bf16(const float* in, const float* g, const float* b, bf16_t* out, int rows, int width, long gtid, long nthr) {
    GS_LOOP(row, rows) { const float* x = in + (size_t)row * width; float s = 0.f;
        for (int i = 0; i < width; ++i) s += x[i];
        const float mu = s / width; float q = 0.f;
        for (int i = 0; i < width; ++i) { const float d = x[i] - mu; q += d * d; }
        const float rs = 1.0f / sqrtf(q / width + 1e-5f); bf16_t* o = out + (size_t)row * width;
        for (int i = 0; i < width; ++i) o[i] = f2bf((x[i] - mu) * rs * g[i] + b[i]); }
}
__device__ __forceinline__ void ph2a_vn(const Params& P, long gtid, long nthr) {
    GS_LOOP(row, TOK) { const bf16_t* x = P.PB + (size_t)row * 1024 + 512; float s = 0.f;
        for (int i = 0; i < 512; ++i) s += bf2f(x[i]);
        const float mu = s / 512.f; float q = 0.f;
        for (int i = 0; i < 512; ++i) { const float d = bf2f(x[i]) - mu; q += d * d; }
        const float rs = 1.0f / sqrtf(q / 512.f + 1e-5f); bf16_t* o = P.VN + (size_t)row * 512;
        for (int i = 0; i < 512; ++i) o[i] = f2bf((bf2f(x[i]) - mu) * rs * P.in[I_GLN_G][i] + P.in[I_GLN_B][i]); }
}
__device__ __forceinline__ void ph2b_gmlp(const Params& P, long gtid, long nthr) {
    GS_LOOP(idx, (size_t)TOK * 512) { const int c = (int)(idx % 512); const long t = idx / 512; const int g = c / 64; const long ch = t / 128; const int p = (int)(t % 128);
        const float* ws = P.in[I_W_S] + ((size_t)g * 128 + p) * 128; float s = 0.f;
        for (int q = 0; q < 128; ++q) s += ws[q] * bf2f(P.VN[(size_t)(ch * 128 + q) * 512 + c]);
        s += P.in[I_B_S][g * 128 + p];
        P.YB[idx] = f2bf(bf2f(P.PB[(size_t)t * 1024 + c]) * s); }
}
__device__ __forceinline__ float pa_shift(const Params& P, long t, int c) {
    const int s = (int)(t % SEQ); const float cur = bf2f(P.PA[(size_t)t * 2048 + c]);
    const float prev = (s > 0) ? bf2f(P.PA[(size_t)(t - 1) * 2048 + c]) : 0.f;
    const float nxt = (s < SEQ - 1) ? bf2f(P.PA[(size_t)(t + 1) * 2048 + c]) : 0.f;
    return cur + P.in[I_MU][c] * (0.5f * (prev + nxt) - cur);
}
__device__ __forceinline__ void ph3a_lora_in(const Params& P, long gtid, long nthr) {
    GS_LOOP(idx, (size_t)TOK * 128) { const int r = (int)(idx % 128); const long t = idx / 128;
        P.WDS[idx] = f2bf(tanhf(pa_shift(P, t, 1536 + r)));
        P.ADS[idx] = f2bf(pa_shift(P, t, 1664 + r));
        P.SG[idx] = f2bf(sigmoidf_(pa_shift(P, t, 1792 + r))); }
}
__device__ __forceinline__ void ph3b_prep(const Params& P, long gtid, long nthr) {
    GS_LOOP(idx, (size_t)TOK * 8) { const int h = (int)(idx % 8); const long t = idx / 8; const int hb = h * 64;
        float ss = 0.f;
        for (int j = 0; j < 64; ++j) { const float v = pa_shift(P, t, 512 + hb + j) * P.in[I_K_K][hb + j]; ss += v * v; }
        const float inv = 1.0f / fmaxf(sqrtf(ss), 1e-12f);
        for (int j = 0; j < 64; ++j) { const int c = hb + j;
            const float k = pa_shift(P, t, 512 + c); const float kk = k * P.in[I_K_K][c] * inv;
            P.R[(size_t)t * 512 + c] = f2bf(pa_shift(P, t, c));
            P.V[(size_t)t * 512 + c] = f2bf(pa_shift(P, t, 1024 + c));
            P.KK[(size_t)t * 512 + c] = f2bf(kk);
            for (int z = 0; z < 2; ++z) {
                float sw = P.in[I_W0][z * 512 + c], sa = P.in[I_A0][z * 512 + c];
                for (int r = 0; r < 64; ++r) { sw += bf2f(P.WDS[(size_t)t * 128 + z * 64 + r]) * P.in[I_W2][((size_t)z * 64 + r) * 512 + c];
                                               sa += bf2f(P.ADS[(size_t)t * 128 + z * 64 + r]) * P.in[I_A2][((size_t)z * 64 + r) * 512 + c]; }
                const float y = -sw; const float sp = fmaxf(y, 0.f) + log1pf(expf(-fabsf(y))); const float wlog = -sp - 0.5f;
                const float ew = expf(wlog);
                const float a = sigmoidf_(sa); const size_t o = ((size_t)t * 2 + z) * 512 + c;
                P.OMW[o] = f2bf(-expm1f(-ew));
                P.KDIR[o] = f2bf(k * (1.0f + (a - 1.0f) * P.in[I_K_A][c]));
                P.BVEC[o] = f2bf(kk * a); } } }
}
__device__ __forceinline__ void scan_item(const Params& P, int chain, int i) {
    const int h = chain % 8, b = (chain / 8) % BATCH, z = chain / (8 * BATCH);
    float S[64];
#pragma unroll
    for (int j = 0; j < 64; ++j) S[j] = 0.f;
    for (int n = 0; n < SEQ; ++n) {
        const long t = (long)b * SEQ + ((z == 0) ? n : (SEQ - 1 - n));
        const bf16_t* r = P.R + (size_t)t * 512 + h * 64; const bf16_t* a = P.KK + (size_t)t * 512 + h * 64;
        const bf16_t* w = P.OMW + ((size_t)t * 2 + z) * 512 + h * 64; const bf16_t* k = P.KDIR + ((size_t)t * 2 + z) * 512 + h * 64;
        const bf16_t* bv = P.BVEC + ((size_t)t * 2 + z) * 512 + h * 64;
        const float v = bf2f(P.V[(size_t)t * 512 + h * 64 + i]);
        float sa = 0.f;
#pragma unroll
        for (int j = 0; j < 64; ++j) sa -= S[j] * bf2f(a[j]);
        float y = 0.f;
#pragma unroll
        for (int j = 0; j < 64; ++j) { S[j] = S[j] * (1.0f - bf2f(w[j])) + sa * bf2f(bv[j]) + v * bf2f(k[j]); y += S[j] * bf2f(r[j]); }
        P.Y01[((size_t)z * TOK + t) * 512 + h * 64 + i] = y;
    }
}
__device__ __forceinline__ void ph5_rwkv_out(const Params& P, long gtid, long nthr) {
    GS_LOOP(idx, (size_t)TOK * 512) { const int c = (int)(idx % 512); const long t = idx / 512; const int hb = (c / 64) * 64;
        const float* y0 = P.Y01 + (size_t)t * 512 + hb; const float* y1 = P.Y01 + ((size_t)TOK + t) * 512 + hb;
        float s = 0.f;
        for (int j = 0; j < 64; ++j) s += y0[j] + y1[j];
        const float mu = s / 64.f; float q = 0.f;
        for (int j = 0; j < 64; ++j) { const float d = y0[j] + y1[j] - mu; q += d * d; }
        const float rs = 1.0f / sqrtf(q / 64.f + 64e-5f);
        const float yn = (y0[c - hb] + y1[c - hb] - mu) * rs * P.in[I_GN_G][c] + P.in[I_GN_B][c];
        float rk = 0.f;
        for (int z = 0; z < 2; ++z)
            for (int j = 0; j < 64; ++j) rk += bf2f(P.R[(size_t)t * 512 + hb + j]) * bf2f(P.KDIR[((size_t)t * 2 + z) * 512 + hb + j]) * P.in[I_R_K][hb + j];
        float g = 0.f;
        for (int r = 0; r < 128; ++r) g += bf2f(P.SG[(size_t)t * 128 + r]) * P.in[I_G2][(size_t)r * 512 + c];
        P.YA[idx] = f2bf((yn + rk * bf2f(P.V[(size_t)t * 512 + c])) * g); }
}
__device__ __forceinline__ void ph_ln_z(const Params& P, const float* g, const float* b, long gtid, long nthr) { ln_rows_bf16(P.Z, g, b, P.HB, TOK, 1024, gtid, nthr); }
__device__ __forceinline__ void ph10a_scores(const Params& P, long gtid, long nthr) {
    GS_LOOP(idx, (size_t)TOK * 4 * 256) { const int m = (int)(idx % 256); const long rowi = idx / 256; const int s = (int)(rowi % SEQ); const int bh = (int)(rowi / SEQ); const int b = bh / 4, h = bh % 4;
        const bf16_t* q = P.Q + ((size_t)b * SEQ + s) * 1024 + h * 256; const bf16_t* k = P.KV + ((size_t)b * 256 + m) * 2048 + h * 256; float a = 0.f;
        for (int d = 0; d < 256; ++d) a += bf2f(q[d]) * bf2f(k[d]);
        P.SCA[idx] = a * 0.0625f; }
}
__device__ __forceinline__ void ph10b_softmax(const Params& P, long gtid, long nthr) {
    GS_LOOP(row, (size_t)TOK * 4) { float* x = P.SCA + (size_t)row * 256; float mx = x[0];
        for (int i = 1; i < 256; ++i) mx = fmaxf(mx, x[i]);
        float s = 0.f;
        for (int i = 0; i < 256; ++i) s += expf(x[i] - mx);
        const float inv = 1.0f / s;
        for (int i = 0; i < 256; ++i) x[i] = expf(x[i] - mx) * inv; }
}
__device__ __forceinline__ void ph10c_out(const Params& P, long gtid, long nthr) {
    GS_LOOP(idx, (size_t)TOK * 1024) { const int c = (int)(idx % 1024); const long t = idx / 1024; const int b = (int)(t / SEQ), s = (int)(t % SEQ), h = c / 256;
        const float* pr = P.SCA + (((size_t)b * 4 + h) * SEQ + s) * 256; float a = 0.f;
        for (int m = 0; m < 256; ++m) a += pr[m] * bf2f(P.KV[((size_t)b * 256 + m) * 2048 + 1024 + c]);
        P.O[idx] = f2bf(a); }
}
__device__ __forceinline__ void ph13a_scores(const Params& P, long gtid, long nthr) {
    GS_LOOP(idx, (size_t)TOK * 2048) { const int k = (int)(idx % 128), z = (int)((idx / 128) % 2), h = (int)((idx / 256) % 8); const long t = idx / 2048;
        const bf16_t* q = P.QP + (size_t)t * 2048 + h * 256 + z * 128; const float* kr = P.in[I_SUBKEYS] + ((size_t)z * 128 + k) * 128; float a = 0.f;
        for (int c = 0; c < 128; ++c) a += bf2f(q[c]) * kr[c];
        P.SC[idx] = a; }
}
__device__ __forceinline__ void ph13b_topk(const Params& P, long gtid, long nthr) {
    GS_LOOP(row, (size_t)TOK * 16) { const float* x = P.SC + (size_t)row * 128; float pv = 0.f; int pi = -1;
        for (int j = 0; j < 16; ++j) { float best = 0.f; int bi = -1;
            for (int i = 0; i < 128; ++i) { const float v = x[i]; const bool elig = (j == 0) || (v < pv) || (v == pv && i > pi);
                if (elig && (bi < 0 || v > best)) { best = v; bi = i; } }
            P.TOPS[(size_t)row * 16 + j] = best; P.TOPI[(size_t)row * 16 + j] = bi; pv = best; pi = bi; } }
}
__device__ __forceinline__ void ph13c_cand(const Params& P, long gtid, long nthr) {
    GS_LOOP(row, (size_t)TOK * 8) { const float* s0 = P.TOPS + (size_t)row * 32; const float* s1 = s0 + 16; const int* i0 = P.TOPI + (size_t)row * 32; const int* i1 = i0 + 16;
        float pv = 0.f; int pi = -1; float mx = 0.f;
        for (int j = 0; j < 16; ++j) { float best = 0.f; int bi = -1;
            for (int c = 0; c < 256; ++c) { const float v = s0[c / 16] + s1[c % 16]; const bool elig = (j == 0) || (v < pv) || (v == pv && c > pi);
                if (elig && (bi < 0 || v > best)) { best = v; bi = c; } }
            if (j == 0) mx = best;
            P.GATE[(size_t)row * 16 + j] = best; P.EXPERT[(size_t)row * 16 + j] = i0[bi / 16] * 128 + i1[bi % 16]; pv = best; pi = bi; }
        float s = 0.f;
        for (int j = 0; j < 16; ++j) s += expf(P.GATE[(size_t)row * 16 + j] - mx);
        const float inv = 1.0f / s;
        for (int j = 0; j < 16; ++j) P.GATE[(size_t)row * 16 + j] = expf(P.GATE[(size_t)row * 16 + j] - mx) * inv; }
}
__device__ __forceinline__ void ph14a_act(const Params& P, long gtid, long nthr) {
    GS_LOOP(idx, (size_t)TOK * 128) { const long t = idx / 128; const bf16_t* x = P.HB + (size_t)t * 1024; const float* ur = P.in[I_PEER_U] + (size_t)P.EXPERT[idx] * 1024; float a = 0.f;
        for (int d = 0; d < 1024; ++d) a += ur[d] * bf2f(x[d]);
        P.COEF[idx] = P.GATE[idx] * geluf_(a); }
}
__device__ __forceinline__ void ph14b_out(const Params& P, long gtid, long nthr) {
    GS_LOOP(idx, (size_t)TOK * 1024) { const int d = (int)(idx % 1024); const long t = idx / 1024; float a = 0.f;
        for (int j = 0; j < 128; ++j) a += P.COEF[(size_t)t * 128 + j] * P.in[I_PEER_V][(size_t)P.EXPERT[(size_t)t * 128 + j] * 1024 + d];
        P.Y[idx] = a; }
}
__device__ __forceinline__ void ph14c_final(const Params& P, long gtid, long nthr) {
    GS_LOOP(row, TOK) { const bf16_t* hr = P.HB + (size_t)row * 1024; const float* yr = P.Y + (size_t)row * 1024; float s = 0.f;
        for (int i = 0; i < 1024; ++i) s += ALPHA_F * bf2f(hr[i]) + yr[i];
        const float mu = s / 1024.f; float q = 0.f;
        for (int i = 0; i < 1024; ++i) { const float d = ALPHA_F * bf2f(hr[i]) + yr[i] - mu; q += d * d; }
        const float rs = 1.0f / sqrtf(q / 1024.f + 1e-5f); float* o = P.out + (size_t)row * 1024;
        for (int i = 0; i < 1024; ++i) o[i] = (ALPHA_F * bf2f(hr[i]) + yr[i] - mu) * rs * P.in[I_LN3_G][i] + P.in[I_LN3_B][i]; }
}

static void make_params(Params& P, void* const* d_in, void* d_out, void* d_ws) {
    memset(&P, 0, sizeof(P));
    for (int i = 0; i < 37; ++i) P.in[i] = (const float*)d_in[i];
    P.out = (float*)d_out; unsigned char* ws = (unsigned char*)d_ws; unsigned char* ob = (unsigned char*)d_out;
    unsigned char* r1 = ws + A_R1; unsigned char* r2 = ws + A_R2;
    P.ctl = (unsigned*)(ws + WS_CTL);
    P.W_IN_T = (bf16_t*)(ws + WS_W + OFF_W_IN); P.W_BR_T = (bf16_t*)(ws + WS_W + OFF_W_BR); P.W_MIX_T = (bf16_t*)(ws + WS_W + OFF_W_MIX);
    P.W_Q_T = (bf16_t*)(ws + WS_W + OFF_W_Q); P.W_KV_T = (bf16_t*)(ws + WS_W + OFF_W_KV); P.W_O_T = (bf16_t*)(ws + WS_W + OFF_W_O); P.W_QUERY_T = (bf16_t*)(ws + WS_W + OFF_W_QUERY);
    P.KV = (bf16_t*)(ws + WS_KV); P.MEMN = (bf16_t*)(ws + WS_MEMN); P.HB = (bf16_t*)(ws + A_HB);
    P.PA = (bf16_t*)r1; P.PB = (bf16_t*)r2; P.VN = (bf16_t*)(r2 + 2 * TU);
    P.YB = (bf16_t*)ob; P.WDS = (bf16_t*)(ob + TU); P.ADS = (bf16_t*)(ob + TU + TU / 4); P.SG = (bf16_t*)(ob + TU + TU / 2);
    P.R = (bf16_t*)(ob + 2 * TU); P.KK = (bf16_t*)(ob + 3 * TU);
    P.V = (bf16_t*)r2; P.OMW = (bf16_t*)(r2 + TU); P.KDIR = (bf16_t*)(r2 + 3 * TU); P.BVEC = (bf16_t*)(r2 + 5 * TU);
    P.Y01 = (float*)r1; P.YA = (bf16_t*)(r2 + TU); P.BR = (bf16_t*)r1; P.MG = (bf16_t*)r2; P.Z = (float*)ob;
    P.Q = (bf16_t*)r1; P.O = (bf16_t*)(r1 + 2 * TU); P.SCA = (float*)r2; P.QP = (bf16_t*)ob;
    P.SC = (float*)r1; P.TOPS = (float*)(r2 + 4 * TU); P.TOPI = (int*)(r2 + 5 * TU); P.GATE = (float*)(r2 + 6 * TU); P.EXPERT = (int*)(r2 + 6 * TU + TU / 2);
    P.COEF = (float*)(r2 + 7 * TU); P.Y = (float*)r1;
    P.UB = (bf16_t*)r1; P.VB = (bf16_t*)(r1 + (size_t)16384 * 1024 * 2);
    P.W_LORA_T = (bf16_t*)(ws + WS_W + OFF_W_LORA); P.WSB = (bf16_t*)(ws + WS_W + OFF_WSB);
    P.LIN = (bf16_t*)(ob + TU); P.V = (bf16_t*)(r2 + 2 * TU); P.K = (bf16_t*)(r2 + 3 * TU); P.OMW = (bf16_t*)r2; P.AL = (bf16_t*)(r2 + 4 * TU); P.G = (bf16_t*)(r2 + 6 * TU);
    P.YA = (bf16_t*)r2;
    P.KH = (bf16_t*)(ws + WS_KV); P.VT = (bf16_t*)(ws + WS_KV + 4 * MiB); P.QH = (bf16_t*)r1; P.PP = (bf16_t*)r2;
    P.GATE = (float*)(r2 + 6 * TU); P.EXPERT = (int*)(r2 + 6 * TU + TU / 2);
}

#ifndef NEW_PEER
#define NEW_PEER 1
#endif
#ifndef USE_DOT2
#define USE_DOT2 0
#endif
#ifndef ATT_OLD
#define ATT_OLD 0
#endif
#ifndef NEW_SCAN
#define NEW_SCAN 1
#endif
#ifndef NEW_ROUTE
#define NEW_ROUTE 1
#endif
#define AX (ATT_OLD ? 1 : 0)
#define N_PHASES ((NEW_ROUTE ? 20 : 23) + AX)
__device__ __forceinline__ void run_simt_phase(const Params& P, int ph, long gtid, long nthr) {
    switch (ph) {
    case 0: ph0_weights(P, gtid, nthr);
            ln_rows_bf16(P.in[I_X], P.in[I_LN_EMB_G], P.in[I_LN_EMB_B], P.HB, TOK, 1024, gtid, nthr);
            ln_rows_bf16(P.in[I_MEM], P.in[I_MLN_G], P.in[I_MLN_B], P.MEMN, BATCH * MEM_LEN, 1024, gtid, nthr); break;
    case 2: ph2a_vn(P, gtid, nthr); break;
    case 3: ph2b_gmlp(P, gtid, nthr); break;
    case 4: ph3a_lora_in(P, gtid, nthr); break;
    case 5: ph3b_prep(P, gtid, nthr); break;
    case 7: ph5_rwkv_out(P, gtid, nthr); break;
    case 11: ph_ln_z(P, P.in[I_LN1_G], P.in[I_LN1_B], gtid, nthr); break;
    case 13: ph10a_scores(P, gtid, nthr); break;
    case 14: ph10b_softmax(P, gtid, nthr); break;
    case 15: ph10c_out(P, gtid, nthr); break;
    case 17: ph_ln_z(P, P.in[I_LN2_G], P.in[I_LN2_B], gtid, nthr); break;
    case 19: ph13a_scores(P, gtid, nthr); break;
    case 20: ph13b_topk(P, gtid, nthr); break;
    case 21: ph13c_cand(P, gtid, nthr); break;
    case 22: ph14a_act(P, gtid, nthr); break;
    case 23: ph14b_out(P, gtid, nthr); break;
    case 24: ph14c_final(P, gtid, nthr); break;
    default: break;
    }
}

#ifdef HOST_EMU
static void emu_run(const Params& P) {
    for (int ph = 0; ph < N_PHASES; ++ph) {
        switch (ph) {
        case 1:
            emu_gemm(P.HB, P.W_IN_T, TOK, 3072, 1024, [&](int r, int c, float a) { if (c < 2048) P.PA[(size_t)r * 2048 + c] = f2bf(a); else P.PB[(size_t)r * 1024 + c - 2048] = f2bf(geluf_(a)); });
            emu_gemm(P.MEMN, P.W_KV_T, BATCH * MEM_LEN, 2048, 1024, [&](int r, int c, float a) { P.KV[(size_t)r * 2048 + c] = f2bf(a); });
            break;
        case 6:
#pragma omp parallel for schedule(dynamic, 1)
            for (int it = 0; it < 2 * BATCH * 8 * 64; ++it) scan_item(P, it / 64, it % 64);
            break;
        case 8:
            emu_gemm(P.YA, P.W_BR_T, TOK, 1024, 512, [&](int r, int c, float a) { P.BR[(size_t)r * 2048 + c] = f2bf(a); });
            emu_gemm(P.YB, P.W_BR_T + (size_t)1024 * 512, TOK, 1024, 512, [&](int r, int c, float a) { P.BR[(size_t)r * 2048 + 1024 + c] = f2bf(a); });
            break;
        case 9: {
            float* tmp = (float*)malloc((size_t)TOK * 2048 * 4);
            emu_gemm(P.HB, P.W_IN_T + (size_t)3072 * 1024, TOK, 2048, 1024, [&](int r, int c, float a) { tmp[(size_t)r * 2048 + c] = a; });
            for (int r = 0; r < TOK; ++r) for (int n = 0; n < 1024; ++n) { const int j = n / 128, i = n % 128;
                const float g0 = tmp[(size_t)r * 2048 + 256 * j + i], g1 = tmp[(size_t)r * 2048 + 256 * j + 128 + i];
                P.MG[(size_t)r * 1024 + n] = f2bf(sigmoidf_(g0) * bf2f(P.BR[(size_t)r * 2048 + n]) + sigmoidf_(g1) * bf2f(P.BR[(size_t)r * 2048 + 1024 + n])); }
            free(tmp); } break;
        case 10: emu_gemm(P.MG, P.W_MIX_T, TOK, 1024, 1024, [&](int r, int c, float a) { P.Z[(size_t)r * 1024 + c] = ALPHA_F * bf2f(P.HB[(size_t)r * 1024 + c]) + a; }); break;
        case 12: emu_gemm(P.HB, P.W_Q_T, TOK, 1024, 1024, [&](int r, int c, float a) { P.Q[(size_t)r * 1024 + c] = f2bf(a); }); break;
        case 16: emu_gemm(P.O, P.W_O_T, TOK, 1024, 1024, [&](int r, int c, float a) { P.Z[(size_t)r * 1024 + c] = ALPHA_F * bf2f(P.HB[(size_t)r * 1024 + c]) + a; }); break;
        case 18: emu_gemm(P.HB, P.W_QUERY_T, TOK, 2048, 1024, [&](int r, int c, float a) { P.QP[(size_t)r * 2048 + c] = f2bf(a); }); break;
        default: {
            const long NT = 64;
#pragma omp parallel for schedule(static, 1)
            for (long g = 0; g < NT; ++g) run_simt_phase(P, ph, g, NT);
        } break;
        }
    }
}
extern "C" void kernel_launch(void* const* d_in, const int* in_sizes, int n_in, void* d_out, int out_size, void* d_ws, size_t ws_size, hipStream_t stream) {
    Params P; make_params(P, d_in, d_out, d_ws);
    memset(d_ws, 0, 1 << 20);
    emu_run(P);
}
#else

typedef float f32x4 __attribute__((ext_vector_type(4)));
typedef unsigned u32x4 __attribute__((ext_vector_type(4)));
typedef unsigned u32x2 __attribute__((ext_vector_type(2)));
typedef __bf16 bf16x2_t __attribute__((ext_vector_type(2)));
__device__ __forceinline__ float wave_sum(float v) {
#pragma unroll
    for (int o = 1; o < 64; o <<= 1) v += __shfl_xor(v, o);
    return v;
}
__device__ __forceinline__ float wave_max(float v) {
#pragma unroll
    for (int o = 1; o < 64; o <<= 1) v = fmaxf(v, __shfl_xor(v, o));
    return v;
}
__device__ __forceinline__ unsigned pk2(float lo, float hi) { return (unsigned)f2bf(lo) | ((unsigned)f2bf(hi) << 16); }
__device__ __forceinline__ float blo(unsigned w) { return __uint_as_float(w << 16); }
__device__ __forceinline__ float bhi(unsigned w) { return __uint_as_float(w & 0xffff0000u); }
__device__ __forceinline__ void wln_f32_bf16(const float* xrow, const float* g, const float* b, bf16_t* orow, int lane) {
    const f32x4* xr = (const f32x4*)xrow + lane; f32x4 v[4]; float s = 0.f;
#pragma unroll
    for (int j = 0; j < 4; ++j) { v[j] = xr[64 * j]; s += (v[j][0] + v[j][1]) + (v[j][2] + v[j][3]); }
    const float mean = wave_sum(s) * (1.f / 1024.f); float s2 = 0.f;
#pragma unroll
    for (int j = 0; j < 4; ++j) { v[j] = v[j] - mean; s2 += (v[j][0] * v[j][0] + v[j][1] * v[j][1]) + (v[j][2] * v[j][2] + v[j][3] * v[j][3]); }
    const float rstd = 1.f / sqrtf(wave_sum(s2) * (1.f / 1024.f) + 1e-5f);
#pragma unroll
    for (int j = 0; j < 4; ++j) { const f32x4 gg = ((const f32x4*)g)[64 * j + lane], bb = ((const f32x4*)b)[64 * j + lane]; const f32x4 o = v[j] * rstd * gg + bb;
        u32x2 w; w.x = pk2(o[0], o[1]); w.y = pk2(o[2], o[3]); *((u32x2*)orow + 64 * j + lane) = w; }
}
__device__ __forceinline__ void d_ln_rows(const float* in, const float* g, const float* b, bf16_t* out, int rows, int gw, int ngw, int lane) {
    for (int m = gw; m < rows; m += ngw) wln_f32_bf16(in + (size_t)m * 1024, g, b, out + (size_t)m * 1024, lane);
}
__device__ __forceinline__ void d_vn(const Params& P, int gw, int ngw, int lane) {
    const f32x4 g0 = ((const f32x4*)P.in[I_GLN_G])[2 * lane], g1 = ((const f32x4*)P.in[I_GLN_G])[2 * lane + 1];
    const f32x4 b0 = ((const f32x4*)P.in[I_GLN_B])[2 * lane], b1 = ((const f32x4*)P.in[I_GLN_B])[2 * lane + 1];
    for (int m = gw; m < TOK; m += ngw) {
        const u32x4 w = *((const u32x4*)(P.PB + (size_t)m * 1024 + 512) + lane);
        float x[8] = {blo(w.x), bhi(w.x), blo(w.y), bhi(w.y), blo(w.z), bhi(w.z), blo(w.w), bhi(w.w)};
        float s = 0.f;
#pragma unroll
        for (int i = 0; i < 8; ++i) s += x[i];
        const float mean = wave_sum(s) * (1.f / 512.f); float s2 = 0.f;
#pragma unroll
        for (int i = 0; i < 8; ++i) { x[i] -= mean; s2 += x[i] * x[i]; }
        const float rstd = 1.f / sqrtf(wave_sum(s2) * (1.f / 512.f) + 1e-5f);
        u32x4 o; o.x = pk2(x[0] * rstd * g0[0] + b0[0], x[1] * rstd * g0[1] + b0[1]); o.y = pk2(x[2] * rstd * g0[2] + b0[2], x[3] * rstd * g0[3] + b0[3]);
        o.z = pk2(x[4] * rstd * g1[0] + b1[0], x[5] * rstd * g1[1] + b1[1]); o.w = pk2(x[6] * rstd * g1[2] + b1[2], x[7] * rstd * g1[3] + b1[3]);
        *((u32x4*)(P.VN + (size_t)m * 512) + lane) = o;
    }
}
__device__ __forceinline__ void d_softmax256(const Params& P, int gw, int ngw, int lane) {
    for (long m = gw; m < (long)TOK * 4; m += ngw) { f32x4* xr = (f32x4*)(P.SCA + (size_t)m * 256) + lane; f32x4 v = *xr;
        const float mx = wave_max(fmaxf(fmaxf(v[0], v[1]), fmaxf(v[2], v[3])));
        v[0] = __expf(v[0] - mx); v[1] = __expf(v[1] - mx); v[2] = __expf(v[2] - mx); v[3] = __expf(v[3] - mx);
        const float inv = 1.0f / wave_sum((v[0] + v[1]) + (v[2] + v[3])); *xr = v * inv; }
}
__device__ __forceinline__ void tr_item(const float* W, int ldw, int src_col0, bf16_t* WT, int K, int dst_row0, int k0, LAS float* scr, int lane) {
    const int c = lane & 7;
    if (src_col0 < 0) {
#pragma unroll
        for (int j = 0; j < 4; ++j) { const int n = (lane >> 3) + 8 * j; *(u32x4*)(WT + (size_t)(dst_row0 + n) * K + k0 + 8 * c) = (u32x4){0u, 0u, 0u, 0u}; }
        return;
    }
#pragma unroll 8
    for (int i = 0; i < 32; ++i) { const int kk = 2 * i + (lane >> 5); scr[kk * 33 + (lane & 31)] = W[(size_t)(k0 + kk) * ldw + src_col0 + (lane & 31)]; }
    asm volatile("s_waitcnt lgkmcnt(0)" ::: "memory");
#pragma unroll
    for (int j = 0; j < 4; ++j) { const int n = (lane >> 3) + 8 * j; const LAS float* sp = scr + (8 * c) * 33 + n;
        u32x4 o; o.x = pk2(sp[0 * 33], sp[1 * 33]); o.y = pk2(sp[2 * 33], sp[3 * 33]); o.z = pk2(sp[4 * 33], sp[5 * 33]); o.w = pk2(sp[6 * 33], sp[7 * 33]);
        *(u32x4*)(WT + (size_t)(dst_row0 + n) * K + k0 + 8 * c) = o; }
    asm volatile("s_waitcnt lgkmcnt(0)" ::: "memory");
}
__device__ __forceinline__ void d_weights(const Params& P, LAS unsigned char* lds, int gw, int ngw, int wave, int lane) {
    LAS float* scr = (LAS float*)(lds + wave * 16384);
    constexpr int I_IN = 160 * 16, I_BR = 2 * 32 * 8, I_SQ = 32 * 16, I_WIDE = 64 * 16;
    constexpr int NITEMS = I_IN + I_BR + 3 * I_SQ + 2 * I_WIDE;
    for (int it = gw; it < NITEMS; it += ngw) {
        int r = it;
        if (r < I_IN) { const int nb = r / 16, kb = r % 16; tr_item(P.in[I_W_IN], IN_COLS, win_src_col(32 * nb), P.W_IN_T, 1024, 32 * nb, 64 * kb, scr, lane); continue; } r -= I_IN;
        if (r < I_BR) { const int br = r / 256, q = r % 256, nb = q / 8, kb = q % 8; tr_item(P.in[I_W_BRANCH] + (size_t)br * 512 * 1024, 1024, 32 * nb, P.W_BR_T, 512, br * 1024 + 32 * nb, 64 * kb, scr, lane); continue; } r -= I_BR;
        if (r < 3 * I_SQ) { const int w = r / I_SQ, q = r % I_SQ, nb = q / 16, kb = q % 16;
            const float* src = (w == 0) ? P.in[I_W_MIX] : (w == 1) ? P.in[I_W_Q] : P.in[I_W_O]; bf16_t* dst = (w == 0) ? P.W_MIX_T : (w == 1) ? P.W_Q_T : P.W_O_T;
            tr_item(src, 1024, 32 * nb, dst, 1024, 32 * nb, 64 * kb, scr, lane); continue; } r -= 3 * I_SQ;
        { const int w = r / I_WIDE, q = r % I_WIDE, nb = q / 16, kb = q % 16;
            tr_item(w == 0 ? P.in[I_W_KV] : P.in[I_W_QUERY], 2048, 32 * nb, w == 0 ? P.W_KV_T : P.W_QUERY_T, 1024, 32 * nb, 64 * kb, scr, lane); }
    }
}
__device__ __forceinline__ void d_tables(const Params& P, long gtid, long nthr) {
    const long n8 = (long)16384 * 1024 / 8;
    for (long i = gtid; i < 2 * n8; i += nthr) { const bool isv = (i >= n8); const long j = isv ? i - n8 : i;
        const f32x4* src = (const f32x4*)(isv ? P.in[I_PEER_V] : P.in[I_PEER_U]) + 2 * j; const f32x4 a = src[0], b = src[1];
        u32x4 o; o.x = pk2(a[0], a[1]); o.y = pk2(a[2], a[3]); o.z = pk2(b[0], b[1]); o.w = pk2(b[2], b[3]);
        *((u32x4*)(isv ? P.VB : P.UB) + j) = o; }
}
__device__ __forceinline__ float dot8(const u32x4& a, const u32x4& b, float acc) {
#if USE_DOT2
    acc = __builtin_amdgcn_fdot2_f32_bf16(__builtin_bit_cast(bf16x2_t, a.x), __builtin_bit_cast(bf16x2_t, b.x), acc, false);
    acc = __builtin_amdgcn_fdot2_f32_bf16(__builtin_bit_cast(bf16x2_t, a.y), __builtin_bit_cast(bf16x2_t, b.y), acc, false);
    acc = __builtin_amdgcn_fdot2_f32_bf16(__builtin_bit_cast(bf16x2_t, a.z), __builtin_bit_cast(bf16x2_t, b.z), acc, false);
    acc = __builtin_amdgcn_fdot2_f32_bf16(__builtin_bit_cast(bf16x2_t, a.w), __builtin_bit_cast(bf16x2_t, b.w), acc, false);
#else
    acc += blo(a.x) * blo(b.x); acc += bhi(a.x) * bhi(b.x); acc += blo(a.y) * blo(b.y); acc += bhi(a.y) * bhi(b.y);
    acc += blo(a.z) * blo(b.z); acc += bhi(a.z) * bhi(b.z); acc += blo(a.w) * blo(b.w); acc += bhi(a.w) * bhi(b.w);
#endif
    return acc;
}
__device__ __forceinline__ void axpy8(float* y, float c, const u32x4& v) {
    y[0] += c * blo(v.x); y[1] += c * bhi(v.x); y[2] += c * blo(v.y); y[3] += c * bhi(v.y);
    y[4] += c * blo(v.z); y[5] += c * bhi(v.z); y[6] += c * blo(v.w); y[7] += c * bhi(v.w);
}
__device__ __forceinline__ void d_peer(const Params& P, int gw, int ngw, int lane) {
    for (long t = gw; t < TOK; t += ngw) {
        const u32x4* xr = (const u32x4*)(P.HB + (size_t)t * 1024); const u32x4 x0 = xr[lane], x1 = xr[64 + lane];
        const int e_lo = P.EXPERT[(size_t)t * 128 + lane], e_hi = P.EXPERT[(size_t)t * 128 + 64 + lane];
        const float g_lo = P.GATE[(size_t)t * 128 + lane], g_hi = P.GATE[(size_t)t * 128 + 64 + lane];
        float y[16];
#pragma unroll
        for (int i = 0; i < 16; ++i) y[i] = 0.f;
#pragma unroll 1
        for (int half = 0; half < 2; ++half) {
            const int ev = half ? e_hi : e_lo; const float gv = half ? g_hi : g_lo;
#pragma unroll 1
            for (int k0 = 0; k0 < 64; k0 += 4) {
                int e[4]; float gt[4]; u32x4 u0[4], u1[4], v0[4], v1[4];
#pragma unroll
                for (int q = 0; q < 4; ++q) { e[q] = __builtin_amdgcn_readlane(ev, k0 + q); gt[q] = __uint_as_float(__builtin_amdgcn_readlane(__float_as_uint(gv), k0 + q)); }
#pragma unroll
                for (int q = 0; q < 4; ++q) { const u32x4* ur = (const u32x4*)(P.UB + (size_t)e[q] * 1024); u0[q] = ur[lane]; u1[q] = ur[64 + lane]; }
#pragma unroll
                for (int q = 0; q < 4; ++q) { const u32x4* vr = (const u32x4*)(P.VB + (size_t)e[q] * 1024); v0[q] = vr[lane]; v1[q] = vr[64 + lane]; }
                float d[4];
#pragma unroll
                for (int q = 0; q < 4; ++q) d[q] = dot8(u1[q], x1, dot8(u0[q], x0, 0.f));
#pragma unroll
                for (int o = 1; o < 64; o <<= 1) {
#pragma unroll
                    for (int q = 0; q < 4; ++q) d[q] += __shfl_xor(d[q], o); }
#pragma unroll
                for (int q = 0; q < 4; ++q) { const float a = d[q]; const float c = gt[q] * 0.5f * a * (1.0f + erff(a * 0.7071067811865476f)); axpy8(y, c, v0[q]); axpy8(y + 8, c, v1[q]); }
            }
        }
        float z[16];
        z[0] = ALPHA_F * blo(x0.x) + y[0]; z[1] = ALPHA_F * bhi(x0.x) + y[1]; z[2] = ALPHA_F * blo(x0.y) + y[2]; z[3] = ALPHA_F * bhi(x0.y) + y[3];
        z[4] = ALPHA_F * blo(x0.z) + y[4]; z[5] = ALPHA_F * bhi(x0.z) + y[5]; z[6] = ALPHA_F * blo(x0.w) + y[6]; z[7] = ALPHA_F * bhi(x0.w) + y[7];
        z[8] = ALPHA_F * blo(x1.x) + y[8]; z[9] = ALPHA_F * bhi(x1.x) + y[9]; z[10] = ALPHA_F * blo(x1.y) + y[10]; z[11] = ALPHA_F * bhi(x1.y) + y[11];
        z[12] = ALPHA_F * blo(x1.z) + y[12]; z[13] = ALPHA_F * bhi(x1.z) + y[13]; z[14] = ALPHA_F * blo(x1.w) + y[14]; z[15] = ALPHA_F * bhi(x1.w) + y[15];
        float s = 0.f;
#pragma unroll
        for (int i = 0; i < 16; ++i) s += z[i];
        const float mean = wave_sum(s) * (1.f / 1024.f); float s2 = 0.f;
#pragma unroll
        for (int i = 0; i < 16; ++i) { z[i] -= mean; s2 += z[i] * z[i]; }
        const float rstd = 1.f / sqrtf(wave_sum(s2) * (1.f / 1024.f) + 1e-5f);
        const float* g = P.in[I_LN3_G]; const float* b = P.in[I_LN3_B]; float* orow = P.out + (size_t)t * 1024;
#pragma unroll
        for (int hh = 0; hh < 2; ++hh)
#pragma unroll
            for (int q = 0; q < 2; ++q) { const int col = hh * 512 + lane * 8 + q * 4; const f32x4 gg = *(const f32x4*)(g + col), bb = *(const f32x4*)(b + col);
                f32x4 o; o[0] = z[hh * 8 + q * 4 + 0] * rstd * gg[0] + bb[0]; o[1] = z[hh * 8 + q * 4 + 1] * rstd * gg[1] + bb[1];
                o[2] = z[hh * 8 + q * 4 + 2] * rstd * gg[2] + bb[2]; o[3] = z[hh * 8 + q * 4 + 3] * rstd * gg[3] + bb[3];
                *(f32x4*)(orow + col) = o; }
    }
}

__device__ __forceinline__ void d_lora_weights(const Params& P, long gtid, long nthr) {
    for (long idx = gtid; idx < (long)2560 * 512; idx += nthr) { const int n = (int)(idx / 512), k = (int)(idx % 512); float v = 0.f;
        if (n < 1024) { const int z = n >> 9, c = n & 511; if (k >= z * 64 && k < z * 64 + 64) v = P.in[I_W2][((size_t)z * 64 + (k - z * 64)) * 512 + c]; }
        else if (n < 2048) { const int z = (n - 1024) >> 9, c = n & 511; const int kk = k - 128; if (kk >= z * 64 && kk < z * 64 + 64) v = P.in[I_A2][((size_t)z * 64 + (kk - z * 64)) * 512 + c]; }
        else { const int c = n - 2048; if (k >= 256 && k < 384) v = P.in[I_G2][(size_t)(k - 256) * 512 + c]; }
        P.W_LORA_T[idx] = f2bf(v); }
    for (long idx = gtid; idx < (long)8 * 128 * 128; idx += nthr) P.WSB[idx] = f2bf(P.in[I_W_S][idx]);
}
__device__ __forceinline__ void shift8(const bf16_t* PA, long t, int s, int col, const float* mu, float* o) {
    const u32x4 c = *(const u32x4*)(PA + (size_t)t * 2048 + col);
    u32x4 p = (u32x4){0u, 0u, 0u, 0u}, n = (u32x4){0u, 0u, 0u, 0u};
    if (s > 0) p = *(const u32x4*)(PA + (size_t)(t - 1) * 2048 + col);
    if (s < SEQ - 1) n = *(const u32x4*)(PA + (size_t)(t + 1) * 2048 + col);
    const f32x4 m0 = *(const f32x4*)(mu + col), m1 = *(const f32x4*)(mu + col + 4);
    const float cc[8] = {blo(c.x), bhi(c.x), blo(c.y), bhi(c.y), blo(c.z), bhi(c.z), blo(c.w), bhi(c.w)};
    const float pp[8] = {blo(p.x), bhi(p.x), blo(p.y), bhi(p.y), blo(p.z), bhi(p.z), blo(p.w), bhi(p.w)};
    const float nn[8] = {blo(n.x), bhi(n.x), blo(n.y), bhi(n.y), blo(n.z), bhi(n.z), blo(n.w), bhi(n.w)};
#pragma unroll
    for (int i = 0; i < 8; ++i) { const float m = (i < 4) ? m0[i] : m1[i - 4]; o[i] = cc[i] + m * (0.5f * (pp[i] + nn[i]) - cc[i]); }
}
__device__ __forceinline__ u32x4 pack8f(const float* v) { u32x4 w; w.x = pk2(v[0], v[1]); w.y = pk2(v[2], v[3]); w.z = pk2(v[4], v[5]); w.w = pk2(v[6], v[7]); return w; }
__device__ __forceinline__ void d_prep_e1(const Params& P, int gw, int ngw, int lane) {
    const float* mu = P.in[I_MU];
    const f32x4 kk0 = *(const f32x4*)(P.in[I_K_K] + 8 * lane), kk1 = *(const f32x4*)(P.in[I_K_K] + 8 * lane + 4);
    for (long t = gw; t < TOK; t += ngw) { const int s = (int)(t % SEQ); float r[8], k[8], v[8];
        shift8(P.PA, t, s, 8 * lane, mu, r); shift8(P.PA, t, s, 512 + 8 * lane, mu, k); shift8(P.PA, t, s, 1024 + 8 * lane, mu, v);
        float q[8]; float ss = 0.f;
#pragma unroll
        for (int i = 0; i < 8; ++i) { q[i] = k[i] * ((i < 4) ? kk0[i] : kk1[i - 4]); ss += q[i] * q[i]; }
        ss += __shfl_xor(ss, 1); ss += __shfl_xor(ss, 2); ss += __shfl_xor(ss, 4);
        const float inv = 1.0f / fmaxf(sqrtf(ss), 1e-12f);
#pragma unroll
        for (int i = 0; i < 8; ++i) q[i] *= inv;
        *(u32x4*)(P.R + (size_t)t * 512 + 8 * lane) = pack8f(r); *(u32x4*)(P.K + (size_t)t * 512 + 8 * lane) = pack8f(k);
        *(u32x4*)(P.V + (size_t)t * 512 + 8 * lane) = pack8f(v); *(u32x4*)(P.KK + (size_t)t * 512 + 8 * lane) = pack8f(q);
        if (lane < 48) { float x[8]; shift8(P.PA, t, s, 1536 + 8 * lane, mu, x);
#pragma unroll
            for (int i = 0; i < 8; ++i) x[i] = (lane < 16) ? tanhf(x[i]) : (lane < 32) ? x[i] : 1.0f / (1.0f + expf(-x[i]));
            *(u32x4*)(P.LIN + (size_t)t * 512 + 8 * lane) = pack8f(x); }
        else *(u32x4*)(P.LIN + (size_t)t * 512 + 8 * lane) = (u32x4){0u, 0u, 0u, 0u};
    }
}
__device__ __forceinline__ void scan_item3(const Params& P, int chain, int i) {
    const int h = chain % 8, b = (chain / 8) % BATCH, z = chain / (8 * BATCH);
    float S[64];
#pragma unroll
    for (int j = 0; j < 64; ++j) S[j] = 0.f;
    const float* ka = P.in[I_K_A] + h * 64;
    for (int n = 0; n < SEQ; ++n) {
        const long t = (long)b * SEQ + ((z == 0) ? n : (SEQ - 1 - n)); const size_t o1 = (size_t)t * 512 + h * 64, o2 = ((size_t)t * 2 + z) * 512 + h * 64;
        const float v = bf2f(P.V[o1 + i]);
        float sa = 0.f;
#pragma unroll
        for (int j = 0; j < 64; ++j) sa -= S[j] * bf2f(P.KK[o1 + j]);
        float y = 0.f;
#pragma unroll
        for (int j = 0; j < 64; ++j) { const float al = bf2f(P.AL[o2 + j]), k = bf2f(P.K[o1 + j]);
            S[j] = S[j] * (1.0f - bf2f(P.OMW[o2 + j])) + sa * (bf2f(P.KK[o1 + j]) * al) + v * (k * (1.0f + (al - 1.0f) * ka[j])); y += S[j] * bf2f(P.R[o1 + j]); }
        P.Y01[((size_t)z * TOK + t) * 512 + h * 64 + i] = y;
    }
}

#define SC_CH 32
#define SC_REC 352
template <int CTRL> __device__ __forceinline__ float dpp_add(float x) {
    return x + __uint_as_float((unsigned)__builtin_amdgcn_update_dpp(0, (int)__float_as_uint(x), CTRL, 0xf, 0xf, false));
}
__device__ __forceinline__ float allsum16(float x) { x = dpp_add<0xB1>(x); x = dpp_add<0x4E>(x); x = dpp_add<0x141>(x); x = dpp_add<0x140>(x); return x; }
__device__ __forceinline__ void d_scan(const Params& P, LAS unsigned char* lds, int tid) {
    const int lane = tid & 63, wave = __builtin_amdgcn_readfirstlane(tid >> 6);
    const int chain = (int)blockIdx.x >> 1, half = (int)blockIdx.x & 1;
    if (chain >= 2 * BATCH * 8) return;
    const int h = chain % 8, b = (chain / 8) % BATCH, z = chain / (8 * BATCH);
    LAS float* buf = (LAS float*)lds;
    const float ka = P.in[I_K_A][h * 64 + lane];
    const long tb = (long)b * SEQ;
    unsigned short gr[4], gk[4], gkk[4], gom[4], gal[4], gv[2];
    auto g_load = [&](int c) {
#pragma unroll
        for (int q = 0; q < 4; ++q) { const int n = c * SC_CH + wave + 8 * q; const long t = tb + ((z == 0) ? n : (SEQ - 1 - n));
            const size_t o1 = (size_t)t * 512 + h * 64 + lane, o2 = ((size_t)t * 2 + z) * 512 + h * 64 + lane;
            gr[q] = P.R[o1]; gk[q] = P.K[o1]; gkk[q] = P.KK[o1]; gom[q] = P.OMW[o2]; gal[q] = P.AL[o2]; }
#pragma unroll
        for (int q = 0; q < 2; ++q) { const int p = tid + 512 * q; const int n = c * SC_CH + (p >> 5); const long t = tb + ((z == 0) ? n : (SEQ - 1 - n));
            gv[q] = P.V[(size_t)t * 512 + h * 64 + half * 32 + (p & 31)]; }
    };
    auto s_write = [&](int c) {
        LAS float* bb = buf + (c & 1) * (SC_CH * SC_REC);
#pragma unroll
        for (int q = 0; q < 4; ++q) { LAS float* rec = bb + (wave + 8 * q) * SC_REC + lane;
            const float k = bf2f(gk[q]), kk = bf2f(gkk[q]), al = bf2f(gal[q]);
            rec[0] = 1.0f - bf2f(gom[q]); rec[64] = k * (1.0f + (al - 1.0f) * ka); rec[128] = -kk; rec[192] = kk * al; rec[256] = bf2f(gr[q]); }
#pragma unroll
        for (int q = 0; q < 2; ++q) { const int p = tid + 512 * q; bb[(p >> 5) * SC_REC + 320 + (p & 31)] = bf2f(gv[q]); }
    };
    const int rg = lane >> 4, jl = lane & 15, rowl = wave * 4 + rg;
    float S0 = 0.f, S1 = 0.f, S2 = 0.f, S3 = 0.f;
    g_load(0); s_write(0); g_load(1);
    asm volatile("s_waitcnt lgkmcnt(0)" ::: "memory"); __syncthreads();
    float* yout = P.Y01 + (size_t)z * TOK * 512 + h * 64 + half * 32 + rowl;
    constexpr int NCH = SEQ / SC_CH;
#pragma unroll 1
    for (int c = 0; c < NCH; ++c) {
        if (c + 1 < NCH) s_write(c + 1);
        if (c + 2 < NCH) g_load(c + 2);
        const LAS float* bb = buf + (c & 1) * (SC_CH * SC_REC);
#pragma unroll 4
        for (int nl = 0; nl < SC_CH; ++nl) { const LAS float* rec = bb + nl * SC_REC + jl * 4;
            const f32x4 w4 = *(const LAS f32x4*)(rec), kd4 = *(const LAS f32x4*)(rec + 64), a4 = *(const LAS f32x4*)(rec + 128), b4 = *(const LAS f32x4*)(rec + 192), r4 = *(const LAS f32x4*)(rec + 256);
            const float v = bb[nl * SC_REC + 320 + rowl];
            float sa = (S0 * a4[0] + S1 * a4[1]) + (S2 * a4[2] + S3 * a4[3]);
            sa = allsum16(sa);
            S0 = S0 * w4[0] + (sa * b4[0] + v * kd4[0]); S1 = S1 * w4[1] + (sa * b4[1] + v * kd4[1]);
            S2 = S2 * w4[2] + (sa * b4[2] + v * kd4[2]); S3 = S3 * w4[3] + (sa * b4[3] + v * kd4[3]);
            float y = (S0 * r4[0] + S1 * r4[1]) + (S2 * r4[2] + S3 * r4[3]);
            y = allsum16(y);
            const int n = c * SC_CH + nl; const long t = tb + ((z == 0) ? n : (SEQ - 1 - n));
            if (jl == 0) yout[(size_t)t * 512] = y;
        }
        asm volatile("s_waitcnt lgkmcnt(0)" ::: "memory"); __syncthreads();
    }
}
__device__ __forceinline__ void d_rwkv_out(const Params& P, int gw, int ngw, int lane) {
    for (long it = gw; it < (long)TOK * 8; it += ngw) { const long t = it >> 3; const int c = (int)(it & 7) * 64 + lane;
        const float y = P.Y01[(size_t)t * 512 + c] + P.Y01[((size_t)TOK + t) * 512 + c];
        const float mu = wave_sum(y) * (1.f / 64.f); const float d = y - mu; const float rs = 1.0f / sqrtf(wave_sum(d * d) * (1.f / 64.f) + 64e-5f);
        const float yn = d * rs * P.in[I_GN_G][c] + P.in[I_GN_B][c];
        const float r = bf2f(P.R[(size_t)t * 512 + c]), k = bf2f(P.K[(size_t)t * 512 + c]), ka = P.in[I_K_A][c];
        const float a0 = bf2f(P.AL[((size_t)t * 2) * 512 + c]), a1 = bf2f(P.AL[((size_t)t * 2 + 1) * 512 + c]);
        const float kd = k * (1.0f + (a0 - 1.0f) * ka) + k * (1.0f + (a1 - 1.0f) * ka);
        const float rk = wave_sum(r * kd * P.in[I_R_K][c]);
        P.YA[(size_t)t * 512 + c] = f2bf((yn + rk * bf2f(P.V[(size_t)t * 512 + c])) * bf2f(P.G[(size_t)t * 512 + c])); }
}

typedef short bf16x8v __attribute__((ext_vector_type(8)));
typedef float f32x16v __attribute__((ext_vector_type(16)));
#define RT_SKROW 272
__device__ __forceinline__ unsigned f2key(float f) { const unsigned u = __float_as_uint(f); return (u & 0x80000000u) ? ~u : (u | 0x80000000u); }
__device__ __forceinline__ float key2f(unsigned k) { const unsigned u = (k & 0x80000000u) ? (k & 0x7fffffffu) : ~k; return __uint_as_float(u); }
#define DECL16(T, P) T P##0, P##1, P##2, P##3, P##4, P##5, P##6, P##7, P##8, P##9, P##10, P##11, P##12, P##13, P##14, P##15
#define CE_D(a, b) do { const unsigned _hi = max(a, b), _lo = min(a, b); a = _hi; b = _lo; } while (0)
#define CE_A(a, b) do { const unsigned _hi = max(a, b), _lo = min(a, b); a = _lo; b = _hi; } while (0)
#define CEP_D(ka, pa, kb, pb) do { const bool _sw = (kb) > (ka); const unsigned _k0 = _sw ? (kb) : (ka), _k1 = _sw ? (ka) : (kb), _p0 = _sw ? (pb) : (pa), _p1 = _sw ? (pa) : (pb); ka = _k0; kb = _k1; pa = _p0; pb = _p1; } while (0)
#define CEP_A(ka, pa, kb, pb) do { const bool _sw = (kb) < (ka); const unsigned _k0 = _sw ? (kb) : (ka), _k1 = _sw ? (ka) : (kb), _p0 = _sw ? (pb) : (pa), _p1 = _sw ? (pa) : (pb); ka = _k0; kb = _k1; pa = _p0; pb = _p1; } while (0)
#define SORT16_DESC(P) do { CE_D(P##0, P##1); CE_A(P##2, P##3); CE_D(P##4, P##5); CE_A(P##6, P##7); CE_D(P##8, P##9); CE_A(P##10, P##11); CE_D(P##12, P##13); CE_A(P##14, P##15); CE_D(P##0, P##2); CE_D(P##1, P##3); CE_A(P##4, P##6); CE_A(P##5, P##7); CE_D(P##8, P##10); CE_D(P##9, P##11); CE_A(P##12, P##14); CE_A(P##13, P##15); CE_D(P##0, P##1); CE_D(P##2, P##3); CE_A(P##4, P##5); CE_A(P##6, P##7); CE_D(P##8, P##9); CE_D(P##10, P##11); CE_A(P##12, P##13); CE_A(P##14, P##15); CE_D(P##0, P##4); CE_D(P##1, P##5); CE_D(P##2, P##6); CE_D(P##3, P##7); CE_A(P##8, P##12); CE_A(P##9, P##13); CE_A(P##10, P##14); CE_A(P##11, P##15); CE_D(P##0, P##2); CE_D(P##1, P##3); CE_D(P##4, P##6); CE_D(P##5, P##7); CE_A(P##8, P##10); CE_A(P##9, P##11); CE_A(P##12, P##14); CE_A(P##13, P##15); CE_D(P##0, P##1); CE_D(P##2, P##3); CE_D(P##4, P##5); CE_D(P##6, P##7); CE_A(P##8, P##9); CE_A(P##10, P##11); CE_A(P##12, P##13); CE_A(P##14, P##15); CE_D(P##0, P##8); CE_D(P##1, P##9); CE_D(P##2, P##10); CE_D(P##3, P##11); CE_D(P##4, P##12); CE_D(P##5, P##13); CE_D(P##6, P##14); CE_D(P##7, P##15); CE_D(P##0, P##4); CE_D(P##1, P##5); CE_D(P##2, P##6); CE_D(P##3, P##7); CE_D(P##8, P##12); CE_D(P##9, P##13); CE_D(P##10, P##14); CE_D(P##11, P##15); CE_D(P##0, P##2); CE_D(P##1, P##3); CE_D(P##4, P##6); CE_D(P##5, P##7); CE_D(P##8, P##10); CE_D(P##9, P##11); CE_D(P##12, P##14); CE_D(P##13, P##15); CE_D(P##0, P##1); CE_D(P##2, P##3); CE_D(P##4, P##5); CE_D(P##6, P##7); CE_D(P##8, P##9); CE_D(P##10, P##11); CE_D(P##12, P##13); CE_D(P##14, P##15); } while (0)
#define SORT16P_DESC(K, Q) do { CEP_D(K##0, Q##0, K##1, Q##1); CEP_A(K##2, Q##2, K##3, Q##3); CEP_D(K##4, Q##4, K##5, Q##5); CEP_A(K##6, Q##6, K##7, Q##7); CEP_D(K##8, Q##8, K##9, Q##9); CEP_A(K##10, Q##10, K##11, Q##11); CEP_D(K##12, Q##12, K##13, Q##13); CEP_A(K##14, Q##14, K##15, Q##15); CEP_D(K##0, Q##0, K##2, Q##2); CEP_D(K##1, Q##1, K##3, Q##3); CEP_A(K##4, Q##4, K##6, Q##6); CEP_A(K##5, Q##5, K##7, Q##7); CEP_D(K##8, Q##8, K##10, Q##10); CEP_D(K##9, Q##9, K##11, Q##11); CEP_A(K##12, Q##12, K##14, Q##14); CEP_A(K##13, Q##13, K##15, Q##15); CEP_D(K##0, Q##0, K##1, Q##1); CEP_D(K##2, Q##2, K##3, Q##3); CEP_A(K##4, Q##4, K##5, Q##5); CEP_A(K##6, Q##6, K##7, Q##7); CEP_D(K##8, Q##8, K##9, Q##9); CEP_D(K##10, Q##10, K##11, Q##11); CEP_A(K##12, Q##12, K##13, Q##13); CEP_A(K##14, Q##14, K##15, Q##15); CEP_D(K##0, Q##0, K##4, Q##4); CEP_D(K##1, Q##1, K##5, Q##5); CEP_D(K##2, Q##2, K##6, Q##6); CEP_D(K##3, Q##3, K##7, Q##7); CEP_A(K##8, Q##8, K##12, Q##12); CEP_A(K##9, Q##9, K##13, Q##13); CEP_A(K##10, Q##10, K##14, Q##14); CEP_A(K##11, Q##11, K##15, Q##15); CEP_D(K##0, Q##0, K##2, Q##2); CEP_D(K##1, Q##1, K##3, Q##3); CEP_D(K##4, Q##4, K##6, Q##6); CEP_D(K##5, Q##5, K##7, Q##7); CEP_A(K##8, Q##8, K##10, Q##10); CEP_A(K##9, Q##9, K##11, Q##11); CEP_A(K##12, Q##12, K##14, Q##14); CEP_A(K##13, Q##13, K##15, Q##15); CEP_D(K##0, Q##0, K##1, Q##1); CEP_D(K##2, Q##2, K##3, Q##3); CEP_D(K##4, Q##4, K##5, Q##5); CEP_D(K##6, Q##6, K##7, Q##7); CEP_A(K##8, Q##8, K##9, Q##9); CEP_A(K##10, Q##10, K##11, Q##11); CEP_A(K##12, Q##12, K##13, Q##13); CEP_A(K##14, Q##14, K##15, Q##15); CEP_D(K##0, Q##0, K##8, Q##8); CEP_D(K##1, Q##1, K##9, Q##9); CEP_D(K##2, Q##2, K##10, Q##10); CEP_D(K##3, Q##3, K##11, Q##11); CEP_D(K##4, Q##4, K##12, Q##12); CEP_D(K##5, Q##5, K##13, Q##13); CEP_D(K##6, Q##6, K##14, Q##14); CEP_D(K##7, Q##7, K##15, Q##15); CEP_D(K##0, Q##0, K##4, Q##4); CEP_D(K##1, Q##1, K##5, Q##5); CEP_D(K##2, Q##2, K##6, Q##6); CEP_D(K##3, Q##3, K##7, Q##7); CEP_D(K##8, Q##8, K##12, Q##12); CEP_D(K##9, Q##9, K##13, Q##13); CEP_D(K##10, Q##10, K##14, Q##14); CEP_D(K##11, Q##11, K##15, Q##15); CEP_D(K##0, Q##0, K##2, Q##2); CEP_D(K##1, Q##1, K##3, Q##3); CEP_D(K##4, Q##4, K##6, Q##6); CEP_D(K##5, Q##5, K##7, Q##7); CEP_D(K##8, Q##8, K##10, Q##10); CEP_D(K##9, Q##9, K##11, Q##11); CEP_D(K##12, Q##12, K##14, Q##14); CEP_D(K##13, Q##13, K##15, Q##15); CEP_D(K##0, Q##0, K##1, Q##1); CEP_D(K##2, Q##2, K##3, Q##3); CEP_D(K##4, Q##4, K##5, Q##5); CEP_D(K##6, Q##6, K##7, Q##7); CEP_D(K##8, Q##8, K##9, Q##9); CEP_D(K##10, Q##10, K##11, Q##11); CEP_D(K##12, Q##12, K##13, Q##13); CEP_D(K##14, Q##14, K##15, Q##15); } while (0)
#define MERGE16_DESC(A, B) do { A##0 = max(A##0, B##15); A##1 = max(A##1, B##14); A##2 = max(A##2, B##13); A##3 = max(A##3, B##12); A##4 = max(A##4, B##11); A##5 = max(A##5, B##10); A##6 = max(A##6, B##9); A##7 = max(A##7, B##8); A##8 = max(A##8, B##7); A##9 = max(A##9, B##6); A##10 = max(A##10, B##5); A##11 = max(A##11, B##4); A##12 = max(A##12, B##3); A##13 = max(A##13, B##2); A##14 = max(A##14, B##1); A##15 = max(A##15, B##0); CE_D(A##0, A##8); CE_D(A##1, A##9); CE_D(A##2, A##10); CE_D(A##3, A##11); CE_D(A##4, A##12); CE_D(A##5, A##13); CE_D(A##6, A##14); CE_D(A##7, A##15); CE_D(A##0, A##4); CE_D(A##1, A##5); CE_D(A##2, A##6); CE_D(A##3, A##7); CE_D(A##8, A##12); CE_D(A##9, A##13); CE_D(A##10, A##14); CE_D(A##11, A##15); CE_D(A##0, A##2); CE_D(A##1, A##3); CE_D(A##4, A##6); CE_D(A##5, A##7); CE_D(A##8, A##10); CE_D(A##9, A##11); CE_D(A##12, A##14); CE_D(A##13, A##15); CE_D(A##0, A##1); CE_D(A##2, A##3); CE_D(A##4, A##5); CE_D(A##6, A##7); CE_D(A##8, A##9); CE_D(A##10, A##11); CE_D(A##12, A##13); CE_D(A##14, A##15); } while (0)
#define MERGE16P_DESC(A, PA, B, PB) do { { const bool _s = B##15 > A##0; PA##0 = _s ? PB##15 : PA##0; A##0 = _s ? B##15 : A##0; } { const bool _s = B##14 > A##1; PA##1 = _s ? PB##14 : PA##1; A##1 = _s ? B##14 : A##1; } { const bool _s = B##13 > A##2; PA##2 = _s ? PB##13 : PA##2; A##2 = _s ? B##13 : A##2; } { const bool _s = B##12 > A##3; PA##3 = _s ? PB##12 : PA##3; A##3 = _s ? B##12 : A##3; } { const bool _s = B##11 > A##4; PA##4 = _s ? PB##11 : PA##4; A##4 = _s ? B##11 : A##4; } { const bool _s = B##10 > A##5; PA##5 = _s ? PB##10 : PA##5; A##5 = _s ? B##10 : A##5; } { const bool _s = B##9 > A##6; PA##6 = _s ? PB##9 : PA##6; A##6 = _s ? B##9 : A##6; } { const bool _s = B##8 > A##7; PA##7 = _s ? PB##8 : PA##7; A##7 = _s ? B##8 : A##7; } { const bool _s = B##7 > A##8; PA##8 = _s ? PB##7 : PA##8; A##8 = _s ? B##7 : A##8; } { const bool _s = B##6 > A##9; PA##9 = _s ? PB##6 : PA##9; A##9 = _s ? B##6 : A##9; } { const bool _s = B##5 > A##10; PA##10 = _s ? PB##5 : PA##10; A##10 = _s ? B##5 : A##10; } { const bool _s = B##4 > A##11; PA##11 = _s ? PB##4 : PA##11; A##11 = _s ? B##4 : A##11; } { const bool _s = B##3 > A##12; PA##12 = _s ? PB##3 : PA##12; A##12 = _s ? B##3 : A##12; } { const bool _s = B##2 > A##13; PA##13 = _s ? PB##2 : PA##13; A##13 = _s ? B##2 : A##13; } { const bool _s = B##1 > A##14; PA##14 = _s ? PB##1 : PA##14; A##14 = _s ? B##1 : A##14; } { const bool _s = B##0 > A##15; PA##15 = _s ? PB##0 : PA##15; A##15 = _s ? B##0 : A##15; } CEP_D(A##0, PA##0, A##8, PA##8); CEP_D(A##1, PA##1, A##9, PA##9); CEP_D(A##2, PA##2, A##10, PA##10); CEP_D(A##3, PA##3, A##11, PA##11); CEP_D(A##4, PA##4, A##12, PA##12); CEP_D(A##5, PA##5, A##13, PA##13); CEP_D(A##6, PA##6, A##14, PA##14); CEP_D(A##7, PA##7, A##15, PA##15); CEP_D(A##0, PA##0, A##4, PA##4); CEP_D(A##1, PA##1, A##5, PA##5); CEP_D(A##2, PA##2, A##6, PA##6); CEP_D(A##3, PA##3, A##7, PA##7); CEP_D(A##8, PA##8, A##12, PA##12); CEP_D(A##9, PA##9, A##13, PA##13); CEP_D(A##10, PA##10, A##14, PA##14); CEP_D(A##11, PA##11, A##15, PA##15); CEP_D(A##0, PA##0, A##2, PA##2); CEP_D(A##1, PA##1, A##3, PA##3); CEP_D(A##4, PA##4, A##6, PA##6); CEP_D(A##5, PA##5, A##7, PA##7); CEP_D(A##8, PA##8, A##10, PA##10); CEP_D(A##9, PA##9, A##11, PA##11); CEP_D(A##12, PA##12, A##14, PA##14); CEP_D(A##13, PA##13, A##15, PA##15); CEP_D(A##0, PA##0, A##1, PA##1); CEP_D(A##2, PA##2, A##3, PA##3); CEP_D(A##4, PA##4, A##5, PA##5); CEP_D(A##6, PA##6, A##7, PA##7); CEP_D(A##8, PA##8, A##9, PA##9); CEP_D(A##10, PA##10, A##11, PA##11); CEP_D(A##12, PA##12, A##13, PA##13); CEP_D(A##14, PA##14, A##15, PA##15); } while (0)
#define FILL_G0(P, ACC, HH) do { P##0 = (f2key(ACC[0]) & ~0x7fu) | (unsigned)(127 - (0 + 4 * (HH))); P##1 = (f2key(ACC[1]) & ~0x7fu) | (unsigned)(127 - (1 + 4 * (HH))); P##2 = (f2key(ACC[2]) & ~0x7fu) | (unsigned)(127 - (2 + 4 * (HH))); P##3 = (f2key(ACC[3]) & ~0x7fu) | (unsigned)(127 - (3 + 4 * (HH))); P##4 = (f2key(ACC[4]) & ~0x7fu) | (unsigned)(127 - (8 + 4 * (HH))); P##5 = (f2key(ACC[5]) & ~0x7fu) | (unsigned)(127 - (9 + 4 * (HH))); P##6 = (f2key(ACC[6]) & ~0x7fu) | (unsigned)(127 - (10 + 4 * (HH))); P##7 = (f2key(ACC[7]) & ~0x7fu) | (unsigned)(127 - (11 + 4 * (HH))); P##8 = (f2key(ACC[8]) & ~0x7fu) | (unsigned)(127 - (16 + 4 * (HH))); P##9 = (f2key(ACC[9]) & ~0x7fu) | (unsigned)(127 - (17 + 4 * (HH))); P##10 = (f2key(ACC[10]) & ~0x7fu) | (unsigned)(127 - (18 + 4 * (HH))); P##11 = (f2key(ACC[11]) & ~0x7fu) | (unsigned)(127 - (19 + 4 * (HH))); P##12 = (f2key(ACC[12]) & ~0x7fu) | (unsigned)(127 - (24 + 4 * (HH))); P##13 = (f2key(ACC[13]) & ~0x7fu) | (unsigned)(127 - (25 + 4 * (HH))); P##14 = (f2key(ACC[14]) & ~0x7fu) | (unsigned)(127 - (26 + 4 * (HH))); P##15 = (f2key(ACC[15]) & ~0x7fu) | (unsigned)(127 - (27 + 4 * (HH))); } while (0)
#define FILL_G1(P, ACC, HH) do { P##0 = (f2key(ACC[0]) & ~0x7fu) | (unsigned)(127 - (32 + 4 * (HH))); P##1 = (f2key(ACC[1]) & ~0x7fu) | (unsigned)(127 - (33 + 4 * (HH))); P##2 = (f2key(ACC[2]) & ~0x7fu) | (unsigned)(127 - (34 + 4 * (HH))); P##3 = (f2key(ACC[3]) & ~0x7fu) | (unsigned)(127 - (35 + 4 * (HH))); P##4 = (f2key(ACC[4]) & ~0x7fu) | (unsigned)(127 - (40 + 4 * (HH))); P##5 = (f2key(ACC[5]) & ~0x7fu) | (unsigned)(127 - (41 + 4 * (HH))); P##6 = (f2key(ACC[6]) & ~0x7fu) | (unsigned)(127 - (42 + 4 * (HH))); P##7 = (f2key(ACC[7]) & ~0x7fu) | (unsigned)(127 - (43 + 4 * (HH))); P##8 = (f2key(ACC[8]) & ~0x7fu) | (unsigned)(127 - (48 + 4 * (HH))); P##9 = (f2key(ACC[9]) & ~0x7fu) | (unsigned)(127 - (49 + 4 * (HH))); P##10 = (f2key(ACC[10]) & ~0x7fu) | (unsigned)(127 - (50 + 4 * (HH))); P##11 = (f2key(ACC[11]) & ~0x7fu) | (unsigned)(127 - (51 + 4 * (HH))); P##12 = (f2key(ACC[12]) & ~0x7fu) | (unsigned)(127 - (56 + 4 * (HH))); P##13 = (f2key(ACC[13]) & ~0x7fu) | (unsigned)(127 - (57 + 4 * (HH))); P##14 = (f2key(ACC[14]) & ~0x7fu) | (unsigned)(127 - (58 + 4 * (HH))); P##15 = (f2key(ACC[15]) & ~0x7fu) | (unsigned)(127 - (59 + 4 * (HH))); } while (0)
#define FILL_G2(P, ACC, HH) do { P##0 = (f2key(ACC[0]) & ~0x7fu) | (unsigned)(127 - (64 + 4 * (HH))); P##1 = (f2key(ACC[1]) & ~0x7fu) | (unsigned)(127 - (65 + 4 * (HH))); P##2 = (f2key(ACC[2]) & ~0x7fu) | (unsigned)(127 - (66 + 4 * (HH))); P##3 = (f2key(ACC[3]) & ~0x7fu) | (unsigned)(127 - (67 + 4 * (HH))); P##4 = (f2key(ACC[4]) & ~0x7fu) | (unsigned)(127 - (72 + 4 * (HH))); P##5 = (f2key(ACC[5]) & ~0x7fu) | (unsigned)(127 - (73 + 4 * (HH))); P##6 = (f2key(ACC[6]) & ~0x7fu) | (unsigned)(127 - (74 + 4 * (HH))); P##7 = (f2key(ACC[7]) & ~0x7fu) | (unsigned)(127 - (75 + 4 * (HH))); P##8 = (f2key(ACC[8]) & ~0x7fu) | (unsigned)(127 - (80 + 4 * (HH))); P##9 = (f2key(ACC[9]) & ~0x7fu) | (unsigned)(127 - (81 + 4 * (HH))); P##10 = (f2key(ACC[10]) & ~0x7fu) | (unsigned)(127 - (82 + 4 * (HH))); P##11 = (f2key(ACC[11]) & ~0x7fu) | (unsigned)(127 - (83 + 4 * (HH))); P##12 = (f2key(ACC[12]) & ~0x7fu) | (unsigned)(127 - (88 + 4 * (HH))); P##13 = (f2key(ACC[13]) & ~0x7fu) | (unsigned)(127 - (89 + 4 * (HH))); P##14 = (f2key(ACC[14]) & ~0x7fu) | (unsigned)(127 - (90 + 4 * (HH))); P##15 = (f2key(ACC[15]) & ~0x7fu) | (unsigned)(127 - (91 + 4 * (HH))); } while (0)
#define FILL_G3(P, ACC, HH) do { P##0 = (f2key(ACC[0]) & ~0x7fu) | (unsigned)(127 - (96 + 4 * (HH))); P##1 = (f2key(ACC[1]) & ~0x7fu) | (unsigned)(127 - (97 + 4 * (HH))); P##2 = (f2key(ACC[2]) & ~0x7fu) | (unsigned)(127 - (98 + 4 * (HH))); P##3 = (f2key(ACC[3]) & ~0x7fu) | (unsigned)(127 - (99 + 4 * (HH))); P##4 = (f2key(ACC[4]) & ~0x7fu) | (unsigned)(127 - (104 + 4 * (HH))); P##5 = (f2key(ACC[5]) & ~0x7fu) | (unsigned)(127 - (105 + 4 * (HH))); P##6 = (f2key(ACC[6]) & ~0x7fu) | (unsigned)(127 - (106 + 4 * (HH))); P##7 = (f2key(ACC[7]) & ~0x7fu) | (unsigned)(127 - (107 + 4 * (HH))); P##8 = (f2key(ACC[8]) & ~0x7fu) | (unsigned)(127 - (112 + 4 * (HH))); P##9 = (f2key(ACC[9]) & ~0x7fu) | (unsigned)(127 - (113 + 4 * (HH))); P##10 = (f2key(ACC[10]) & ~0x7fu) | (unsigned)(127 - (114 + 4 * (HH))); P##11 = (f2key(ACC[11]) & ~0x7fu) | (unsigned)(127 - (115 + 4 * (HH))); P##12 = (f2key(ACC[12]) & ~0x7fu) | (unsigned)(127 - (120 + 4 * (HH))); P##13 = (f2key(ACC[13]) & ~0x7fu) | (unsigned)(127 - (121 + 4 * (HH))); P##14 = (f2key(ACC[14]) & ~0x7fu) | (unsigned)(127 - (122 + 4 * (HH))); P##15 = (f2key(ACC[15]) & ~0x7fu) | (unsigned)(127 - (123 + 4 * (HH))); } while (0)
#define XCHG16(O, A) do { O##0 = (unsigned)__shfl_xor((int)A##0, 32); O##1 = (unsigned)__shfl_xor((int)A##1, 32); O##2 = (unsigned)__shfl_xor((int)A##2, 32); O##3 = (unsigned)__shfl_xor((int)A##3, 32); O##4 = (unsigned)__shfl_xor((int)A##4, 32); O##5 = (unsigned)__shfl_xor((int)A##5, 32); O##6 = (unsigned)__shfl_xor((int)A##6, 32); O##7 = (unsigned)__shfl_xor((int)A##7, 32); O##8 = (unsigned)__shfl_xor((int)A##8, 32); O##9 = (unsigned)__shfl_xor((int)A##9, 32); O##10 = (unsigned)__shfl_xor((int)A##10, 32); O##11 = (unsigned)__shfl_xor((int)A##11, 32); O##12 = (unsigned)__shfl_xor((int)A##12, 32); O##13 = (unsigned)__shfl_xor((int)A##13, 32); O##14 = (unsigned)__shfl_xor((int)A##14, 32); O##15 = (unsigned)__shfl_xor((int)A##15, 32); } while (0)
#define COPY16(D, S) do { D##0 = S##0; D##1 = S##1; D##2 = S##2; D##3 = S##3; D##4 = S##4; D##5 = S##5; D##6 = S##6; D##7 = S##7; D##8 = S##8; D##9 = S##9; D##10 = S##10; D##11 = S##11; D##12 = S##12; D##13 = S##13; D##14 = S##14; D##15 = S##15; } while (0)
#define FILL_CANDS() do { ck0_0 = (f2key(key2f(ta0 & ~0x7fu) + key2f(tb0 & ~0x7fu)) & ~0xffu) | 255u; ck0_1 = (f2key(key2f(ta0 & ~0x7fu) + key2f(tb1 & ~0x7fu)) & ~0xffu) | 254u; ck0_2 = (f2key(key2f(ta0 & ~0x7fu) + key2f(tb2 & ~0x7fu)) & ~0xffu) | 253u; ck0_3 = (f2key(key2f(ta0 & ~0x7fu) + key2f(tb3 & ~0x7fu)) & ~0xffu) | 252u; ck0_4 = (f2key(key2f(ta0 & ~0x7fu) + key2f(tb4 & ~0x7fu)) & ~0xffu) | 251u; ck0_5 = (f2key(key2f(ta0 & ~0x7fu) + key2f(tb5 & ~0x7fu)) & ~0xffu) | 250u; ck0_6 = (f2key(key2f(ta0 & ~0x7fu) + key2f(tb6 & ~0x7fu)) & ~0xffu) | 249u; ck0_7 = (f2key(key2f(ta0 & ~0x7fu) + key2f(tb7 & ~0x7fu)) & ~0xffu) | 248u; ck0_8 = (f2key(key2f(ta0 & ~0x7fu) + key2f(tb8 & ~0x7fu)) & ~0xffu) | 247u; ck0_9 = (f2key(key2f(ta0 & ~0x7fu) + key2f(tb9 & ~0x7fu)) & ~0xffu) | 246u; ck0_10 = (f2key(key2f(ta0 & ~0x7fu) + key2f(tb10 & ~0x7fu)) & ~0xffu) | 245u; ck0_11 = (f2key(key2f(ta0 & ~0x7fu) + key2f(tb11 & ~0x7fu)) & ~0xffu) | 244u; ck0_12 = (f2key(key2f(ta0 & ~0x7fu) + key2f(tb12 & ~0x7fu)) & ~0xffu) | 243u; ck0_13 = (f2key(key2f(ta0 & ~0x7fu) + key2f(tb13 & ~0x7fu)) & ~0xffu) | 242u; ck0_14 = (f2key(key2f(ta0 & ~0x7fu) + key2f(tb14 & ~0x7fu)) & ~0xffu) | 241u; ck0_15 = (f2key(key2f(ta0 & ~0x7fu) + key2f(tb15 & ~0x7fu)) & ~0xffu) | 240u; ck1_0 = (f2key(key2f(ta1 & ~0x7fu) + key2f(tb0 & ~0x7fu)) & ~0xffu) | 239u; ck1_1 = (f2key(key2f(ta1 & ~0x7fu) + key2f(tb1 & ~0x7fu)) & ~0xffu) | 238u; ck1_2 = (f2key(key2f(ta1 & ~0x7fu) + key2f(tb2 & ~0x7fu)) & ~0xffu) | 237u; ck1_3 = (f2key(key2f(ta1 & ~0x7fu) + key2f(tb3 & ~0x7fu)) & ~0xffu) | 236u; ck1_4 = (f2key(key2f(ta1 & ~0x7fu) + key2f(tb4 & ~0x7fu)) & ~0xffu) | 235u; ck1_5 = (f2key(key2f(ta1 & ~0x7fu) + key2f(tb5 & ~0x7fu)) & ~0xffu) | 234u; ck1_6 = (f2key(key2f(ta1 & ~0x7fu) + key2f(tb6 & ~0x7fu)) & ~0xffu) | 233u; ck1_7 = (f2key(key2f(ta1 & ~0x7fu) + key2f(tb7 & ~0x7fu)) & ~0xffu) | 232u; ck1_8 = (f2key(key2f(ta2 & ~0x7fu) + key2f(tb0 & ~0x7fu)) & ~0xffu) | 223u; ck1_9 = (f2key(key2f(ta2 & ~0x7fu) + key2f(tb1 & ~0x7fu)) & ~0xffu) | 222u; ck1_10 = (f2key(key2f(ta2 & ~0x7fu) + key2f(tb2 & ~0x7fu)) & ~0xffu) | 221u; ck1_11 = (f2key(key2f(ta2 & ~0x7fu) + key2f(tb3 & ~0x7fu)) & ~0xffu) | 220u; ck1_12 = (f2key(key2f(ta2 & ~0x7fu) + key2f(tb4 & ~0x7fu)) & ~0xffu) | 219u; ck1_13 = (f2key(key2f(ta3 & ~0x7fu) + key2f(tb0 & ~0x7fu)) & ~0xffu) | 207u; ck1_14 = (f2key(key2f(ta3 & ~0x7fu) + key2f(tb1 & ~0x7fu)) & ~0xffu) | 206u; ck1_15 = (f2key(key2f(ta3 & ~0x7fu) + key2f(tb2 & ~0x7fu)) & ~0xffu) | 205u; ck2_0 = (f2key(key2f(ta3 & ~0x7fu) + key2f(tb3 & ~0x7fu)) & ~0xffu) | 204u; ck2_1 = (f2key(key2f(ta4 & ~0x7fu) + key2f(tb0 & ~0x7fu)) & ~0xffu) | 191u; ck2_2 = (f2key(key2f(ta4 & ~0x7fu) + key2f(tb1 & ~0x7fu)) & ~0xffu) | 190u; ck2_3 = (f2key(key2f(ta4 & ~0x7fu) + key2f(tb2 & ~0x7fu)) & ~0xffu) | 189u; ck2_4 = (f2key(key2f(ta5 & ~0x7fu) + key2f(tb0 & ~0x7fu)) & ~0xffu) | 175u; ck2_5 = (f2key(key2f(ta5 & ~0x7fu) + key2f(tb1 & ~0x7fu)) & ~0xffu) | 174u; ck2_6 = (f2key(key2f(ta6 & ~0x7fu) + key2f(tb0 & ~0x7fu)) & ~0xffu) | 159u; ck2_7 = (f2key(key2f(ta6 & ~0x7fu) + key2f(tb1 & ~0x7fu)) & ~0xffu) | 158u; ck2_8 = (f2key(key2f(ta7 & ~0x7fu) + key2f(tb0 & ~0x7fu)) & ~0xffu) | 143u; ck2_9 = (f2key(key2f(ta7 & ~0x7fu) + key2f(tb1 & ~0x7fu)) & ~0xffu) | 142u; ck2_10 = (f2key(key2f(ta8 & ~0x7fu) + key2f(tb0 & ~0x7fu)) & ~0xffu) | 127u; ck2_11 = (f2key(key2f(ta9 & ~0x7fu) + key2f(tb0 & ~0x7fu)) & ~0xffu) | 111u; ck2_12 = (f2key(key2f(ta10 & ~0x7fu) + key2f(tb0 & ~0x7fu)) & ~0xffu) | 95u; ck2_13 = (f2key(key2f(ta11 & ~0x7fu) + key2f(tb0 & ~0x7fu)) & ~0xffu) | 79u; ck2_14 = (f2key(key2f(ta12 & ~0x7fu) + key2f(tb0 & ~0x7fu)) & ~0xffu) | 63u; ck2_15 = (f2key(key2f(ta13 & ~0x7fu) + key2f(tb0 & ~0x7fu)) & ~0xffu) | 47u; ck3_0 = (f2key(key2f(ta14 & ~0x7fu) + key2f(tb0 & ~0x7fu)) & ~0xffu) | 31u; ck3_1 = (f2key(key2f(ta15 & ~0x7fu) + key2f(tb0 & ~0x7fu)) & ~0xffu) | 15u; ck3_2 = 0u; ck3_3 = 0u; ck3_4 = 0u; ck3_5 = 0u; ck3_6 = 0u; ck3_7 = 0u; ck3_8 = 0u; ck3_9 = 0u; ck3_10 = 0u; ck3_11 = 0u; ck3_12 = 0u; ck3_13 = 0u; ck3_14 = 0u; ck3_15 = 0u; } while (0)
#define WRITE_LUT(LP) do { *(LAS u32x4*)(LP) = (u32x4){((127u - (ta0 & 127u)) << 0) | ((127u - (ta1 & 127u)) << 8) | ((127u - (ta2 & 127u)) << 16) | ((127u - (ta3 & 127u)) << 24), ((127u - (ta4 & 127u)) << 0) | ((127u - (ta5 & 127u)) << 8) | ((127u - (ta6 & 127u)) << 16) | ((127u - (ta7 & 127u)) << 24), ((127u - (ta8 & 127u)) << 0) | ((127u - (ta9 & 127u)) << 8) | ((127u - (ta10 & 127u)) << 16) | ((127u - (ta11 & 127u)) << 24), ((127u - (ta12 & 127u)) << 0) | ((127u - (ta13 & 127u)) << 8) | ((127u - (ta14 & 127u)) << 16) | ((127u - (ta15 & 127u)) << 24)}; *(LAS u32x4*)((LP) + 16) = (u32x4){((127u - (tb0 & 127u)) << 0) | ((127u - (tb1 & 127u)) << 8) | ((127u - (tb2 & 127u)) << 16) | ((127u - (tb3 & 127u)) << 24), ((127u - (tb4 & 127u)) << 0) | ((127u - (tb5 & 127u)) << 8) | ((127u - (tb6 & 127u)) << 16) | ((127u - (tb7 & 127u)) << 24), ((127u - (tb8 & 127u)) << 0) | ((127u - (tb9 & 127u)) << 8) | ((127u - (tb10 & 127u)) << 16) | ((127u - (tb11 & 127u)) << 24), ((127u - (tb12 & 127u)) << 0) | ((127u - (tb13 & 127u)) << 8) | ((127u - (tb14 & 127u)) << 16) | ((127u - (tb15 & 127u)) << 24)}; } while (0)
#define LOOKUP16(PQ, K, LP) do { { const unsigned _f = 255u - (K##0 & 255u); PQ##0 = (unsigned)(LP)[_f >> 4] * 128u + (unsigned)(LP)[16u + (_f & 15u)]; } { const unsigned _f = 255u - (K##1 & 255u); PQ##1 = (unsigned)(LP)[_f >> 4] * 128u + (unsigned)(LP)[16u + (_f & 15u)]; } { const unsigned _f = 255u - (K##2 & 255u); PQ##2 = (unsigned)(LP)[_f >> 4] * 128u + (unsigned)(LP)[16u + (_f & 15u)]; } { const unsigned _f = 255u - (K##3 & 255u); PQ##3 = (unsigned)(LP)[_f >> 4] * 128u + (unsigned)(LP)[16u + (_f & 15u)]; } { const unsigned _f = 255u - (K##4 & 255u); PQ##4 = (unsigned)(LP)[_f >> 4] * 128u + (unsigned)(LP)[16u + (_f & 15u)]; } { const unsigned _f = 255u - (K##5 & 255u); PQ##5 = (unsigned)(LP)[_f >> 4] * 128u + (unsigned)(LP)[16u + (_f & 15u)]; } { const unsigned _f = 255u - (K##6 & 255u); PQ##6 = (unsigned)(LP)[_f >> 4] * 128u + (unsigned)(LP)[16u + (_f & 15u)]; } { const unsigned _f = 255u - (K##7 & 255u); PQ##7 = (unsigned)(LP)[_f >> 4] * 128u + (unsigned)(LP)[16u + (_f & 15u)]; } { const unsigned _f = 255u - (K##8 & 255u); PQ##8 = (unsigned)(LP)[_f >> 4] * 128u + (unsigned)(LP)[16u + (_f & 15u)]; } { const unsigned _f = 255u - (K##9 & 255u); PQ##9 = (unsigned)(LP)[_f >> 4] * 128u + (unsigned)(LP)[16u + (_f & 15u)]; } { const unsigned _f = 255u - (K##10 & 255u); PQ##10 = (unsigned)(LP)[_f >> 4] * 128u + (unsigned)(LP)[16u + (_f & 15u)]; } { const unsigned _f = 255u - (K##11 & 255u); PQ##11 = (unsigned)(LP)[_f >> 4] * 128u + (unsigned)(LP)[16u + (_f & 15u)]; } { const unsigned _f = 255u - (K##12 & 255u); PQ##12 = (unsigned)(LP)[_f >> 4] * 128u + (unsigned)(LP)[16u + (_f & 15u)]; } { const unsigned _f = 255u - (K##13 & 255u); PQ##13 = (unsigned)(LP)[_f >> 4] * 128u + (unsigned)(LP)[16u + (_f & 15u)]; } { const unsigned _f = 255u - (K##14 & 255u); PQ##14 = (unsigned)(LP)[_f >> 4] * 128u + (unsigned)(LP)[16u + (_f & 15u)]; } { const unsigned _f = 255u - (K##15 & 255u); PQ##15 = (unsigned)(LP)[_f >> 4] * 128u + (unsigned)(LP)[16u + (_f & 15u)]; } } while (0)
#define GATES16(E, K, MX, SUM) do { E##0 = __expf(key2f(K##0 & ~0xffu) - (MX)); SUM += E##0; E##1 = __expf(key2f(K##1 & ~0xffu) - (MX)); SUM += E##1; E##2 = __expf(key2f(K##2 & ~0xffu) - (MX)); SUM += E##2; E##3 = __expf(key2f(K##3 & ~0xffu) - (MX)); SUM += E##3; E##4 = __expf(key2f(K##4 & ~0xffu) - (MX)); SUM += E##4; E##5 = __expf(key2f(K##5 & ~0xffu) - (MX)); SUM += E##5; E##6 = __expf(key2f(K##6 & ~0xffu) - (MX)); SUM += E##6; E##7 = __expf(key2f(K##7 & ~0xffu) - (MX)); SUM += E##7; E##8 = __expf(key2f(K##8 & ~0xffu) - (MX)); SUM += E##8; E##9 = __expf(key2f(K##9 & ~0xffu) - (MX)); SUM += E##9; E##10 = __expf(key2f(K##10 & ~0xffu) - (MX)); SUM += E##10; E##11 = __expf(key2f(K##11 & ~0xffu) - (MX)); SUM += E##11; E##12 = __expf(key2f(K##12 & ~0xffu) - (MX)); SUM += E##12; E##13 = __expf(key2f(K##13 & ~0xffu) - (MX)); SUM += E##13; E##14 = __expf(key2f(K##14 & ~0xffu) - (MX)); SUM += E##14; E##15 = __expf(key2f(K##15 & ~0xffu) - (MX)); SUM += E##15; } while (0)
#define STORE_GATES(GP, EP, E, PQ, INV) do { *(f32x4*)((GP) + 0) = (f32x4){E##0 * (INV), E##1 * (INV), E##2 * (INV), E##3 * (INV)}; *(u32x4*)((EP) + 0) = (u32x4){PQ##0, PQ##1, PQ##2, PQ##3}; *(f32x4*)((GP) + 4) = (f32x4){E##4 * (INV), E##5 * (INV), E##6 * (INV), E##7 * (INV)}; *(u32x4*)((EP) + 4) = (u32x4){PQ##4, PQ##5, PQ##6, PQ##7}; *(f32x4*)((GP) + 8) = (f32x4){E##8 * (INV), E##9 * (INV), E##10 * (INV), E##11 * (INV)}; *(u32x4*)((EP) + 8) = (u32x4){PQ##8, PQ##9, PQ##10, PQ##11}; *(f32x4*)((GP) + 12) = (f32x4){E##12 * (INV), E##13 * (INV), E##14 * (INV), E##15 * (INV)}; *(u32x4*)((EP) + 12) = (u32x4){PQ##12, PQ##13, PQ##14, PQ##15}; } while (0)

__device__ __forceinline__ void d_route(const Params& P, LAS unsigned char* lds, int tid, int gw, int ngw) {
    const int lane = tid & 63, wave = __builtin_amdgcn_readfirstlane(tid >> 6);
    for (int idx = tid; idx < 2 * 128 * 128 / 2; idx += 512) { const int e = idx * 2, row = e >> 7, c = e & 127;
        const float a = P.in[I_SUBKEYS][e], b = P.in[I_SUBKEYS][e + 1];
        *(LAS unsigned*)(lds + row * RT_SKROW + c * 2) = pk2(a, b); }
    asm volatile("s_waitcnt lgkmcnt(0)" ::: "memory"); __syncthreads();
    const int hh = lane >> 5, l31 = lane & 31;
#define ROUTE_HALF(QROW, SKZ, T) do { \
        bf16x8v qf[8]; f32x16v acc[4]; \
        _Pragma("unroll") for (int ks = 0; ks < 8; ++ks) qf[ks] = *(const bf16x8v*)((QROW) + ks * 16 + 8 * hh); \
        _Pragma("unroll") for (int kb = 0; kb < 4; ++kb) { \
            _Pragma("unroll") for (int i = 0; i < 16; ++i) acc[kb][i] = 0.f; \
            _Pragma("unroll") for (int ks = 0; ks < 8; ++ks) { const bf16x8v af = *(const LAS bf16x8v*)((SKZ) + (kb * 32 + l31) * RT_SKROW + (ks * 16 + 8 * hh) * 2); \
                acc[kb] = __builtin_amdgcn_mfma_f32_32x32x16_bf16(af, qf[ks], acc[kb], 0, 0, 0); } } \
        DECL16(unsigned, ga); DECL16(unsigned, gb); DECL16(unsigned, gc); DECL16(unsigned, gd); DECL16(unsigned, ob); \
        __builtin_amdgcn_sched_barrier(0); FILL_G0(ga, acc[0], hh); SORT16_DESC(ga); __builtin_amdgcn_sched_barrier(0); FILL_G1(gb, acc[1], hh); SORT16_DESC(gb); __builtin_amdgcn_sched_barrier(0); MERGE16_DESC(ga, gb); __builtin_amdgcn_sched_barrier(0); \
        FILL_G2(gc, acc[2], hh); SORT16_DESC(gc); __builtin_amdgcn_sched_barrier(0); FILL_G3(gd, acc[3], hh); SORT16_DESC(gd); __builtin_amdgcn_sched_barrier(0); MERGE16_DESC(gc, gd); __builtin_amdgcn_sched_barrier(0); MERGE16_DESC(ga, gc); __builtin_amdgcn_sched_barrier(0); \
        XCHG16(ob, ga); MERGE16_DESC(ga, ob); COPY16(T, ga); __builtin_amdgcn_sched_barrier(0); } while (0)
#pragma unroll 1
    for (int task = gw; task < TOK * 8 / 32; task += ngw) {
        const long r0 = (long)task * 32; const bf16_t* qrow = P.QP + (size_t)(r0 + l31) * 256;
        DECL16(unsigned, ta); DECL16(unsigned, tb);
        ROUTE_HALF(qrow, lds, ta);
        ROUTE_HALF(qrow + 128, lds + 128 * RT_SKROW, tb);
        DECL16(unsigned, ck0_); DECL16(unsigned, ck1_); DECL16(unsigned, ck2_); DECL16(unsigned, ck3_);
        LAS unsigned char* lut = lds + 2 * 128 * RT_SKROW + wave * 1024 + l31 * 32;
        WRITE_LUT(lut);
        FILL_CANDS(); __builtin_amdgcn_sched_barrier(0);
        SORT16_DESC(ck0_); __builtin_amdgcn_sched_barrier(0); SORT16_DESC(ck1_); __builtin_amdgcn_sched_barrier(0); MERGE16_DESC(ck0_, ck1_); __builtin_amdgcn_sched_barrier(0);
        SORT16_DESC(ck2_); __builtin_amdgcn_sched_barrier(0); SORT16_DESC(ck3_); __builtin_amdgcn_sched_barrier(0); MERGE16_DESC(ck2_, ck3_); __builtin_amdgcn_sched_barrier(0); MERGE16_DESC(ck0_, ck2_); __builtin_amdgcn_sched_barrier(0);
        DECL16(unsigned, cp0_);
        LOOKUP16(cp0_, ck0_, lut);
        DECL16(float, ee); const float mx = key2f(ck0_0 & ~0xffu); float sum = 0.f;
        GATES16(ee, ck0_, mx, sum);
        const float inv = 1.0f / sum;
        if (lane < 32) { float* gp = P.GATE + (size_t)(r0 + lane) * 16; int* ep = P.EXPERT + (size_t)(r0 + lane) * 16; STORE_GATES(gp, ep, ee, cp0_, inv); }
    }
#undef ROUTE_HALF
}

__device__ __forceinline__ void d_gmlp(const Params& P, LAS unsigned char* lds, int tid) {
    const int lane = tid & 63, wave = __builtin_amdgcn_readfirstlane(tid >> 6), hh = lane >> 5, l31 = lane & 31;
    const int chunk = (int)blockIdx.x >> 1, hb = (int)blockIdx.x & 1;
    if (chunk >= TOK / 128) return;
    LAS bf16_t* VNt = (LAS bf16_t*)lds;
    {
        const int cg = hb * 256 + 8 * l31;
        const f32x4 g0 = *(const f32x4*)(P.in[I_GLN_G] + cg), g1 = *(const f32x4*)(P.in[I_GLN_G] + cg + 4);
        const f32x4 b0 = *(const f32x4*)(P.in[I_GLN_B] + cg), b1 = *(const f32x4*)(P.in[I_GLN_B] + cg + 4);
#pragma unroll 4
        for (int tt = 0; tt < 16; ++tt) { const int q = wave * 16 + tt; const long t = (long)chunk * 128 + q;
            const u32x4 w = *((const u32x4*)(P.PB + (size_t)t * 1024 + 512) + lane);
            float x[8] = {blo(w.x), bhi(w.x), blo(w.y), bhi(w.y), blo(w.z), bhi(w.z), blo(w.w), bhi(w.w)};
            float s = 0.f;
#pragma unroll
            for (int i = 0; i < 8; ++i) s += x[i];
            const float mean = wave_sum(s) * (1.f / 512.f); float s2 = 0.f;
#pragma unroll
            for (int i = 0; i < 8; ++i) { x[i] -= mean; s2 += x[i] * x[i]; }
            const float rstd = 1.f / sqrtf(wave_sum(s2) * (1.f / 512.f) + 1e-5f);
            if (hh == hb) {
#pragma unroll
                for (int i = 0; i < 8; ++i) { const float gg = (i < 4) ? g0[i] : g1[i - 4], bb = (i < 4) ? b0[i] : b1[i - 4];
                    VNt[(8 * l31 + i) * 136 + q] = f2bf(x[i] * rstd * gg + bb); } }
        }
    }
    asm volatile("s_waitcnt lgkmcnt(0)" ::: "memory"); __syncthreads();
    const int pb = wave >> 1, db = wave & 1;
#pragma unroll 1
    for (int gl = 0; gl < 4; ++gl) { const int g = 4 * hb + gl;
        f32x16v acc;
#pragma unroll
        for (int i = 0; i < 16; ++i) acc[i] = 0.f;
        const bf16_t* arow = P.WSB + ((size_t)g * 128 + pb * 32 + l31) * 128 + 8 * hh;
        const LAS bf16_t* brow = VNt + (gl * 64 + db * 32 + l31) * 136 + 8 * hh;
#pragma unroll
        for (int ks = 0; ks < 8; ++ks) { const bf16x8v af = *(const bf16x8v*)(arow + ks * 16); const bf16x8v bfr = *(const LAS bf16x8v*)(brow + ks * 16);
            acc = __builtin_amdgcn_mfma_f32_32x32x16_bf16(af, bfr, acc, 0, 0, 0); }
        const int c = g * 64 + db * 32 + l31;
#pragma unroll
        for (int r = 0; r < 16; ++r) { const int p = pb * 32 + (r & 3) + 8 * (r >> 2) + 4 * hh; const long t = (long)chunk * 128 + p;
            const float sv = acc[r] + P.in[I_B_S][g * 128 + p];
            P.YB[(size_t)t * 512 + c] = f2bf(bf2f(P.PB[(size_t)t * 1024 + c]) * sv); }
    }
}
constexpr int RING_BYTES = 131072, LDSCTL_OFF = RING_BYTES, MISC_OFF = LDSCTL_OFF + 320, LDS_BYTES = 147456;
constexpr int CW_BAR = 4096;
#ifndef MK_PER_PHASE
#define MK_PER_PHASE 0
#endif
struct KArgs { Params P; };
template <class DE, bool ALIGN = true> __device__ __forceinline__ void run_gemm(LAS unsigned char* lds, const bf16_t* A, const bf16_t* Bt, int M, int N, int K, const DE& E,
                                                                     int bgrp = 1 << 30, size_t bgstride = 0) {
    pg8::Gemm g{A, Bt, M, N, K, K, K, bgrp, bgstride}; pg8::StaticOrder S; S.init(M, N, (int)gridDim.x, (int)blockIdx.x);
    pg8::gemm_phase<DE, pg8::StaticOrder, ALIGN, true>(lds, g, S, E);
}
__global__ void __launch_bounds__(512, 2) mega_fwd(KArgs a) {
    extern __shared__ __attribute__((aligned(16))) unsigned char lds_raw[];
    LAS unsigned char* lds = (LAS unsigned char*)lds_raw;
    volatile LAS unsigned* MISC = (volatile LAS unsigned*)(lds + MISC_OFF);
    const Params& P = a.P;
    const int tid = threadIdx.x;
    for (int u = tid; u < (LDS_BYTES - LDSCTL_OFF) / 4; u += 512) ((LAS unsigned*)(lds + LDSCTL_OFF))[u] = 0u;
    __syncthreads();
    XcdBarrier bar; bar.bar = P.ctl + CW_BAR; bar.x = 0; bar.st = nullptr;
    bar = xcd_barrier_post(P.ctl + CW_BAR, MISC + 8);
    const long gtid = (long)blockIdx.x * 512 + tid, nthr = (long)gridDim.x * 512;
    const int lane = tid & 63, wave = __builtin_amdgcn_readfirstlane(tid >> 6), gw = (int)blockIdx.x * 8 + wave, ngw = (int)gridDim.x * 8;
#define PHASE(body) do { body; xcd_barrier(bar); } while (0)
    PHASE((d_weights(P, lds, gw, ngw, wave, lane), d_lora_weights(P, gtid, nthr), d_ln_rows(P.in[I_X], P.in[I_LN_EMB_G], P.in[I_LN_EMB_B], P.HB, TOK, gw, ngw, lane),
           d_ln_rows(P.in[I_MEM], P.in[I_MLN_G], P.in[I_MLN_B], P.MEMN, BATCH * MEM_LEN, gw, ngw, lane)));
    PHASE(({ { pg8::DEpiP1 E{{P.PA, P.PB}}; run_gemm(lds, P.HB, P.W_IN_T, TOK, 3072, 1024, E); }
             { pg8::DEpiTile E2{P.KH, 4, 1, 1.0f}; run_gemm(lds, P.MEMN, P.W_KV_T, BATCH * MEM_LEN, 1024, 1024, E2); }
             { pg8::DEpiTile E3{P.VT, 1, 4, 1.0f}; run_gemm(lds, P.W_KV_T + (size_t)1024 * 1024, P.MEMN, 1024, BATCH * MEM_LEN, 1024, E3); } }));
    PHASE((d_gmlp(P, lds, tid), d_prep_e1(P, gw, ngw, lane)));
    PHASE(({ { pg8::DEpiLora<0> E{P.in[I_W0], P.OMW}; run_gemm(lds, P.LIN, P.W_LORA_T, TOK, 1024, 512, E); }
             { pg8::DEpiLora<1> E{P.in[I_A0], P.AL}; run_gemm(lds, P.LIN, P.W_LORA_T + (size_t)1024 * 512, TOK, 1024, 512, E); }
             { pg8::DEpiLora<2> E{nullptr, P.G}; run_gemm(lds, P.LIN, P.W_LORA_T + (size_t)2048 * 512, TOK, 512, 512, E); } }));
    PHASE(d_scan(P, lds, tid));
    PHASE(d_rwkv_out(P, gw, ngw, lane));
    PHASE(({ { pg8::DEpiPlain E{{P.BR, 2048, 0}}; run_gemm(lds, P.YA, P.W_BR_T, TOK, 1024, 512, E); }
             { pg8::DEpiPlain E2{{P.BR, 2048, 1024}}; run_gemm(lds, P.YB, P.W_BR_T + (size_t)1024 * 512, TOK, 1024, 512, E2); } }));
    PHASE(({ pg8::DEpiMerge E{{P.BR, P.MG}}; run_gemm(lds, P.HB, P.W_IN_T + (size_t)3072 * 1024, TOK, 2048, 1024, E); }));
    PHASE(({ pg8::DEpiResid E{{P.HB, P.Z}}; run_gemm(lds, P.MG, P.W_MIX_T, TOK, 1024, 1024, E); }));
    PHASE(d_ln_rows(P.Z, P.in[I_LN1_G], P.in[I_LN1_B], P.HB, TOK, gw, ngw, lane));
    PHASE(({ pg8::DEpiQ EQ{{P.QH, 1, 0, 0.0625f}}; run_gemm(lds, P.HB, P.W_Q_T, TOK, 1024, 1024, EQ); }));
    PHASE(({ pg8::DEpiSoftmax E{P.PP}; run_gemm<pg8::DEpiSoftmax, false>(lds, P.QH, P.KH, TOK * 4, 256, 256, E, 8, (size_t)256 * 256 * 2); }));
    PHASE(({ pg8::DEpiO E{P.O}; run_gemm(lds, P.PP, P.VT, TOK * 4, 256, 256, E, 8, (size_t)256 * 256 * 2); }));
    PHASE(({ pg8::DEpiResid E{{P.HB, P.Z}}; run_gemm(lds, P.O, P.W_O_T, TOK, 1024, 1024, E); }));
    PHASE(d_ln_rows(P.Z, P.in[I_LN2_G], P.in[I_LN2_B], P.HB, TOK, gw, ngw, lane));
    PHASE(({ pg8::DEpiPlain E{{P.QP, 2048, 0}}; run_gemm(lds, P.HB, P.W_QUERY_T, TOK, 2048, 1024, E); }));
    PHASE((d_route(P, lds, tid, gw, ngw), d_tables(P, gtid, nthr)));
    d_peer(P, gw, ngw, lane);
#undef PHASE
}
extern "C" void kernel_launch(void* const* d_in, const int* in_sizes, int n_in, void* d_out, int out_size, void* d_ws, size_t ws_size, hipStream_t stream) {
    static int grid = 0;
    if (grid == 0) {
        int dev = 0, cus = 0;
        if (n_in != 37 || ws_size < WS_NEED || hipGetDevice(&dev) != hipSuccess || hipDeviceGetAttribute(&cus, hipDeviceAttributeMultiprocessorCount, dev) != hipSuccess) {
            fprintf(stderr, "kernel_launch: bad arguments (n_in %d, ws %zu < %zu)\n", n_in, ws_size, (size_t)WS_NEED); grid = -1; return; }
        if (hipFuncSetAttribute((const void*)mega_fwd, hipFuncAttributeMaxDynamicSharedMemorySize, LDS_BYTES) != hipSuccess) { fprintf(stderr, "kernel_launch: hipFuncSetAttribute failed\n"); grid = -1; return; }
        grid = cus;
    }
    if (grid < 0) return;
    (void)hipMemsetAsync((char*)d_ws + WS_CTL, 0, 1 * MiB, stream);
    KArgs a; memset(&a, 0, sizeof(a)); make_params(a.P, d_in, d_out, d_ws);
    hipLaunchKernelGGL(mega_fwd, dim3(grid), dim3(512), LDS_BYTES, stream, a);
}
#endif
```

```cpp
#ifdef HOST_EMU
#include "emu.h"
#else
#include <hip/hip_runtime.h>
#include <cstdio>
#include <cstdint>
#include <cstring>
#endif

#ifndef BATCH
#define BATCH 8
#endif
#ifndef SEQ
#define SEQ 2048
#endif
#define DM 1024
#define TOK (BATCH * SEQ)
#define IN_COLS 4992
#define MEM_LEN 256
#define ALPHA_F 1.189207115002721f
typedef unsigned short bf16_t;

#ifdef HOST_EMU
static inline float bf2f(bf16_t v) { unsigned u = (unsigned)v << 16; float f; memcpy(&f, &u, 4); return f; }
static inline bf16_t f2bf(float f) { unsigned u; memcpy(&u, &f, 4); return (bf16_t)((u + 0x7fffu + ((u >> 16) & 1u)) >> 16); }
#else
__device__ __forceinline__ float bf2f(bf16_t v) { return __uint_as_float((unsigned)v << 16); }
__device__ __forceinline__ bf16_t f2bf(float f) { unsigned u = __float_as_uint(f); return (bf16_t)((u + 0x7fffu + ((u >> 16) & 1u)) >> 16); }
#endif
__device__ __forceinline__ float sigmoidf_(float x) { return 1.0f / (1.0f + expf(-x)); }
__device__ __forceinline__ float geluf_(float x) { return 0.5f * x * (1.0f + erff(x * 0.7071067811865476f)); }

struct Params {
    const float* in[37];
    float* out;
    unsigned* ctl;
    bf16_t *W_IN_T, *W_BR_T, *W_MIX_T, *W_Q_T, *W_KV_T, *W_O_T, *W_QUERY_T;
    bf16_t *KV, *MEMN, *HB;
    bf16_t *PA, *PB, *VN, *YB;
    bf16_t *WDS, *ADS, *SG;
    bf16_t *R, *V, *KK, *OMW, *KDIR, *BVEC;
    float *Y01;
    bf16_t *YA, *BR, *MG;
    float* Z;
    bf16_t *Q, *O;
    float* SCA;
    bf16_t* QP;
    float* SC; float* TOPS; int* TOPI; float* GATE; int* EXPERT; float* COEF; float* Y;
    bf16_t *UB, *VB;
    unsigned char *U8, *V8; float *SU, *SV;
    bf16_t *W_LORA_T;
    bf16_t *WSB;
    bf16_t *LIN, *K, *AL, *G;
    bf16_t *KH, *VT, *QH, *PP;
};
enum { I_X = 0, I_MEM, I_LN_EMB_G, I_LN_EMB_B, I_W_IN, I_MU, I_W0, I_W2, I_A0, I_A2, I_G2, I_K_K, I_K_A, I_R_K, I_GN_G, I_GN_B,
       I_GLN_G, I_GLN_B, I_W_S, I_B_S, I_W_BRANCH, I_W_MIX, I_LN1_G, I_LN1_B, I_MLN_G, I_MLN_B, I_W_Q, I_W_KV, I_W_O, I_LN2_G, I_LN2_B,
       I_W_QUERY, I_SUBKEYS, I_PEER_U, I_PEER_V, I_LN3_G, I_LN3_B };

constexpr size_t MiB = 1u << 20;
constexpr size_t TU = (size_t)TOK * 1024;
constexpr size_t WS_CTL = 0;
constexpr size_t WS_W = 1 * MiB;
constexpr size_t OFF_W_IN = 0, OFF_W_BR = OFF_W_IN + (size_t)5120 * 1024 * 2, OFF_W_MIX = OFF_W_BR + (size_t)2048 * 512 * 2,
                 OFF_W_Q = OFF_W_MIX + (size_t)1024 * 1024 * 2, OFF_W_KV = OFF_W_Q + (size_t)1024 * 1024 * 2,
                 OFF_W_O = OFF_W_KV + (size_t)2048 * 1024 * 2, OFF_W_QUERY = OFF_W_O + (size_t)1024 * 1024 * 2,
                 OFF_W_END = OFF_W_QUERY + (size_t)2048 * 1024 * 2;
static_assert(OFF_W_END <= 27 * MiB, "weights region");
constexpr size_t OFF_W_LORA = OFF_W_END, OFF_W_END2 = OFF_W_LORA + (size_t)2560 * 512 * 2;
constexpr size_t OFF_WSB = OFF_W_END2;
static_assert(OFF_WSB + 8 * 128 * 128 * 2 <= 29 * MiB, "weights region 2");
constexpr size_t WS_KV = 30 * MiB;
constexpr size_t WS_MEMN = 38 * MiB;
constexpr size_t WS_ACT = 42 * MiB;
constexpr size_t A_HB = WS_ACT;
constexpr size_t A_R1 = A_HB + 2 * TU;
constexpr size_t A_R2 = A_R1 + 4 * TU;
constexpr size_t WS_NEED = A_R2 + 7 * TU;
#ifndef HOST_EMU
static_assert(WS_NEED <= 256 * MiB, "workspace map exceeds 256 MiB");
#endif

struct EpiP1 { bf16_t* PA; bf16_t* PB; };
struct EpiPlain { bf16_t* O; int ldc; int col_off; };
struct EpiMerge { const bf16_t* BR; bf16_t* MG; };
struct EpiResid { const bf16_t* H; float* Z; };

#ifndef HOST_EMU
namespace pg8 {
#define PG8_LAS __attribute__((address_space(3)))
typedef unsigned short bf16_t;
typedef short bf16x8 __attribute__((ext_vector_type(8)));
typedef float f32x4 __attribute__((ext_vector_type(4)));
typedef unsigned u32x4 __attribute__((ext_vector_type(4)));
constexpr int BM = 256, BK = 64, HALF = 128, HTB = HALF * BK * 2  , STAGE_BYTES = 8 * HTB, NXCD = 8, WGM = 8;

__host__ __device__ __forceinline__ int lds_byte(int r, int c) { const int st = (r >> 4) * 2 + (c >> 5), rr = r & 15, cc = c & 31, ob = rr * 64 + cc * 2; return st * 1024 + (ob ^ (((ob >> 9) & 1) << 5)); }
__host__ __device__ __forceinline__ void stage_rc(int b, int& R, int& C) { const int st = b / 1024, sb = b % 1024, swz = sb ^ (((sb >> 9) & 1) << 5); R = (st >> 1) * 16 + swz / 64; C = (st & 1) * 32 + (swz % 64) / 2; }
__host__ __device__ __forceinline__ int perm32(int rho) { const int n = rho >> 4, i = rho & 15; return 8 * (i >> 2) + 4 * n + (i & 3); }

struct Unit { int pm, pn; };
struct Gemm { const bf16_t* A; const bf16_t* Bt; int M, N, K; int lda, ldb; int bgrp; size_t bgstride; };

struct StaticOrder {
    int nM, nN, nwg, G, c;
    __host__ __device__ void init(int M, int N, int G_, int c_) { nM = M / BM; nN = N / BM; nwg = nM * nN; G = G_; c = c_; }
    __host__ __device__ bool next(int i, Unit& u) const {
        const long L = (long)i * G + c; if (L >= nwg) return false;
        int wgid = (int)L; { const int q = nwg / NXCD, r = nwg % NXCD, xcd = wgid % NXCD, off = wgid / NXCD; wgid = (xcd < r ? xcd * (q + 1) : r * (q + 1) + (xcd - r) * q) + off; }
        const int nig = WGM * nN, gid = wgid / nig, fm = gid * WGM, gsz = (nM - fm) < WGM ? (nM - fm) : WGM;
        u.pm = fm + ((wgid % nig) % gsz); u.pn = (wgid % nig) / gsz; return true;
    }
    __device__ __forceinline__ void a_ready(const Unit&) const {}
    __device__ __forceinline__ void done(const Unit&) const {}
};

typedef float f32x2c __attribute__((ext_vector_type(2))); typedef __bf16 bf16x2c __attribute__((ext_vector_type(2)));
__device__ __forceinline__ unsigned cvt_pk_bf16(float lo, float hi) { const f32x2c v = {lo, hi}; const bf16x2c b = __builtin_convertvector(v, bf16x2c); return __builtin_bit_cast(unsigned, b); }
typedef float f32x2 __attribute__((ext_vector_type(2)));
__device__ __forceinline__ f32x2 gelu_pk(f32x2 v) {
    const f32x2 av = __builtin_elementwise_abs(v), d = av * 0.2316418882f + 1.0f;
    f32x2 t; t.x = __builtin_amdgcn_rcpf(d.x); t.y = __builtin_amdgcn_rcpf(d.y);
    f32x2 q = t * 0.5307027145f + (-0.7265760135f); q = q * t + 0.7107068705f; q = q * t + (-0.142248368f); q = q * t + 0.127414796f; q = q * t;
    const f32x2 s = (v * v) * (-0.72134752044f);
    f32x2 e; e.x = __builtin_amdgcn_exp2f(s.x); e.y = __builtin_amdgcn_exp2f(s.y);
    const f32x2 m = v * (q * e), r = v - m;
    f32x2 o; o.x = v.x < 0.f ? m.x : r.x; o.y = v.y < 0.f ? m.y : r.y; return o;
}


template <class Epi, class Sched, bool ALIGN_EPI = false, bool SP2 = false>
__device__ __forceinline__ void gemm_phase(PG8_LAS unsigned char* lds, const Gemm g, const Sched& S, const Epi& E) {
    int tid_ = threadIdx.x; asm volatile("" : "+v"(tid_));
    const int tid = tid_, wid = __builtin_amdgcn_readfirstlane(tid >> 6), lane = tid & 63, wr = wid >> 2, wc = wid & 3, fr = lane & 15, fq = lane >> 4;
    const int K = g.K, nt = K / BK;
    unsigned voffA[2], voffB[2];
#pragma unroll
    for (int i = 0; i < 2; ++i) { int R, C; stage_rc(tid * 16 + i * 8192, R, C); const int Rb = Epi::PERM ? ((R & ~31) + perm32(R & 31)) : R;
        voffA[i] = (unsigned)(R * g.lda + C) * 2u; voffB[i] = (unsigned)(Rb * g.ldb + C) * 2u; }
    const size_t kstep = (size_t)(BK * 2);
    const size_t hstepA = (size_t)HALF * g.lda * 2, hstepB = (size_t)HALF * g.ldb * 2;
    const size_t tstepA = 2 * hstepA, tstepB = 2 * hstepB;
    const unsigned ldsw = (unsigned)wid * 1024u;
    const int aoff = lds_byte(wr * 64 + fr, fq * 8), boff = lds_byte(wc * 32 + fr, fq * 8);
#define PG8_SA(b, h) (((b) * 2 + (h)) * HTB)
#define PG8_SB(b, h) ((4 + (b) * 2 + (h)) * HTB)
#define PG8_STAGE(bufoff, gbase, voff) do { _Pragma("unroll") for (int _i = 0; _i < 2; ++_i) \
        __builtin_amdgcn_global_load_lds((const unsigned*)((const char*)(gbase) + (voff)[_i]), (PG8_LAS unsigned*)(lds + (bufoff) + ldsw + _i * 8192), 16, 0, 0); } while (0)
#define PG8_LDA(dst, b, h) do { _Pragma("unroll") for (int m = 0; m < 4; ++m) _Pragma("unroll") for (int k = 0; k < 2; ++k) dst[m][k] = *(const PG8_LAS bf16x8*)(lds + PG8_SA(b, h) + aoff + m * 2048 + k * 1024); } while (0)
#define PG8_LDB(dst, b, h) do { _Pragma("unroll") for (int n = 0; n < 2; ++n) _Pragma("unroll") for (int k = 0; k < 2; ++k) dst[n][k] = *(const PG8_LAS bf16x8*)(lds + PG8_SB(b, h) + boff + n * 2048 + k * 1024); } while (0)
#define PG8_MMA(ai, bj, At, Bt) do { __builtin_amdgcn_s_setprio(1); _Pragma("unroll") for (int m = 0; m < 4; ++m) _Pragma("unroll") for (int n = 0; n < 2; ++n) _Pragma("unroll") for (int k = 0; k < 2; ++k) \
        acc[ai][bj][m][n] = __builtin_amdgcn_mfma_f32_16x16x32_bf16(Bt[n][k], At[m][k], acc[ai][bj][m][n], 0, 0, 0); __builtin_amdgcn_s_setprio(0); } while (0)
#define PG8_WAIT_V(n) asm volatile("s_waitcnt vmcnt(" #n ")" ::: "memory")
#define PG8_WAIT_L(n) asm volatile("s_waitcnt lgkmcnt(" #n ")" ::: "memory")
#define PG8_BAR __builtin_amdgcn_s_barrier()
#define PG8_SCHED __builtin_amdgcn_sched_barrier(0)
    Unit cur, nxt; int ui = 0;
    if (!S.next(0, cur)) return;
    f32x4 acc[2][2][4][2];
#pragma unroll
    for (int a = 0; a < 2; ++a)
#pragma unroll
        for (int b = 0; b < 2; ++b)
#pragma unroll
            for (int m = 0; m < 4; ++m)
#pragma unroll
                for (int n = 0; n < 2; ++n) acc[a][b][m][n] = (f32x4){0.f, 0.f, 0.f, 0.f};
    bf16x8 At[4][2], B0[2][2], B1[2][2];
    const char* cA = (const char*)g.A + (size_t)cur.pm * tstepA; const char* cB = (const char*)g.Bt + (size_t)cur.pn * tstepB + (size_t)(cur.pm / g.bgrp) * g.bgstride;
    S.a_ready(cur);
    if constexpr (SP2) {
        PG8_STAGE(PG8_SB(0, 0), cB, voffB); PG8_STAGE(PG8_SB(0, 1), cB + hstepB, voffB); PG8_STAGE(PG8_SA(0, 0), cA, voffA); PG8_STAGE(PG8_SA(0, 1), cA + hstepA, voffA);
        if (wr == 1) PG8_BAR;
        PG8_WAIT_V(2); PG8_BAR;
        PG8_STAGE(PG8_SB(1, 0), cB + kstep, voffB); PG8_STAGE(PG8_SA(1, 0), cA + kstep, voffA); PG8_STAGE(PG8_SB(1, 1), cB + hstepB + kstep, voffB);
        PG8_WAIT_V(6); PG8_BAR;
    } else {
        PG8_STAGE(PG8_SB(0, 0), cB, voffB); PG8_STAGE(PG8_SA(0, 0), cA, voffA); PG8_STAGE(PG8_SB(0, 1), cB + hstepB, voffB); PG8_STAGE(PG8_SA(0, 1), cA + hstepA, voffA);
        if (wr == 1) PG8_BAR;
        PG8_WAIT_V(4); PG8_BAR;
        PG8_STAGE(PG8_SB(1, 0), cB + kstep, voffB); PG8_STAGE(PG8_SA(1, 0), cA + kstep, voffA); PG8_STAGE(PG8_SB(1, 1), cB + hstepB + kstep, voffB);
        PG8_WAIT_V(6); PG8_BAR;
    }
    for (;;) {
        const bool has_next = S.next(ui + 1, nxt);
        const char* nA = has_next ? (const char*)g.A + (size_t)nxt.pm * tstepA : cA; const char* nB = has_next ? (const char*)g.Bt + (size_t)nxt.pn * tstepB + (size_t)(nxt.pm / g.bgrp) * g.bgstride : cB;
#pragma unroll 1
        for (int t = 0; t < nt; t += 2) {
            const bool last = (t == nt - 2);
            const char* a1 = cA + (size_t)(t + 1) * kstep;
            const char* a2 = last ? nA : cA + (size_t)(t + 2) * kstep; const char* b2 = last ? nB : cB + (size_t)(t + 2) * kstep;
            const char* a3 = a2 + kstep; const char* b3 = b2 + kstep;
            if (last && has_next) S.a_ready(nxt);
            if constexpr (SP2) {
            PG8_LDB(B0, 0, 0); PG8_LDB(B1, 0, 1); PG8_SCHED; PG8_LDA(At, 0, 0); PG8_STAGE(PG8_SA(1, 1), a1 + hstepA, voffA);
            PG8_WAIT_V(8); PG8_WAIT_L(0); PG8_BAR; PG8_MMA(0, 0, At, B0); PG8_MMA(0, 1, At, B1); PG8_BAR; PG8_SCHED;
            PG8_LDA(At, 0, 1); PG8_STAGE(PG8_SB(0, 0), b2, voffB); PG8_STAGE(PG8_SB(0, 1), b2 + hstepB, voffB); PG8_STAGE(PG8_SA(0, 0), a2, voffA);
            PG8_WAIT_V(8); PG8_WAIT_L(0); PG8_BAR; PG8_MMA(1, 0, At, B0); PG8_MMA(1, 1, At, B1); PG8_BAR; PG8_SCHED;
            PG8_LDB(B0, 1, 0); PG8_LDB(B1, 1, 1); PG8_SCHED; PG8_LDA(At, 1, 0); PG8_STAGE(PG8_SA(0, 1), a2 + hstepA, voffA);
            PG8_WAIT_V(8); PG8_WAIT_L(0); PG8_BAR; PG8_MMA(0, 0, At, B0); PG8_MMA(0, 1, At, B1); PG8_BAR; PG8_SCHED;
            PG8_LDA(At, 1, 1); PG8_STAGE(PG8_SB(1, 0), b3, voffB); PG8_STAGE(PG8_SB(1, 1), b3 + hstepB, voffB); PG8_STAGE(PG8_SA(1, 0), a3, voffA);
            PG8_WAIT_V(8); PG8_WAIT_L(0); PG8_BAR; PG8_MMA(1, 0, At, B0); PG8_MMA(1, 1, At, B1); PG8_BAR; PG8_SCHED;
            } else {
            PG8_LDB(B0, 0, 0); PG8_SCHED; PG8_LDA(At, 0, 0); PG8_STAGE(PG8_SA(1, 1), a1 + hstepA, voffA);
            PG8_WAIT_L(8); PG8_BAR; PG8_WAIT_L(0); PG8_MMA(0, 0, At, B0); PG8_BAR; PG8_SCHED;
            PG8_LDB(B1, 0, 1); PG8_STAGE(PG8_SB(0, 0), b2, voffB);
            PG8_BAR; PG8_WAIT_L(0); PG8_MMA(0, 1, At, B1); PG8_BAR;
            PG8_LDA(At, 0, 1); PG8_STAGE(PG8_SA(0, 0), a2, voffA);
            PG8_BAR; PG8_WAIT_L(0); PG8_MMA(1, 0, At, B0); PG8_BAR; PG8_SCHED;
            PG8_STAGE(PG8_SB(0, 1), b2 + hstepB, voffB);
            PG8_WAIT_V(6); PG8_BAR; PG8_MMA(1, 1, At, B1); PG8_BAR;
            PG8_LDB(B0, 1, 0); PG8_SCHED; PG8_LDA(At, 1, 0); PG8_STAGE(PG8_SA(0, 1), a2 + hstepA, voffA);
            PG8_WAIT_L(8); PG8_BAR; PG8_WAIT_L(0); PG8_MMA(0, 0, At, B0); PG8_BAR; PG8_SCHED;
            PG8_LDB(B1, 1, 1); PG8_STAGE(PG8_SB(1, 0), b3, voffB);
            PG8_BAR; PG8_WAIT_L(0); PG8_MMA(0, 1, At, B1); PG8_BAR;
            PG8_LDA(At, 1, 1); PG8_STAGE(PG8_SA(1, 0), a3, voffA);
            PG8_BAR; PG8_WAIT_L(0); PG8_MMA(1, 0, At, B0); PG8_BAR; PG8_SCHED;
            PG8_STAGE(PG8_SB(1, 1), b3 + hstepB, voffB);
            PG8_WAIT_V(6); PG8_BAR; PG8_MMA(1, 1, At, B1); PG8_BAR;
            }
        }
        if constexpr (ALIGN_EPI) { if (wr == 0) PG8_BAR; }
        if constexpr (!Epi::AFTER_DRAIN) { E(acc, cur, wr, wc, fr, fq); S.done(cur); }
        if (!has_next) break;
#pragma unroll
        for (int a = 0; a < 2; ++a)
#pragma unroll
            for (int b = 0; b < 2; ++b)
#pragma unroll
                for (int m = 0; m < 4; ++m)
#pragma unroll
                    for (int n = 0; n < 2; ++n) acc[a][b][m][n] = (f32x4){0.f, 0.f, 0.f, 0.f};
        cur = nxt; cA = nA; cB = nB; ++ui;
        if constexpr (ALIGN_EPI) { if (wr == 1) PG8_BAR; }
    }
    PG8_WAIT_V(0);
    if constexpr (!ALIGN_EPI) { if (wr == 0) PG8_BAR; }
    PG8_BAR;
    if constexpr (Epi::AFTER_DRAIN) { E.fused(acc, cur, wr, wc, fr, fq, lds, wid, lane); S.done(cur); }
#undef PG8_SA
#undef PG8_SB
#undef PG8_STAGE
#undef PG8_LDA
#undef PG8_LDB
#undef PG8_MMA
#undef PG8_WAIT_V
#undef PG8_WAIT_L
#undef PG8_BAR
#undef PG8_SCHED
}
}

namespace pg8 {
__device__ __forceinline__ u32x4 pack8(const f32x4& v0, const f32x4& v1) { u32x4 w; w.x = cvt_pk_bf16(v0[0], v0[1]); w.y = cvt_pk_bf16(v0[2], v0[3]); w.z = cvt_pk_bf16(v1[0], v1[1]); w.w = cvt_pk_bf16(v1[2], v1[3]); return w; }
__device__ __forceinline__ f32x4 gelu4(const f32x4& v) { f32x2 a = gelu_pk((f32x2){v[0], v[1]}), b = gelu_pk((f32x2){v[2], v[3]}); return (f32x4){a.x, a.y, b.x, b.y}; }
struct DEpiP1 {
    static constexpr bool PERM = true, AFTER_DRAIN = false; EpiP1 e;
    __device__ __forceinline__ void operator()(const f32x4 (&acc)[2][2][4][2], const Unit& u, int wr, int wc, int fr, int fq) const {
        const int row0 = u.pm * BM + wr * 64 + fr; const bool isb = (u.pn >= 8);
        bf16_t* base = isb ? e.PB : e.PA; const int ldc = isb ? 1024 : 2048; const int col0 = (isb ? (u.pn - 8) : u.pn) * BM + wc * 32 + 8 * fq;
#pragma unroll
        for (int ai = 0; ai < 2; ++ai)
#pragma unroll
            for (int m = 0; m < 4; ++m) { bf16_t* rowp = base + (size_t)(row0 + ai * HALF + m * 16) * ldc + col0;
#pragma unroll
                for (int bj = 0; bj < 2; ++bj) { f32x4 v0 = acc[ai][bj][m][0], v1 = acc[ai][bj][m][1];
                    if (isb) { v0 = gelu4(v0); v1 = gelu4(v1); }
                    *(u32x4*)(rowp + bj * HALF) = pack8(v0, v1); } }
    }
};
struct DEpiPlain {
    static constexpr bool PERM = true, AFTER_DRAIN = false; EpiPlain e;
    __device__ __forceinline__ void operator()(const f32x4 (&acc)[2][2][4][2], const Unit& u, int wr, int wc, int fr, int fq) const {
        const int row0 = u.pm * BM + wr * 64 + fr; const int col0 = e.col_off + u.pn * BM + wc * 32 + 8 * fq;
#pragma unroll
        for (int ai = 0; ai < 2; ++ai)
#pragma unroll
            for (int m = 0; m < 4; ++m) { bf16_t* rowp = e.O + (size_t)(row0 + ai * HALF + m * 16) * e.ldc + col0;
#pragma unroll
                for (int bj = 0; bj < 2; ++bj) *(u32x4*)(rowp + bj * HALF) = pack8(acc[ai][bj][m][0], acc[ai][bj][m][1]); }
    }
};
__device__ __forceinline__ float sig_fast(float x) { return __builtin_amdgcn_rcpf(1.0f + __expf(-x)); }
__device__ __forceinline__ float bflo(unsigned w) { return __uint_as_float(w << 16); }
__device__ __forceinline__ float bfhi(unsigned w) { return __uint_as_float(w & 0xffff0000u); }
struct DEpiMerge {
    static constexpr bool PERM = true, AFTER_DRAIN = false; EpiMerge e;
    __device__ __forceinline__ void operator()(const f32x4 (&acc)[2][2][4][2], const Unit& u, int wr, int wc, int fr, int fq) const {
        const int row0 = u.pm * BM + wr * 64 + fr; const int n0 = u.pn * HALF + wc * 32 + 8 * fq;
#pragma unroll
        for (int ai = 0; ai < 2; ++ai)
#pragma unroll
            for (int m = 0; m < 4; ++m) { const size_t row = (size_t)(row0 + ai * HALF + m * 16);
                const u32x4 b0 = *(const u32x4*)(e.BR + row * 2048 + n0), b1 = *(const u32x4*)(e.BR + row * 2048 + 1024 + n0);
                const f32x4 g00 = acc[ai][0][m][0], g01 = acc[ai][0][m][1], g10 = acc[ai][1][m][0], g11 = acc[ai][1][m][1];
                f32x4 o0, o1;
                o0[0] = sig_fast(g00[0]) * bflo(b0.x) + sig_fast(g10[0]) * bflo(b1.x); o0[1] = sig_fast(g00[1]) * bfhi(b0.x) + sig_fast(g10[1]) * bfhi(b1.x);
                o0[2] = sig_fast(g00[2]) * bflo(b0.y) + sig_fast(g10[2]) * bflo(b1.y); o0[3] = sig_fast(g00[3]) * bfhi(b0.y) + sig_fast(g10[3]) * bfhi(b1.y);
                o1[0] = sig_fast(g01[0]) * bflo(b0.z) + sig_fast(g11[0]) * bflo(b1.z); o1[1] = sig_fast(g01[1]) * bfhi(b0.z) + sig_fast(g11[1]) * bfhi(b1.z);
                o1[2] = sig_fast(g01[2]) * bflo(b0.w) + sig_fast(g11[2]) * bflo(b1.w); o1[3] = sig_fast(g01[3]) * bfhi(b0.w) + sig_fast(g11[3]) * bfhi(b1.w);
                *(u32x4*)(e.MG + row * 1024 + n0) = pack8(o0, o1); }
    }
};
struct DEpiResid {
    static constexpr bool PERM = false, AFTER_DRAIN = false; EpiResid e;
    __device__ __forceinline__ void operator()(const f32x4 (&acc)[2][2][4][2], const Unit& u, int wr, int wc, int fr, int fq) const {
        const int row0 = u.pm * BM + wr * 64 + fr, col0 = u.pn * BM + wc * 32 + 4 * fq;
        typedef unsigned u32x2 __attribute__((ext_vector_type(2)));
#pragma unroll
        for (int ai = 0; ai < 2; ++ai)
#pragma unroll
            for (int m = 0; m < 4; ++m) { const size_t ro = (size_t)(row0 + ai * HALF + m * 16) * 1024 + col0;
#pragma unroll
                for (int bj = 0; bj < 2; ++bj)
#pragma unroll
                    for (int n = 0; n < 2; ++n) { const u32x2 h = *(const u32x2*)(e.H + ro + bj * HALF + n * 16); const f32x4 a = acc[ai][bj][m][n];
                        f32x4 o; o[0] = ALPHA_F * bflo(h.x) + a[0]; o[1] = ALPHA_F * bfhi(h.x) + a[1]; o[2] = ALPHA_F * bflo(h.y) + a[2]; o[3] = ALPHA_F * bfhi(h.y) + a[3];
                        *(f32x4*)(e.Z + ro + bj * HALF + n * 16) = o; } }
    }
};

struct DEpiTile {
    static constexpr bool PERM = true, AFTER_DRAIN = false; bf16_t* O; int sm, sn; float scale;
    __device__ __forceinline__ void operator()(const f32x4 (&acc)[2][2][4][2], const Unit& u, int wr, int wc, int fr, int fq) const {
        bf16_t* base = O + (size_t)(u.pm * sm + u.pn * sn) * 65536; const int row0 = wr * 64 + fr, col0 = wc * 32 + 8 * fq;
#pragma unroll
        for (int ai = 0; ai < 2; ++ai)
#pragma unroll
            for (int m = 0; m < 4; ++m) { bf16_t* rowp = base + (size_t)(row0 + ai * HALF + m * 16) * 256 + col0;
#pragma unroll
                for (int bj = 0; bj < 2; ++bj) *(u32x4*)(rowp + bj * HALF) = pack8(acc[ai][bj][m][0] * scale, acc[ai][bj][m][1] * scale); }
    }
};
struct DEpiQ { static constexpr bool PERM = true, AFTER_DRAIN = false; DEpiTile t;
    __device__ __forceinline__ void operator()(const f32x4 (&acc)[2][2][4][2], const Unit& u, int wr, int wc, int fr, int fq) const {
        Unit v; v.pm = (u.pm >> 3) * 32 + u.pn * 8 + (u.pm & 7); v.pn = 0; t(acc, v, wr, wc, fr, fq); } };
struct DEpiO {
    static constexpr bool PERM = true, AFTER_DRAIN = false; bf16_t* O;
    __device__ __forceinline__ void operator()(const f32x4 (&acc)[2][2][4][2], const Unit& u, int wr, int wc, int fr, int fq) const {
        const int bh = u.pm >> 3, b = bh >> 2, h = bh & 3; const int s0 = (u.pm & 7) * 256 + wr * 64 + fr;
        bf16_t* base = O + ((size_t)b * SEQ) * 1024 + h * 256 + wc * 32 + 8 * fq;
#pragma unroll
        for (int ai = 0; ai < 2; ++ai)
#pragma unroll
            for (int m = 0; m < 4; ++m) { bf16_t* rowp = base + (size_t)(s0 + ai * HALF + m * 16) * 1024;
#pragma unroll
                for (int bj = 0; bj < 2; ++bj) *(u32x4*)(rowp + bj * HALF) = pack8(acc[ai][bj][m][0], acc[ai][bj][m][1]); }
    }
};
struct DEpiSoftmax {
    static constexpr bool PERM = true, AFTER_DRAIN = true; bf16_t* Pout;
    __device__ __forceinline__ void fused(f32x4 (&acc)[2][2][4][2], const Unit& u, int wr, int wc, int fr, int fq, PG8_LAS unsigned char* lds, int wid, int lane) const {
        PG8_LAS float* PM = (PG8_LAS float*)lds;
        PG8_LAS float* PS = (PG8_LAS float*)(lds + 4096);
#pragma unroll
        for (int ai = 0; ai < 2; ++ai)
#pragma unroll
            for (int m = 0; m < 4; ++m) { float mx = -3.0e38f;
#pragma unroll
                for (int bj = 0; bj < 2; ++bj)
#pragma unroll
                    for (int n = 0; n < 2; ++n) { const f32x4 x = acc[ai][bj][m][n]; mx = fmaxf(mx, fmaxf(fmaxf(x[0], x[1]), fmaxf(x[2], x[3]))); }
                mx = fmaxf(mx, __shfl_xor(mx, 16)); mx = fmaxf(mx, __shfl_xor(mx, 32));
                if (fq == 0) PM[(ai * HALF + wr * 64 + m * 16 + fr) * 4 + wc] = mx; }
        asm volatile("s_waitcnt lgkmcnt(0)" ::: "memory"); __builtin_amdgcn_s_barrier(); asm volatile("" ::: "memory");
#pragma unroll
        for (int ai = 0; ai < 2; ++ai)
#pragma unroll
            for (int m = 0; m < 4; ++m) { const int row = ai * HALF + wr * 64 + m * 16 + fr; const f32x4 p4 = *(const PG8_LAS f32x4*)(PM + row * 4);
                const float gm = fmaxf(fmaxf(p4[0], p4[1]), fmaxf(p4[2], p4[3])); float sum = 0.f;
#pragma unroll
                for (int bj = 0; bj < 2; ++bj)
#pragma unroll
                    for (int n = 0; n < 2; ++n) { f32x4 x = acc[ai][bj][m][n]; x[0] = __expf(x[0] - gm); x[1] = __expf(x[1] - gm); x[2] = __expf(x[2] - gm); x[3] = __expf(x[3] - gm);
                        acc[ai][bj][m][n] = x; sum += (x[0] + x[1]) + (x[2] + x[3]); }
                sum += __shfl_xor(sum, 16); sum += __shfl_xor(sum, 32);
                if (fq == 0) PS[row * 4 + wc] = sum; }
        asm volatile("s_waitcnt lgkmcnt(0)" ::: "memory"); __builtin_amdgcn_s_barrier(); asm volatile("" ::: "memory");
#pragma unroll
        for (int ai = 0; ai < 2; ++ai)
#pragma unroll
            for (int m = 0; m < 4; ++m) { const int row = ai * HALF + wr * 64 + m * 16 + fr; const f32x4 s4 = *(const PG8_LAS f32x4*)(PS + row * 4);
                const float inv = 1.0f / ((s4[0] + s4[1]) + (s4[2] + s4[3])); bf16_t* rowp = Pout + ((size_t)u.pm * 256 + row) * 256 + wc * 32 + 8 * fq;
#pragma unroll
                for (int bj = 0; bj < 2; ++bj) *(u32x4*)(rowp + bj * HALF) = pack8(acc[ai][bj][m][0] * inv, acc[ai][bj][m][1] * inv); }
        asm volatile("s_waitcnt lgkmcnt(0)" ::: "memory"); __builtin_amdgcn_s_barrier(); asm volatile("" ::: "memory");
    }
};
template <int KIND> struct DEpiLora {
    static constexpr bool PERM = true, AFTER_DRAIN = false; const float* bsrc0; bf16_t* O;
    __device__ __forceinline__ static f32x4 act4(f32x4 x) {
        f32x4 o;
#pragma unroll
        for (int i = 0; i < 4; ++i) {
            if (KIND == 0) { const float y = -x[i]; const float sp = fmaxf(y, 0.f) + __logf(1.0f + __expf(-fabsf(y))); const float ew = __expf(-sp - 0.5f); o[i] = 1.0f - __expf(-ew); }
            else if (KIND == 1) o[i] = __builtin_amdgcn_rcpf(1.0f + __expf(-x[i]));
            else o[i] = x[i]; }
        return o;
    }
    __device__ __forceinline__ void operator()(const f32x4 (&acc)[2][2][4][2], const Unit& u, int wr, int wc, int fr, int fq) const {
        const int row0 = u.pm * BM + wr * 64 + fr; const int z = (KIND == 2) ? 0 : (u.pn >> 1); const int cb = ((KIND == 2) ? u.pn : (u.pn & 1)) * 256 + wc * 32 + 8 * fq;
        f32x4 bv[2][2];
#pragma unroll
        for (int bj = 0; bj < 2; ++bj)
#pragma unroll
            for (int n = 0; n < 2; ++n) bv[bj][n] = (KIND == 2) ? (f32x4){0.f, 0.f, 0.f, 0.f} : *(const f32x4*)(bsrc0 + z * 512 + cb + bj * HALF + 4 * n);
#pragma unroll
        for (int ai = 0; ai < 2; ++ai)
#pragma unroll
            for (int m = 0; m < 4; ++m) { const size_t row = (size_t)(row0 + ai * HALF + m * 16);
                bf16_t* dst = (KIND == 2) ? (O + row * 512 + cb) : (O + (row * 2 + z) * 512 + cb);
#pragma unroll
                for (int bj = 0; bj < 2; ++bj) *(u32x4*)(dst + bj * HALF) = pack8(act4(acc[ai][bj][m][0] + bv[bj][0]), act4(acc[ai][bj][m][1] + bv[bj][1])); }
    }
};
}
#define LAS __attribute__((address_space(3)))
#define XB_TMO      128
#define XB_XCNT(j)  (256  + 64 * (j))
#define XB_XSUB(j)  (1280 + 64 * (j))
#define XB_XGEN(j)  (2304 + 64 * (j))
#define XB_TOP      3328
#define XB_TOPGEN   3392
#define XCD_BAR_WORDS 3456
#define XB_SPIN_CAP (1u << 18)

__device__ __forceinline__ unsigned xb_ld(unsigned* p)              { return __hip_atomic_load(p, __ATOMIC_RELAXED, __HIP_MEMORY_SCOPE_AGENT); }
__device__ __forceinline__ unsigned xb_add(unsigned* p, unsigned v) { return __hip_atomic_fetch_add(p, v, __ATOMIC_RELAXED, __HIP_MEMORY_SCOPE_AGENT); }
__device__ __forceinline__ unsigned xb_xcc_id() { return (unsigned)__builtin_amdgcn_s_getreg((3 << 11) | 20) & 0xFu; }
#define XB_SPIN(cond, bar) do { unsigned _sp = 0; while (cond) { __builtin_amdgcn_s_sleep(1); \
    if ((++_sp & 255u) == 0u) { if (xb_ld(&(bar)[XB_TMO])) break; if (_sp > XB_SPIN_CAP) { atomicAdd(&(bar)[XB_TMO], 1u); break; } } } } while (0)

struct XcdBarrier {
    unsigned* bar; unsigned x;
    volatile LAS unsigned* st;
};

__device__ __forceinline__ XcdBarrier xcd_barrier_post(unsigned* bar, volatile LAS unsigned* st) {
    XcdBarrier b; b.bar = bar; b.x = xb_xcc_id(); b.st = st;
    if (threadIdx.x == 0) (void)xb_add(&bar[XB_XCNT(b.x)], 1u);
    return b;
}
__device__ __forceinline__ void xcd_barrier_complete(unsigned* bar, unsigned x, unsigned& nloc, unsigned& nx) {
    const unsigned G = gridDim.x * gridDim.y * gridDim.z;
    unsigned sum, cnt, mine, sp = 0u;
    for (;;) {
        sum = 0u; cnt = 0u; mine = 0u;
#pragma unroll
        for (unsigned j = 0; j < 16; ++j) { const unsigned c = xb_ld(&bar[XB_XCNT(j)]); sum += c; cnt += (c > 0u) ? 1u : 0u; mine = (j == x) ? c : mine; }
        if (sum == G) break;
        __builtin_amdgcn_s_sleep(1);
        if ((++sp & 255u) == 0u) { if (xb_ld(&bar[XB_TMO])) break; if (sp > XB_SPIN_CAP) { atomicAdd(&bar[XB_TMO], 1u); break; } }
    }
    nloc = mine > 0u ? mine : 1u; nx = cnt > 0u ? cnt : 1u;
}

__device__ __forceinline__ void xcd_barrier(const XcdBarrier& b) {
    asm volatile("s_waitcnt vmcnt(0)" ::: "memory");
    __syncthreads();
    if (threadIdx.x == 0) {
        unsigned* bar = b.bar;
        __builtin_amdgcn_s_waitcnt(0);
        unsigned nloc = b.st[0], nx = b.st[1];
        if (nloc == 0u) { xcd_barrier_complete(bar, b.x, nloc, nx); b.st[0] = nloc; b.st[1] = nx; }
        const unsigned old = xb_add(&bar[XB_XSUB(b.x)], 1u);
        const unsigned gen = old / nloc;
        if (old + 1u == (gen + 1u) * nloc) {
            __builtin_amdgcn_fence(__ATOMIC_RELEASE, "agent");
            asm volatile("s_waitcnt vmcnt(0)" ::: "memory");
            const unsigned og = xb_add(&bar[XB_TOP], 1u);
            const unsigned tg = og / nx;
            if (og + 1u == (tg + 1u) * nx) xb_add(&bar[XB_TOPGEN], 1u);
            else XB_SPIN(xb_ld(&bar[XB_TOPGEN]) == tg, bar);
            __builtin_amdgcn_fence(__ATOMIC_ACQUIRE, "agent");
            xb_add(&bar[XB_XGEN(b.x)], 1u);
            asm volatile("s_waitcnt vmcnt(0)" ::: "memory");
        } else {
            XB_SPIN(xb_ld(&bar[XB_XGEN(b.x)]) == gen, bar);
            __builtin_amdgcn_fence(__ATOMIC_ACQUIRE, "agent");
            asm volatile("s_waitcnt vmcnt(0)" ::: "memory");
        }
    }
    __syncthreads();
}

#endif

#ifdef HOST_EMU
template <class F> static void emu_gemm(const bf16_t* A, const bf16_t* Bt, int M, int N, int K, F f) {
#pragma omp parallel for schedule(static)
    for (int r = 0; r < M; ++r)
        for (int c = 0; c < N; ++c) { float a = 0.f; for (int k = 0; k < K; ++k) a += bf2f(A[(size_t)r * K + k]) * bf2f(Bt[(size_t)c * K + k]); f(r, c, a); }
}
#endif

#define GS_LOOP(idx, n) for (long idx = gtid; idx < (long)(n); idx += nthr)

__device__ __forceinline__ int win_src_col(int n) {
    if (n < 1920) return n;
    if (n < 2048) return -1;
    if (n < 3072) return 1920 + (n - 2048);
    const int m = n - 3072, j = m / 256, i = m % 256;
    return (i < 128) ? (2944 + 128 * j + i) : (2944 + 1024 + 128 * j + (i - 128));
}
__device__ __forceinline__ void ph0_weights(const Params& P, long gtid, long nthr) {
    GS_LOOP(idx, (size_t)5120 * 1024) { const int n = (int)(idx / 1024), k = (int)(idx % 1024); const int c = win_src_col(n);
        P.W_IN_T[idx] = (c < 0) ? (bf16_t)0 : f2bf(P.in[I_W_IN][(size_t)k * IN_COLS + c]); }
    GS_LOOP(idx, (size_t)2048 * 512) { const int n = (int)(idx / 512), k = (int)(idx % 512); const int br = n / 1024, nn = n % 1024;
        P.W_BR_T[idx] = f2bf(P.in[I_W_BRANCH][((size_t)br * 512 + k) * 1024 + nn]); }
    GS_LOOP(idx, (size_t)1024 * 1024) { const int n = (int)(idx / 1024), k = (int)(idx % 1024);
        P.W_MIX_T[idx] = f2bf(P.in[I_W_MIX][(size_t)k * 1024 + n]);
        P.W_Q_T[idx] = f2bf(P.in[I_W_Q][(size_t)k * 1024 + n]);
        P.W_O_T[idx] = f2bf(P.in[I_W_O][(size_t)k * 1024 + n]); }
    GS_LOOP(idx, (size_t)2048 * 1024) { const int n = (int)(idx / 1024), k = (int)(idx % 1024);
        P.W_KV_T[idx] = f2bf(P.in[I_W_KV][(size_t)k * 2048 + n]);
        P.W_QUERY_T[idx] = f2bf(P.in[I_W_QUERY][(size_t)k * 2048 + n]); }
}
__device__ __forceinline__ void ln_rows_bf16(const float* in, const float* g, const float* b, bf16_t* out, int rows, int width, long gtid, long nthr) {
    GS_LOOP(row, rows) { const float* x = in + (size_t)row * width; float s = 0.f;
        for (int i = 0; i < width; ++i) s += x[i];
        const float mu = s / width; float q = 0.f;
        for (int i = 0; i < width; ++i) { const float d = x[i] - mu; q += d * d; }
        const float rs = 1.0f / sqrtf(q / width + 1e-5f); bf16_t* o = out + (size_t)row * width;
        for (int i = 0; i < width; ++i) o[i] = f2bf((x[i] - mu) * rs * g[i] + b[i]); }
}
__device__ __forceinline__ void ph2a_vn(const Params& P, long gtid, long nthr) {
    GS_LOOP(row, TOK) { const bf16_t* x = P.PB + (size_t)row * 1024 + 512; float s = 0.f;
        for (int i = 0; i < 512; ++i) s += bf2f(x[i]);
        const float mu = s / 512.f; float q = 0.f;
        for (int i = 0; i < 512; ++i) { const float d = bf2f(x[i]) - mu; q += d * d; }
        const float rs = 1.0f / sqrtf(q / 512.f + 1e-5f); bf16_t* o = P.VN + (size_t)row * 512;
        for (int i = 0; i < 512; ++i) o[i] = f2bf((bf2f(x[i]) - mu) * rs * P.in[I_GLN_G][i] + P.in[I_GLN_B][i]); }
}
__device__ __forceinline__ void ph2b_gmlp(const Params& P, long gtid, long nthr) {
    GS_LOOP(idx, (size_t)TOK * 512) { const int c = (int)(idx % 512); const long t = idx / 512; const int g = c / 64; const long ch = t / 128; const int p = (int)(t % 128);
        const float* ws = P.in[I_W_S] + ((size_t)g * 128 + p) * 128; float s = 0.f;
        for (int q = 0; q < 128; ++q) s += ws[q] * bf2f(P.VN[(size_t)(ch * 128 + q) * 512 + c]);
        s += P.in[I_B_S][g * 128 + p];
        P.YB[idx] = f2bf(bf2f(P.PB[(size_t)t * 1024 + c]) * s); }
}
__device__ __forceinline__ float pa_shift(const Params& P, long t, int c) {
    const int s = (int)(t % SEQ); const float cur = bf2f(P.PA[(size_t)t * 2048 + c]);
    const float prev = (s > 0) ? bf2f(P.PA[(size_t)(t - 1) * 2048 + c]) : 0.f;
    const float nxt = (s < SEQ - 1) ? bf2f(P.PA[(size_t)(t + 1) * 2048 + c]) : 0.f;
    return cur + P.in[I_MU][c] * (0.5f * (prev + nxt) - cur);
}
__device__ __forceinline__ void ph3a_lora_in(const Params& P, long gtid, long nthr) {
    GS_LOOP(idx, (size_t)TOK * 128) { const int r = (int)(idx % 128); const long t = idx / 128;
        P.WDS[idx] = f2bf(tanhf(pa_shift(P, t, 1536 + r)));
        P.ADS[idx] = f2bf(pa_shift(P, t, 1664 + r));
        P.SG[idx] = f2bf(sigmoidf_(pa_shift(P, t, 1792 + r))); }
}
__device__ __forceinline__ void ph3b_prep(const Params& P, long gtid, long nthr) {
    GS_LOOP(idx, (size_t)TOK * 8) { const int h = (int)(idx % 8); const long t = idx / 8; const int hb = h * 64;
        float ss = 0.f;
        for (int j = 0; j < 64; ++j) { const float v = pa_shift(P, t, 512 + hb + j) * P.in[I_K_K][hb + j]; ss += v * v; }
        const float inv = 1.0f / fmaxf(sqrtf(ss), 1e-12f);
        for (int j = 0; j < 64; ++j) { const int c = hb + j;
            const float k = pa_shift(P, t, 512 + c); const float kk = k * P.in[I_K_K][c] * inv;
            P.R[(size_t)t * 512 + c] = f2bf(pa_shift(P, t, c));
            P.V[(size_t)t * 512 + c] = f2bf(pa_shift(P, t, 1024 + c));
            P.KK[(size_t)t * 512 + c] = f2bf(kk);
            for (int z = 0; z < 2; ++z) {
                float sw = P.in[I_W0][z * 512 + c], sa = P.in[I_A0][z * 512 + c];
                for (int r = 0; r < 64; ++r) { sw += bf2f(P.WDS[(size_t)t * 128 + z * 64 + r]) * P.in[I_W2][((size_t)z * 64 + r) * 512 + c];
                                               sa += bf2f(P.ADS[(size_t)t * 128 + z * 64 + r]) * P.in[I_A2][((size_t)z * 64 + r) * 512 + c]; }
                const float y = -sw; const float sp = fmaxf(y, 0.f) + log1pf(expf(-fabsf(y))); const float wlog = -sp - 0.5f;
                const float ew = expf(wlog);
                const float a = sigmoidf_(sa); const size_t o = ((size_t)t * 2 + z) * 512 + c;
                P.OMW[o] = f2bf(-expm1f(-ew));
                P.KDIR[o] = f2bf(k * (1.0f + (a - 1.0f) * P.in[I_K_A][c]));
                P.BVEC[o] = f2bf(kk * a); } } }
}
__device__ __forceinline__ void scan_item(const Params& P, int chain, int i) {
    const int h = chain % 8, b = (chain / 8) % BATCH, z = chain / (8 * BATCH);
    float S[64];
#pragma unroll
    for (int j = 0; j < 64; ++j) S[j] = 0.f;
    for (int n = 0; n < SEQ; ++n) {
        const long t = (long)b * SEQ + ((z == 0) ? n : (SEQ - 1 - n));
        const bf16_t* r = P.R + (size_t)t * 512 + h * 64; const bf16_t* a = P.KK + (size_t)t * 512 + h * 64;
        const bf16_t* w = P.OMW + ((size_t)t * 2 + z) * 512 + h * 64; const bf16_t* k = P.KDIR + ((size_t)t * 2 + z) * 512 + h * 64;
        const bf16_t* bv = P.BVEC + ((size_t)t * 2 + z) * 512 + h * 64;
        const float v = bf2f(P.V[(size_t)t * 512 + h * 64 + i]);
        float sa = 0.f;
#pragma unroll
        for (int j = 0; j < 64; ++j) sa -= S[j] * bf2f(a[j]);
        float y = 0.f;
#pragma unroll
        for (int j = 0; j < 64; ++j) { S[j] = S[j] * (1.0f - bf2f(w[j])) + sa * bf2f(bv[j]) + v * bf2f(k[j]); y += S[j] * bf2f(r[j]); }
        P.Y01[((size_t)z * TOK + t) * 512 + h * 64 + i] = y;
    }
}
__device__ __forceinline__ void ph5_rwkv_out(const Params& P, long gtid, long nthr) {
    GS_LOOP(idx, (size_t)TOK * 512) { const int c = (int)(idx % 512); const long t = idx / 512; const int hb = (c / 64) * 64;
        const float* y0 = P.Y01 + (size_t)t * 512 + hb; const float* y1 = P.Y01 + ((size_t)TOK + t) * 512 + hb;
        float s = 0.f;
        for (int j = 0; j < 64; ++j) s += y0[j] + y1[j];
        const float mu = s / 64.f; float q = 0.f;
        for (int j = 0; j < 64; ++j) { const float d = y0[j] + y1[j] - mu; q += d * d; }
        const float rs = 1.0f / sqrtf(q / 64.f + 64e-5f);
        const float yn = (y0[c - hb] + y1[c - hb] - mu) * rs * P.in[I_GN_G][c] + P.in[I_GN_B][c];
        float rk = 0.f;
        for (int z = 0; z < 2; ++z)
            for (int j = 0; j < 64; ++j) rk += bf2f(P.R[(size_t)t * 512 + hb + j]) * bf2f(P.KDIR[((size_t)t * 2 + z) * 512 + hb + j]) * P.in[I_R_K][hb + j];
        float g = 0.f;
        for (int r = 0; r < 128; ++r) g += bf2f(P.SG[(size_t)t * 128 + r]) * P.in[I_G2][(size_t)r * 512 + c];
        P.YA[idx] = f2bf((yn + rk * bf2f(P.V[(size_t)t * 512 + c])) * g); }
}
__device__ __forceinline__ void ph_ln_z(const Params& P, const float* g, const float* b, long gtid, long nthr) { ln_rows_bf16(P.Z, g, b, P.HB, TOK, 1024, gtid, nthr); }
__device__ __forceinline__ void ph10a_scores(const Params& P, long gtid, long nthr) {
    GS_LOOP(idx, (size_t)TOK * 4 * 256) { const int m = (int)(idx % 256); const long rowi = idx / 256; const int s = (int)(rowi % SEQ); const int bh = (int)(rowi / SEQ); const int b = bh / 4, h = bh % 4;
        const bf16_t* q = P.Q + ((size_t)b * SEQ + s) * 1024 + h * 256; const bf16_t* k = P.KV + ((size_t)b * 256 + m) * 2048 + h * 256; float a = 0.f;
        for (int d = 0; d < 256; ++d) a += bf2f(q[d]) * bf2f(k[d]);
        P.SCA[idx] = a * 0.0625f; }
}
__device__ __forceinline__ void ph10b_softmax(const Params& P, long gtid, long nthr) {
    GS_LOOP(row, (size_t)TOK * 4) { float* x = P.SCA + (size_t)row * 256; float mx = x[0];
        for (int i = 1; i < 256; ++i) mx = fmaxf(mx, x[i]);
        float s = 0.f;
        for (int i = 0; i < 256; ++i) s += expf(x[i] - mx);
        const float inv = 1.0f / s;
        for (int i = 0; i < 256; ++i) x[i] = expf(x[i] - mx) * inv; }
}
__device__ __forceinline__ void ph10c_out(const Params& P, long gtid, long nthr) {
    GS_LOOP(idx, (size_t)TOK * 1024) { const int c = (int)(idx % 1024); const long t = idx / 1024; const int b = (int)(t / SEQ), s = (int)(t % SEQ), h = c / 256;
        const float* pr = P.SCA + (((size_t)b * 4 + h) * SEQ + s) * 256; float a = 0.f;
        for (int m = 0; m < 256; ++m) a += pr[m] * bf2f(P.KV[((size_t)b * 256 + m) * 2048 + 1024 + c]);
        P.O[idx] = f2bf(a); }
}
__device__ __forceinline__ void ph13a_scores(const Params& P, long gtid, long nthr) {
    GS_LOOP(idx, (size_t)TOK * 2048) { const int k = (int)(idx % 128), z = (int)((idx / 128) % 2), h = (int)((idx / 256) % 8); const long t = idx / 2048;
        const bf16_t* q = P.QP + (size_t)t * 2048 + h * 256 + z * 128; const float* kr = P.in[I_SUBKEYS] + ((size_t)z * 128 + k) * 128; float a = 0.f;
        for (int c = 0; c < 128; ++c) a += bf2f(q[c]) * kr[c];
        P.SC[idx] = a; }
}
__device__ __forceinline__ void ph13b_topk(const Params& P, long gtid, long nthr) {
    GS_LOOP(row, (size_t)TOK * 16) { const float* x = P.SC + (size_t)row * 128; float pv = 0.f; int pi = -1;
        for (int j = 0; j < 16; ++j) { float best = 0.f; int bi = -1;
            for (int i = 0; i < 128; ++i) { const float v = x[i]; const bool elig = (j == 0) || (v < pv) || (v == pv && i > pi);
                if (elig && (bi < 0 || v > best)) { best = v; bi = i; } }
            P.TOPS[(size_t)row * 16 + j] = best; P.TOPI[(size_t)row * 16 + j] = bi; pv = best; pi = bi; } }
}
__device__ __forceinline__ void ph13c_cand(const Params& P, long gtid, long nthr) {
    GS_LOOP(row, (size_t)TOK * 8) { const float* s0 = P.TOPS + (size_t)row * 32; const float* s1 = s0 + 16; const int* i0 = P.TOPI + (size_t)row * 32; const int* i1 = i0 + 16;
        float pv = 0.f; int pi = -1; float mx = 0.f;
        for (int j = 0; j < 16; ++j) { float best = 0.f; int bi = -1;
            for (int c = 0; c < 256; ++c) { const float v = s0[c / 16] + s1[c % 16]; const bool elig = (j == 0) || (v < pv) || (v == pv && c > pi);
                if (elig && (bi < 0 || v > best)) { best = v; bi = c; } }
            if (j == 0) mx = best;
            P.GATE[(size_t)row * 16 + j] = best; P.EXPERT[(size_t)row * 16 + j] = i0[bi / 16] * 128 + i1[bi % 16]; pv = best; pi = bi; }
        float s = 0.f;
        for (int j = 0; j < 16; ++j) s += expf(P.GATE[(size_t)row * 16 + j] - mx);
        const float inv = 1.0f / s;
        for (int j = 0; j < 16; ++j) P.GATE[(size_t)row * 16 + j] = expf(P.GATE[(size_t)row * 16 + j] - mx) * inv; }
}
__device__ __forceinline__ void ph14a_act(const Params& P, long gtid, long nthr) {
    GS_LOOP(idx, (size_t)TOK * 128) { const long t = idx / 128; const bf16_t* x = P.HB + (size_t)t * 1024; const float* ur = P.in[I_PEER_U] + (size_t)P.EXPERT[idx] * 1024; float a = 0.f;
        for (int d = 0; d < 1024; ++d) a += ur[d] * bf2f(x[d]);
        P.COEF[idx] = P.GATE[idx] * geluf_(a); }
}
__device__ __forceinline__ void ph14b_out(const Params& P, long gtid, long nthr) {
    GS_LOOP(idx, (size_t)TOK * 1024) { const int d = (int)(idx % 1024); const long t = idx / 1024; float a = 0.f;
        for (int j = 0; j < 128; ++j) a += P.COEF[(size_t)t * 128 + j] * P.in[I_PEER_V][(size_t)P.EXPERT[(size_t)t * 128 + j] * 1024 + d];
        P.Y[idx] = a; }
}
__device__ __forceinline__ void ph14c_final(const Params& P, long gtid, long nthr) {
    GS_LOOP(row, TOK) { const bf16_t* hr = P.HB + (size_t)row * 1024; const float* yr = P.Y + (size_t)row * 1024; float s = 0.f;
        for (int i = 0; i < 1024; ++i) s += ALPHA_F * bf2f(hr[i]) + yr[i];
        const float mu = s / 1024.f; float q = 0.f;
        for (int i = 0; i < 1024; ++i) { const float d = ALPHA_F * bf2f(hr[i]) + yr[i] - mu; q += d * d; }
        const float rs = 1.0f / sqrtf(q / 1024.f + 1e-5f); float* o = P.out + (size_t)row * 1024;
        for (int i = 0; i < 1024; ++i) o[i] = (ALPHA_F * bf2f(hr[i]) + yr[i] - mu) * rs * P.in[I_LN3_G][i] + P.in[I_LN3_B][i]; }
}

static void make_params(Params& P, void* const* d_in, void* d_out, void* d_ws) {
    memset(&P, 0, sizeof(P));
    for (int i = 0; i < 37; ++i) P.in[i] = (const float*)d_in[i];
    P.out = (float*)d_out; unsigned char* ws = (unsigned char*)d_ws; unsigned char* ob = (unsigned char*)d_out;
    unsigned char* r1 = ws + A_R1; unsigned char* r2 = ws + A_R2;
    P.ctl = (unsigned*)(ws + WS_CTL);
    P.W_IN_T = (bf16_t*)(ws + WS_W + OFF_W_IN); P.W_BR_T = (bf16_t*)(ws + WS_W + OFF_W_BR); P.W_MIX_T = (bf16_t*)(ws + WS_W + OFF_W_MIX);
    P.W_Q_T = (bf16_t*)(ws + WS_W + OFF_W_Q); P.W_KV_T = (bf16_t*)(ws + WS_W + OFF_W_KV); P.W_O_T = (bf16_t*)(ws + WS_W + OFF_W_O); P.W_QUERY_T = (bf16_t*)(ws + WS_W + OFF_W_QUERY);
    P.KV = (bf16_t*)(ws + WS_KV); P.MEMN = (bf16_t*)(ws + WS_MEMN); P.HB = (bf16_t*)(ws + A_HB);
    P.PA = (bf16_t*)r1; P.PB = (bf16_t*)r2; P.VN = (bf16_t*)(r2 + 2 * TU);
    P.YB = (bf16_t*)ob; P.WDS = (bf16_t*)(ob + TU); P.ADS = (bf16_t*)(ob + TU + TU / 4); P.SG = (bf16_t*)(ob + TU + TU / 2);
    P.R = (bf16_t*)(ob + 2 * TU); P.KK = (bf16_t*)(ob + 3 * TU);
    P.V = (bf16_t*)r2; P.OMW = (bf16_t*)(r2 + TU); P.KDIR = (bf16_t*)(r2 + 3 * TU); P.BVEC = (bf16_t*)(r2 + 5 * TU);
    P.Y01 = (float*)r1; P.YA = (bf16_t*)(r2 + TU); P.BR = (bf16_t*)r1; P.MG = (bf16_t*)r2; P.Z = (float*)ob;
    P.Q = (bf16_t*)r1; P.O = (bf16_t*)(r1 + 2 * TU); P.SCA = (float*)r2; P.QP = (bf16_t*)ob;
    P.SC = (float*)r1; P.TOPS = (float*)(r2 + 4 * TU); P.TOPI = (int*)(r2 + 5 * TU); P.GATE = (float*)(r2 + 6 * TU); P.EXPERT = (int*)(r2 + 6 * TU + TU / 2);
    P.COEF = (float*)(r2 + 7 * TU); P.Y = (float*)r1;
    P.UB = (bf16_t*)r1; P.VB = (bf16_t*)(r1 + (size_t)16384 * 1024 * 2);
    P.U8 = r1; P.V8 = r1 + (size_t)16384 * 1024; P.SU = (float*)(r1 + (size_t)2 * 16384 * 1024); P.SV = P.SU + 16384;
    P.W_LORA_T = (bf16_t*)(ws + WS_W + OFF_W_LORA); P.WSB = (bf16_t*)(ws + WS_W + OFF_WSB);
    P.LIN = (bf16_t*)(ob + TU); P.V = (bf16_t*)(r2 + 2 * TU); P.K = (bf16_t*)(r2 + 3 * TU); P.OMW = (bf16_t*)r2; P.AL = (bf16_t*)(r2 + 4 * TU); P.G = (bf16_t*)(r2 + 6 * TU);
    P.YA = (bf16_t*)r2;
    P.KH = (bf16_t*)(ws + WS_KV); P.VT = (bf16_t*)(ws + WS_KV + 4 * MiB); P.QH = (bf16_t*)r1; P.PP = (bf16_t*)r2;
    P.GATE = (float*)(r2 + 6 * TU); P.EXPERT = (int*)(r2 + 6 * TU + TU / 2);
}

#ifndef NEW_PEER
#define NEW_PEER 1
#endif
#ifndef USE_DOT2
#define USE_DOT2 0
#endif
#ifndef ATT_OLD
#define ATT_OLD 0
#endif
#ifndef NEW_SCAN
#define NEW_SCAN 1
#endif
#ifndef NEW_ROUTE
#define NEW_ROUTE 1
#endif
#ifndef PEER_FP8
#define PEER_FP8 1
#endif
#define AX (ATT_OLD ? 1 : 0)
#define N_PHASES ((NEW_ROUTE ? 20 : 23) + AX)
__device__ __forceinline__ void run_simt_phase(const Params& P, int ph, long gtid, long nthr) {
    switch (ph) {
    case 0: ph0_weights(P, gtid, nthr);
            ln_rows_bf16(P.in[I_X], P.in[I_LN_EMB_G], P.in[I_LN_EMB_B], P.HB, TOK, 1024, gtid, nthr);
            ln_rows_bf16(P.in[I_MEM], P.in[I_MLN_G], P.in[I_MLN_B], P.MEMN, BATCH * MEM_LEN, 1024, gtid, nthr); break;
    case 2: ph2a_vn(P, gtid, nthr); break;
    case 3: ph2b_gmlp(P, gtid, nthr); break;
    case 4: ph3a_lora_in(P, gtid, nthr); break;
    case 5: ph3b_prep(P, gtid, nthr); break;
    case 7: ph5_rwkv_out(P, gtid, nthr); break;
    case 11: ph_ln_z(P, P.in[I_LN1_G], P.in[I_LN1_B], gtid, nthr); break;
    case 13: ph10a_scores(P, gtid, nthr); break;
    case 14: ph10b_softmax(P, gtid, nthr); break;
    case 15: ph10c_out(P, gtid, nthr); break;
    case 17: ph_ln_z(P, P.in[I_LN2_G], P.in[I_LN2_B], gtid, nthr); break;
    case 19: ph13a_scores(P, gtid, nthr); break;
    case 20: ph13b_topk(P, gtid, nthr); break;
    case 21: ph13c_cand(P, gtid, nthr); break;
    case 22: ph14a_act(P, gtid, nthr); break;
    case 23: ph14b_out(P, gtid, nthr); break;
    case 24: ph14c_final(P, gtid, nthr); break;
    default: break;
    }
}

#ifdef HOST_EMU
static void emu_run(const Params& P) {
    for (int ph = 0; ph < N_PHASES; ++ph) {
        switch (ph) {
        case 1:
            emu_gemm(P.HB, P.W_IN_T, TOK, 3072, 1024, [&](int r, int c, float a) { if (c < 2048) P.PA[(size_t)r * 2048 + c] = f2bf(a); else P.PB[(size_t)r * 1024 + c - 2048] = f2bf(geluf_(a)); });
            emu_gemm(P.MEMN, P.W_KV_T, BATCH * MEM_LEN, 2048, 1024, [&](int r, int c, float a) { P.KV[(size_t)r * 2048 + c] = f2bf(a); });
            break;
        case 6:
#pragma omp parallel for schedule(dynamic, 1)
            for (int it = 0; it < 2 * BATCH * 8 * 64; ++it) scan_item(P, it / 64, it % 64);
            break;
        case 8:
            emu_gemm(P.YA, P.W_BR_T, TOK, 1024, 512, [&](int r, int c, float a) { P.BR[(size_t)r * 2048 + c] = f2bf(a); });
            emu_gemm(P.YB, P.W_BR_T + (size_t)1024 * 512, TOK, 1024, 512, [&](int r, int c, float a) { P.BR[(size_t)r * 2048 + 1024 + c] = f2bf(a); });
            break;
        case 9: {
            float* tmp = (float*)malloc((size_t)TOK * 2048 * 4);
            emu_gemm(P.HB, P.W_IN_T + (size_t)3072 * 1024, TOK, 2048, 1024, [&](int r, int c, float a) { tmp[(size_t)r * 2048 + c] = a; });
            for (int r = 0; r < TOK; ++r) for (int n = 0; n < 1024; ++n) { const int j = n / 128, i = n % 128;
                const float g0 = tmp[(size_t)r * 2048 + 256 * j + i], g1 = tmp[(size_t)r * 2048 + 256 * j + 128 + i];
                P.MG[(size_t)r * 1024 + n] = f2bf(sigmoidf_(g0) * bf2f(P.BR[(size_t)r * 2048 + n]) + sigmoidf_(g1) * bf2f(P.BR[(size_t)r * 2048 + 1024 + n])); }
            free(tmp); } break;
        case 10: emu_gemm(P.MG, P.W_MIX_T, TOK, 1024, 1024, [&](int r, int c, float a) { P.Z[(size_t)r * 1024 + c] = ALPHA_F * bf2f(P.HB[(size_t)r * 1024 + c]) + a; }); break;
        case 12: emu_gemm(P.HB, P.W_Q_T, TOK, 1024, 1024, [&](int r, int c, float a) { P.Q[(size_t)r * 1024 + c] = f2bf(a); }); break;
        case 16: emu_gemm(P.O, P.W_O_T, TOK, 1024, 1024, [&](int r, int c, float a) { P.Z[(size_t)r * 1024 + c] = ALPHA_F * bf2f(P.HB[(size_t)r * 1024 + c]) + a; }); break;
        case 18: emu_gemm(P.HB, P.W_QUERY_T, TOK, 2048, 1024, [&](int r, int c, float a) { P.QP[(size_t)r * 2048 + c] = f2bf(a); }); break;
        default: {
            const long NT = 64;
#pragma omp parallel for schedule(static, 1)
            for (long g = 0; g < NT; ++g) run_simt_phase(P, ph, g, NT);
        } break;
        }
    }
}
extern "C" void kernel_launch(void* const* d_in, const int* in_sizes, int n_in, void* d_out, int out_size, void* d_ws, size_t ws_size, hipStream_t stream) {
    Params P; make_params(P, d_in, d_out, d_ws);
    memset(d_ws, 0, 1 << 20);
    emu_run(P);
}
#else

typedef float f32x4 __attribute__((ext_vector_type(4)));
typedef unsigned u32x4 __attribute__((ext_vector_type(4)));
typedef unsigned u32x2 __attribute__((ext_vector_type(2)));
typedef __bf16 bf16x2_t __attribute__((ext_vector_type(2)));
__device__ __forceinline__ float wave_sum(float v) {
#pragma unroll
    for (int o = 1; o < 64; o <<= 1) v += __shfl_xor(v, o);
    return v;
}
__device__ __forceinline__ float wave_max(float v) {
#pragma unroll
    for (int o = 1; o < 64; o <<= 1) v = fmaxf(v, __shfl_xor(v, o));
    return v;
}
__device__ __forceinline__ unsigned pk2(float lo, float hi) { return (unsigned)f2bf(lo) | ((unsigned)f2bf(hi) << 16); }
__device__ __forceinline__ float blo(unsigned w) { return __uint_as_float(w << 16); }
__device__ __forceinline__ float bhi(unsigned w) { return __uint_as_float(w & 0xffff0000u); }
__device__ __forceinline__ void wln_f32_bf16(const float* xrow, const float* g, const float* b, bf16_t* orow, int lane) {
    const f32x4* xr = (const f32x4*)xrow + lane; f32x4 v[4]; float s = 0.f;
#pragma unroll
    for (int j = 0; j < 4; ++j) { v[j] = xr[64 * j]; s += (v[j][0] + v[j][1]) + (v[j][2] + v[j][3]); }
    const float mean = wave_sum(s) * (1.f / 1024.f); float s2 = 0.f;
#pragma unroll
    for (int j = 0; j < 4; ++j) { v[j] = v[j] - mean; s2 += (v[j][0] * v[j][0] + v[j][1] * v[j][1]) + (v[j][2] * v[j][2] + v[j][3] * v[j][3]); }
    const float rstd = 1.f / sqrtf(wave_sum(s2) * (1.f / 1024.f) + 1e-5f);
#pragma unroll
    for (int j = 0; j < 4; ++j) { const f32x4 gg = ((const f32x4*)g)[64 * j + lane], bb = ((const f32x4*)b)[64 * j + lane]; const f32x4 o = v[j] * rstd * gg + bb;
        u32x2 w; w.x = pk2(o[0], o[1]); w.y = pk2(o[2], o[3]); *((u32x2*)orow + 64 * j + lane) = w; }
}
__device__ __forceinline__ void d_ln_rows(const float* in, const float* g, const float* b, bf16_t* out, int rows, int gw, int ngw, int lane) {
    for (int m = gw; m < rows; m += ngw) wln_f32_bf16(in + (size_t)m * 1024, g, b, out + (size_t)m * 1024, lane);
}
__device__ __forceinline__ void d_vn(const Params& P, int gw, int ngw, int lane) {
    const f32x4 g0 = ((const f32x4*)P.in[I_GLN_G])[2 * lane], g1 = ((const f32x4*)P.in[I_GLN_G])[2 * lane + 1];
    const f32x4 b0 = ((const f32x4*)P.in[I_GLN_B])[2 * lane], b1 = ((const f32x4*)P.in[I_GLN_B])[2 * lane + 1];
    for (int m = gw; m < TOK; m += ngw) {
        const u32x4 w = *((const u32x4*)(P.PB + (size_t)m * 1024 + 512) + lane);
        float x[8] = {blo(w.x), bhi(w.x), blo(w.y), bhi(w.y), blo(w.z), bhi(w.z), blo(w.w), bhi(w.w)};
        float s = 0.f;
#pragma unroll
        for (int i = 0; i < 8; ++i) s += x[i];
        const float mean = wave_sum(s) * (1.f / 512.f); float s2 = 0.f;
#pragma unroll
        for (int i = 0; i < 8; ++i) { x[i] -= mean; s2 += x[i] * x[i]; }
        const float rstd = 1.f / sqrtf(wave_sum(s2) * (1.f / 512.f) + 1e-5f);
        u32x4 o; o.x = pk2(x[0] * rstd * g0[0] + b0[0], x[1] * rstd * g0[1] + b0[1]); o.y = pk2(x[2] * rstd * g0[2] + b0[2], x[3] * rstd * g0[3] + b0[3]);
        o.z = pk2(x[4] * rstd * g1[0] + b1[0], x[5] * rstd * g1[1] + b1[1]); o.w = pk2(x[6] * rstd * g1[2] + b1[2], x[7] * rstd * g1[3] + b1[3]);
        *((u32x4*)(P.VN + (size_t)m * 512) + lane) = o;
    }
}
__device__ __forceinline__ void d_softmax256(const Params& P, int gw, int ngw, int lane) {
    for (long m = gw; m < (long)TOK * 4; m += ngw) { f32x4* xr = (f32x4*)(P.SCA + (size_t)m * 256) + lane; f32x4 v = *xr;
        const float mx = wave_max(fmaxf(fmaxf(v[0], v[1]), fmaxf(v[2], v[3])));
        v[0] = __expf(v[0] - mx); v[1] = __expf(v[1] - mx); v[2] = __expf(v[2] - mx); v[3] = __expf(v[3] - mx);
        const float inv = 1.0f / wave_sum((v[0] + v[1]) + (v[2] + v[3])); *xr = v * inv; }
}
__device__ __forceinline__ void tr_item(const float* W, int ldw, int src_col0, bf16_t* WT, int K, int dst_row0, int k0, LAS float* scr, int lane) {
    const int c = lane & 7;
    if (src_col0 < 0) {
#pragma unroll
        for (int j = 0; j < 4; ++j) { const int n = (lane >> 3) + 8 * j; *(u32x4*)(WT + (size_t)(dst_row0 + n) * K + k0 + 8 * c) = (u32x4){0u, 0u, 0u, 0u}; }
        return;
    }
#pragma unroll 8
    for (int i = 0; i < 32; ++i) { const int kk = 2 * i + (lane >> 5); scr[kk * 33 + (lane & 31)] = W[(size_t)(k0 + kk) * ldw + src_col0 + (lane & 31)]; }
    asm volatile("s_waitcnt lgkmcnt(0)" ::: "memory");
#pragma unroll
    for (int j = 0; j < 4; ++j) { const int n = (lane >> 3) + 8 * j; const LAS float* sp = scr + (8 * c) * 33 + n;
        u32x4 o; o.x = pk2(sp[0 * 33], sp[1 * 33]); o.y = pk2(sp[2 * 33], sp[3 * 33]); o.z = pk2(sp[4 * 33], sp[5 * 33]); o.w = pk2(sp[6 * 33], sp[7 * 33]);
        *(u32x4*)(WT + (size_t)(dst_row0 + n) * K + k0 + 8 * c) = o; }
    asm volatile("s_waitcnt lgkmcnt(0)" ::: "memory");
}
__device__ __forceinline__ void d_weights(const Params& P, LAS unsigned char* lds, int gw, int ngw, int wave, int lane) {
    LAS float* scr = (LAS float*)(lds + wave * 16384);
    constexpr int I_IN = 160 * 16, I_BR = 2 * 32 * 8, I_SQ = 32 * 16, I_WIDE = 64 * 16;
    constexpr int NITEMS = I_IN + I_BR + 3 * I_SQ + 2 * I_WIDE;
    for (int it = gw; it < NITEMS; it += ngw) {
        int r = it;
        if (r < I_IN) { const int nb = r / 16, kb = r % 16; tr_item(P.in[I_W_IN], IN_COLS, win_src_col(32 * nb), P.W_IN_T, 1024, 32 * nb, 64 * kb, scr, lane); continue; } r -= I_IN;
        if (r < I_BR) { const int br = r / 256, q = r % 256, nb = q / 8, kb = q % 8; tr_item(P.in[I_W_BRANCH] + (size_t)br * 512 * 1024, 1024, 32 * nb, P.W_BR_T, 512, br * 1024 + 32 * nb, 64 * kb, scr, lane); continue; } r -= I_BR;
        if (r < 3 * I_SQ) { const int w = r / I_SQ, q = r % I_SQ, nb = q / 16, kb = q % 16;
            const float* src = (w == 0) ? P.in[I_W_MIX] : (w == 1) ? P.in[I_W_Q] : P.in[I_W_O]; bf16_t* dst = (w == 0) ? P.W_MIX_T : (w == 1) ? P.W_Q_T : P.W_O_T;
            tr_item(src, 1024, 32 * nb, dst, 1024, 32 * nb, 64 * kb, scr, lane); continue; } r -= 3 * I_SQ;
        { const int w = r / I_WIDE, q = r % I_WIDE, nb = q / 16, kb = q % 16;
            tr_item(w == 0 ? P.in[I_W_KV] : P.in[I_W_QUERY], 2048, 32 * nb, w == 0 ? P.W_KV_T : P.W_QUERY_T, 1024, 32 * nb, 64 * kb, scr, lane); }
    }
}
__device__ __forceinline__ void d_tables(const Params& P, long gtid, long nthr) {
    const long n8 = (long)16384 * 1024 / 8;
    for (long i = gtid; i < 2 * n8; i += nthr) { const bool isv = (i >= n8); const long j = isv ? i - n8 : i;
        const f32x4* src = (const f32x4*)(isv ? P.in[I_PEER_V] : P.in[I_PEER_U]) + 2 * j; const f32x4 a = src[0], b = src[1];
        u32x4 o; o.x = pk2(a[0], a[1]); o.y = pk2(a[2], a[3]); o.z = pk2(b[0], b[1]); o.w = pk2(b[2], b[3]);
        *((u32x4*)(isv ? P.VB : P.UB) + j) = o; }
}
__device__ __forceinline__ float dot8(const u32x4& a, const u32x4& b, float acc) {
#if USE_DOT2
    acc = __builtin_amdgcn_fdot2_f32_bf16(__builtin_bit_cast(bf16x2_t, a.x), __builtin_bit_cast(bf16x2_t, b.x), acc, false);
    acc = __builtin_amdgcn_fdot2_f32_bf16(__builtin_bit_cast(bf16x2_t, a.y), __builtin_bit_cast(bf16x2_t, b.y), acc, false);
    acc = __builtin_amdgcn_fdot2_f32_bf16(__builtin_bit_cast(bf16x2_t, a.z), __builtin_bit_cast(bf16x2_t, b.z), acc, false);
    acc = __builtin_amdgcn_fdot2_f32_bf16(__builtin_bit_cast(bf16x2_t, a.w), __builtin_bit_cast(bf16x2_t, b.w), acc, false);
#else
    acc += blo(a.x) * blo(b.x); acc += bhi(a.x) * bhi(b.x); acc += blo(a.y) * blo(b.y); acc += bhi(a.y) * bhi(b.y);
    acc += blo(a.z) * blo(b.z); acc += bhi(a.z) * bhi(b.z); acc += blo(a.w) * blo(b.w); acc += bhi(a.w) * bhi(b.w);
#endif
    return acc;
}
__device__ __forceinline__ void axpy8(float* y, float c, const u32x4& v) {
    y[0] += c * blo(v.x); y[1] += c * bhi(v.x); y[2] += c * blo(v.y); y[3] += c * bhi(v.y);
    y[4] += c * blo(v.z); y[5] += c * bhi(v.z); y[6] += c * blo(v.w); y[7] += c * bhi(v.w);
}
__device__ __forceinline__ void d_peer(const Params& P, int gw, int ngw, int lane) {
    for (long t = gw; t < TOK; t += ngw) {
        const u32x4* xr = (const u32x4*)(P.HB + (size_t)t * 1024); const u32x4 x0 = xr[lane], x1 = xr[64 + lane];
        const int e_lo = P.EXPERT[(size_t)t * 128 + lane], e_hi = P.EXPERT[(size_t)t * 128 + 64 + lane];
        const float g_lo = P.GATE[(size_t)t * 128 + lane], g_hi = P.GATE[(size_t)t * 128 + 64 + lane];
        float y[16];
#pragma unroll
        for (int i = 0; i < 16; ++i) y[i] = 0.f;
#pragma unroll 1
        for (int half = 0; half < 2; ++half) {
            const int ev = half ? e_hi : e_lo; const float gv = half ? g_hi : g_lo;
#pragma unroll 1
            for (int k0 = 0; k0 < 64; k0 += 4) {
                int e[4]; float gt[4]; u32x4 u0[4], u1[4], v0[4], v1[4];
#pragma unroll
                for (int q = 0; q < 4; ++q) { e[q] = __builtin_amdgcn_readlane(ev, k0 + q); gt[q] = __uint_as_float(__builtin_amdgcn_readlane(__float_as_uint(gv), k0 + q)); }
#pragma unroll
                for (int q = 0; q < 4; ++q) { const u32x4* ur = (const u32x4*)(P.UB + (size_t)e[q] * 1024); u0[q] = ur[lane]; u1[q] = ur[64 + lane]; }
#pragma unroll
                for (int q = 0; q < 4; ++q) { const u32x4* vr = (const u32x4*)(P.VB + (size_t)e[q] * 1024); v0[q] = vr[lane]; v1[q] = vr[64 + lane]; }
                float d[4];
#pragma unroll
                for (int q = 0; q < 4; ++q) d[q] = dot8(u1[q], x1, dot8(u0[q], x0, 0.f));
#pragma unroll
                for (int o = 1; o < 64; o <<= 1) {
#pragma unroll
                    for (int q = 0; q < 4; ++q) d[q] += __shfl_xor(d[q], o); }
#pragma unroll
                for (int q = 0; q < 4; ++q) { const float a = d[q]; const float c = gt[q] * 0.5f * a * (1.0f + erff(a * 0.7071067811865476f)); axpy8(y, c, v0[q]); axpy8(y + 8, c, v1[q]); }
            }
        }
        float z[16];
        z[0] = ALPHA_F * blo(x0.x) + y[0]; z[1] = ALPHA_F * bhi(x0.x) + y[1]; z[2] = ALPHA_F * blo(x0.y) + y[2]; z[3] = ALPHA_F * bhi(x0.y) + y[3];
        z[4] = ALPHA_F * blo(x0.z) + y[4]; z[5] = ALPHA_F * bhi(x0.z) + y[5]; z[6] = ALPHA_F * blo(x0.w) + y[6]; z[7] = ALPHA_F * bhi(x0.w) + y[7];
        z[8] = ALPHA_F * blo(x1.x) + y[8]; z[9] = ALPHA_F * bhi(x1.x) + y[9]; z[10] = ALPHA_F * blo(x1.y) + y[10]; z[11] = ALPHA_F * bhi(x1.y) + y[11];
        z[12] = ALPHA_F * blo(x1.z) + y[12]; z[13] = ALPHA_F * bhi(x1.z) + y[13]; z[14] = ALPHA_F * blo(x1.w) + y[14]; z[15] = ALPHA_F * bhi(x1.w) + y[15];
        float s = 0.f;
#pragma unroll
        for (int i = 0; i < 16; ++i) s += z[i];
        const float mean = wave_sum(s) * (1.f / 1024.f); float s2 = 0.f;
#pragma unroll
        for (int i = 0; i < 16; ++i) { z[i] -= mean; s2 += z[i] * z[i]; }
        const float rstd = 1.f / sqrtf(wave_sum(s2) * (1.f / 1024.f) + 1e-5f);
        const float* g = P.in[I_LN3_G]; const float* b = P.in[I_LN3_B]; float* orow = P.out + (size_t)t * 1024;
#pragma unroll
        for (int hh = 0; hh < 2; ++hh)
#pragma unroll
            for (int q = 0; q < 2; ++q) { const int col = hh * 512 + lane * 8 + q * 4; const f32x4 gg = *(const f32x4*)(g + col), bb = *(const f32x4*)(b + col);
                f32x4 o; o[0] = z[hh * 8 + q * 4 + 0] * rstd * gg[0] + bb[0]; o[1] = z[hh * 8 + q * 4 + 1] * rstd * gg[1] + bb[1];
                o[2] = z[hh * 8 + q * 4 + 2] * rstd * gg[2] + bb[2]; o[3] = z[hh * 8 + q * 4 + 3] * rstd * gg[3] + bb[3];
                *(f32x4*)(orow + col) = o; }
    }
}

__device__ __forceinline__ void d_lora_weights(const Params& P, long gtid, long nthr) {
    for (long idx = gtid; idx < (long)2560 * 512; idx += nthr) { const int n = (int)(idx / 512), k = (int)(idx % 512); float v = 0.f;
        if (n < 1024) { const int z = n >> 9, c = n & 511; if (k >= z * 64 && k < z * 64 + 64) v = P.in[I_W2][((size_t)z * 64 + (k - z * 64)) * 512 + c]; }
        else if (n < 2048) { const int z = (n - 1024) >> 9, c = n & 511; const int kk = k - 128; if (kk >= z * 64 && kk < z * 64 + 64) v = P.in[I_A2][((size_t)z * 64 + (kk - z * 64)) * 512 + c]; }
        else { const int c = n - 2048; if (k >= 256 && k < 384) v = P.in[I_G2][(size_t)(k - 256) * 512 + c]; }
        P.W_LORA_T[idx] = f2bf(v); }
    for (long idx = gtid; idx < (long)8 * 128 * 128; idx += nthr) P.WSB[idx] = f2bf(P.in[I_W_S][idx]);
}
__device__ __forceinline__ void shift8(const bf16_t* PA, long t, int s, int col, const float* mu, float* o) {
    const u32x4 c = *(const u32x4*)(PA + (size_t)t * 2048 + col);
    u32x4 p = (u32x4){0u, 0u, 0u, 0u}, n = (u32x4){0u, 0u, 0u, 0u};
    if (s > 0) p = *(const u32x4*)(PA + (size_t)(t - 1) * 2048 + col);
    if (s < SEQ - 1) n = *(const u32x4*)(PA + (size_t)(t + 1) * 2048 + col);
    const f32x4 m0 = *(const f32x4*)(mu + col), m1 = *(const f32x4*)(mu + col + 4);
    const float cc[8] = {blo(c.x), bhi(c.x), blo(c.y), bhi(c.y), blo(c.z), bhi(c.z), blo(c.w), bhi(c.w)};
    const float pp[8] = {blo(p.x), bhi(p.x), blo(p.y), bhi(p.y), blo(p.z), bhi(p.z), blo(p.w), bhi(p.w)};
    const float nn[8] = {blo(n.x), bhi(n.x), blo(n.y), bhi(n.y), blo(n.z), bhi(n.z), blo(n.w), bhi(n.w)};
#pragma unroll
    for (int i = 0; i < 8; ++i) { const float m = (i < 4) ? m0[i] : m1[i - 4]; o[i] = cc[i] + m * (0.5f * (pp[i] + nn[i]) - cc[i]); }
}
__device__ __forceinline__ u32x4 pack8f(const float* v) { u32x4 w; w.x = pk2(v[0], v[1]); w.y = pk2(v[2], v[3]); w.z = pk2(v[4], v[5]); w.w = pk2(v[6], v[7]); return w; }
__device__ __forceinline__ void d_prep_e1(const Params& P, int gw, int ngw, int lane) {
    const float* mu = P.in[I_MU];
    const f32x4 kk0 = *(const f32x4*)(P.in[I_K_K] + 8 * lane), kk1 = *(const f32x4*)(P.in[I_K_K] + 8 * lane + 4);
    for (long t = gw; t < TOK; t += ngw) { const int s = (int)(t % SEQ); float r[8], k[8], v[8];
        shift8(P.PA, t, s, 8 * lane, mu, r); shift8(P.PA, t, s, 512 + 8 * lane, mu, k); shift8(P.PA, t, s, 1024 + 8 * lane, mu, v);
        float q[8]; float ss = 0.f;
#pragma unroll
        for (int i = 0; i < 8; ++i) { q[i] = k[i] * ((i < 4) ? kk0[i] : kk1[i - 4]); ss += q[i] * q[i]; }
        ss += __shfl_xor(ss, 1); ss += __shfl_xor(ss, 2); ss += __shfl_xor(ss, 4);
        const float inv = 1.0f / fmaxf(sqrtf(ss), 1e-12f);
#pragma unroll
        for (int i = 0; i < 8; ++i) q[i] *= inv;
        *(u32x4*)(P.R + (size_t)t * 512 + 8 * lane) = pack8f(r); *(u32x4*)(P.K + (size_t)t * 512 + 8 * lane) = pack8f(k);
        *(u32x4*)(P.V + (size_t)t * 512 + 8 * lane) = pack8f(v); *(u32x4*)(P.KK + (size_t)t * 512 + 8 * lane) = pack8f(q);
        if (lane < 48) { float x[8]; shift8(P.PA, t, s, 1536 + 8 * lane, mu, x);
#pragma unroll
            for (int i = 0; i < 8; ++i) x[i] = (lane < 16) ? tanhf(x[i]) : (lane < 32) ? x[i] : 1.0f / (1.0f + expf(-x[i]));
            *(u32x4*)(P.LIN + (size_t)t * 512 + 8 * lane) = pack8f(x); }
        else *(u32x4*)(P.LIN + (size_t)t * 512 + 8 * lane) = (u32x4){0u, 0u, 0u, 0u};
    }
}
__device__ __forceinline__ void scan_item3(const Params& P, int chain, int i) {
    const int h = chain % 8, b = (chain / 8) % BATCH, z = chain / (8 * BATCH);
    float S[64];
#pragma unroll
    for (int j = 0; j < 64; ++j) S[j] = 0.f;
    const float* ka = P.in[I_K_A] + h * 64;
    for (int n = 0; n < SEQ; ++n) {
        const long t = (long)b * SEQ + ((z == 0) ? n : (SEQ - 1 - n)); const size_t o1 = (size_t)t * 512 + h * 64, o2 = ((size_t)t * 2 + z) * 512 + h * 64;
        const float v = bf2f(P.V[o1 + i]);
        float sa = 0.f;
#pragma unroll
        for (int j = 0; j < 64; ++j) sa -= S[j] * bf2f(P.KK[o1 + j]);
        float y = 0.f;
#pragma unroll
        for (int j = 0; j < 64; ++j) { const float al = bf2f(P.AL[o2 + j]), k = bf2f(P.K[o1 + j]);
            S[j] = S[j] * (1.0f - bf2f(P.OMW[o2 + j])) + sa * (bf2f(P.KK[o1 + j]) * al) + v * (k * (1.0f + (al - 1.0f) * ka[j])); y += S[j] * bf2f(P.R[o1 + j]); }
        P.Y01[((size_t)z * TOK + t) * 512 + h * 64 + i] = y;
    }
}

#define SC_CH 32
#define SC_REC 352
template <int CTRL> __device__ __forceinline__ float dpp_add(float x) {
    return x + __uint_as_float((unsigned)__builtin_amdgcn_update_dpp(0, (int)__float_as_uint(x), CTRL, 0xf, 0xf, false));
}
__device__ __forceinline__ float allsum16(float x) { x = dpp_add<0xB1>(x); x = dpp_add<0x4E>(x); x = dpp_add<0x141>(x); x = dpp_add<0x140>(x); return x; }
__device__ __forceinline__ void d_scan(const Params& P, LAS unsigned char* lds, int tid) {
    const int lane = tid & 63, wave = __builtin_amdgcn_readfirstlane(tid >> 6);
    const int chain = (int)blockIdx.x >> 1, half = (int)blockIdx.x & 1;
    if (chain >= 2 * BATCH * 8) return;
    const int h = chain % 8, b = (chain / 8) % BATCH, z = chain / (8 * BATCH);
    LAS float* buf = (LAS float*)lds;
    const float ka = P.in[I_K_A][h * 64 + lane];
    const long tb = (long)b * SEQ;
    unsigned short gr[4], gk[4], gkk[4], gom[4], gal[4], gv[2];
    auto g_load = [&](int c) {
#pragma unroll
        for (int q = 0; q < 4; ++q) { const int n = c * SC_CH + wave + 8 * q; const long t = tb + ((z == 0) ? n : (SEQ - 1 - n));
            const size_t o1 = (size_t)t * 512 + h * 64 + lane, o2 = ((size_t)t * 2 + z) * 512 + h * 64 + lane;
            gr[q] = P.R[o1]; gk[q] = P.K[o1]; gkk[q] = P.KK[o1]; gom[q] = P.OMW[o2]; gal[q] = P.AL[o2]; }
#pragma unroll
        for (int q = 0; q < 2; ++q) { const int p = tid + 512 * q; const int n = c * SC_CH + (p >> 5); const long t = tb + ((z == 0) ? n : (SEQ - 1 - n));
            gv[q] = P.V[(size_t)t * 512 + h * 64 + half * 32 + (p & 31)]; }
    };
    auto s_write = [&](int c) {
        LAS float* bb = buf + (c & 1) * (SC_CH * SC_REC);
#pragma unroll
        for (int q = 0; q < 4; ++q) { LAS float* rec = bb + (wave + 8 * q) * SC_REC + lane;
            const float k = bf2f(gk[q]), kk = bf2f(gkk[q]), al = bf2f(gal[q]);
            rec[0] = 1.0f - bf2f(gom[q]); rec[64] = k * (1.0f + (al - 1.0f) * ka); rec[128] = -kk; rec[192] = kk * al; rec[256] = bf2f(gr[q]); }
#pragma unroll
        for (int q = 0; q < 2; ++q) { const int p = tid + 512 * q; bb[(p >> 5) * SC_REC + 320 + (p & 31)] = bf2f(gv[q]); }
    };
    const int rg = lane >> 4, jl = lane & 15, rowl = wave * 4 + rg;
    float S0 = 0.f, S1 = 0.f, S2 = 0.f, S3 = 0.f;
    g_load(0); s_write(0); g_load(1);
    asm volatile("s_waitcnt lgkmcnt(0)" ::: "memory"); __syncthreads();
    float* yout = P.Y01 + (size_t)z * TOK * 512 + h * 64 + half * 32 + rowl;
    constexpr int NCH = SEQ / SC_CH;
#pragma unroll 1
    for (int c = 0; c < NCH; ++c) {
        if (c + 1 < NCH) s_write(c + 1);
        if (c + 2 < NCH) g_load(c + 2);
        const LAS float* bb = buf + (c & 1) * (SC_CH * SC_REC);
#pragma unroll 4
        for (int nl = 0; nl < SC_CH; ++nl) { const LAS float* rec = bb + nl * SC_REC + jl * 4;
            const f32x4 w4 = *(const LAS f32x4*)(rec), kd4 = *(const LAS f32x4*)(rec + 64), a4 = *(const LAS f32x4*)(rec + 128), b4 = *(const LAS f32x4*)(rec + 192), r4 = *(const LAS f32x4*)(rec + 256);
            const float v = bb[nl * SC_REC + 320 + rowl];
            float sa = (S0 * a4[0] + S1 * a4[1]) + (S2 * a4[2] + S3 * a4[3]);
            sa = allsum16(sa);
            S0 = S0 * w4[0] + (sa * b4[0] + v * kd4[0]); S1 = S1 * w4[1] + (sa * b4[1] + v * kd4[1]);
            S2 = S2 * w4[2] + (sa * b4[2] + v * kd4[2]); S3 = S3 * w4[3] + (sa * b4[3] + v * kd4[3]);
            float y = (S0 * r4[0] + S1 * r4[1]) + (S2 * r4[2] + S3 * r4[3]);
            y = allsum16(y);
            const int n = c * SC_CH + nl; const long t = tb + ((z == 0) ? n : (SEQ - 1 - n));
            if (jl == 0) yout[(size_t)t * 512] = y;
        }
        asm volatile("s_waitcnt lgkmcnt(0)" ::: "memory"); __syncthreads();
    }
}
__device__ __forceinline__ void d_rwkv_out(const Params& P, int gw, int ngw, int lane) {
    for (long it = gw; it < (long)TOK * 8; it += ngw) { const long t = it >> 3; const int c = (int)(it & 7) * 64 + lane;
        const float y = P.Y01[(size_t)t * 512 + c] + P.Y01[((size_t)TOK + t) * 512 + c];
        const float mu = wave_sum(y) * (1.f / 64.f); const float d = y - mu; const float rs = 1.0f / sqrtf(wave_sum(d * d) * (1.f / 64.f) + 64e-5f);
        const float yn = d * rs * P.in[I_GN_G][c] + P.in[I_GN_B][c];
        const float r = bf2f(P.R[(size_t)t * 512 + c]), k = bf2f(P.K[(size_t)t * 512 + c]), ka = P.in[I_K_A][c];
        const float a0 = bf2f(P.AL[((size_t)t * 2) * 512 + c]), a1 = bf2f(P.AL[((size_t)t * 2 + 1) * 512 + c]);
        const float kd = k * (1.0f + (a0 - 1.0f) * ka) + k * (1.0f + (a1 - 1.0f) * ka);
        const float rk = wave_sum(r * kd * P.in[I_R_K][c]);
        P.YA[(size_t)t * 512 + c] = f2bf((yn + rk * bf2f(P.V[(size_t)t * 512 + c])) * bf2f(P.G[(size_t)t * 512 + c])); }
}


typedef float f32x2v __attribute__((ext_vector_type(2)));
__device__ __forceinline__ void d_tables8(const Params& P, int gw, int ngw, int lane) {
    for (int row = gw; row < 2 * 16384; row += ngw) { const bool isv = row >= 16384; const int e = isv ? row - 16384 : row;
        const f32x4* src = (const f32x4*)((isv ? P.in[I_PEER_V] : P.in[I_PEER_U]) + (size_t)e * 1024 + 16 * lane);
        const f32x4 a = src[0], b = src[1], c = src[2], d = src[3];
        float m = fmaxf(fmaxf(fmaxf(fabsf(a[0]), fabsf(a[1])), fmaxf(fabsf(a[2]), fabsf(a[3]))), fmaxf(fmaxf(fabsf(b[0]), fabsf(b[1])), fmaxf(fabsf(b[2]), fabsf(b[3]))));
        m = fmaxf(m, fmaxf(fmaxf(fmaxf(fabsf(c[0]), fabsf(c[1])), fmaxf(fabsf(c[2]), fabsf(c[3]))), fmaxf(fmaxf(fabsf(d[0]), fabsf(d[1])), fmaxf(fabsf(d[2]), fabsf(d[3])))));
        m = wave_max(m); const float sc = (m > 0.f) ? m * (1.0f / 240.0f) : 1.0f, inv = 1.0f / sc;
        int w0 = 0, w1 = 0, w2 = 0, w3 = 0;
        w0 = __builtin_amdgcn_cvt_pk_fp8_f32(a[0] * inv, a[1] * inv, w0, false); w0 = __builtin_amdgcn_cvt_pk_fp8_f32(a[2] * inv, a[3] * inv, w0, true);
        w1 = __builtin_amdgcn_cvt_pk_fp8_f32(b[0] * inv, b[1] * inv, w1, false); w1 = __builtin_amdgcn_cvt_pk_fp8_f32(b[2] * inv, b[3] * inv, w1, true);
        w2 = __builtin_amdgcn_cvt_pk_fp8_f32(c[0] * inv, c[1] * inv, w2, false); w2 = __builtin_amdgcn_cvt_pk_fp8_f32(c[2] * inv, c[3] * inv, w2, true);
        w3 = __builtin_amdgcn_cvt_pk_fp8_f32(d[0] * inv, d[1] * inv, w3, false); w3 = __builtin_amdgcn_cvt_pk_fp8_f32(d[2] * inv, d[3] * inv, w3, true);
        *((u32x4*)((isv ? P.V8 : P.U8) + (size_t)e * 1024) + lane) = (u32x4){(unsigned)w0, (unsigned)w1, (unsigned)w2, (unsigned)w3};
        if (lane == 0) (isv ? P.SV : P.SU)[e] = sc; }
}
__device__ __forceinline__ void dec16(const u32x4& w, float* o) {
    const f32x2v a0 = __builtin_amdgcn_cvt_pk_f32_fp8((int)w.x, false), a1 = __builtin_amdgcn_cvt_pk_f32_fp8((int)w.x, true);
    const f32x2v b0 = __builtin_amdgcn_cvt_pk_f32_fp8((int)w.y, false), b1 = __builtin_amdgcn_cvt_pk_f32_fp8((int)w.y, true);
    const f32x2v c0 = __builtin_amdgcn_cvt_pk_f32_fp8((int)w.z, false), c1 = __builtin_amdgcn_cvt_pk_f32_fp8((int)w.z, true);
    const f32x2v d0 = __builtin_amdgcn_cvt_pk_f32_fp8((int)w.w, false), d1 = __builtin_amdgcn_cvt_pk_f32_fp8((int)w.w, true);
    o[0] = a0[0]; o[1] = a0[1]; o[2] = a1[0]; o[3] = a1[1]; o[4] = b0[0]; o[5] = b0[1]; o[6] = b1[0]; o[7] = b1[1];
    o[8] = c0[0]; o[9] = c0[1]; o[10] = c1[0]; o[11] = c1[1]; o[12] = d0[0]; o[13] = d0[1]; o[14] = d1[0]; o[15] = d1[1];
}
__device__ __forceinline__ void d_peer8(const Params& P, int gw, int ngw, int lane) {
    for (long t = gw; t < TOK; t += ngw) {
        const u32x4* xr = (const u32x4*)(P.HB + (size_t)t * 1024 + 16 * lane); const u32x4 xa = xr[0], xb = xr[1];
        const float x[16] = {blo(xa.x), bhi(xa.x), blo(xa.y), bhi(xa.y), blo(xa.z), bhi(xa.z), blo(xa.w), bhi(xa.w),
                             blo(xb.x), bhi(xb.x), blo(xb.y), bhi(xb.y), blo(xb.z), bhi(xb.z), blo(xb.w), bhi(xb.w)};
        const int e_lo = P.EXPERT[(size_t)t * 128 + lane], e_hi = P.EXPERT[(size_t)t * 128 + 64 + lane];
        const float g_lo = P.GATE[(size_t)t * 128 + lane], g_hi = P.GATE[(size_t)t * 128 + 64 + lane];
        const float su_lo = P.SU[e_lo], su_hi = P.SU[e_hi], sv_lo = P.SV[e_lo], sv_hi = P.SV[e_hi];
        float d_lo = 0.f, d_hi = 0.f;
#pragma unroll 1
        for (int half = 0; half < 2; ++half) { const int ev = half ? e_hi : e_lo; float dacc = 0.f;
#pragma unroll 1
            for (int k0 = 0; k0 < 64; k0 += 8) { u32x4 u[8];
#pragma unroll
                for (int q = 0; q < 8; ++q) { const int e = __builtin_amdgcn_readlane(ev, k0 + q); u[q] = *((const u32x4*)(P.U8 + (size_t)e * 1024) + lane); }
                float d[8];
#pragma unroll
                for (int q = 0; q < 8; ++q) { float f[16]; dec16(u[q], f); float a0 = 0.f, a1 = 0.f;
#pragma unroll
                    for (int i = 0; i < 8; ++i) { a0 += f[i] * x[i]; a1 += f[8 + i] * x[8 + i]; }
                    d[q] = a0 + a1; }
#pragma unroll
                for (int o = 1; o < 64; o <<= 1) {
#pragma unroll
                    for (int q = 0; q < 8; ++q) d[q] += __shfl_xor(d[q], o); }
#pragma unroll
                for (int q = 0; q < 8; ++q) dacc = (lane == k0 + q) ? d[q] : dacc; }
            if (half) d_hi = dacc; else d_lo = dacc; }
        const float al = d_lo * su_lo, ah = d_hi * su_hi;
        const float c_lo = g_lo * 0.5f * al * (1.0f + erff(al * 0.7071067811865476f)) * sv_lo, c_hi = g_hi * 0.5f * ah * (1.0f + erff(ah * 0.7071067811865476f)) * sv_hi;
        float y[16];
#pragma unroll
        for (int i = 0; i < 16; ++i) y[i] = 0.f;
#pragma unroll 1
        for (int half = 0; half < 2; ++half) { const int ev = half ? e_hi : e_lo; const float cv = half ? c_hi : c_lo;
#pragma unroll 1
            for (int k0 = 0; k0 < 64; k0 += 8) { u32x4 v[8]; float c[8];
#pragma unroll
                for (int q = 0; q < 8; ++q) { const int e = __builtin_amdgcn_readlane(ev, k0 + q); c[q] = __uint_as_float(__builtin_amdgcn_readlane(__float_as_uint(cv), k0 + q));
                    v[q] = *((const u32x4*)(P.V8 + (size_t)e * 1024) + lane); }
#pragma unroll
                for (int q = 0; q < 8; ++q) { float f[16]; dec16(v[q], f);
#pragma unroll
                    for (int i = 0; i < 16; ++i) y[i] += c[q] * f[i]; } } }
        float z[16]; float s = 0.f;
#pragma unroll
        for (int i = 0; i < 16; ++i) { z[i] = ALPHA_F * x[i] + y[i]; s += z[i]; }
        const float mean = wave_sum(s) * (1.f / 1024.f); float s2 = 0.f;
#pragma unroll
        for (int i = 0; i < 16; ++i) { z[i] -= mean; s2 += z[i] * z[i]; }
        const float rstd = 1.f / sqrtf(wave_sum(s2) * (1.f / 1024.f) + 1e-5f);
        const float* g = P.in[I_LN3_G] + 16 * lane; const float* b = P.in[I_LN3_B] + 16 * lane; float* orow = P.out + (size_t)t * 1024 + 16 * lane;
#pragma unroll
        for (int q = 0; q < 4; ++q) { const f32x4 gg = *(const f32x4*)(g + 4 * q), bb = *(const f32x4*)(b + 4 * q);
            f32x4 o; o[0] = z[4 * q] * rstd * gg[0] + bb[0]; o[1] = z[4 * q + 1] * rstd * gg[1] + bb[1]; o[2] = z[4 * q + 2] * rstd * gg[2] + bb[2]; o[3] = z[4 * q + 3] * rstd * gg[3] + bb[3];
            *(f32x4*)(orow + 4 * q) = o; }
    }
}
typedef short bf16x8v __attribute__((ext_vector_type(8)));
typedef float f32x16v __attribute__((ext_vector_type(16)));
#define RT_SKROW 272
__device__ __forceinline__ unsigned f2key(float f) { const unsigned u = __float_as_uint(f); return (u & 0x80000000u) ? ~u : (u | 0x80000000u); }
__device__ __forceinline__ float key2f(unsigned k) { const unsigned u = (k & 0x80000000u) ? (k & 0x7fffffffu) : ~k; return __uint_as_float(u); }
#define DECL16(T, P) T P##0, P##1, P##2, P##3, P##4, P##5, P##6, P##7, P##8, P##9, P##10, P##11, P##12, P##13, P##14, P##15
#define CE_D(a, b) do { const unsigned _hi = max(a, b), _lo = min(a, b); a = _hi; b = _lo; } while (0)
#define CE_A(a, b) do { const unsigned _hi = max(a, b), _lo = min(a, b); a = _lo; b = _hi; } while (0)
#define CEP_D(ka, pa, kb, pb) do { const bool _sw = (kb) > (ka); const unsigned _k0 = _sw ? (kb) : (ka), _k1 = _sw ? (ka) : (kb), _p0 = _sw ? (pb) : (pa), _p1 = _sw ? (pa) : (pb); ka = _k0; kb = _k1; pa = _p0; pb = _p1; } while (0)
#define CEP_A(ka, pa, kb, pb) do { const bool _sw = (kb) < (ka); const unsigned _k0 = _sw ? (kb) : (ka), _k1 = _sw ? (ka) : (kb), _p0 = _sw ? (pb) : (pa), _p1 = _sw ? (pa) : (pb); ka = _k0; kb = _k1; pa = _p0; pb = _p1; } while (0)
#define SORT16_DESC(P) do { CE_D(P##0, P##1); CE_A(P##2, P##3); CE_D(P##4, P##5); CE_A(P##6, P##7); CE_D(P##8, P##9); CE_A(P##10, P##11); CE_D(P##12, P##13); CE_A(P##14, P##15); CE_D(P##0, P##2); CE_D(P##1, P##3); CE_A(P##4, P##6); CE_A(P##5, P##7); CE_D(P##8, P##10); CE_D(P##9, P##11); CE_A(P##12, P##14); CE_A(P##13, P##15); CE_D(P##0, P##1); CE_D(P##2, P##3); CE_A(P##4, P##5); CE_A(P##6, P##7); CE_D(P##8, P##9); CE_D(P##10, P##11); CE_A(P##12, P##13); CE_A(P##14, P##15); CE_D(P##0, P##4); CE_D(P##1, P##5); CE_D(P##2, P##6); CE_D(P##3, P##7); CE_A(P##8, P##12); CE_A(P##9, P##13); CE_A(P##10, P##14); CE_A(P##11, P##15); CE_D(P##0, P##2); CE_D(P##1, P##3); CE_D(P##4, P##6); CE_D(P##5, P##7); CE_A(P##8, P##10); CE_A(P##9, P##11); CE_A(P##12, P##14); CE_A(P##13, P##15); CE_D(P##0, P##1); CE_D(P##2, P##3); CE_D(P##4, P##5); CE_D(P##6, P##7); CE_A(P##8, P##9); CE_A(P##10, P##11); CE_A(P##12, P##13); CE_A(P##14, P##15); CE_D(P##0, P##8); CE_D(P##1, P##9); CE_D(P##2, P##10); CE_D(P##3, P##11); CE_D(P##4, P##12); CE_D(P##5, P##13); CE_D(P##6, P##14); CE_D(P##7, P##15); CE_D(P##0, P##4); CE_D(P##1, P##5); CE_D(P##2, P##6); CE_D(P##3, P##7); CE_D(P##8, P##12); CE_D(P##9, P##13); CE_D(P##10, P##14); CE_D(P##11, P##15); CE_D(P##0, P##2); CE_D(P##1, P##3); CE_D(P##4, P##6); CE_D(P##5, P##7); CE_D(P##8, P##10); CE_D(P##9, P##11); CE_D(P##12, P##14); CE_D(P##13, P##15); CE_D(P##0, P##1); CE_D(P##2, P##3); CE_D(P##4, P##5); CE_D(P##6, P##7); CE_D(P##8, P##9); CE_D(P##10, P##11); CE_D(P##12, P##13); CE_D(P##14, P##15); } while (0)
#define SORT16P_DESC(K, Q) do { CEP_D(K##0, Q##0, K##1, Q##1); CEP_A(K##2, Q##2, K##3, Q##3); CEP_D(K##4, Q##4, K##5, Q##5); CEP_A(K##6, Q##6, K##7, Q##7); CEP_D(K##8, Q##8, K##9, Q##9); CEP_A(K##10, Q##10, K##11, Q##11); CEP_D(K##12, Q##12, K##13, Q##13); CEP_A(K##14, Q##14, K##15, Q##15); CEP_D(K##0, Q##0, K##2, Q##2); CEP_D(K##1, Q##1, K##3, Q##3); CEP_A(K##4, Q##4, K##6, Q##6); CEP_A(K##5, Q##5, K##7, Q##7); CEP_D(K##8, Q##8, K##10, Q##10); CEP_D(K##9, Q##9, K##11, Q##11); CEP_A(K##12, Q##12, K##14, Q##14); CEP_A(K##13, Q##13, K##15, Q##15); CEP_D(K##0, Q##0, K##1, Q##1); CEP_D(K##2, Q##2, K##3, Q##3); CEP_A(K##4, Q##4, K##5, Q##5); CEP_A(K##6, Q##6, K##7, Q##7); CEP_D(K##8, Q##8, K##9, Q##9); CEP_D(K##10, Q##10, K##11, Q##11); CEP_A(K##12, Q##12, K##13, Q##13); CEP_A(K##14, Q##14, K##15, Q##15); CEP_D(K##0, Q##0, K##4, Q##4); CEP_D(K##1, Q##1, K##5, Q##5); CEP_D(K##2, Q##2, K##6, Q##6); CEP_D(K##3, Q##3, K##7, Q##7); CEP_A(K##8, Q##8, K##12, Q##12); CEP_A(K##9, Q##9, K##13, Q##13); CEP_A(K##10, Q##10, K##14, Q##14); CEP_A(K##11, Q##11, K##15, Q##15); CEP_D(K##0, Q##0, K##2, Q##2); CEP_D(K##1, Q##1, K##3, Q##3); CEP_D(K##4, Q##4, K##6, Q##6); CEP_D(K##5, Q##5, K##7, Q##7); CEP_A(K##8, Q##8, K##10, Q##10); CEP_A(K##9, Q##9, K##11, Q##11); CEP_A(K##12, Q##12, K##14, Q##14); CEP_A(K##13, Q##13, K##15, Q##15); CEP_D(K##0, Q##0, K##1, Q##1); CEP_D(K##2, Q##2, K##3, Q##3); CEP_D(K##4, Q##4, K##5, Q##5); CEP_D(K##6, Q##6, K##7, Q##7); CEP_A(K##8, Q##8, K##9, Q##9); CEP_A(K##10, Q##10, K##11, Q##11); CEP_A(K##12, Q##12, K##13, Q##13); CEP_A(K##14, Q##14, K##15, Q##15); CEP_D(K##0, Q##0, K##8, Q##8); CEP_D(K##1, Q##1, K##9, Q##9); CEP_D(K##2, Q##2, K##10, Q##10); CEP_D(K##3, Q##3, K##11, Q##11); CEP_D(K##4, Q##4, K##12, Q##12); CEP_D(K##5, Q##5, K##13, Q##13); CEP_D(K##6, Q##6, K##14, Q##14); CEP_D(K##7, Q##7, K##15, Q##15); CEP_D(K##0, Q##0, K##4, Q##4); CEP_D(K##1, Q##1, K##5, Q##5); CEP_D(K##2, Q##2, K##6, Q##6); CEP_D(K##3, Q##3, K##7, Q##7); CEP_D(K##8, Q##8, K##12, Q##12); CEP_D(K##9, Q##9, K##13, Q##13); CEP_D(K##10, Q##10, K##14, Q##14); CEP_D(K##11, Q##11, K##15, Q##15); CEP_D(K##0, Q##0, K##2, Q##2); CEP_D(K##1, Q##1, K##3, Q##3); CEP_D(K##4, Q##4, K##6, Q##6); CEP_D(K##5, Q##5, K##7, Q##7); CEP_D(K##8, Q##8, K##10, Q##10); CEP_D(K##9, Q##9, K##11, Q##11); CEP_D(K##12, Q##12, K##14, Q##14); CEP_D(K##13, Q##13, K##15, Q##15); CEP_D(K##0, Q##0, K##1, Q##1); CEP_D(K##2, Q##2, K##3, Q##3); CEP_D(K##4, Q##4, K##5, Q##5); CEP_D(K##6, Q##6, K##7, Q##7); CEP_D(K##8, Q##8, K##9, Q##9); CEP_D(K##10, Q##10, K##11, Q##11); CEP_D(K##12, Q##12, K##13, Q##13); CEP_D(K##14, Q##14, K##15, Q##15); } while (0)
#define MERGE16_DESC(A, B) do { A##0 = max(A##0, B##15); A##1 = max(A##1, B##14); A##2 = max(A##2, B##13); A##3 = max(A##3, B##12); A##4 = max(A##4, B##11); A##5 = max(A##5, B##10); A##6 = max(A##6, B##9); A##7 = max(A##7, B##8); A##8 = max(A##8, B##7); A##9 = max(A##9, B##6); A##10 = max(A##10, B##5); A##11 = max(A##11, B##4); A##12 = max(A##12, B##3); A##13 = max(A##13, B##2); A##14 = max(A##14, B##1); A##15 = max(A##15, B##0); CE_D(A##0, A##8); CE_D(A##1, A##9); CE_D(A##2, A##10); CE_D(A##3, A##11); CE_D(A##4, A##12); CE_D(A##5, A##13); CE_D(A##6, A##14); CE_D(A##7, A##15); CE_D(A##0, A##4); CE_D(A##1, A##5); CE_D(A##2, A##6); CE_D(A##3, A##7); CE_D(A##8, A##12); CE_D(A##9, A##13); CE_D(A##10, A##14); CE_D(A##11, A##15); CE_D(A##0, A##2); CE_D(A##1, A##3); CE_D(A##4, A##6); CE_D(A##5, A##7); CE_D(A##8, A##10); CE_D(A##9, A##11); CE_D(A##12, A##14); CE_D(A##13, A##15); CE_D(A##0, A##1); CE_D(A##2, A##3); CE_D(A##4, A##5); CE_D(A##6, A##7); CE_D(A##8, A##9); CE_D(A##10, A##11); CE_D(A##12, A##13); CE_D(A##14, A##15); } while (0)
#define MERGE16P_DESC(A, PA, B, PB) do { { const bool _s = B##15 > A##0; PA##0 = _s ? PB##15 : PA##0; A##0 = _s ? B##15 : A##0; } { const bool _s = B##14 > A##1; PA##1 = _s ? PB##14 : PA##1; A##1 = _s ? B##14 : A##1; } { const bool _s = B##13 > A##2; PA##2 = _s ? PB##13 : PA##2; A##2 = _s ? B##13 : A##2; } { const bool _s = B##12 > A##3; PA##3 = _s ? PB##12 : PA##3; A##3 = _s ? B##12 : A##3; } { const bool _s = B##11 > A##4; PA##4 = _s ? PB##11 : PA##4; A##4 = _s ? B##11 : A##4; } { const bool _s = B##10 > A##5; PA##5 = _s ? PB##10 : PA##5; A##5 = _s ? B##10 : A##5; } { const bool _s = B##9 > A##6; PA##6 = _s ? PB##9 : PA##6; A##6 = _s ? B##9 : A##6; } { const bool _s = B##8 > A##7; PA##7 = _s ? PB##8 : PA##7; A##7 = _s ? B##8 : A##7; } { const bool _s = B##7 > A##8; PA##8 = _s ? PB##7 : PA##8; A##8 = _s ? B##7 : A##8; } { const bool _s = B##6 > A##9; PA##9 = _s ? PB##6 : PA##9; A##9 = _s ? B##6 : A##9; } { const bool _s = B##5 > A##10; PA##10 = _s ? PB##5 : PA##10; A##10 = _s ? B##5 : A##10; } { const bool _s = B##4 > A##11; PA##11 = _s ? PB##4 : PA##11; A##11 = _s ? B##4 : A##11; } { const bool _s = B##3 > A##12; PA##12 = _s ? PB##3 : PA##12; A##12 = _s ? B##3 : A##12; } { const bool _s = B##2 > A##13; PA##13 = _s ? PB##2 : PA##13; A##13 = _s ? B##2 : A##13; } { const bool _s = B##1 > A##14; PA##14 = _s ? PB##1 : PA##14; A##14 = _s ? B##1 : A##14; } { const bool _s = B##0 > A##15; PA##15 = _s ? PB##0 : PA##15; A##15 = _s ? B##0 : A##15; } CEP_D(A##0, PA##0, A##8, PA##8); CEP_D(A##1, PA##1, A##9, PA##9); CEP_D(A##2, PA##2, A##10, PA##10); CEP_D(A##3, PA##3, A##11, PA##11); CEP_D(A##4, PA##4, A##12, PA##12); CEP_D(A##5, PA##5, A##13, PA##13); CEP_D(A##6, PA##6, A##14, PA##14); CEP_D(A##7, PA##7, A##15, PA##15); CEP_D(A##0, PA##0, A##4, PA##4); CEP_D(A##1, PA##1, A##5, PA##5); CEP_D(A##2, PA##2, A##6, PA##6); CEP_D(A##3, PA##3, A##7, PA##7); CEP_D(A##8, PA##8, A##12, PA##12); CEP_D(A##9, PA##9, A##13, PA##13); CEP_D(A##10, PA##10, A##14, PA##14); CEP_D(A##11, PA##11, A##15, PA##15); CEP_D(A##0, PA##0, A##2, PA##2); CEP_D(A##1, PA##1, A##3, PA##3); CEP_D(A##4, PA##4, A##6, PA##6); CEP_D(A##5, PA##5, A##7, PA##7); CEP_D(A##8, PA##8, A##10, PA##10); CEP_D(A##9, PA##9, A##11, PA##11); CEP_D(A##12, PA##12, A##14, PA##14); CEP_D(A##13, PA##13, A##15, PA##15); CEP_D(A##0, PA##0, A##1, PA##1); CEP_D(A##2, PA##2, A##3, PA##3); CEP_D(A##4, PA##4, A##5, PA##5); CEP_D(A##6, PA##6, A##7, PA##7); CEP_D(A##8, PA##8, A##9, PA##9); CEP_D(A##10, PA##10, A##11, PA##11); CEP_D(A##12, PA##12, A##13, PA##13); CEP_D(A##14, PA##14, A##15, PA##15); } while (0)
#define FILL_G0(P, ACC, HH) do { P##0 = (f2key(ACC[0]) & ~0x7fu) | (unsigned)(127 - (0 + 4 * (HH))); P##1 = (f2key(ACC[1]) & ~0x7fu) | (unsigned)(127 - (1 + 4 * (HH))); P##2 = (f2key(ACC[2]) & ~0x7fu) | (unsigned)(127 - (2 + 4 * (HH))); P##3 = (f2key(ACC[3]) & ~0x7fu) | (unsigned)(127 - (3 + 4 * (HH))); P##4 = (f2key(ACC[4]) & ~0x7fu) | (unsigned)(127 - (8 + 4 * (HH))); P##5 = (f2key(ACC[5]) & ~0x7fu) | (unsigned)(127 - (9 + 4 * (HH))); P##6 = (f2key(ACC[6]) & ~0x7fu) | (unsigned)(127 - (10 + 4 * (HH))); P##7 = (f2key(ACC[7]) & ~0x7fu) | (unsigned)(127 - (11 + 4 * (HH))); P##8 = (f2key(ACC[8]) & ~0x7fu) | (unsigned)(127 - (16 + 4 * (HH))); P##9 = (f2key(ACC[9]) & ~0x7fu) | (unsigned)(127 - (17 + 4 * (HH))); P##10 = (f2key(ACC[10]) & ~0x7fu) | (unsigned)(127 - (18 + 4 * (HH))); P##11 = (f2key(ACC[11]) & ~0x7fu) | (unsigned)(127 - (19 + 4 * (HH))); P##12 = (f2key(ACC[12]) & ~0x7fu) | (unsigned)(127 - (24 + 4 * (HH))); P##13 = (f2key(ACC[13]) & ~0x7fu) | (unsigned)(127 - (25 + 4 * (HH))); P##14 = (f2key(ACC[14]) & ~0x7fu) | (unsigned)(127 - (26 + 4 * (HH))); P##15 = (f2key(ACC[15]) & ~0x7fu) | (unsigned)(127 - (27 + 4 * (HH))); } while (0)
#define FILL_G1(P, ACC, HH) do { P##0 = (f2key(ACC[0]) & ~0x7fu) | (unsigned)(127 - (32 + 4 * (HH))); P##1 = (f2key(ACC[1]) & ~0x7fu) | (unsigned)(127 - (33 + 4 * (HH))); P##2 = (f2key(ACC[2]) & ~0x7fu) | (unsigned)(127 - (34 + 4 * (HH))); P##3 = (f2key(ACC[3]) & ~0x7fu) | (unsigned)(127 - (35 + 4 * (HH))); P##4 = (f2key(ACC[4]) & ~0x7fu) | (unsigned)(127 - (40 + 4 * (HH))); P##5 = (f2key(ACC[5]) & ~0x7fu) | (unsigned)(127 - (41 + 4 * (HH))); P##6 = (f2key(ACC[6]) & ~0x7fu) | (unsigned)(127 - (42 + 4 * (HH))); P##7 = (f2key(ACC[7]) & ~0x7fu) | (unsigned)(127 - (43 + 4 * (HH))); P##8 = (f2key(ACC[8]) & ~0x7fu) | (unsigned)(127 - (48 + 4 * (HH))); P##9 = (f2key(ACC[9]) & ~0x7fu) | (unsigned)(127 - (49 + 4 * (HH))); P##10 = (f2key(ACC[10]) & ~0x7fu) | (unsigned)(127 - (50 + 4 * (HH))); P##11 = (f2key(ACC[11]) & ~0x7fu) | (unsigned)(127 - (51 + 4 * (HH))); P##12 = (f2key(ACC[12]) & ~0x7fu) | (unsigned)(127 - (56 + 4 * (HH))); P##13 = (f2key(ACC[13]) & ~0x7fu) | (unsigned)(127 - (57 + 4 * (HH))); P##14 = (f2key(ACC[14]) & ~0x7fu) | (unsigned)(127 - (58 + 4 * (HH))); P##15 = (f2key(ACC[15]) & ~0x7fu) | (unsigned)(127 - (59 + 4 * (HH))); } while (0)
#define FILL_G2(P, ACC, HH) do { P##0 = (f2key(ACC[0]) & ~0x7fu) | (unsigned)(127 - (64 + 4 * (HH))); P##1 = (f2key(ACC[1]) & ~0x7fu) | (unsigned)(127 - (65 + 4 * (HH))); P##2 = (f2key(ACC[2]) & ~0x7fu) | (unsigned)(127 - (66 + 4 * (HH))); P##3 = (f2key(ACC[3]) & ~0x7fu) | (unsigned)(127 - (67 + 4 * (HH))); P##4 = (f2key(ACC[4]) & ~0x7fu) | (unsigned)(127 - (72 + 4 * (HH))); P##5 = (f2key(ACC[5]) & ~0x7fu) | (unsigned)(127 - (73 + 4 * (HH))); P##6 = (f2key(ACC[6]) & ~0x7fu) | (unsigned)(127 - (74 + 4 * (HH))); P##7 = (f2key(ACC[7]) & ~0x7fu) | (unsigned)(127 - (75 + 4 * (HH))); P##8 = (f2key(ACC[8]) & ~0x7fu) | (unsigned)(127 - (80 + 4 * (HH))); P##9 = (f2key(ACC[9]) & ~0x7fu) | (unsigned)(127 - (81 + 4 * (HH))); P##10 = (f2key(ACC[10]) & ~0x7fu) | (unsigned)(127 - (82 + 4 * (HH))); P##11 = (f2key(ACC[11]) & ~0x7fu) | (unsigned)(127 - (83 + 4 * (HH))); P##12 = (f2key(ACC[12]) & ~0x7fu) | (unsigned)(127 - (88 + 4 * (HH))); P##13 = (f2key(ACC[13]) & ~0x7fu) | (unsigned)(127 - (89 + 4 * (HH))); P##14 = (f2key(ACC[14]) & ~0x7fu) | (unsigned)(127 - (90 + 4 * (HH))); P##15 = (f2key(ACC[15]) & ~0x7fu) | (unsigned)(127 - (91 + 4 * (HH))); } while (0)
#define FILL_G3(P, ACC, HH) do { P##0 = (f2key(ACC[0]) & ~0x7fu) | (unsigned)(127 - (96 + 4 * (HH))); P##1 = (f2key(ACC[1]) & ~0x7fu) | (unsigned)(127 - (97 + 4 * (HH))); P##2 = (f2key(ACC[2]) & ~0x7fu) | (unsigned)(127 - (98 + 4 * (HH))); P##3 = (f2key(ACC[3]) & ~0x7fu) | (unsigned)(127 - (99 + 4 * (HH))); P##4 = (f2key(ACC[4]) & ~0x7fu) | (unsigned)(127 - (104 + 4 * (HH))); P##5 = (f2key(ACC[5]) & ~0x7fu) | (unsigned)(127 - (105 + 4 * (HH))); P##6 = (f2key(ACC[6]) & ~0x7fu) | (unsigned)(127 - (106 + 4 * (HH))); P##7 = (f2key(ACC[7]) & ~0x7fu) | (unsigned)(127 - (107 + 4 * (HH))); P##8 = (f2key(ACC[8]) & ~0x7fu) | (unsigned)(127 - (112 + 4 * (HH))); P##9 = (f2key(ACC[9]) & ~0x7fu) | (unsigned)(127 - (113 + 4 * (HH))); P##10 = (f2key(ACC[10]) & ~0x7fu) | (unsigned)(127 - (114 + 4 * (HH))); P##11 = (f2key(ACC[11]) & ~0x7fu) | (unsigned)(127 - (115 + 4 * (HH))); P##12 = (f2key(ACC[12]) & ~0x7fu) | (unsigned)(127 - (120 + 4 * (HH))); P##13 = (f2key(ACC[13]) & ~0x7fu) | (unsigned)(127 - (121 + 4 * (HH))); P##14 = (f2key(ACC[14]) & ~0x7fu) | (unsigned)(127 - (122 + 4 * (HH))); P##15 = (f2key(ACC[15]) & ~0x7fu) | (unsigned)(127 - (123 + 4 * (HH))); } while (0)
#define XCHG16(O, A) do { O##0 = (unsigned)__shfl_xor((int)A##0, 32); O##1 = (unsigned)__shfl_xor((int)A##1, 32); O##2 = (unsigned)__shfl_xor((int)A##2, 32); O##3 = (unsigned)__shfl_xor((int)A##3, 32); O##4 = (unsigned)__shfl_xor((int)A##4, 32); O##5 = (unsigned)__shfl_xor((int)A##5, 32); O##6 = (unsigned)__shfl_xor((int)A##6, 32); O##7 = (unsigned)__shfl_xor((int)A##7, 32); O##8 = (unsigned)__shfl_xor((int)A##8, 32); O##9 = (unsigned)__shfl_xor((int)A##9, 32); O##10 = (unsigned)__shfl_xor((int)A##10, 32); O##11 = (unsigned)__shfl_xor((int)A##11, 32); O##12 = (unsigned)__shfl_xor((int)A##12, 32); O##13 = (unsigned)__shfl_xor((int)A##13, 32); O##14 = (unsigned)__shfl_xor((int)A##14, 32); O##15 = (unsigned)__shfl_xor((int)A##15, 32); } while (0)
#define COPY16(D, S) do { D##0 = S##0; D##1 = S##1; D##2 = S##2; D##3 = S##3; D##4 = S##4; D##5 = S##5; D##6 = S##6; D##7 = S##7; D##8 = S##8; D##9 = S##9; D##10 = S##10; D##11 = S##11; D##12 = S##12; D##13 = S##13; D##14 = S##14; D##15 = S##15; } while (0)
#define FILL_CANDS() do { ck0_0 = (f2key(key2f(ta0 & ~0x7fu) + key2f(tb0 & ~0x7fu)) & ~0xffu) | 255u; ck0_1 = (f2key(key2f(ta0 & ~0x7fu) + key2f(tb1 & ~0x7fu)) & ~0xffu) | 254u; ck0_2 = (f2key(key2f(ta0 & ~0x7fu) + key2f(tb2 & ~0x7fu)) & ~0xffu) | 253u; ck0_3 = (f2key(key2f(ta0 & ~0x7fu) + key2f(tb3 & ~0x7fu)) & ~0xffu) | 252u; ck0_4 = (f2key(key2f(ta0 & ~0x7fu) + key2f(tb4 & ~0x7fu)) & ~0xffu) | 251u; ck0_5 = (f2key(key2f(ta0 & ~0x7fu) + key2f(tb5 & ~0x7fu)) & ~0xffu) | 250u; ck0_6 = (f2key(key2f(ta0 & ~0x7fu) + key2f(tb6 & ~0x7fu)) & ~0xffu) | 249u; ck0_7 = (f2key(key2f(ta0 & ~0x7fu) + key2f(tb7 & ~0x7fu)) & ~0xffu) | 248u; ck0_8 = (f2key(key2f(ta0 & ~0x7fu) + key2f(tb8 & ~0x7fu)) & ~0xffu) | 247u; ck0_9 = (f2key(key2f(ta0 & ~0x7fu) + key2f(tb9 & ~0x7fu)) & ~0xffu) | 246u; ck0_10 = (f2key(key2f(ta0 & ~0x7fu) + key2f(tb10 & ~0x7fu)) & ~0xffu) | 245u; ck0_11 = (f2key(key2f(ta0 & ~0x7fu) + key2f(tb11 & ~0x7fu)) & ~0xffu) | 244u; ck0_12 = (f2key(key2f(ta0 & ~0x7fu) + key2f(tb12 & ~0x7fu)) & ~0xffu) | 243u; ck0_13 = (f2key(key2f(ta0 & ~0x7fu) + key2f(tb13 & ~0x7fu)) & ~0xffu) | 242u; ck0_14 = (f2key(key2f(ta0 & ~0x7fu) + key2f(tb14 & ~0x7fu)) & ~0xffu) | 241u; ck0_15 = (f2key(key2f(ta0 & ~0x7fu) + key2f(tb15 & ~0x7fu)) & ~0xffu) | 240u; ck1_0 = (f2key(key2f(ta1 & ~0x7fu) + key2f(tb0 & ~0x7fu)) & ~0xffu) | 239u; ck1_1 = (f2key(key2f(ta1 & ~0x7fu) + key2f(tb1 & ~0x7fu)) & ~0xffu) | 238u; ck1_2 = (f2key(key2f(ta1 & ~0x7fu) + key2f(tb2 & ~0x7fu)) & ~0xffu) | 237u; ck1_3 = (f2key(key2f(ta1 & ~0x7fu) + key2f(tb3 & ~0x7fu)) & ~0xffu) | 236u; ck1_4 = (f2key(key2f(ta1 & ~0x7fu) + key2f(tb4 & ~0x7fu)) & ~0xffu) | 235u; ck1_5 = (f2key(key2f(ta1 & ~0x7fu) + key2f(tb5 & ~0x7fu)) & ~0xffu) | 234u; ck1_6 = (f2key(key2f(ta1 & ~0x7fu) + key2f(tb6 & ~0x7fu)) & ~0xffu) | 233u; ck1_7 = (f2key(key2f(ta1 & ~0x7fu) + key2f(tb7 & ~0x7fu)) & ~0xffu) | 232u; ck1_8 = (f2key(key2f(ta2 & ~0x7fu) + key2f(tb0 & ~0x7fu)) & ~0xffu) | 223u; ck1_9 = (f2key(key2f(ta2 & ~0x7fu) + key2f(tb1 & ~0x7fu)) & ~0xffu) | 222u; ck1_10 = (f2key(key2f(ta2 & ~0x7fu) + key2f(tb2 & ~0x7fu)) & ~0xffu) | 221u; ck1_11 = (f2key(key2f(ta2 & ~0x7fu) + key2f(tb3 & ~0x7fu)) & ~0xffu) | 220u; ck1_12 = (f2key(key2f(ta2 & ~0x7fu) + key2f(tb4 & ~0x7fu)) & ~0xffu) | 219u; ck1_13 = (f2key(key2f(ta3 & ~0x7fu) + key2f(tb0 & ~0x7fu)) & ~0xffu) | 207u; ck1_14 = (f2key(key2f(ta3 & ~0x7fu) + key2f(tb1 & ~0x7fu)) & ~0xffu) | 206u; ck1_15 = (f2key(key2f(ta3 & ~0x7fu) + key2f(tb2 & ~0x7fu)) & ~0xffu) | 205u; ck2_0 = (f2key(key2f(ta3 & ~0x7fu) + key2f(tb3 & ~0x7fu)) & ~0xffu) | 204u; ck2_1 = (f2key(key2f(ta4 & ~0x7fu) + key2f(tb0 & ~0x7fu)) & ~0xffu) | 191u; ck2_2 = (f2key(key2f(ta4 & ~0x7fu) + key2f(tb1 & ~0x7fu)) & ~0xffu) | 190u; ck2_3 = (f2key(key2f(ta4 & ~0x7fu) + key2f(tb2 & ~0x7fu)) & ~0xffu) | 189u; ck2_4 = (f2key(key2f(ta5 & ~0x7fu) + key2f(tb0 & ~0x7fu)) & ~0xffu) | 175u; ck2_5 = (f2key(key2f(ta5 & ~0x7fu) + key2f(tb1 & ~0x7fu)) & ~0xffu) | 174u; ck2_6 = (f2key(key2f(ta6 & ~0x7fu) + key2f(tb0 & ~0x7fu)) & ~0xffu) | 159u; ck2_7 = (f2key(key2f(ta6 & ~0x7fu) + key2f(tb1 & ~0x7fu)) & ~0xffu) | 158u; ck2_8 = (f2key(key2f(ta7 & ~0x7fu) + key2f(tb0 & ~0x7fu)) & ~0xffu) | 143u; ck2_9 = (f2key(key2f(ta7 & ~0x7fu) + key2f(tb1 & ~0x7fu)) & ~0xffu) | 142u; ck2_10 = (f2key(key2f(ta8 & ~0x7fu) + key2f(tb0 & ~0x7fu)) & ~0xffu) | 127u; ck2_11 = (f2key(key2f(ta9 & ~0x7fu) + key2f(tb0 & ~0x7fu)) & ~0xffu) | 111u; ck2_12 = (f2key(key2f(ta10 & ~0x7fu) + key2f(tb0 & ~0x7fu)) & ~0xffu) | 95u; ck2_13 = (f2key(key2f(ta11 & ~0x7fu) + key2f(tb0 & ~0x7fu)) & ~0xffu) | 79u; ck2_14 = (f2key(key2f(ta12 & ~0x7fu) + key2f(tb0 & ~0x7fu)) & ~0xffu) | 63u; ck2_15 = (f2key(key2f(ta13 & ~0x7fu) + key2f(tb0 & ~0x7fu)) & ~0xffu) | 47u; ck3_0 = (f2key(key2f(ta14 & ~0x7fu) + key2f(tb0 & ~0x7fu)) & ~0xffu) | 31u; ck3_1 = (f2key(key2f(ta15 & ~0x7fu) + key2f(tb0 & ~0x7fu)) & ~0xffu) | 15u; ck3_2 = 0u; ck3_3 = 0u; ck3_4 = 0u; ck3_5 = 0u; ck3_6 = 0u; ck3_7 = 0u; ck3_8 = 0u; ck3_9 = 0u; ck3_10 = 0u; ck3_11 = 0u; ck3_12 = 0u; ck3_13 = 0u; ck3_14 = 0u; ck3_15 = 0u; } while (0)
#define WRITE_LUT(LP) do { *(LAS u32x4*)(LP) = (u32x4){((127u - (ta0 & 127u)) << 0) | ((127u - (ta1 & 127u)) << 8) | ((127u - (ta2 & 127u)) << 16) | ((127u - (ta3 & 127u)) << 24), ((127u - (ta4 & 127u)) << 0) | ((127u - (ta5 & 127u)) << 8) | ((127u - (ta6 & 127u)) << 16) | ((127u - (ta7 & 127u)) << 24), ((127u - (ta8 & 127u)) << 0) | ((127u - (ta9 & 127u)) << 8) | ((127u - (ta10 & 127u)) << 16) | ((127u - (ta11 & 127u)) << 24), ((127u - (ta12 & 127u)) << 0) | ((127u - (ta13 & 127u)) << 8) | ((127u - (ta14 & 127u)) << 16) | ((127u - (ta15 & 127u)) << 24)}; *(LAS u32x4*)((LP) + 16) = (u32x4){((127u - (tb0 & 127u)) << 0) | ((127u - (tb1 & 127u)) << 8) | ((127u - (tb2 & 127u)) << 16) | ((127u - (tb3 & 127u)) << 24), ((127u - (tb4 & 127u)) << 0) | ((127u - (tb5 & 127u)) << 8) | ((127u - (tb6 & 127u)) << 16) | ((127u - (tb7 & 127u)) << 24), ((127u - (tb8 & 127u)) << 0) | ((127u - (tb9 & 127u)) << 8) | ((127u - (tb10 & 127u)) << 16) | ((127u - (tb11 & 127u)) << 24), ((127u - (tb12 & 127u)) << 0) | ((127u - (tb13 & 127u)) << 8) | ((127u - (tb14 & 127u)) << 16) | ((127u - (tb15 & 127u)) << 24)}; } while (0)
#define LOOKUP16(PQ, K, LP) do { { const unsigned _f = 255u - (K##0 & 255u); PQ##0 = (unsigned)(LP)[_f >> 4] * 128u + (unsigned)(LP)[16u + (_f & 15u)]; } { const unsigned _f = 255u - (K##1 & 255u); PQ##1 = (unsigned)(LP)[_f >> 4] * 128u + (unsigned)(LP)[16u + (_f & 15u)]; } { const unsigned _f = 255u - (K##2 & 255u); PQ##2 = (unsigned)(LP)[_f >> 4] * 128u + (unsigned)(LP)[16u + (_f & 15u)]; } { const unsigned _f = 255u - (K##3 & 255u); PQ##3 = (unsigned)(LP)[_f >> 4] * 128u + (unsigned)(LP)[16u + (_f & 15u)]; } { const unsigned _f = 255u - (K##4 & 255u); PQ##4 = (unsigned)(LP)[_f >> 4] * 128u + (unsigned)(LP)[16u + (_f & 15u)]; } { const unsigned _f = 255u - (K##5 & 255u); PQ##5 = (unsigned)(LP)[_f >> 4] * 128u + (unsigned)(LP)[16u + (_f & 15u)]; } { const unsigned _f = 255u - (K##6 & 255u); PQ##6 = (unsigned)(LP)[_f >> 4] * 128u + (unsigned)(LP)[16u + (_f & 15u)]; } { const unsigned _f = 255u - (K##7 & 255u); PQ##7 = (unsigned)(LP)[_f >> 4] * 128u + (unsigned)(LP)[16u + (_f & 15u)]; } { const unsigned _f = 255u - (K##8 & 255u); PQ##8 = (unsigned)(LP)[_f >> 4] * 128u + (unsigned)(LP)[16u + (_f & 15u)]; } { const unsigned _f = 255u - (K##9 & 255u); PQ##9 = (unsigned)(LP)[_f >> 4] * 128u + (unsigned)(LP)[16u + (_f & 15u)]; } { const unsigned _f = 255u - (K##10 & 255u); PQ##10 = (unsigned)(LP)[_f >> 4] * 128u + (unsigned)(LP)[16u + (_f & 15u)]; } { const unsigned _f = 255u - (K##11 & 255u); PQ##11 = (unsigned)(LP)[_f >> 4] * 128u + (unsigned)(LP)[16u + (_f & 15u)]; } { const unsigned _f = 255u - (K##12 & 255u); PQ##12 = (unsigned)(LP)[_f >> 4] * 128u + (unsigned)(LP)[16u + (_f & 15u)]; } { const unsigned _f = 255u - (K##13 & 255u); PQ##13 = (unsigned)(LP)[_f >> 4] * 128u + (unsigned)(LP)[16u + (_f & 15u)]; } { const unsigned _f = 255u - (K##14 & 255u); PQ##14 = (unsigned)(LP)[_f >> 4] * 128u + (unsigned)(LP)[16u + (_f & 15u)]; } { const unsigned _f = 255u - (K##15 & 255u); PQ##15 = (unsigned)(LP)[_f >> 4] * 128u + (unsigned)(LP)[16u + (_f & 15u)]; } } while (0)
#define GATES16(E, K, MX, SUM) do { E##0 = __expf(key2f(K##0 & ~0xffu) - (MX)); SUM += E##0; E##1 = __expf(key2f(K##1 & ~0xffu) - (MX)); SUM += E##1; E##2 = __expf(key2f(K##2 & ~0xffu) - (MX)); SUM += E##2; E##3 = __expf(key2f(K##3 & ~0xffu) - (MX)); SUM += E##3; E##4 = __expf(key2f(K##4 & ~0xffu) - (MX)); SUM += E##4; E##5 = __expf(key2f(K##5 & ~0xffu) - (MX)); SUM += E##5; E##6 = __expf(key2f(K##6 & ~0xffu) - (MX)); SUM += E##6; E##7 = __expf(key2f(K##7 & ~0xffu) - (MX)); SUM += E##7; E##8 = __expf(key2f(K##8 & ~0xffu) - (MX)); SUM += E##8; E##9 = __expf(key2f(K##9 & ~0xffu) - (MX)); SUM += E##9; E##10 = __expf(key2f(K##10 & ~0xffu) - (MX)); SUM += E##10; E##11 = __expf(key2f(K##11 & ~0xffu) - (MX)); SUM += E##11; E##12 = __expf(key2f(K##12 & ~0xffu) - (MX)); SUM += E##12; E##13 = __expf(key2f(K##13 & ~0xffu) - (MX)); SUM += E##13; E##14 = __expf(key2f(K##14 & ~0xffu) - (MX)); SUM += E##14; E##15 = __expf(key2f(K##15 & ~0xffu) - (MX)); SUM += E##15; } while (0)
#define STORE_GATES(GP, EP, E, PQ, INV) do { *(f32x4*)((GP) + 0) = (f32x4){E##0 * (INV), E##1 * (INV), E##2 * (INV), E##3 * (INV)}; *(u32x4*)((EP) + 0) = (u32x4){PQ##0, PQ##1, PQ##2, PQ##3}; *(f32x4*)((GP) + 4) = (f32x4){E##4 * (INV), E##5 * (INV), E##6 * (INV), E##7 * (INV)}; *(u32x4*)((EP) + 4) = (u32x4){PQ##4, PQ##5, PQ##6, PQ##7}; *(f32x4*)((GP) + 8) = (f32x4){E##8 * (INV), E##9 * (INV), E##10 * (INV), E##11 * (INV)}; *(u32x4*)((EP) + 8) = (u32x4){PQ##8, PQ##9, PQ##10, PQ##11}; *(f32x4*)((GP) + 12) = (f32x4){E##12 * (INV), E##13 * (INV), E##14 * (INV), E##15 * (INV)}; *(u32x4*)((EP) + 12) = (u32x4){PQ##12, PQ##13, PQ##14, PQ##15}; } while (0)

__device__ __forceinline__ void d_route(const Params& P, LAS unsigned char* lds, int tid, int gw, int ngw) {
    const int lane = tid & 63, wave = __builtin_amdgcn_readfirstlane(tid >> 6);
    for (int idx = tid; idx < 2 * 128 * 128 / 2; idx += 512) { const int e = idx * 2, row = e >> 7, c = e & 127;
        const float a = P.in[I_SUBKEYS][e], b = P.in[I_SUBKEYS][e + 1];
        *(LAS unsigned*)(lds + row * RT_SKROW + c * 2) = pk2(a, b); }
    asm volatile("s_waitcnt lgkmcnt(0)" ::: "memory"); __syncthreads();
    const int hh = lane >> 5, l31 = lane & 31;
#define ROUTE_HALF(QROW, SKZ, T) do { \
        bf16x8v qf[8]; f32x16v acc[4]; \
        _Pragma("unroll") for (int ks = 0; ks < 8; ++ks) qf[ks] = *(const bf16x8v*)((QROW) + ks * 16 + 8 * hh); \
        _Pragma("unroll") for (int kb = 0; kb < 4; ++kb) { \
            _Pragma("unroll") for (int i = 0; i < 16; ++i) acc[kb][i] = 0.f; \
            _Pragma("unroll") for (int ks = 0; ks < 8; ++ks) { const bf16x8v af = *(const LAS bf16x8v*)((SKZ) + (kb * 32 + l31) * RT_SKROW + (ks * 16 + 8 * hh) * 2); \
                acc[kb] = __builtin_amdgcn_mfma_f32_32x32x16_bf16(af, qf[ks], acc[kb], 0, 0, 0); } } \
        DECL16(unsigned, ga); DECL16(unsigned, gb); DECL16(unsigned, gc); DECL16(unsigned, gd); DECL16(unsigned, ob); \
        __builtin_amdgcn_sched_barrier(0); FILL_G0(ga, acc[0], hh); SORT16_DESC(ga); __builtin_amdgcn_sched_barrier(0); FILL_G1(gb, acc[1], hh); SORT16_DESC(gb); __builtin_amdgcn_sched_barrier(0); MERGE16_DESC(ga, gb); __builtin_amdgcn_sched_barrier(0); \
        FILL_G2(gc, acc[2], hh); SORT16_DESC(gc); __builtin_amdgcn_sched_barrier(0); FILL_G3(gd, acc[3], hh); SORT16_DESC(gd); __builtin_amdgcn_sched_barrier(0); MERGE16_DESC(gc, gd); __builtin_amdgcn_sched_barrier(0); MERGE16_DESC(ga, gc); __builtin_amdgcn_sched_barrier(0); \
        XCHG16(ob, ga); MERGE16_DESC(ga, ob); COPY16(T, ga); __builtin_amdgcn_sched_barrier(0); } while (0)
#pragma unroll 1
    for (int task = gw; task < TOK * 8 / 32; task += ngw) {
        const long r0 = (long)task * 32; const bf16_t* qrow = P.QP + (size_t)(r0 + l31) * 256;
        DECL16(unsigned, ta); DECL16(unsigned, tb);
        ROUTE_HALF(qrow, lds, ta);
        ROUTE_HALF(qrow + 128, lds + 128 * RT_SKROW, tb);
        DECL16(unsigned, ck0_); DECL16(unsigned, ck1_); DECL16(unsigned, ck2_); DECL16(unsigned, ck3_);
        LAS unsigned char* lut = lds + 2 * 128 * RT_SKROW + wave * 1024 + l31 * 32;
        WRITE_LUT(lut);
        FILL_CANDS(); __builtin_amdgcn_sched_barrier(0);
        SORT16_DESC(ck0_); __builtin_amdgcn_sched_barrier(0); SORT16_DESC(ck1_); __builtin_amdgcn_sched_barrier(0); MERGE16_DESC(ck0_, ck1_); __builtin_amdgcn_sched_barrier(0);
        SORT16_DESC(ck2_); __builtin_amdgcn_sched_barrier(0); SORT16_DESC(ck3_); __builtin_amdgcn_sched_barrier(0); MERGE16_DESC(ck2_, ck3_); __builtin_amdgcn_sched_barrier(0); MERGE16_DESC(ck0_, ck2_); __builtin_amdgcn_sched_barrier(0);
        DECL16(unsigned, cp0_);
        LOOKUP16(cp0_, ck0_, lut);
        DECL16(float, ee); const float mx = key2f(ck0_0 & ~0xffu); float sum = 0.f;
        GATES16(ee, ck0_, mx, sum);
        const float inv = 1.0f / sum;
        if (lane < 32) { float* gp = P.GATE + (size_t)(r0 + lane) * 16; int* ep = P.EXPERT + (size_t)(r0 + lane) * 16; STORE_GATES(gp, ep, ee, cp0_, inv); }
    }
#undef ROUTE_HALF
}

__device__ __forceinline__ void d_gmlp(const Params& P, LAS unsigned char* lds, int tid) {
    const int lane = tid & 63, wave = __builtin_amdgcn_readfirstlane(tid >> 6), hh = lane >> 5, l31 = lane & 31;
    const int chunk = (int)blockIdx.x >> 1, hb = (int)blockIdx.x & 1;
    if (chunk >= TOK / 128) return;
    LAS bf16_t* VNt = (LAS bf16_t*)lds;
    {
        const int cg = hb * 256 + 8 * l31;
        const f32x4 g0 = *(const f32x4*)(P.in[I_GLN_G] + cg), g1 = *(const f32x4*)(P.in[I_GLN_G] + cg + 4);
        const f32x4 b0 = *(const f32x4*)(P.in[I_GLN_B] + cg), b1 = *(const f32x4*)(P.in[I_GLN_B] + cg + 4);
#pragma unroll 4
        for (int tt = 0; tt < 16; ++tt) { const int q = wave * 16 + tt; const long t = (long)chunk * 128 + q;
            const u32x4 w = *((const u32x4*)(P.PB + (size_t)t * 1024 + 512) + lane);
            float x[8] = {blo(w.x), bhi(w.x), blo(w.y), bhi(w.y), blo(w.z), bhi(w.z), blo(w.w), bhi(w.w)};
            float s = 0.f;
#pragma unroll
            for (int i = 0; i < 8; ++i) s += x[i];
            const float mean = wave_sum(s) * (1.f / 512.f); float s2 = 0.f;
#pragma unroll
            for (int i = 0; i < 8; ++i) { x[i] -= mean; s2 += x[i] * x[i]; }
            const float rstd = 1.f / sqrtf(wave_sum(s2) * (1.f / 512.f) + 1e-5f);
            if (hh == hb) {
#pragma unroll
                for (int i = 0; i < 8; ++i) { const float gg = (i < 4) ? g0[i] : g1[i - 4], bb = (i < 4) ? b0[i] : b1[i - 4];
                    VNt[(8 * l31 + i) * 136 + q] = f2bf(x[i] * rstd * gg + bb); } }
        }
    }
    asm volatile("s_waitcnt lgkmcnt(0)" ::: "memory"); __syncthreads();
    const int pb = wave >> 1, db = wave & 1;
#pragma unroll 1
    for (int gl = 0; gl < 4; ++gl) { const int g = 4 * hb + gl;
        f32x16v acc;
#pragma unroll
        for (int i = 0; i < 16; ++i) acc[i] = 0.f;
        const bf16_t* arow = P.WSB + ((size_t)g * 128 + pb * 32 + l31) * 128 + 8 * hh;
        const LAS bf16_t* brow = VNt + (gl * 64 + db * 32 + l31) * 136 + 8 * hh;
#pragma unroll
        for (int ks = 0; ks < 8; ++ks) { const bf16x8v af = *(const bf16x8v*)(arow + ks * 16); const bf16x8v bfr = *(const LAS bf16x8v*)(brow + ks * 16);
            acc = __builtin_amdgcn_mfma_f32_32x32x16_bf16(af, bfr, acc, 0, 0, 0); }
        const int c = g * 64 + db * 32 + l31;
#pragma unroll
        for (int r = 0; r < 16; ++r) { const int p = pb * 32 + (r & 3) + 8 * (r >> 2) + 4 * hh; const long t = (long)chunk * 128 + p;
            const float sv = acc[r] + P.in[I_B_S][g * 128 + p];
            P.YB[(size_t)t * 512 + c] = f2bf(bf2f(P.PB[(size_t)t * 1024 + c]) * sv); }
    }
}
constexpr int RING_BYTES = 131072, LDSCTL_OFF = RING_BYTES, MISC_OFF = LDSCTL_OFF + 320, LDS_BYTES = 147456;
constexpr int CW_BAR = 4096;
#ifndef MK_PER_PHASE
#define MK_PER_PHASE 0
#endif
struct KArgs { Params P; };
template <class DE, bool ALIGN = true> __device__ __forceinline__ void run_gemm(LAS unsigned char* lds, const bf16_t* A, const bf16_t* Bt, int M, int N, int K, const DE& E,
                                                                     int bgrp = 1 << 30, size_t bgstride = 0) {
    pg8::Gemm g{A, Bt, M, N, K, K, K, bgrp, bgstride}; pg8::StaticOrder S; S.init(M, N, (int)gridDim.x, (int)blockIdx.x);
    pg8::gemm_phase<DE, pg8::StaticOrder, ALIGN, true>(lds, g, S, E);
}
__global__ void __launch_bounds__(512, 2) mega_fwd(KArgs a) {
    extern __shared__ __attribute__((aligned(16))) unsigned char lds_raw[];
    LAS unsigned char* lds = (LAS unsigned char*)lds_raw;
    volatile LAS unsigned* MISC = (volatile LAS unsigned*)(lds + MISC_OFF);
    const Params& P = a.P;
    const int tid = threadIdx.x;
    for (int u = tid; u < (LDS_BYTES - LDSCTL_OFF) / 4; u += 512) ((LAS unsigned*)(lds + LDSCTL_OFF))[u] = 0u;
    __syncthreads();
    XcdBarrier bar; bar.bar = P.ctl + CW_BAR; bar.x = 0; bar.st = nullptr;
    bar = xcd_barrier_post(P.ctl + CW_BAR, MISC + 8);
    const long gtid = (long)blockIdx.x * 512 + tid, nthr = (long)gridDim.x * 512;
    const int lane = tid & 63, wave = __builtin_amdgcn_readfirstlane(tid >> 6), gw = (int)blockIdx.x * 8 + wave, ngw = (int)gridDim.x * 8;
#define PHASE(body) do { body; xcd_barrier(bar); } while (0)
    PHASE((d_weights(P, lds, gw, ngw, wave, lane), d_lora_weights(P, gtid, nthr), d_ln_rows(P.in[I_X], P.in[I_LN_EMB_G], P.in[I_LN_EMB_B], P.HB, TOK, gw, ngw, lane),
           d_ln_rows(P.in[I_MEM], P.in[I_MLN_G], P.in[I_MLN_B], P.MEMN, BATCH * MEM_LEN, gw, ngw, lane)));
    PHASE(({ { pg8::DEpiP1 E{{P.PA, P.PB}}; run_gemm(lds, P.HB, P.W_IN_T, TOK, 3072, 1024, E); }
             { pg8::DEpiTile E2{P.KH, 4, 1, 1.0f}; run_gemm(lds, P.MEMN, P.W_KV_T, BATCH * MEM_LEN, 1024, 1024, E2); }
             { pg8::DEpiTile E3{P.VT, 1, 4, 1.0f}; run_gemm(lds, P.W_KV_T + (size_t)1024 * 1024, P.MEMN, 1024, BATCH * MEM_LEN, 1024, E3); } }));
    PHASE((d_gmlp(P, lds, tid), d_prep_e1(P, gw, ngw, lane)));
    PHASE(({ { pg8::DEpiLora<0> E{P.in[I_W0], P.OMW}; run_gemm(lds, P.LIN, P.W_LORA_T, TOK, 1024, 512, E); }
             { pg8::DEpiLora<1> E{P.in[I_A0], P.AL}; run_gemm(lds, P.LIN, P.W_LORA_T + (size_t)1024 * 512, TOK, 1024, 512, E); }
             { pg8::DEpiLora<2> E{nullptr, P.G}; run_gemm(lds, P.LIN, P.W_LORA_T + (size_t)2048 * 512, TOK, 512, 512, E); } }));
    PHASE(d_scan(P, lds, tid));
    PHASE(d_rwkv_out(P, gw, ngw, lane));
    PHASE(({ { pg8::DEpiPlain E{{P.BR, 2048, 0}}; run_gemm(lds, P.YA, P.W_BR_T, TOK, 1024, 512, E); }
             { pg8::DEpiPlain E2{{P.BR, 2048, 1024}}; run_gemm(lds, P.YB, P.W_BR_T + (size_t)1024 * 512, TOK, 1024, 512, E2); } }));
    PHASE(({ pg8::DEpiMerge E{{P.BR, P.MG}}; run_gemm(lds, P.HB, P.W_IN_T + (size_t)3072 * 1024, TOK, 2048, 1024, E); }));
    PHASE(({ pg8::DEpiResid E{{P.HB, P.Z}}; run_gemm(lds, P.MG, P.W_MIX_T, TOK, 1024, 1024, E); }));
    PHASE(d_ln_rows(P.Z, P.in[I_LN1_G], P.in[I_LN1_B], P.HB, TOK, gw, ngw, lane));
    PHASE(({ pg8::DEpiQ EQ{{P.QH, 1, 0, 0.0625f}}; run_gemm(lds, P.HB, P.W_Q_T, TOK, 1024, 1024, EQ); }));
    PHASE(({ pg8::DEpiSoftmax E{P.PP}; run_gemm<pg8::DEpiSoftmax, false>(lds, P.QH, P.KH, TOK * 4, 256, 256, E, 8, (size_t)256 * 256 * 2); }));
    PHASE(({ pg8::DEpiO E{P.O}; run_gemm(lds, P.PP, P.VT, TOK * 4, 256, 256, E, 8, (size_t)256 * 256 * 2); }));
    PHASE(({ pg8::DEpiResid E{{P.HB, P.Z}}; run_gemm(lds, P.O, P.W_O_T, TOK, 1024, 1024, E); }));
    PHASE(d_ln_rows(P.Z, P.in[I_LN2_G], P.in[I_LN2_B], P.HB, TOK, gw, ngw, lane));
    PHASE(({ pg8::DEpiPlain E{{P.QP, 2048, 0}}; run_gemm(lds, P.HB, P.W_QUERY_T, TOK, 2048, 1024, E); }));
#if PEER_FP8
    PHASE((d_route(P, lds, tid, gw, ngw), d_tables8(P, gw, ngw, lane)));
    d_peer8(P, gw, ngw, lane);
#else
    PHASE((d_route(P, lds, tid, gw, ngw), d_tables(P, gtid, nthr)));
    d_peer(P, gw, ngw, lane);
#endif
#undef PHASE
}
extern "C" void kernel_launch(void* const* d_in, const int* in_sizes, int n_in, void* d_out, int out_size, void* d_ws, size_t ws_size, hipStream_t stream) {
    static int grid = 0;
    if (grid == 0) {
        int dev = 0, cus = 0;
        if (n_in != 37 || ws_size < WS_NEED || hipGetDevice(&dev) != hipSuccess || hipDeviceGetAttribute(&cus, hipDeviceAttributeMultiprocessorCount, dev) != hipSuccess) {
            fprintf(stderr, "kernel_launch: bad arguments (n_in %d, ws %zu < %zu)\n", n_in, ws_size, (size_t)WS_NEED); grid = -1; return; }
        if (hipFuncSetAttribute((const void*)mega_fwd, hipFuncAttributeMaxDynamicSharedMemorySize, LDS_BYTES) != hipSuccess) { fprintf(stderr, "kernel_launch: hipFuncSetAttribute failed\n"); grid = -1; return; }
        grid = cus;
    }
    if (grid < 0) return;
    (void)hipMemsetAsync((char*)d_ws + WS_CTL, 0, 1 * MiB, stream);
    KArgs a; memset(&a, 0, sizeof(a)); make_params(a.P, d_in, d_out, d_ws);
    hipLaunchKernelGGL(mega_fwd, dim3(grid), dim3(512), LDS_BYTES, stream, a);
}
#endif
```

```cpp
#ifdef HOST_EMU
#include "emu.h"
#else
#include <hip/hip_runtime.h>
#include <cstdio>
#include <cstdint>
#include <cstring>
#endif

#ifndef BATCH
#define BATCH 8
#endif
#ifndef SEQ
#define SEQ 2048
#endif
#define DM 1024
#define TOK (BATCH * SEQ)
#define IN_COLS 4992
#define MEM_LEN 256
#define ALPHA_F 1.189207115002721f
typedef unsigned short bf16_t;

#ifdef HOST_EMU
static inline float bf2f(bf16_t v) { unsigned u = (unsigned)v << 16; float f; memcpy(&f, &u, 4); return f; }
static inline bf16_t f2bf(float f) { unsigned u; memcpy(&u, &f, 4); return (bf16_t)((u + 0x7fffu + ((u >> 16) & 1u)) >> 16); }
#else
__device__ __forceinline__ float bf2f(bf16_t v) { return __uint_as_float((unsigned)v << 16); }
__device__ __forceinline__ bf16_t f2bf(float f) { unsigned u = __float_as_uint(f); return (bf16_t)((u + 0x7fffu + ((u >> 16) & 1u)) >> 16); }
#endif
__device__ __forceinline__ float sigmoidf_(float x) { return 1.0f / (1.0f + expf(-x)); }
__device__ __forceinline__ float geluf_(float x) { return 0.5f * x * (1.0f + erff(x * 0.7071067811865476f)); }

struct Params {
    const float* in[37];
    float* out;
    unsigned* ctl;
    bf16_t *W_IN_T, *W_BR_T, *W_MIX_T, *W_Q_T, *W_KV_T, *W_O_T, *W_QUERY_T;
    bf16_t *KV, *MEMN, *HB;
    bf16_t *PA, *PB, *VN, *YB;
    bf16_t *WDS, *ADS, *SG;
    bf16_t *R, *V, *KK, *OMW, *KDIR, *BVEC;
    float *Y01;
    bf16_t *YA, *BR, *MG;
    float* Z;
    bf16_t *Q, *O;
    float* SCA;
    bf16_t* QP;
    float* SC; float* TOPS; int* TOPI; float* GATE; int* EXPERT; float* COEF; float* Y;
    bf16_t *UB, *VB;
    unsigned char *U8, *V8; float *SU, *SV;
    bf16_t *W_LORA_T;
    bf16_t *WSB;
    bf16_t *LIN, *K, *AL, *G;
    bf16_t *KH, *VT, *QH, *PP;
};
enum { I_X = 0, I_MEM, I_LN_EMB_G, I_LN_EMB_B, I_W_IN, I_MU, I_W0, I_W2, I_A0, I_A2, I_G2, I_K_K, I_K_A, I_R_K, I_GN_G, I_GN_B,
       I_GLN_G, I_GLN_B, I_W_S, I_B_S, I_W_BRANCH, I_W_MIX, I_LN1_G, I_LN1_B, I_MLN_G, I_MLN_B, I_W_Q, I_W_KV, I_W_O, I_LN2_G, I_LN2_B,
       I_W_QUERY, I_SUBKEYS, I_PEER_U, I_PEER_V, I_LN3_G, I_LN3_B };

constexpr size_t MiB = 1u << 20;
constexpr size_t TU = (size_t)TOK * 1024;
constexpr size_t WS_CTL = 0;
constexpr size_t WS_W = 1 * MiB;
constexpr size_t OFF_W_IN = 0, OFF_W_BR = OFF_W_IN + (size_t)5120 * 1024 * 2, OFF_W_MIX = OFF_W_BR + (size_t)2048 * 512 * 2,
                 OFF_W_Q = OFF_W_MIX + (size_t)1024 * 1024 * 2, OFF_W_KV = OFF_W_Q + (size_t)1024 * 1024 * 2,
                 OFF_W_O = OFF_W_KV + (size_t)2048 * 1024 * 2, OFF_W_QUERY = OFF_W_O + (size_t)1024 * 1024 * 2,
                 OFF_W_END = OFF_W_QUERY + (size_t)2048 * 1024 * 2;
static_assert(OFF_W_END <= 27 * MiB, "weights region");
constexpr size_t OFF_W_LORA = OFF_W_END, OFF_W_END2 = OFF_W_LORA + (size_t)2560 * 512 * 2;
constexpr size_t OFF_WSB = OFF_W_END2;
static_assert(OFF_WSB + 8 * 128 * 128 * 2 <= 29 * MiB, "weights region 2");
constexpr size_t WS_KV = 30 * MiB;
constexpr size_t WS_MEMN = 38 * MiB;
constexpr size_t WS_ACT = 42 * MiB;
constexpr size_t A_HB = WS_ACT;
constexpr size_t A_R1 = A_HB + 2 * TU;
constexpr size_t A_R2 = A_R1 + 4 * TU;
constexpr size_t WS_NEED = A_R2 + 7 * TU;
#ifndef HOST_EMU
static_assert(WS_NEED <= 256 * MiB, "workspace map exceeds 256 MiB");
#endif

struct EpiP1 { bf16_t* PA; bf16_t* PB; };
struct EpiPlain { bf16_t* O; int ldc; int col_off; };
struct EpiMerge { const bf16_t* BR; bf16_t* MG; };
struct EpiResid { const bf16_t* H; float* Z; };

#ifndef HOST_EMU
namespace pg8 {
#define PG8_LAS __attribute__((address_space(3)))
typedef unsigned short bf16_t;
typedef short bf16x8 __attribute__((ext_vector_type(8)));
typedef float f32x4 __attribute__((ext_vector_type(4)));
typedef unsigned u32x4 __attribute__((ext_vector_type(4)));
constexpr int BM = 256, BK = 64, HALF = 128, HTB = HALF * BK * 2  , STAGE_BYTES = 8 * HTB, NXCD = 8, WGM = 8;

__host__ __device__ __forceinline__ int lds_byte(int r, int c) { const int st = (r >> 4) * 2 + (c >> 5), rr = r & 15, cc = c & 31, ob = rr * 64 + cc * 2; return st * 1024 + (ob ^ (((ob >> 9) & 1) << 5)); }
__host__ __device__ __forceinline__ void stage_rc(int b, int& R, int& C) { const int st = b / 1024, sb = b % 1024, swz = sb ^ (((sb >> 9) & 1) << 5); R = (st >> 1) * 16 + swz / 64; C = (st & 1) * 32 + (swz % 64) / 2; }
__host__ __device__ __forceinline__ int perm32(int rho) { const int n = rho >> 4, i = rho & 15; return 8 * (i >> 2) + 4 * n + (i & 3); }

struct Unit { int pm, pn; };
struct Gemm { const bf16_t* A; const bf16_t* Bt; int M, N, K; int lda, ldb; int bgrp; size_t bgstride; };

struct StaticOrder {
    int nM, nN, nwg, G, c;
    __host__ __device__ void init(int M, int N, int G_, int c_) { nM = M / BM; nN = N / BM; nwg = nM * nN; G = G_; c = c_; }
    __host__ __device__ bool next(int i, Unit& u) const {
        const long L = (long)i * G + c; if (L >= nwg) return false;
        int wgid = (int)L; { const int q = nwg / NXCD, r = nwg % NXCD, xcd = wgid % NXCD, off = wgid / NXCD; wgid = (xcd < r ? xcd * (q + 1) : r * (q + 1) + (xcd - r) * q) + off; }
        const int nig = WGM * nN, gid = wgid / nig, fm = gid * WGM, gsz = (nM - fm) < WGM ? (nM - fm) : WGM;
        u.pm = fm + ((wgid % nig) % gsz); u.pn = (wgid % nig) / gsz; return true;
    }
    __device__ __forceinline__ void a_ready(const Unit&) const {}
    __device__ __forceinline__ void done(const Unit&) const {}
};

typedef float f32x2c __attribute__((ext_vector_type(2))); typedef __bf16 bf16x2c __attribute__((ext_vector_type(2)));
__device__ __forceinline__ unsigned cvt_pk_bf16(float lo, float hi) { const f32x2c v = {lo, hi}; const bf16x2c b = __builtin_convertvector(v, bf16x2c); return __builtin_bit_cast(unsigned, b); }
typedef float f32x2 __attribute__((ext_vector_type(2)));
__device__ __forceinline__ f32x2 gelu_pk(f32x2 v) {
    const f32x2 av = __builtin_elementwise_abs(v), d = av * 0.2316418882f + 1.0f;
    f32x2 t; t.x = __builtin_amdgcn_rcpf(d.x); t.y = __builtin_amdgcn_rcpf(d.y);
    f32x2 q = t * 0.5307027145f + (-0.7265760135f); q = q * t + 0.7107068705f; q = q * t + (-0.142248368f); q = q * t + 0.127414796f; q = q * t;
    const f32x2 s = (v * v) * (-0.72134752044f);
    f32x2 e; e.x = __builtin_amdgcn_exp2f(s.x); e.y = __builtin_amdgcn_exp2f(s.y);
    const f32x2 m = v * (q * e), r = v - m;
    f32x2 o; o.x = v.x < 0.f ? m.x : r.x; o.y = v.y < 0.f ? m.y : r.y; return o;
}


template <class Epi, class Sched, bool ALIGN_EPI = false, bool SP2 = false>
__device__ __forceinline__ void gemm_phase(PG8_LAS unsigned char* lds, const Gemm g, const Sched& S, const Epi& E) {
    int tid_ = threadIdx.x; asm volatile("" : "+v"(tid_));
    const int tid = tid_, wid = __builtin_amdgcn_readfirstlane(tid >> 6), lane = tid & 63, wr = wid >> 2, wc = wid & 3, fr = lane & 15, fq = lane >> 4;
    const int K = g.K, nt = K / BK;
    unsigned voffA[2], voffB[2];
#pragma unroll
    for (int i = 0; i < 2; ++i) { int R, C; stage_rc(tid * 16 + i * 8192, R, C); const int Rb = Epi::PERM ? ((R & ~31) + perm32(R & 31)) : R;
        voffA[i] = (unsigned)(R * g.lda + C) * 2u; voffB[i] = (unsigned)(Rb * g.ldb + C) * 2u; }
    const size_t kstep = (size_t)(BK * 2);
    const size_t hstepA = (size_t)HALF * g.lda * 2, hstepB = (size_t)HALF * g.ldb * 2;
    const size_t tstepA = 2 * hstepA, tstepB = 2 * hstepB;
    const unsigned ldsw = (unsigned)wid * 1024u;
    const int aoff = lds_byte(wr * 64 + fr, fq * 8), boff = lds_byte(wc * 32 + fr, fq * 8);
#define PG8_SA(b, h) (((b) * 2 + (h)) * HTB)
#define PG8_SB(b, h) ((4 + (b) * 2 + (h)) * HTB)
#define PG8_STAGE(bufoff, gbase, voff) do { _Pragma("unroll") for (int _i = 0; _i < 2; ++_i) \
        __builtin_amdgcn_global_load_lds((const unsigned*)((const char*)(gbase) + (voff)[_i]), (PG8_LAS unsigned*)(lds + (bufoff) + ldsw + _i * 8192), 16, 0, 0); } while (0)
#define PG8_LDA(dst, b, h) do { _Pragma("unroll") for (int m = 0; m < 4; ++m) _Pragma("unroll") for (int k = 0; k < 2; ++k) dst[m][k] = *(const PG8_LAS bf16x8*)(lds + PG8_SA(b, h) + aoff + m * 2048 + k * 1024); } while (0)
#define PG8_LDB(dst, b, h) do { _Pragma("unroll") for (int n = 0; n < 2; ++n) _Pragma("unroll") for (int k = 0; k < 2; ++k) dst[n][k] = *(const PG8_LAS bf16x8*)(lds + PG8_SB(b, h) + boff + n * 2048 + k * 1024); } while (0)
#define PG8_MMA(ai, bj, At, Bt) do { __builtin_amdgcn_s_setprio(1); _Pragma("unroll") for (int m = 0; m < 4; ++m) _Pragma("unroll") for (int n = 0; n < 2; ++n) _Pragma("unroll") for (int k = 0; k < 2; ++k) \
        acc[ai][bj][m][n] = __builtin_amdgcn_mfma_f32_16x16x32_bf16(Bt[n][k], At[m][k], acc[ai][bj][m][n], 0, 0, 0); __builtin_amdgcn_s_setprio(0); } while (0)
#define PG8_WAIT_V(n) asm volatile("s_waitcnt vmcnt(" #n ")" ::: "memory")
#define PG8_WAIT_L(n) asm volatile("s_waitcnt lgkmcnt(" #n ")" ::: "memory")
#define PG8_BAR __builtin_amdgcn_s_barrier()
#define PG8_SCHED __builtin_amdgcn_sched_barrier(0)
    Unit cur, nxt; int ui = 0;
    if (!S.next(0, cur)) return;
    f32x4 acc[2][2][4][2];
#pragma unroll
    for (int a = 0; a < 2; ++a)
#pragma unroll
        for (int b = 0; b < 2; ++b)
#pragma unroll
            for (int m = 0; m < 4; ++m)
#pragma unroll
                for (int n = 0; n < 2; ++n) acc[a][b][m][n] = (f32x4){0.f, 0.f, 0.f, 0.f};
    bf16x8 At[4][2], B0[2][2], B1[2][2];
    const char* cA = (const char*)g.A + (size_t)cur.pm * tstepA; const char* cB = (const char*)g.Bt + (size_t)cur.pn * tstepB + (size_t)(cur.pm / g.bgrp) * g.bgstride;
    S.a_ready(cur);
    if constexpr (SP2) {
        PG8_STAGE(PG8_SB(0, 0), cB, voffB); PG8_STAGE(PG8_SB(0, 1), cB + hstepB, voffB); PG8_STAGE(PG8_SA(0, 0), cA, voffA); PG8_STAGE(PG8_SA(0, 1), cA + hstepA, voffA);
        if (wr == 1) PG8_BAR;
        PG8_WAIT_V(2); PG8_BAR;
        PG8_STAGE(PG8_SB(1, 0), cB + kstep, voffB); PG8_STAGE(PG8_SA(1, 0), cA + kstep, voffA); PG8_STAGE(PG8_SB(1, 1), cB + hstepB + kstep, voffB);
        PG8_WAIT_V(6); PG8_BAR;
    } else {
        PG8_STAGE(PG8_SB(0, 0), cB, voffB); PG8_STAGE(PG8_SA(0, 0), cA, voffA); PG8_STAGE(PG8_SB(0, 1), cB + hstepB, voffB); PG8_STAGE(PG8_SA(0, 1), cA + hstepA, voffA);
        if (wr == 1) PG8_BAR;
        PG8_WAIT_V(4); PG8_BAR;
        PG8_STAGE(PG8_SB(1, 0), cB + kstep, voffB); PG8_STAGE(PG8_SA(1, 0), cA + kstep, voffA); PG8_STAGE(PG8_SB(1, 1), cB + hstepB + kstep, voffB);
        PG8_WAIT_V(6); PG8_BAR;
    }
    for (;;) {
        const bool has_next = S.next(ui + 1, nxt);
        const char* nA = has_next ? (const char*)g.A + (size_t)nxt.pm * tstepA : cA; const char* nB = has_next ? (const char*)g.Bt + (size_t)nxt.pn * tstepB + (size_t)(nxt.pm / g.bgrp) * g.bgstride : cB;
#pragma unroll 1
        for (int t = 0; t < nt; t += 2) {
            const bool last = (t == nt - 2);
            const char* a1 = cA + (size_t)(t + 1) * kstep;
            const char* a2 = last ? nA : cA + (size_t)(t + 2) * kstep; const char* b2 = last ? nB : cB + (size_t)(t + 2) * kstep;
            const char* a3 = a2 + kstep; const char* b3 = b2 + kstep;
            if (last && has_next) S.a_ready(nxt);
            if constexpr (SP2) {
            PG8_LDB(B0, 0, 0); PG8_LDB(B1, 0, 1); PG8_SCHED; PG8_LDA(At, 0, 0); PG8_STAGE(PG8_SA(1, 1), a1 + hstepA, voffA);
            PG8_WAIT_V(8); PG8_WAIT_L(0); PG8_BAR; PG8_MMA(0, 0, At, B0); PG8_MMA(0, 1, At, B1); PG8_BAR; PG8_SCHED;
            PG8_LDA(At, 0, 1); PG8_STAGE(PG8_SB(0, 0), b2, voffB); PG8_STAGE(PG8_SB(0, 1), b2 + hstepB, voffB); PG8_STAGE(PG8_SA(0, 0), a2, voffA);
            PG8_WAIT_V(8); PG8_WAIT_L(0); PG8_BAR; PG8_MMA(1, 0, At, B0); PG8_MMA(1, 1, At, B1); PG8_BAR; PG8_SCHED;
            PG8_LDB(B0, 1, 0); PG8_LDB(B1, 1, 1); PG8_SCHED; PG8_LDA(At, 1, 0); PG8_STAGE(PG8_SA(0, 1), a2 + hstepA, voffA);
            PG8_WAIT_V(8); PG8_WAIT_L(0); PG8_BAR; PG8_MMA(0, 0, At, B0); PG8_MMA(0, 1, At, B1); PG8_BAR; PG8_SCHED;
            PG8_LDA(At, 1, 1); PG8_STAGE(PG8_SB(1, 0), b3, voffB); PG8_STAGE(PG8_SB(1, 1), b3 + hstepB, voffB); PG8_STAGE(PG8_SA(1, 0), a3, voffA);
            PG8_WAIT_V(8); PG8_WAIT_L(0); PG8_BAR; PG8_MMA(1, 0, At, B0); PG8_MMA(1, 1, At, B1); PG8_BAR; PG8_SCHED;
            } else {
            PG8_LDB(B0, 0, 0); PG8_SCHED; PG8_LDA(At, 0, 0); PG8_STAGE(PG8_SA(1, 1), a1 + hstepA, voffA);
            PG8_WAIT_L(8); PG8_BAR; PG8_WAIT_L(0); PG8_MMA(0, 0, At, B0); PG8_BAR; PG8_SCHED;
            PG8_LDB(B1, 0, 1); PG8_STAGE(PG8_SB(0, 0), b2, voffB);
            PG8_BAR; PG8_WAIT_L(0); PG8_MMA(0, 1, At, B1); PG8_BAR;
            PG8_LDA(At, 0, 1); PG8_STAGE(PG8_SA(0, 0), a2, voffA);
            PG8_BAR; PG8_WAIT_L(0); PG8_MMA(1, 0, At, B0); PG8_BAR; PG8_SCHED;
            PG8_STAGE(PG8_SB(0, 1), b2 + hstepB, voffB);
            PG8_WAIT_V(6); PG8_BAR; PG8_MMA(1, 1, At, B1); PG8_BAR;
            PG8_LDB(B0, 1, 0); PG8_SCHED; PG8_LDA(At, 1, 0); PG8_STAGE(PG8_SA(0, 1), a2 + hstepA, voffA);
            PG8_WAIT_L(8); PG8_BAR; PG8_WAIT_L(0); PG8_MMA(0, 0, At, B0); PG8_BAR; PG8_SCHED;
            PG8_LDB(B1, 1, 1); PG8_STAGE(PG8_SB(1, 0), b3, voffB);
            PG8_BAR; PG8_WAIT_L(0); PG8_MMA(0, 1, At, B1); PG8_BAR;
            PG8_LDA(At, 1, 1); PG8_STAGE(PG8_SA(1, 0), a3, voffA);
            PG8_BAR; PG8_WAIT_L(0); PG8_MMA(1, 0, At, B0); PG8_BAR; PG8_SCHED;
            PG8_STAGE(PG8_SB(1, 1), b3 + hstepB, voffB);
            PG8_WAIT_V(6); PG8_BAR; PG8_MMA(1, 1, At, B1); PG8_BAR;
            }
        }
        if constexpr (ALIGN_EPI) { if (wr == 0) PG8_BAR; }
        if constexpr (!Epi::AFTER_DRAIN) { E(acc, cur, wr, wc, fr, fq); S.done(cur); }
        if (!has_next) break;
#pragma unroll
        for (int a = 0; a < 2; ++a)
#pragma unroll
            for (int b = 0; b < 2; ++b)
#pragma unroll
                for (int m = 0; m < 4; ++m)
#pragma unroll
                    for (int n = 0; n < 2; ++n) acc[a][b][m][n] = (f32x4){0.f, 0.f, 0.f, 0.f};
        cur = nxt; cA = nA; cB = nB; ++ui;
        if constexpr (ALIGN_EPI) { if (wr == 1) PG8_BAR; }
    }
    PG8_WAIT_V(0);
    if constexpr (!ALIGN_EPI) { if (wr == 0) PG8_BAR; }
    PG8_BAR;
    if constexpr (Epi::AFTER_DRAIN) { E.fused(acc, cur, wr, wc, fr, fq, lds, wid, lane); S.done(cur); }
#undef PG8_SA
#undef PG8_SB
#undef PG8_STAGE
#undef PG8_LDA
#undef PG8_LDB
#undef PG8_MMA
#undef PG8_WAIT_V
#undef PG8_WAIT_L
#undef PG8_BAR
#undef PG8_SCHED
}
}

namespace pg8 {
__device__ __forceinline__ u32x4 pack8(const f32x4& v0, const f32x4& v1) { u32x4 w; w.x = cvt_pk_bf16(v0[0], v0[1]); w.y = cvt_pk_bf16(v0[2], v0[3]); w.z = cvt_pk_bf16(v1[0], v1[1]); w.w = cvt_pk_bf16(v1[2], v1[3]); return w; }
__device__ __forceinline__ f32x4 gelu4(const f32x4& v) { f32x2 a = gelu_pk((f32x2){v[0], v[1]}), b = gelu_pk((f32x2){v[2], v[3]}); return (f32x4){a.x, a.y, b.x, b.y}; }
struct DEpiP1 {
    static constexpr bool PERM = true, AFTER_DRAIN = false; EpiP1 e;
    __device__ __forceinline__ void operator()(const f32x4 (&acc)[2][2][4][2], const Unit& u, int wr, int wc, int fr, int fq) const {
        const int row0 = u.pm * BM + wr * 64 + fr; const bool isb = (u.pn >= 8);
        bf16_t* base = isb ? e.PB : e.PA; const int ldc = isb ? 1024 : 2048; const int col0 = (isb ? (u.pn - 8) : u.pn) * BM + wc * 32 + 8 * fq;
#pragma unroll
        for (int ai = 0; ai < 2; ++ai)
#pragma unroll
            for (int m = 0; m < 4; ++m) { bf16_t* rowp = base + (size_t)(row0 + ai * HALF + m * 16) * ldc + col0;
#pragma unroll
                for (int bj = 0; bj < 2; ++bj) { f32x4 v0 = acc[ai][bj][m][0], v1 = acc[ai][bj][m][1];
                    if (isb) { v0 = gelu4(v0); v1 = gelu4(v1); }
                    *(u32x4*)(rowp + bj * HALF) = pack8(v0, v1); } }
    }
};
struct DEpiPlain {
    static constexpr bool PERM = true, AFTER_DRAIN = false; EpiPlain e;
    __device__ __forceinline__ void operator()(const f32x4 (&acc)[2][2][4][2], const Unit& u, int wr, int wc, int fr, int fq) const {
        const int row0 = u.pm * BM + wr * 64 + fr; const int col0 = e.col_off + u.pn * BM + wc * 32 + 8 * fq;
#pragma unroll
        for (int ai = 0; ai < 2; ++ai)
#pragma unroll
            for (int m = 0; m < 4; ++m) { bf16_t* rowp = e.O + (size_t)(row0 + ai * HALF + m * 16) * e.ldc + col0;
#pragma unroll
                for (int bj = 0; bj < 2; ++bj) *(u32x4*)(rowp + bj * HALF) = pack8(acc[ai][bj][m][0], acc[ai][bj][m][1]); }
    }
};
__device__ __forceinline__ float sig_fast(float x) { return __builtin_amdgcn_rcpf(1.0f + __expf(-x)); }
__device__ __forceinline__ float bflo(unsigned w) { return __uint_as_float(w << 16); }
__device__ __forceinline__ float bfhi(unsigned w) { return __uint_as_float(w & 0xffff0000u); }
struct DEpiMerge {
    static constexpr bool PERM = true, AFTER_DRAIN = false; EpiMerge e;
    __device__ __forceinline__ void operator()(const f32x4 (&acc)[2][2][4][2], const Unit& u, int wr, int wc, int fr, int fq) const {
        const int row0 = u.pm * BM + wr * 64 + fr; const int n0 = u.pn * HALF + wc * 32 + 8 * fq;
#pragma unroll
        for (int ai = 0; ai < 2; ++ai)
#pragma unroll
            for (int m = 0; m < 4; ++m) { const size_t row = (size_t)(row0 + ai * HALF + m * 16);
                const u32x4 b0 = *(const u32x4*)(e.BR + row * 2048 + n0), b1 = *(const u32x4*)(e.BR + row * 2048 + 1024 + n0);
                const f32x4 g00 = acc[ai][0][m][0], g01 = acc[ai][0][m][1], g10 = acc[ai][1][m][0], g11 = acc[ai][1][m][1];
                f32x4 o0, o1;
                o0[0] = sig_fast(g00[0]) * bflo(b0.x) + sig_fast(g10[0]) * bflo(b1.x); o0[1] = sig_fast(g00[1]) * bfhi(b0.x) + sig_fast(g10[1]) * bfhi(b1.x);
                o0[2] = sig_fast(g00[2]) * bflo(b0.y) + sig_fast(g10[2]) * bflo(b1.y); o0[3] = sig_fast(g00[3]) * bfhi(b0.y) + sig_fast(g10[3]) * bfhi(b1.y);
                o1[0] = sig_fast(g01[0]) * bflo(b0.z) + sig_fast(g11[0]) * bflo(b1.z); o1[1] = sig_fast(g01[1]) * bfhi(b0.z) + sig_fast(g11[1]) * bfhi(b1.z);
                o1[2] = sig_fast(g01[2]) * bflo(b0.w) + sig_fast(g11[2]) * bflo(b1.w); o1[3] = sig_fast(g01[3]) * bfhi(b0.w) + sig_fast(g11[3]) * bfhi(b1.w);
                *(u32x4*)(e.MG + row * 1024 + n0) = pack8(o0, o1); }
    }
};
struct DEpiResid {
    static constexpr bool PERM = false, AFTER_DRAIN = false; EpiResid e;
    __device__ __forceinline__ void operator()(const f32x4 (&acc)[2][2][4][2], const Unit& u, int wr, int wc, int fr, int fq) const {
        const int row0 = u.pm * BM + wr * 64 + fr, col0 = u.pn * BM + wc * 32 + 4 * fq;
        typedef unsigned u32x2 __attribute__((ext_vector_type(2)));
#pragma unroll
        for (int ai = 0; ai < 2; ++ai)
#pragma unroll
            for (int m = 0; m < 4; ++m) { const size_t ro = (size_t)(row0 + ai * HALF + m * 16) * 1024 + col0;
#pragma unroll
                for (int bj = 0; bj < 2; ++bj)
#pragma unroll
                    for (int n = 0; n < 2; ++n) { const u32x2 h = *(const u32x2*)(e.H + ro + bj * HALF + n * 16); const f32x4 a = acc[ai][bj][m][n];
                        f32x4 o; o[0] = ALPHA_F * bflo(h.x) + a[0]; o[1] = ALPHA_F * bfhi(h.x) + a[1]; o[2] = ALPHA_F * bflo(h.y) + a[2]; o[3] = ALPHA_F * bfhi(h.y) + a[3];
                        *(f32x4*)(e.Z + ro + bj * HALF + n * 16) = o; } }
    }
};

struct DEpiTile {
    static constexpr bool PERM = true, AFTER_DRAIN = false; bf16_t* O; int sm, sn; float scale;
    __device__ __forceinline__ void operator()(const f32x4 (&acc)[2][2][4][2], const Unit& u, int wr, int wc, int fr, int fq) const {
        bf16_t* base = O + (size_t)(u.pm * sm + u.pn * sn) * 65536; const int row0 = wr * 64 + fr, col0 = wc * 32 + 8 * fq;
#pragma unroll
        for (int ai = 0; ai < 2; ++ai)
#pragma unroll
            for (int m = 0; m < 4; ++m) { bf16_t* rowp = base + (size_t)(row0 + ai * HALF + m * 16) * 256 + col0;
#pragma unroll
                for (int bj = 0; bj < 2; ++bj) *(u32x4*)(rowp + bj * HALF) = pack8(acc[ai][bj][m][0] * scale, acc[ai][bj][m][1] * scale); }
    }
};
struct DEpiQ { static constexpr bool PERM = true, AFTER_DRAIN = false; DEpiTile t;
    __device__ __forceinline__ void operator()(const f32x4 (&acc)[2][2][4][2], const Unit& u, int wr, int wc, int fr, int fq) const {
        Unit v; v.pm = (u.pm >> 3) * 32 + u.pn * 8 + (u.pm & 7); v.pn = 0; t(acc, v, wr, wc, fr, fq); } };
struct DEpiO {
    static constexpr bool PERM = true, AFTER_DRAIN = false; bf16_t* O;
    __device__ __forceinline__ void operator()(const f32x4 (&acc)[2][2][4][2], const Unit& u, int wr, int wc, int fr, int fq) const {
        const int bh = u.pm >> 3, b = bh >> 2, h = bh & 3; const int s0 = (u.pm & 7) * 256 + wr * 64 + fr;
        bf16_t* base = O + ((size_t)b * SEQ) * 1024 + h * 256 + wc * 32 + 8 * fq;
#pragma unroll
        for (int ai = 0; ai < 2; ++ai)
#pragma unroll
            for (int m = 0; m < 4; ++m) { bf16_t* rowp = base + (size_t)(s0 + ai * HALF + m * 16) * 1024;
#pragma unroll
                for (int bj = 0; bj < 2; ++bj) *(u32x4*)(rowp + bj * HALF) = pack8(acc[ai][bj][m][0], acc[ai][bj][m][1]); }
    }
};
struct DEpiSoftmax {
    static constexpr bool PERM = true, AFTER_DRAIN = true; bf16_t* Pout;
    __device__ __forceinline__ void fused(f32x4 (&acc)[2][2][4][2], const Unit& u, int wr, int wc, int fr, int fq, PG8_LAS unsigned char* lds, int wid, int lane) const {
        PG8_LAS float* PM = (PG8_LAS float*)lds;
        PG8_LAS float* PS = (PG8_LAS float*)(lds + 4096);
#pragma unroll
        for (int ai = 0; ai < 2; ++ai)
#pragma unroll
            for (int m = 0; m < 4; ++m) { float mx = -3.0e38f;
#pragma unroll
                for (int bj = 0; bj < 2; ++bj)
#pragma unroll
                    for (int n = 0; n < 2; ++n) { const f32x4 x = acc[ai][bj][m][n]; mx = fmaxf(mx, fmaxf(fmaxf(x[0], x[1]), fmaxf(x[2], x[3]))); }
                mx = fmaxf(mx, __shfl_xor(mx, 16)); mx = fmaxf(mx, __shfl_xor(mx, 32));
                if (fq == 0) PM[(ai * HALF + wr * 64 + m * 16 + fr) * 4 + wc] = mx; }
        asm volatile("s_waitcnt lgkmcnt(0)" ::: "memory"); __builtin_amdgcn_s_barrier(); asm volatile("" ::: "memory");
#pragma unroll
        for (int ai = 0; ai < 2; ++ai)
#pragma unroll
            for (int m = 0; m < 4; ++m) { const int row = ai * HALF + wr * 64 + m * 16 + fr; const f32x4 p4 = *(const PG8_LAS f32x4*)(PM + row * 4);
                const float gm = fmaxf(fmaxf(p4[0], p4[1]), fmaxf(p4[2], p4[3])); float sum = 0.f;
#pragma unroll
                for (int bj = 0; bj < 2; ++bj)
#pragma unroll
                    for (int n = 0; n < 2; ++n) { f32x4 x = acc[ai][bj][m][n]; x[0] = __expf(x[0] - gm); x[1] = __expf(x[1] - gm); x[2] = __expf(x[2] - gm); x[3] = __expf(x[3] - gm);
                        acc[ai][bj][m][n] = x; sum += (x[0] + x[1]) + (x[2] + x[3]); }
                sum += __shfl_xor(sum, 16); sum += __shfl_xor(sum, 32);
                if (fq == 0) PS[row * 4 + wc] = sum; }
        asm volatile("s_waitcnt lgkmcnt(0)" ::: "memory"); __builtin_amdgcn_s_barrier(); asm volatile("" ::: "memory");
#pragma unroll
        for (int ai = 0; ai < 2; ++ai)
#pragma unroll
            for (int m = 0; m < 4; ++m) { const int row = ai * HALF + wr * 64 + m * 16 + fr; const f32x4 s4 = *(const PG8_LAS f32x4*)(PS + row * 4);
                const float inv = 1.0f / ((s4[0] + s4[1]) + (s4[2] + s4[3])); bf16_t* rowp = Pout + ((size_t)u.pm * 256 + row) * 256 + wc * 32 + 8 * fq;
#pragma unroll
                for (int bj = 0; bj < 2; ++bj) *(u32x4*)(rowp + bj * HALF) = pack8(acc[ai][bj][m][0] * inv, acc[ai][bj][m][1] * inv); }
        asm volatile("s_waitcnt lgkmcnt(0)" ::: "memory"); __builtin_amdgcn_s_barrier(); asm volatile("" ::: "memory");
    }
};
template <int KIND> struct DEpiLora {
    static constexpr bool PERM = true, AFTER_DRAIN = false; const float* bsrc0; bf16_t* O;
    __device__ __forceinline__ static f32x4 act4(f32x4 x) {
        f32x4 o;
#pragma unroll
        for (int i = 0; i < 4; ++i) {
            if (KIND == 0) { const float y = -x[i]; const float sp = fmaxf(y, 0.f) + __logf(1.0f + __expf(-fabsf(y))); const float ew = __expf(-sp - 0.5f); o[i] = 1.0f - __expf(-ew); }
            else if (KIND == 1) o[i] = __builtin_amdgcn_rcpf(1.0f + __expf(-x[i]));
            else o[i] = x[i]; }
        return o;
    }
    __device__ __forceinline__ void operator()(const f32x4 (&acc)[2][2][4][2], const Unit& u, int wr, int wc, int fr, int fq) const {
        const int row0 = u.pm * BM + wr * 64 + fr; const int z = (KIND == 2) ? 0 : (u.pn >> 1); const int cb = ((KIND == 2) ? u.pn : (u.pn & 1)) * 256 + wc * 32 + 8 * fq;
        f32x4 bv[2][2];
#pragma unroll
        for (int bj = 0; bj < 2; ++bj)
#pragma unroll
            for (int n = 0; n < 2; ++n) bv[bj][n] = (KIND == 2) ? (f32x4){0.f, 0.f, 0.f, 0.f} : *(const f32x4*)(bsrc0 + z * 512 + cb + bj * HALF + 4 * n);
#pragma unroll
        for (int ai = 0; ai < 2; ++ai)
#pragma unroll
            for (int m = 0; m < 4; ++m) { const size_t row = (size_t)(row0 + ai * HALF + m * 16);
                bf16_t* dst = (KIND == 2) ? (O + row * 512 + cb) : (O + (row * 2 + z) * 512 + cb);
#pragma unroll
                for (int bj = 0; bj < 2; ++bj) *(u32x4*)(dst + bj * HALF) = pack8(act4(acc[ai][bj][m][0] + bv[bj][0]), act4(acc[ai][bj][m][1] + bv[bj][1])); }
    }
};
}
#define LAS __attribute__((address_space(3)))
#define XB_TMO      128
#define XB_XCNT(j)  (256  + 64 * (j))
#define XB_XSUB(j)  (1280 + 64 * (j))
#define XB_XGEN(j)  (2304 + 64 * (j))
#define XB_TOP      3328
#define XB_TOPGEN   3392
#define XCD_BAR_WORDS 3456
#define XB_SPIN_CAP (1u << 18)

__device__ __forceinline__ unsigned xb_ld(unsigned* p)              { return __hip_atomic_load(p, __ATOMIC_RELAXED, __HIP_MEMORY_SCOPE_AGENT); }
__device__ __forceinline__ unsigned xb_add(unsigned* p, unsigned v) { return __hip_atomic_fetch_add(p, v, __ATOMIC_RELAXED, __HIP_MEMORY_SCOPE_AGENT); }
__device__ __forceinline__ unsigned xb_xcc_id() { return (unsigned)__builtin_amdgcn_s_getreg((3 << 11) | 20) & 0xFu; }
#define XB_SPIN(cond, bar) do { unsigned _sp = 0; while (cond) { __builtin_amdgcn_s_sleep(1); \
    if ((++_sp & 255u) == 0u) { if (xb_ld(&(bar)[XB_TMO])) break; if (_sp > XB_SPIN_CAP) { atomicAdd(&(bar)[XB_TMO], 1u); break; } } } } while (0)

struct XcdBarrier {
    unsigned* bar; unsigned x;
    volatile LAS unsigned* st;
};

__device__ __forceinline__ XcdBarrier xcd_barrier_post(unsigned* bar, volatile LAS unsigned* st) {
    XcdBarrier b; b.bar = bar; b.x = xb_xcc_id(); b.st = st;
    if (threadIdx.x == 0) (void)xb_add(&bar[XB_XCNT(b.x)], 1u);
    return b;
}
__device__ __forceinline__ void xcd_barrier_complete(unsigned* bar, unsigned x, unsigned& nloc, unsigned& nx) {
    const unsigned G = gridDim.x * gridDim.y * gridDim.z;
    unsigned sum, cnt, mine, sp = 0u;
    for (;;) {
        sum = 0u; cnt = 0u; mine = 0u;
#pragma unroll
        for (unsigned j = 0; j < 16; ++j) { const unsigned c = xb_ld(&bar[XB_XCNT(j)]); sum += c; cnt += (c > 0u) ? 1u : 0u; mine = (j == x) ? c : mine; }
        if (sum == G) break;
        __builtin_amdgcn_s_sleep(1);
        if ((++sp & 255u) == 0u) { if (xb_ld(&bar[XB_TMO])) break; if (sp > XB_SPIN_CAP) { atomicAdd(&bar[XB_TMO], 1u); break; } }
    }
    nloc = mine > 0u ? mine : 1u; nx = cnt > 0u ? cnt : 1u;
}

__device__ __forceinline__ void xcd_barrier(const XcdBarrier& b) {
    asm volatile("s_waitcnt vmcnt(0)" ::: "memory");
    __syncthreads();
    if (threadIdx.x == 0) {
        unsigned* bar = b.bar;
        __builtin_amdgcn_s_waitcnt(0);
        unsigned nloc = b.st[0], nx = b.st[1];
        if (nloc == 0u) { xcd_barrier_complete(bar, b.x, nloc, nx); b.st[0] = nloc; b.st[1] = nx; }
        const unsigned old = xb_add(&bar[XB_XSUB(b.x)], 1u);
        const unsigned gen = old / nloc;
        if (old + 1u == (gen + 1u) * nloc) {
            __builtin_amdgcn_fence(__ATOMIC_RELEASE, "agent");
            asm volatile("s_waitcnt vmcnt(0)" ::: "memory");
            const unsigned og = xb_add(&bar[XB_TOP], 1u);
            const unsigned tg = og / nx;
            if (og + 1u == (tg + 1u) * nx) xb_add(&bar[XB_TOPGEN], 1u);
            else XB_SPIN(xb_ld(&bar[XB_TOPGEN]) == tg, bar);
            __builtin_amdgcn_fence(__ATOMIC_ACQUIRE, "agent");
            xb_add(&bar[XB_XGEN(b.x)], 1u);
            asm volatile("s_waitcnt vmcnt(0)" ::: "memory");
        } else {
            XB_SPIN(xb_ld(&bar[XB_XGEN(b.x)]) == gen, bar);
            __builtin_amdgcn_fence(__ATOMIC_ACQUIRE, "agent");
            asm volatile("s_waitcnt vmcnt(0)" ::: "memory");
        }
    }
    __syncthreads();
}

#endif

#ifdef HOST_EMU
template <class F> static void emu_gemm(const bf16_t* A, const bf16_t* Bt, int M, int N, int K, F f) {
#pragma omp parallel for schedule(static)
    for (int r = 0; r < M; ++r)
        for (int c = 0; c < N; ++c) { float a = 0.f; for (int k = 0; k < K; ++k) a += bf2f(A[(size_t)r * K + k]) * bf2f(Bt[(size_t)c * K + k]); f(r, c, a); }
}
#endif

#define GS_LOOP(idx, n) for (long idx = gtid; idx < (long)(n); idx += nthr)

__device__ __forceinline__ int win_src_col(int n) {
    if (n < 1920) return n;
    if (n < 2048) return -1;
    if (n < 3072) return 1920 + (n - 2048);
    const int m = n - 3072, j = m / 256, i = m % 256;
    return (i < 128) ? (2944 + 128 * j + i) : (2944 + 1024 + 128 * j + (i - 128));
}
__device__ __forceinline__ void ph0_weights(const Params& P, long gtid, long nthr) {
    GS_LOOP(idx, (size_t)5120 * 1024) { const int n = (int)(idx / 1024), k = (int)(idx % 1024); const int c = win_src_col(n);
        P.W_IN_T[idx] = (c < 0) ? (bf16_t)0 : f2bf(P.in[I_W_IN][(size_t)k * IN_COLS + c]); }
    GS_LOOP(idx, (size_t)2048 * 512) { const int n = (int)(idx / 512), k = (int)(idx % 512); const int br = n / 1024, nn = n % 1024;
        P.W_BR_T[idx] = f2bf(P.in[I_W_BRANCH][((size_t)br * 512 + k) * 1024 + nn]); }
    GS_LOOP(idx, (size_t)1024 * 1024) { const int n = (int)(idx / 1024), k = (int)(idx % 1024);
        P.W_MIX_T[idx] = f2bf(P.in[I_W_MIX][(size_t)k * 1024 + n]);
        P.W_Q_T[idx] = f2bf(P.in[I_W_Q][(size_t)k * 1024 + n]);
        P.W_O_T[idx] = f2bf(P.in[I_W_O][(size_t)k * 1024 + n]); }
    GS_LOOP(idx, (size_t)2048 * 1024) { const int n = (int)(idx / 1024), k = (int)(idx % 1024);
        P.W_KV_T[idx] = f2bf(P.in[I_W_KV][(size_t)k * 2048 + n]);
        P.W_QUERY_T[idx] = f2bf(P.in[I_W_QUERY][(size_t)k * 2048 + n]); }
}
__device__ __forceinline__ void ln_rows_bf16(const float* in, const float* g, const float* b, bf16_t* out, int rows, int width, long gtid, long nthr) {
    GS_LOOP(row, rows) { const float* x = in + (size_t)row * width; float s = 0.f;
        for (int i = 0; i < width; ++i) s += x[i];
        const float mu = s / width; float q = 0.f;
        for (int i = 0; i < width; ++i) { const float d = x[i] - mu; q += d * d; }
        const float rs = 1.0f / sqrtf(q / width + 1e-5f); bf16_t* o = out + (size_t)row * width;
        for (int i = 0; i < width; ++i) o[i] = f2bf((x[i] - mu) * rs * g[i] + b[i]); }
}
__device__ __forceinline__ void ph2a_vn(const Params& P, long gtid, long nthr) {
    GS_LOOP(row, TOK) { const bf16_t* x = P.PB + (size_t)row * 1024 + 512; float s = 0.f;
        for (int i = 0; i < 512; ++i) s += bf2f(x[i]);
        const float mu = s / 512.f; float q = 0.f;
        for (int i = 0; i < 512; ++i) { const float d = bf2f(x[i]) - mu; q += d * d; }
        const float rs = 1.0f / sqrtf(q / 512.f + 1e-5f); bf16_t* o = P.VN + (size_t)row * 512;
        for (int i = 0; i < 512; ++i) o[i] = f2bf((bf2f(x[i]) - mu) * rs * P.in[I_GLN_G][i] + P.in[I_GLN_B][i]); }
}
__device__ __forceinline__ void ph2b_gmlp(const Params& P, long gtid, long nthr) {
    GS_LOOP(idx, (size_t)TOK * 512) { const int c = (int)(idx % 512); const long t = idx / 512; const int g = c / 64; const long ch = t / 128; const int p = (int)(t % 128);
        const float* ws = P.in[I_W_S] + ((size_t)g * 128 + p) * 128; float s = 0.f;
        for (int q = 0; q < 128; ++q) s += ws[q] * bf2f(P.VN[(size_t)(ch * 128 + q) * 512 + c]);
        s += P.in[I_B_S][g * 128 + p];
        P.YB[idx] = f2bf(bf2f(P.PB[(size_t)t * 1024 + c]) * s); }
}
__device__ __forceinline__ float pa_shift(const Params& P, long t, int c) {
    const int s = (int)(t % SEQ); const float cur = bf2f(P.PA[(size_t)t * 2048 + c]);
    const float prev = (s > 0) ? bf2f(P.PA[(size_t)(t - 1) * 2048 + c]) : 0.f;
    const float nxt = (s < SEQ - 1) ? bf2f(P.PA[(size_t)(t + 1) * 2048 + c]) : 0.f;
    return cur + P.in[I_MU][c] * (0.5f * (prev + nxt) - cur);
}
__device__ __forceinline__ void ph3a_lora_in(const Params& P, long gtid, long nthr) {
    GS_LOOP(idx, (size_t)TOK * 128) { const int r = (int)(idx % 128); const long t = idx / 128;
        P.WDS[idx] = f2bf(tanhf(pa_shift(P, t, 1536 + r)));
        P.ADS[idx] = f2bf(pa_shift(P, t, 1664 + r));
        P.SG[idx] = f2bf(sigmoidf_(pa_shift(P, t, 1792 + r))); }
}
__device__ __forceinline__ void ph3b_prep(const Params& P, long gtid, long nthr) {
    GS_LOOP(idx, (size_t)TOK * 8) { const int h = (int)(idx % 8); const long t = idx / 8; const int hb = h * 64;
        float ss = 0.f;
        for (int j = 0; j < 64; ++j) { const float v = pa_shift(P, t, 512 + hb + j) * P.in[I_K_K][hb + j]; ss += v * v; }
        const float inv = 1.0f / fmaxf(sqrtf(ss), 1e-12f);
        for (int j = 0; j < 64; ++j) { const int c = hb + j;
            const float k = pa_shift(P, t, 512 + c); const float kk = k * P.in[I_K_K][c] * inv;
            P.R[(size_t)t * 512 + c] = f2bf(pa_shift(P, t, c));
            P.V[(size_t)t * 512 + c] = f2bf(pa_shift(P, t, 1024 + c));
            P.KK[(size_t)t * 512 + c] = f2bf(kk);
            for (int z = 0; z < 2; ++z) {
                float sw = P.in[I_W0][z * 512 + c], sa = P.in[I_A0][z * 512 + c];
                for (int r = 0; r < 64; ++r) { sw += bf2f(P.WDS[(size_t)t * 128 + z * 64 + r]) * P.in[I_W2][((size_t)z * 64 + r) * 512 + c];
                                               sa += bf2f(P.ADS[(size_t)t * 128 + z * 64 + r]) * P.in[I_A2][((size_t)z * 64 + r) * 512 + c]; }
                const float y = -sw; const float sp = fmaxf(y, 0.f) + log1pf(expf(-fabsf(y))); const float wlog = -sp - 0.5f;
                const float ew = expf(wlog);
                const float a = sigmoidf_(sa); const size_t o = ((size_t)t * 2 + z) * 512 + c;
                P.OMW[o] = f2bf(-expm1f(-ew));
                P.KDIR[o] = f2bf(k * (1.0f + (a - 1.0f) * P.in[I_K_A][c]));
                P.BVEC[o] = f2bf(kk * a); } } }
}
__device__ __forceinline__ void scan_item(const Params& P, int chain, int i) {
    const int h = chain % 8, b = (chain / 8) % BATCH, z = chain / (8 * BATCH);
    float S[64];
#pragma unroll
    for (int j = 0; j < 64; ++j) S[j] = 0.f;
    for (int n = 0; n < SEQ; ++n) {
        const long t = (long)b * SEQ + ((z == 0) ? n : (SEQ - 1 - n));
        const bf16_t* r = P.R + (size_t)t * 512 + h * 64; const bf16_t* a = P.KK + (size_t)t * 512 + h * 64;
        const bf16_t* w = P.OMW + ((size_t)t * 2 + z) * 512 + h * 64; const bf16_t* k = P.KDIR + ((size_t)t * 2 + z) * 512 + h * 64;
        const bf16_t* bv = P.BVEC + ((size_t)t * 2 + z) * 512 + h * 64;
        const float v = bf2f(P.V[(size_t)t * 512 + h * 64 + i]);
        float sa = 0.f;
#pragma unroll
        for (int j = 0; j < 64; ++j) sa -= S[j] * bf2f(a[j]);
        float y = 0.f;
#pragma unroll
        for (int j = 0; j < 64; ++j) { S[j] = S[j] * (1.0f - bf2f(w[j])) + sa * bf2f(bv[j]) + v * bf2f(k[j]); y += S[j] * bf2f(r[j]); }
        P.Y01[((size_t)z * TOK + t) * 512 + h * 64 + i] = y;
    }
}
__device__ __forceinline__ void ph5_rwkv_out(const Params& P, long gtid, long nthr) {
    GS_LOOP(idx, (size_t)TOK * 512) { const int c = (int)(idx % 512); const long t = idx / 512; const int hb = (c / 64) * 64;
        const float* y0 = P.Y01 + (size_t)t * 512 + hb; const float* y1 = P.Y01 + ((size_t)TOK + t) * 512 + hb;
        float s = 0.f;
        for (int j = 0; j < 64; ++j) s += y0[j] + y1[j];
        const float mu = s / 64.f; float q = 0.f;
        for (int j = 0; j < 64; ++j) { const float d = y0[j] + y1[j] - mu; q += d * d; }
        const float rs = 1.0f / sqrtf(q / 64.f + 64e-5f);
        const float yn = (y0[c - hb] + y1[c - hb] - mu) * rs * P.in[I_GN_G][c] + P.in[I_GN_B][c];
        float rk = 0.f;
        for (int z = 0; z < 2; ++z)
            for (int j = 0; j < 64; ++j) rk += bf2f(P.R[(size_t)t * 512 + hb + j]) * bf2f(P.KDIR[((size_t)t * 2 + z) * 512 + hb + j]) * P.in[I_R_K][hb + j];
        float g = 0.f;
        for (int r = 0; r < 128; ++r) g += bf2f(P.SG[(size_t)t * 128 + r]) * P.in[I_G2][(size_t)r * 512 + c];
        P.YA[idx] = f2bf((yn + rk * bf2f(P.V[(size_t)t * 512 + c])) * g); }
}
__device__ __forceinline__ void ph_ln_z(const Params& P, const float* g, const float* b, long gtid, long nthr) { ln_rows_bf16(P.Z, g, b, P.HB, TOK, 1024, gtid, nthr); }
__device__ __forceinline__ void ph10a_scores(const Params& P, long gtid, long nthr) {
    GS_LOOP(idx, (size_t)TOK * 4 * 256) { const int m = (int)(idx % 256); const long rowi = idx / 256; const int s = (int)(rowi % SEQ); const int bh = (int)(rowi / SEQ); const int b = bh / 4, h = bh % 4;
        const bf16_t* q = P.Q + ((size_t)b * SEQ + s) * 1024 + h * 256; const bf16_t* k = P.KV + ((size_t)b * 256 + m) * 2048 + h * 256; float a = 0.f;
        for (int d = 0; d < 256; ++d) a += bf2f(q[d]) * bf2f(k[d]);
        P.SCA[idx] = a * 0.0625f; }
}
__device__ __forceinline__ void ph10b_softmax(const Params& P, long gtid, long nthr) {
    GS_LOOP(row, (size_t)TOK * 4) { float* x = P.SCA + (size_t)row * 256; float mx = x[0];
        for (int i = 1; i < 256; ++i) mx = fmaxf(mx, x[i]);
        float s = 0.f;
        for (int i = 0; i < 256; ++i) s += expf(x[i] - mx);
        const float inv = 1.0f / s;
        for (int i = 0; i < 256; ++i) x[i] = expf(x[i] - mx) * inv; }
}
__device__ __forceinline__ void ph10c_out(const Params& P, long gtid, long nthr) {
    GS_LOOP(idx, (size_t)TOK * 1024) { const int c = (int)(idx % 1024); const long t = idx / 1024; const int b = (int)(t / SEQ), s = (int)(t % SEQ), h = c / 256;
        const float* pr = P.SCA + (((size_t)b * 4 + h) * SEQ + s) * 256; float a = 0.f;
        for (int m = 0; m < 256; ++m) a += pr[m] * bf2f(P.KV[((size_t)b * 256 + m) * 2048 + 1024 + c]);
        P.O[idx] = f2bf(a); }
}
__device__ __forceinline__ void ph13a_scores(const Params& P, long gtid, long nthr) {
    GS_LOOP(idx, (size_t)TOK * 2048) { const int k = (int)(idx % 128), z = (int)((idx / 128) % 2), h = (int)((idx / 256) % 8); const long t = idx / 2048;
        const bf16_t* q = P.QP + (size_t)t * 2048 + h * 256 + z * 128; const float* kr = P.in[I_SUBKEYS] + ((size_t)z * 128 + k) * 128; float a = 0.f;
        for (int c = 0; c < 128; ++c) a += bf2f(q[c]) * kr[c];
        P.SC[idx] = a; }
}
__device__ __forceinline__ void ph13b_topk(const Params& P, long gtid, long nthr) {
    GS_LOOP(row, (size_t)TOK * 16) { const float* x = P.SC + (size_t)row * 128; float pv = 0.f; int pi = -1;
        for (int j = 0; j < 16; ++j) { float best = 0.f; int bi = -1;
            for (int i = 0; i < 128; ++i) { const float v = x[i]; const bool elig = (j == 0) || (v < pv) || (v == pv && i > pi);
                if (elig && (bi < 0 || v > best)) { best = v; bi = i; } }
            P.TOPS[(size_t)row * 16 + j] = best; P.TOPI[(size_t)row * 16 + j] = bi; pv = best; pi = bi; } }
}
__device__ __forceinline__ void ph13c_cand(const Params& P, long gtid, long nthr) {
    GS_LOOP(row, (size_t)TOK * 8) { const float* s0 = P.TOPS + (size_t)row * 32; const float* s1 = s0 + 16; const int* i0 = P.TOPI + (size_t)row * 32; const int* i1 = i0 + 16;
        float pv = 0.f; int pi = -1; float mx = 0.f;
        for (int j = 0; j < 16; ++j) { float best = 0.f; int bi = -1;
            for (int c = 0; c < 256; ++c) { const float v = s0[c / 16] + s1[c % 16]; const bool elig = (j == 0) || (v < pv) || (v == pv && c > pi);
                if (elig && (bi < 0 || v > best)) { best = v; bi = c; } }
            if (j == 0) mx = best;
            P.GATE[(size_t)row * 16 + j] = best; P.EXPERT[(size_t)row * 16 + j] = i0[bi / 16] * 128 + i1[bi % 16]; pv = best; pi = bi; }
        float s = 0.f;
        for (int j = 0; j < 16; ++j) s += expf(P.GATE[(size_t)row * 16 + j] - mx);
        const float inv = 1.0f / s;
        for (int j = 0; j < 16; ++j) P.GATE[(size_t)row * 16 + j] = expf(P.GATE[(size_t)row * 16 + j] - mx) * inv; }
}
__device__ __forceinline__ void ph14a_act(const Params& P, long gtid, long nthr) {
    GS_LOOP(idx, (size_t)TOK * 128) { const long t = idx / 128; const bf16_t* x = P.HB + (size_t)t * 1024; const float* ur = P.in[I_PEER_U] + (size_t)P.EXPERT[idx] * 1024; float a = 0.f;
        for (int d = 0; d < 1024; ++d) a += ur[d] * bf2f(x[d]);
        P.COEF[idx] = P.GATE[idx] * geluf_(a); }
}
__device__ __forceinline__ void ph14b_out(const Params& P, long gtid, long nthr) {
    GS_LOOP(idx, (size_t)TOK * 1024) { const int d = (int)(idx % 1024); const long t = idx / 1024; float a = 0.f;
        for (int j = 0; j < 128; ++j) a += P.COEF[(size_t)t * 128 + j] * P.in[I_PEER_V][(size_t)P.EXPERT[(size_t)t * 128 + j] * 1024 + d];
        P.Y[idx] = a; }
}
__device__ __forceinline__ void ph14c_final(const Params& P, long gtid, long nthr) {
    GS_LOOP(row, TOK) { const bf16_t* hr = P.HB + (size_t)row * 1024; const float* yr = P.Y + (size_t)row * 1024; float s = 0.f;
        for (int i = 0; i < 1024; ++i) s += ALPHA_F * bf2f(hr[i]) + yr[i];
        const float mu = s / 1024.f; float q = 0.f;
        for (int i = 0; i < 1024; ++i) { const float d = ALPHA_F * bf2f(hr[i]) + yr[i] - mu; q += d * d; }
        const float rs = 1.0f / sqrtf(q / 1024.f + 1e-5f); float* o = P.out + (size_t)row * 1024;
        for (int i = 0; i < 1024; ++i) o[i] = (ALPHA_F * bf2f(hr[i]) + yr[i] - mu) * rs * P.in[I_LN3_G][i] + P.in[I_LN3_B][i]; }
}

static void make_params(Params& P, void* const* d_in, void* d_out, void* d_ws) {
    memset(&P, 0, sizeof(P));
    for (int i = 0; i < 37; ++i) P.in[i] = (const float*)d_in[i];
    P.out = (float*)d_out; unsigned char* ws = (unsigned char*)d_ws; unsigned char* ob = (unsigned char*)d_out;
    unsigned char* r1 = ws + A_R1; unsigned char* r2 = ws + A_R2;
    P.ctl = (unsigned*)(ws + WS_CTL);
    P.W_IN_T = (bf16_t*)(ws + WS_W + OFF_W_IN); P.W_BR_T = (bf16_t*)(ws + WS_W + OFF_W_BR); P.W_MIX_T = (bf16_t*)(ws + WS_W + OFF_W_MIX);
    P.W_Q_T = (bf16_t*)(ws + WS_W + OFF_W_Q); P.W_KV_T = (bf16_t*)(ws + WS_W + OFF_W_KV); P.W_O_T = (bf16_t*)(ws + WS_W + OFF_W_O); P.W_QUERY_T = (bf16_t*)(ws + WS_W + OFF_W_QUERY);
    P.KV = (bf16_t*)(ws + WS_KV); P.MEMN = (bf16_t*)(ws + WS_MEMN); P.HB = (bf16_t*)(ws + A_HB);
    P.PA = (bf16_t*)r1; P.PB = (bf16_t*)r2; P.VN = (bf16_t*)(r2 + 2 * TU);
    P.YB = (bf16_t*)ob; P.WDS = (bf16_t*)(ob + TU); P.ADS = (bf16_t*)(ob + TU + TU / 4); P.SG = (bf16_t*)(ob + TU + TU / 2);
    P.R = (bf16_t*)(ob + 2 * TU); P.KK = (bf16_t*)(ob + 3 * TU);
    P.V = (bf16_t*)r2; P.OMW = (bf16_t*)(r2 + TU); P.KDIR = (bf16_t*)(r2 + 3 * TU); P.BVEC = (bf16_t*)(r2 + 5 * TU);
    P.Y01 = (float*)r1; P.YA = (bf16_t*)(r2 + TU); P.BR = (bf16_t*)r1; P.MG = (bf16_t*)r2; P.Z = (float*)ob;
    P.Q = (bf16_t*)r1; P.O = (bf16_t*)(r1 + 2 * TU); P.SCA = (float*)r2; P.QP = (bf16_t*)ob;
    P.SC = (float*)r1; P.TOPS = (float*)(r2 + 4 * TU); P.TOPI = (int*)(r2 + 5 * TU); P.GATE = (float*)(r2 + 6 * TU); P.EXPERT = (int*)(r2 + 6 * TU + TU / 2);
    P.COEF = (float*)(r2 + 7 * TU); P.Y = (float*)r1;
    P.UB = (bf16_t*)r1; P.VB = (bf16_t*)(r1 + (size_t)16384 * 1024 * 2);
    P.U8 = r1; P.V8 = r1 + (size_t)16384 * 1024; P.SU = (float*)(r1 + (size_t)2 * 16384 * 1024); P.SV = P.SU + 16384;
    P.W_LORA_T = (bf16_t*)(ws + WS_W + OFF_W_LORA); P.WSB = (bf16_t*)(ws + WS_W + OFF_WSB);
    P.LIN = (bf16_t*)(ob + TU); P.V = (bf16_t*)(r2 + 2 * TU); P.K = (bf16_t*)(r2 + 3 * TU); P.OMW = (bf16_t*)r2; P.AL = (bf16_t*)(r2 + 4 * TU); P.G = (bf16_t*)(r2 + 6 * TU);
    P.YA = (bf16_t*)r2;
    P.KH = (bf16_t*)(ws + WS_KV); P.VT = (bf16_t*)(ws + WS_KV + 4 * MiB); P.QH = (bf16_t*)r1; P.PP = (bf16_t*)r2;
    P.GATE = (float*)(r2 + 6 * TU); P.EXPERT = (int*)(r2 + 6 * TU + TU / 2);
}

#ifndef NEW_PEER
#define NEW_PEER 1
#endif
#ifndef USE_DOT2
#define USE_DOT2 0
#endif
#ifndef ATT_OLD
#define ATT_OLD 0
#endif
#ifndef NEW_SCAN
#define NEW_SCAN 1
#endif
#ifndef NEW_ROUTE
#define NEW_ROUTE 1
#endif
#ifndef PEER_FP8
#define PEER_FP8 1
#endif
#define AX (ATT_OLD ? 1 : 0)
#define N_PHASES ((NEW_ROUTE ? 20 : 23) + AX)
__device__ __forceinline__ void run_simt_phase(const Params& P, int ph, long gtid, long nthr) {
    switch (ph) {
    case 0: ph0_weights(P, gtid, nthr);
            ln_rows_bf16(P.in[I_X], P.in[I_LN_EMB_G], P.in[I_LN_EMB_B], P.HB, TOK, 1024, gtid, nthr);
            ln_rows_bf16(P.in[I_MEM], P.in[I_MLN_G], P.in[I_MLN_B], P.MEMN, BATCH * MEM_LEN, 1024, gtid, nthr); break;
    case 2: ph2a_vn(P, gtid, nthr); break;
    case 3: ph2b_gmlp(P, gtid, nthr); break;
    case 4: ph3a_lora_in(P, gtid, nthr); break;
    case 5: ph3b_prep(P, gtid, nthr); break;
    case 7: ph5_rwkv_out(P, gtid, nthr); break;
    case 11: ph_ln_z(P, P.in[I_LN1_G], P.in[I_LN1_B], gtid, nthr); break;
    case 13: ph10a_scores(P, gtid, nthr); break;
    case 14: ph10b_softmax(P, gtid, nthr); break;
    case 15: ph10c_out(P, gtid, nthr); break;
    case 17: ph_ln_z(P, P.in[I_LN2_G], P.in[I_LN2_B], gtid, nthr); break;
    case 19: ph13a_scores(P, gtid, nthr); break;
    case 20: ph13b_topk(P, gtid, nthr); break;
    case 21: ph13c_cand(P, gtid, nthr); break;
    case 22: ph14a_act(P, gtid, nthr); break;
    case 23: ph14b_out(P, gtid, nthr); break;
    case 24: ph14c_final(P, gtid, nthr); break;
    default: break;
    }
}

#ifdef HOST_EMU
static void emu_run(const Params& P) {
    for (int ph = 0; ph < N_PHASES; ++ph) {
        switch (ph) {
        case 1:
            emu_gemm(P.HB, P.W_IN_T, TOK, 3072, 1024, [&](int r, int c, float a) { if (c < 2048) P.PA[(size_t)r * 2048 + c] = f2bf(a); else P.PB[(size_t)r * 1024 + c - 2048] = f2bf(geluf_(a)); });
            emu_gemm(P.MEMN, P.W_KV_T, BATCH * MEM_LEN, 2048, 1024, [&](int r, int c, float a) { P.KV[(size_t)r * 2048 + c] = f2bf(a); });
            break;
        case 6:
#pragma omp parallel for schedule(dynamic, 1)
            for (int it = 0; it < 2 * BATCH * 8 * 64; ++it) scan_item(P, it / 64, it % 64);
            break;
        case 8:
            emu_gemm(P.YA, P.W_BR_T, TOK, 1024, 512, [&](int r, int c, float a) { P.BR[(size_t)r * 2048 + c] = f2bf(a); });
            emu_gemm(P.YB, P.W_BR_T + (size_t)1024 * 512, TOK, 1024, 512, [&](int r, int c, float a) { P.BR[(size_t)r * 2048 + 1024 + c] = f2bf(a); });
            break;
        case 9: {
            float* tmp = (float*)malloc((size_t)TOK * 2048 * 4);
            emu_gemm(P.HB, P.W_IN_T + (size_t)3072 * 1024, TOK, 2048, 1024, [&](int r, int c, float a) { tmp[(size_t)r * 2048 + c] = a; });
            for (int r = 0; r < TOK; ++r) for (int n = 0; n < 1024; ++n) { const int j = n / 128, i = n % 128;
                const float g0 = tmp[(size_t)r * 2048 + 256 * j + i], g1 = tmp[(size_t)r * 2048 + 256 * j + 128 + i];
                P.MG[(size_t)r * 1024 + n] = f2bf(sigmoidf_(g0) * bf2f(P.BR[(size_t)r * 2048 + n]) + sigmoidf_(g1) * bf2f(P.BR[(size_t)r * 2048 + 1024 + n])); }
            free(tmp); } break;
        case 10: emu_gemm(P.MG, P.W_MIX_T, TOK, 1024, 1024, [&](int r, int c, float a) { P.Z[(size_t)r * 1024 + c] = ALPHA_F * bf2f(P.HB[(size_t)r * 1024 + c]) + a; }); break;
        case 12: emu_gemm(P.HB, P.W_Q_T, TOK, 1024, 1024, [&](int r, int c, float a) { P.Q[(size_t)r * 1024 + c] = f2bf(a); }); break;
        case 16: emu_gemm(P.O, P.W_O_T, TOK, 1024, 1024, [&](int r, int c, float a) { P.Z[(size_t)r * 1024 + c] = ALPHA_F * bf2f(P.HB[(size_t)r * 1024 + c]) + a; }); break;
        case 18: emu_gemm(P.HB, P.W_QUERY_T, TOK, 2048, 1024, [&](int r, int c, float a) { P.QP[(size_t)r * 2048 + c] = f2bf(a); }); break;
        default: {
            const long NT = 64;
#pragma omp parallel for schedule(static, 1)
            for (long g = 0; g < NT; ++g) run_simt_phase(P, ph, g, NT);
        } break;
        }
    }
}
extern "C" void kernel_launch(void* const* d_in, const int* in_sizes, int n_in, void* d_out, int out_size, void* d_ws, size_t ws_size, hipStream_t stream) {
    Params P; make_params(P, d_in, d_out, d_ws);
    memset(d_ws, 0, 1 << 20);
    emu_run(P);
}
#else

typedef float f32x4 __attribute__((ext_vector_type(4)));
typedef unsigned u32x4 __attribute__((ext_vector_type(4)));
typedef unsigned u32x2 __attribute__((ext_vector_type(2)));
typedef __bf16 bf16x2_t __attribute__((ext_vector_type(2)));
__device__ __forceinline__ float wave_sum(float v) {
#pragma unroll
    for (int o = 1; o < 64; o <<= 1) v += __shfl_xor(v, o);
    return v;
}
__device__ __forceinline__ float wave_max(float v) {
#pragma unroll
    for (int o = 1; o < 64; o <<= 1) v = fmaxf(v, __shfl_xor(v, o));
    return v;
}
__device__ __forceinline__ unsigned pk2(float lo, float hi) { return (unsigned)f2bf(lo) | ((unsigned)f2bf(hi) << 16); }
__device__ __forceinline__ float blo(unsigned w) { return __uint_as_float(w << 16); }
__device__ __forceinline__ float bhi(unsigned w) { return __uint_as_float(w & 0xffff0000u); }
__device__ __forceinline__ void wln_f32_bf16(const float* xrow, const float* g, const float* b, bf16_t* orow, int lane) {
    const f32x4* xr = (const f32x4*)xrow + lane; f32x4 v[4]; float s = 0.f;
#pragma unroll
    for (int j = 0; j < 4; ++j) { v[j] = xr[64 * j]; s += (v[j][0] + v[j][1]) + (v[j][2] + v[j][3]); }
    const float mean = wave_sum(s) * (1.f / 1024.f); float s2 = 0.f;
#pragma unroll
    for (int j = 0; j < 4; ++j) { v[j] = v[j] - mean; s2 += (v[j][0] * v[j][0] + v[j][1] * v[j][1]) + (v[j][2] * v[j][2] + v[j][3] * v[j][3]); }
    const float rstd = 1.f / sqrtf(wave_sum(s2) * (1.f / 1024.f) + 1e-5f);
#pragma unroll
    for (int j = 0; j < 4; ++j) { const f32x4 gg = ((const f32x4*)g)[64 * j + lane], bb = ((const f32x4*)b)[64 * j + lane]; const f32x4 o = v[j] * rstd * gg + bb;
        u32x2 w; w.x = pk2(o[0], o[1]); w.y = pk2(o[2], o[3]); *((u32x2*)orow + 64 * j + lane) = w; }
}
__device__ __forceinline__ void d_ln_rows(const float* in, const float* g, const float* b, bf16_t* out, int rows, int gw, int ngw, int lane) {
    for (int m = gw; m < rows; m += ngw) wln_f32_bf16(in + (size_t)m * 1024, g, b, out + (size_t)m * 1024, lane);
}
__device__ __forceinline__ void d_vn(const Params& P, int gw, int ngw, int lane) {
    const f32x4 g0 = ((const f32x4*)P.in[I_GLN_G])[2 * lane], g1 = ((const f32x4*)P.in[I_GLN_G])[2 * lane + 1];
    const f32x4 b0 = ((const f32x4*)P.in[I_GLN_B])[2 * lane], b1 = ((const f32x4*)P.in[I_GLN_B])[2 * lane + 1];
    for (int m = gw; m < TOK; m += ngw) {
        const u32x4 w = *((const u32x4*)(P.PB + (size_t)m * 1024 + 512) + lane);
        float x[8] = {blo(w.x), bhi(w.x), blo(w.y), bhi(w.y), blo(w.z), bhi(w.z), blo(w.w), bhi(w.w)};
        float s = 0.f;
#pragma unroll
        for (int i = 0; i < 8; ++i) s += x[i];
        const float mean = wave_sum(s) * (1.f / 512.f); float s2 = 0.f;
#pragma unroll
        for (int i = 0; i < 8; ++i) { x[i] -= mean; s2 += x[i] * x[i]; }
        const float rstd = 1.f / sqrtf(wave_sum(s2) * (1.f / 512.f) + 1e-5f);
        u32x4 o; o.x = pk2(x[0] * rstd * g0[0] + b0[0], x[1] * rstd * g0[1] + b0[1]); o.y = pk2(x[2] * rstd * g0[2] + b0[2], x[3] * rstd * g0[3] + b0[3]);
        o.z = pk2(x[4] * rstd * g1[0] + b1[0], x[5] * rstd * g1[1] + b1[1]); o.w = pk2(x[6] * rstd * g1[2] + b1[2], x[7] * rstd * g1[3] + b1[3]);
        *((u32x4*)(P.VN + (size_t)m * 512) + lane) = o;
    }
}
__device__ __forceinline__ void d_softmax256(const Params& P, int gw, int ngw, int lane) {
    for (long m = gw; m < (long)TOK * 4; m += ngw) { f32x4* xr = (f32x4*)(P.SCA + (size_t)m * 256) + lane; f32x4 v = *xr;
        const float mx = wave_max(fmaxf(fmaxf(v[0], v[1]), fmaxf(v[2], v[3])));
        v[0] = __expf(v[0] - mx); v[1] = __expf(v[1] - mx); v[2] = __expf(v[2] - mx); v[3] = __expf(v[3] - mx);
        const float inv = 1.0f / wave_sum((v[0] + v[1]) + (v[2] + v[3])); *xr = v * inv; }
}
__device__ __forceinline__ void tr_item(const float* W, int ldw, int src_col0, bf16_t* WT, int K, int dst_row0, int k0, LAS float* scr, int lane) {
    const int c = lane & 7;
    if (src_col0 < 0) {
#pragma unroll
        for (int j = 0; j < 4; ++j) { const int n = (lane >> 3) + 8 * j; *(u32x4*)(WT + (size_t)(dst_row0 + n) * K + k0 + 8 * c) = (u32x4){0u, 0u, 0u, 0u}; }
        return;
    }
#pragma unroll 8
    for (int i = 0; i < 32; ++i) { const int kk = 2 * i + (lane >> 5); scr[kk * 33 + (lane & 31)] = W[(size_t)(k0 + kk) * ldw + src_col0 + (lane & 31)]; }
    asm volatile("s_waitcnt lgkmcnt(0)" ::: "memory");
#pragma unroll
    for (int j = 0; j < 4; ++j) { const int n = (lane >> 3) + 8 * j; const LAS float* sp = scr + (8 * c) * 33 + n;
        u32x4 o; o.x = pk2(sp[0 * 33], sp[1 * 33]); o.y = pk2(sp[2 * 33], sp[3 * 33]); o.z = pk2(sp[4 * 33], sp[5 * 33]); o.w = pk2(sp[6 * 33], sp[7 * 33]);
        *(u32x4*)(WT + (size_t)(dst_row0 + n) * K + k0 + 8 * c) = o; }
    asm volatile("s_waitcnt lgkmcnt(0)" ::: "memory");
}
__device__ __forceinline__ void d_weights(const Params& P, LAS unsigned char* lds, int gw, int ngw, int wave, int lane) {
    LAS float* scr = (LAS float*)(lds + wave * 16384);
    constexpr int I_IN = 160 * 16, I_BR = 2 * 32 * 8, I_SQ = 32 * 16, I_WIDE = 64 * 16;
    constexpr int NITEMS = I_IN + I_BR + 3 * I_SQ + 2 * I_WIDE;
    for (int it = gw; it < NITEMS; it += ngw) {
        int r = it;
        if (r < I_IN) { const int nb = r / 16, kb = r % 16; tr_item(P.in[I_W_IN], IN_COLS, win_src_col(32 * nb), P.W_IN_T, 1024, 32 * nb, 64 * kb, scr, lane); continue; } r -= I_IN;
        if (r < I_BR) { const int br = r / 256, q = r % 256, nb = q / 8, kb = q % 8; tr_item(P.in[I_W_BRANCH] + (size_t)br * 512 * 1024, 1024, 32 * nb, P.W_BR_T, 512, br * 1024 + 32 * nb, 64 * kb, scr, lane); continue; } r -= I_BR;
        if (r < 3 * I_SQ) { const int w = r / I_SQ, q = r % I_SQ, nb = q / 16, kb = q % 16;
            const float* src = (w == 0) ? P.in[I_W_MIX] : (w == 1) ? P.in[I_W_Q] : P.in[I_W_O]; bf16_t* dst = (w == 0) ? P.W_MIX_T : (w == 1) ? P.W_Q_T : P.W_O_T;
            tr_item(src, 1024, 32 * nb, dst, 1024, 32 * nb, 64 * kb, scr, lane); continue; } r -= 3 * I_SQ;
        { const int w = r / I_WIDE, q = r % I_WIDE, nb = q / 16, kb = q % 16;
            tr_item(w == 0 ? P.in[I_W_KV] : P.in[I_W_QUERY], 2048, 32 * nb, w == 0 ? P.W_KV_T : P.W_QUERY_T, 1024, 32 * nb, 64 * kb, scr, lane); }
    }
}
__device__ __forceinline__ void d_tables(const Params& P, long gtid, long nthr) {
    const long n8 = (long)16384 * 1024 / 8;
    for (long i = gtid; i < 2 * n8; i += nthr) { const bool isv = (i >= n8); const long j = isv ? i - n8 : i;
        const f32x4* src = (const f32x4*)(isv ? P.in[I_PEER_V] : P.in[I_PEER_U]) + 2 * j; const f32x4 a = src[0], b = src[1];
        u32x4 o; o.x = pk2(a[0], a[1]); o.y = pk2(a[2], a[3]); o.z = pk2(b[0], b[1]); o.w = pk2(b[2], b[3]);
        *((u32x4*)(isv ? P.VB : P.UB) + j) = o; }
}
__device__ __forceinline__ float dot8(const u32x4& a, const u32x4& b, float acc) {
#if USE_DOT2
    acc = __builtin_amdgcn_fdot2_f32_bf16(__builtin_bit_cast(bf16x2_t, a.x), __builtin_bit_cast(bf16x2_t, b.x), acc, false);
    acc = __builtin_amdgcn_fdot2_f32_bf16(__builtin_bit_cast(bf16x2_t, a.y), __builtin_bit_cast(bf16x2_t, b.y), acc, false);
    acc = __builtin_amdgcn_fdot2_f32_bf16(__builtin_bit_cast(bf16x2_t, a.z), __builtin_bit_cast(bf16x2_t, b.z), acc, false);
    acc = __builtin_amdgcn_fdot2_f32_bf16(__builtin_bit_cast(bf16x2_t, a.w), __builtin_bit_cast(bf16x2_t, b.w), acc, false);
#else
    acc += blo(a.x) * blo(b.x); acc += bhi(a.x) * bhi(b.x); acc += blo(a.y) * blo(b.y); acc += bhi(a.y) * bhi(b.y);
    acc += blo(a.z) * blo(b.z); acc += bhi(a.z) * bhi(b.z); acc += blo(a.w) * blo(b.w); acc += bhi(a.w) * bhi(b.w);
#endif
    return acc;
}
__device__ __forceinline__ void axpy8(float* y, float c, const u32x4& v) {
    y[0] += c * blo(v.x); y[1] += c * bhi(v.x); y[2] += c * blo(v.y); y[3] += c * bhi(v.y);
    y[4] += c * blo(v.z); y[5] += c * bhi(v.z); y[6] += c * blo(v.w); y[7] += c * bhi(v.w);
}
__device__ __forceinline__ void d_peer(const Params& P, int gw, int ngw, int lane) {
    for (long t = gw; t < TOK; t += ngw) {
        const u32x4* xr = (const u32x4*)(P.HB + (size_t)t * 1024); const u32x4 x0 = xr[lane], x1 = xr[64 + lane];
        const int e_lo = P.EXPERT[(size_t)t * 128 + lane], e_hi = P.EXPERT[(size_t)t * 128 + 64 + lane];
        const float g_lo = P.GATE[(size_t)t * 128 + lane], g_hi = P.GATE[(size_t)t * 128 + 64 + lane];
        float y[16];
#pragma unroll
        for (int i = 0; i < 16; ++i) y[i] = 0.f;
#pragma unroll 1
        for (int half = 0; half < 2; ++half) {
            const int ev = half ? e_hi : e_lo; const float gv = half ? g_hi : g_lo;
#pragma unroll 1
            for (int k0 = 0; k0 < 64; k0 += 4) {
                int e[4]; float gt[4]; u32x4 u0[4], u1[4], v0[4], v1[4];
#pragma unroll
                for (int q = 0; q < 4; ++q) { e[q] = __builtin_amdgcn_readlane(ev, k0 + q); gt[q] = __uint_as_float(__builtin_amdgcn_readlane(__float_as_uint(gv), k0 + q)); }
#pragma unroll
                for (int q = 0; q < 4; ++q) { const u32x4* ur = (const u32x4*)(P.UB + (size_t)e[q] * 1024); u0[q] = ur[lane]; u1[q] = ur[64 + lane]; }
#pragma unroll
                for (int q = 0; q < 4; ++q) { const u32x4* vr = (const u32x4*)(P.VB + (size_t)e[q] * 1024); v0[q] = vr[lane]; v1[q] = vr[64 + lane]; }
                float d[4];
#pragma unroll
                for (int q = 0; q < 4; ++q) d[q] = dot8(u1[q], x1, dot8(u0[q], x0, 0.f));
#pragma unroll
                for (int o = 1; o < 64; o <<= 1) {
#pragma unroll
                    for (int q = 0; q < 4; ++q) d[q] += __shfl_xor(d[q], o); }
#pragma unroll
                for (int q = 0; q < 4; ++q) { const float a = d[q]; const float c = gt[q] * 0.5f * a * (1.0f + erff(a * 0.7071067811865476f)); axpy8(y, c, v0[q]); axpy8(y + 8, c, v1[q]); }
            }
        }
        float z[16];
        z[0] = ALPHA_F * blo(x0.x) + y[0]; z[1] = ALPHA_F * bhi(x0.x) + y[1]; z[2] = ALPHA_F * blo(x0.y) + y[2]; z[3] = ALPHA_F * bhi(x0.y) + y[3];
        z[4] = ALPHA_F * blo(x0.z) + y[4]; z[5] = ALPHA_F * bhi(x0.z) + y[5]; z[6] = ALPHA_F * blo(x0.w) + y[6]; z[7] = ALPHA_F * bhi(x0.w) + y[7];
        z[8] = ALPHA_F * blo(x1.x) + y[8]; z[9] = ALPHA_F * bhi(x1.x) + y[9]; z[10] = ALPHA_F * blo(x1.y) + y[10]; z[11] = ALPHA_F * bhi(x1.y) + y[11];
        z[12] = ALPHA_F * blo(x1.z) + y[12]; z[13] = ALPHA_F * bhi(x1.z) + y[13]; z[14] = ALPHA_F * blo(x1.w) + y[14]; z[15] = ALPHA_F * bhi(x1.w) + y[15];
        float s = 0.f;
#pragma unroll
        for (int i = 0; i < 16; ++i) s += z[i];
        const float mean = wave_sum(s) * (1.f / 1024.f); float s2 = 0.f;
#pragma unroll
        for (int i = 0; i < 16; ++i) { z[i] -= mean; s2 += z[i] * z[i]; }
        const float rstd = 1.f / sqrtf(wave_sum(s2) * (1.f / 1024.f) + 1e-5f);
        const float* g = P.in[I_LN3_G]; const float* b = P.in[I_LN3_B]; float* orow = P.out + (size_t)t * 1024;
#pragma unroll
        for (int hh = 0; hh < 2; ++hh)
#pragma unroll
            for (int q = 0; q < 2; ++q) { const int col = hh * 512 + lane * 8 + q * 4; const f32x4 gg = *(const f32x4*)(g + col), bb = *(const f32x4*)(b + col);
                f32x4 o; o[0] = z[hh * 8 + q * 4 + 0] * rstd * gg[0] + bb[0]; o[1] = z[hh * 8 + q * 4 + 1] * rstd * gg[1] + bb[1];
                o[2] = z[hh * 8 + q * 4 + 2] * rstd * gg[2] + bb[2]; o[3] = z[hh * 8 + q * 4 + 3] * rstd * gg[3] + bb[3];
                *(f32x4*)(orow + col) = o; }
    }
}

__device__ __forceinline__ void d_lora_weights(const Params& P, long gtid, long nthr) {
    for (long idx = gtid; idx < (long)2560 * 512; idx += nthr) { const int n = (int)(idx / 512), k = (int)(idx % 512); float v = 0.f;
        if (n < 1024) { const int z = n >> 9, c = n & 511; if (k >= z * 64 && k < z * 64 + 64) v = P.in[I_W2][((size_t)z * 64 + (k - z * 64)) * 512 + c]; }
        else if (n < 2048) { const int z = (n - 1024) >> 9, c = n & 511; const int kk = k - 128; if (kk >= z * 64 && kk < z * 64 + 64) v = P.in[I_A2][((size_t)z * 64 + (kk - z * 64)) * 512 + c]; }
        else { const int c = n - 2048; if (k >= 256 && k < 384) v = P.in[I_G2][(size_t)(k - 256) * 512 + c]; }
        P.W_LORA_T[idx] = f2bf(v); }
    for (long idx = gtid; idx < (long)8 * 128 * 128; idx += nthr) P.WSB[idx] = f2bf(P.in[I_W_S][idx]);
}
__device__ __forceinline__ void shift8(const bf16_t* PA, long t, int s, int col, const float* mu, float* o) {
    const u32x4 c = *(const u32x4*)(PA + (size_t)t * 2048 + col);
    u32x4 p = (u32x4){0u, 0u, 0u, 0u}, n = (u32x4){0u, 0u, 0u, 0u};
    if (s > 0) p = *(const u32x4*)(PA + (size_t)(t - 1) * 2048 + col);
    if (s < SEQ - 1) n = *(const u32x4*)(PA + (size_t)(t + 1) * 2048 + col);
    const f32x4 m0 = *(const f32x4*)(mu + col), m1 = *(const f32x4*)(mu + col + 4);
    const float cc[8] = {blo(c.x), bhi(c.x), blo(c.y), bhi(c.y), blo(c.z), bhi(c.z), blo(c.w), bhi(c.w)};
    const float pp[8] = {blo(p.x), bhi(p.x), blo(p.y), bhi(p.y), blo(p.z), bhi(p.z), blo(p.w), bhi(p.w)};
    const float nn[8] = {blo(n.x), bhi(n.x), blo(n.y), bhi(n.y), blo(n.z), bhi(n.z), blo(n.w), bhi(n.w)};
#pragma unroll
    for (int i = 0; i < 8; ++i) { const float m = (i < 4) ? m0[i] : m1[i - 4]; o[i] = cc[i] + m * (0.5f * (pp[i] + nn[i]) - cc[i]); }
}
__device__ __forceinline__ u32x4 pack8f(const float* v) { u32x4 w; w.x = pk2(v[0], v[1]); w.y = pk2(v[2], v[3]); w.z = pk2(v[4], v[5]); w.w = pk2(v[6], v[7]); return w; }
__device__ __forceinline__ void d_prep_e1(const Params& P, int gw, int ngw, int lane) {
    const float* mu = P.in[I_MU];
    const f32x4 kk0 = *(const f32x4*)(P.in[I_K_K] + 8 * lane), kk1 = *(const f32x4*)(P.in[I_K_K] + 8 * lane + 4);
    for (long t = gw; t < TOK; t += ngw) { const int s = (int)(t % SEQ); float r[8], k[8], v[8];
        shift8(P.PA, t, s, 8 * lane, mu, r); shift8(P.PA, t, s, 512 + 8 * lane, mu, k); shift8(P.PA, t, s, 1024 + 8 * lane, mu, v);
        float q[8]; float ss = 0.f;
#pragma unroll
        for (int i = 0; i < 8; ++i) { q[i] = k[i] * ((i < 4) ? kk0[i] : kk1[i - 4]); ss += q[i] * q[i]; }
        ss += __shfl_xor(ss, 1); ss += __shfl_xor(ss, 2); ss += __shfl_xor(ss, 4);
        const float inv = 1.0f / fmaxf(sqrtf(ss), 1e-12f);
#pragma unroll
        for (int i = 0; i < 8; ++i) q[i] *= inv;
        *(u32x4*)(P.R + (size_t)t * 512 + 8 * lane) = pack8f(r); *(u32x4*)(P.K + (size_t)t * 512 + 8 * lane) = pack8f(k);
        *(u32x4*)(P.V + (size_t)t * 512 + 8 * lane) = pack8f(v); *(u32x4*)(P.KK + (size_t)t * 512 + 8 * lane) = pack8f(q);
        if (lane < 48) { float x[8]; shift8(P.PA, t, s, 1536 + 8 * lane, mu, x);
#pragma unroll
            for (int i = 0; i < 8; ++i) x[i] = (lane < 16) ? tanhf(x[i]) : (lane < 32) ? x[i] : 1.0f / (1.0f + expf(-x[i]));
            *(u32x4*)(P.LIN + (size_t)t * 512 + 8 * lane) = pack8f(x); }
        else *(u32x4*)(P.LIN + (size_t)t * 512 + 8 * lane) = (u32x4){0u, 0u, 0u, 0u};
    }
}
__device__ __forceinline__ void scan_item3(const Params& P, int chain, int i) {
    const int h = chain % 8, b = (chain / 8) % BATCH, z = chain / (8 * BATCH);
    float S[64];
#pragma unroll
    for (int j = 0; j < 64; ++j) S[j] = 0.f;
    const float* ka = P.in[I_K_A] + h * 64;
    for (int n = 0; n < SEQ; ++n) {
        const long t = (long)b * SEQ + ((z == 0) ? n : (SEQ - 1 - n)); const size_t o1 = (size_t)t * 512 + h * 64, o2 = ((size_t)t * 2 + z) * 512 + h * 64;
        const float v = bf2f(P.V[o1 + i]);
        float sa = 0.f;
#pragma unroll
        for (int j = 0; j < 64; ++j) sa -= S[j] * bf2f(P.KK[o1 + j]);
        float y = 0.f;
#pragma unroll
        for (int j = 0; j < 64; ++j) { const float al = bf2f(P.AL[o2 + j]), k = bf2f(P.K[o1 + j]);
            S[j] = S[j] * (1.0f - bf2f(P.OMW[o2 + j])) + sa * (bf2f(P.KK[o1 + j]) * al) + v * (k * (1.0f + (al - 1.0f) * ka[j])); y += S[j] * bf2f(P.R[o1 + j]); }
        P.Y01[((size_t)z * TOK + t) * 512 + h * 64 + i] = y;
    }
}

#define SC_CH 32
#define SC_REC 352
template <int CTRL> __device__ __forceinline__ float dpp_add(float x) {
    return x + __uint_as_float((unsigned)__builtin_amdgcn_update_dpp(0, (int)__float_as_uint(x), CTRL, 0xf, 0xf, false));
}
__device__ __forceinline__ float allsum16(float x) { x = dpp_add<0xB1>(x); x = dpp_add<0x4E>(x); x = dpp_add<0x141>(x); x = dpp_add<0x140>(x); return x; }
__device__ __forceinline__ void d_scan(const Params& P, LAS unsigned char* lds, int tid) {
    const int lane = tid & 63, wave = __builtin_amdgcn_readfirstlane(tid >> 6);
    const int chain = (int)blockIdx.x >> 1, half = (int)blockIdx.x & 1;
    if (chain >= 2 * BATCH * 8) return;
    const int h = chain % 8, b = (chain / 8) % BATCH, z = chain / (8 * BATCH);
    LAS float* buf = (LAS float*)lds;
    const float ka = P.in[I_K_A][h * 64 + lane];
    const long tb = (long)b * SEQ;
    unsigned short gr[4], gk[4], gkk[4], gom[4], gal[4], gv[2];
    auto g_load = [&](int c) {
#pragma unroll
        for (int q = 0; q < 4; ++q) { const int n = c * SC_CH + wave + 8 * q; const long t = tb + ((z == 0) ? n : (SEQ - 1 - n));
            const size_t o1 = (size_t)t * 512 + h * 64 + lane, o2 = ((size_t)t * 2 + z) * 512 + h * 64 + lane;
            gr[q] = P.R[o1]; gk[q] = P.K[o1]; gkk[q] = P.KK[o1]; gom[q] = P.OMW[o2]; gal[q] = P.AL[o2]; }
#pragma unroll
        for (int q = 0; q < 2; ++q) { const int p = tid + 512 * q; const int n = c * SC_CH + (p >> 5); const long t = tb + ((z == 0) ? n : (SEQ - 1 - n));
            gv[q] = P.V[(size_t)t * 512 + h * 64 + half * 32 + (p & 31)]; }
    };
    auto s_write = [&](int c) {
        LAS float* bb = buf + (c & 1) * (SC_CH * SC_REC);
#pragma unroll
        for (int q = 0; q < 4; ++q) { LAS float* rec = bb + (wave + 8 * q) * SC_REC + lane;
            const float k = bf2f(gk[q]), kk = bf2f(gkk[q]), al = bf2f(gal[q]);
            rec[0] = 1.0f - bf2f(gom[q]); rec[64] = k * (1.0f + (al - 1.0f) * ka); rec[128] = -kk; rec[192] = kk * al; rec[256] = bf2f(gr[q]); }
#pragma unroll
        for (int q = 0; q < 2; ++q) { const int p = tid + 512 * q; bb[(p >> 5) * SC_REC + 320 + (p & 31)] = bf2f(gv[q]); }
    };
    const int rg = lane >> 4, jl = lane & 15, rowl = wave * 4 + rg;
    float S0 = 0.f, S1 = 0.f, S2 = 0.f, S3 = 0.f;
    g_load(0); s_write(0); g_load(1);
    asm volatile("s_waitcnt lgkmcnt(0)" ::: "memory"); __syncthreads();
    float* yout = P.Y01 + (size_t)z * TOK * 512 + h * 64 + half * 32 + rowl;
    constexpr int NCH = SEQ / SC_CH;
    float ykeep = 0.f;
    const LAS float* vbase = buf + 320 + rowl;
#define SC_LOAD(W, KD, A, B, R, V, rec_, nl_) do { W = *(const LAS f32x4*)((rec_)); KD = *(const LAS f32x4*)((rec_) + 64); A = *(const LAS f32x4*)((rec_) + 128); \
        B = *(const LAS f32x4*)((rec_) + 192); R = *(const LAS f32x4*)((rec_) + 256); V = (vb_)[(nl_) * SC_REC]; } while (0)
#define SC_STEP(W, KD, A, B, R, V, nl_) do { \
        float sa_ = (S0 * A[0] + S1 * A[1]) + (S2 * A[2] + S3 * A[3]); sa_ = allsum16(sa_); \
        S0 = S0 * W[0] + (sa_ * B[0] + V * KD[0]); S1 = S1 * W[1] + (sa_ * B[1] + V * KD[1]); \
        S2 = S2 * W[2] + (sa_ * B[2] + V * KD[2]); S3 = S3 * W[3] + (sa_ * B[3] + V * KD[3]); \
        float y_ = (S0 * R[0] + S1 * R[1]) + (S2 * R[2] + S3 * R[3]); y_ = allsum16(y_); \
        ykeep = (jl == ((nl_) & 15)) ? y_ : ykeep; } while (0)
#pragma unroll 1
    for (int c = 0; c < NCH; ++c) {
        if (c + 1 < NCH) s_write(c + 1);
        if (c + 2 < NCH) g_load(c + 2);
        const LAS float* bb = buf + (c & 1) * (SC_CH * SC_REC) + jl * 4; const LAS float* vb_ = vbase + (c & 1) * (SC_CH * SC_REC);
        f32x4 w0, k0, a0, b0, r0, w1, k1, a1, b1, r1; float v0, v1;
        SC_LOAD(w0, k0, a0, b0, r0, v0, bb, 0);
#pragma unroll
        for (int nl = 0; nl < SC_CH; nl += 2) {
            SC_LOAD(w1, k1, a1, b1, r1, v1, bb + (nl + 1) * SC_REC, nl + 1);
            SC_STEP(w0, k0, a0, b0, r0, v0, nl);
            if (nl + 2 < SC_CH) SC_LOAD(w0, k0, a0, b0, r0, v0, bb + (nl + 2) * SC_REC, nl + 2);
            SC_STEP(w1, k1, a1, b1, r1, v1, nl + 1);
            if (((nl + 1) & 15) == 15) { const int n = c * SC_CH + (nl + 1 - 15) + jl; const long t = tb + ((z == 0) ? n : (SEQ - 1 - n)); yout[(size_t)t * 512] = ykeep; }
        }
        asm volatile("s_waitcnt lgkmcnt(0)" ::: "memory"); __syncthreads();
    }
#undef SC_LOAD
#undef SC_STEP
}
__device__ __forceinline__ void d_rwkv_out(const Params& P, int gw, int ngw, int lane) {
    for (long it = gw; it < (long)TOK * 8; it += ngw) { const long t = it >> 3; const int c = (int)(it & 7) * 64 + lane;
        const float y = P.Y01[(size_t)t * 512 + c] + P.Y01[((size_t)TOK + t) * 512 + c];
        const float mu = wave_sum(y) * (1.f / 64.f); const float d = y - mu; const float rs = 1.0f / sqrtf(wave_sum(d * d) * (1.f / 64.f) + 64e-5f);
        const float yn = d * rs * P.in[I_GN_G][c] + P.in[I_GN_B][c];
        const float r = bf2f(P.R[(size_t)t * 512 + c]), k = bf2f(P.K[(size_t)t * 512 + c]), ka = P.in[I_K_A][c];
        const float a0 = bf2f(P.AL[((size_t)t * 2) * 512 + c]), a1 = bf2f(P.AL[((size_t)t * 2 + 1) * 512 + c]);
        const float kd = k * (1.0f + (a0 - 1.0f) * ka) + k * (1.0f + (a1 - 1.0f) * ka);
        const float rk = wave_sum(r * kd * P.in[I_R_K][c]);
        P.YA[(size_t)t * 512 + c] = f2bf((yn + rk * bf2f(P.V[(size_t)t * 512 + c])) * bf2f(P.G[(size_t)t * 512 + c])); }
}


typedef float f32x2v __attribute__((ext_vector_type(2)));
__device__ __forceinline__ void d_tables8(const Params& P, int gw, int ngw, int lane) {
    for (int row = gw; row < 2 * 16384; row += ngw) { const bool isv = row >= 16384; const int e = isv ? row - 16384 : row;
        const f32x4* src = (const f32x4*)((isv ? P.in[I_PEER_V] : P.in[I_PEER_U]) + (size_t)e * 1024 + 16 * lane);
        const f32x4 a = src[0], b = src[1], c = src[2], d = src[3];
        float m = fmaxf(fmaxf(fmaxf(fabsf(a[0]), fabsf(a[1])), fmaxf(fabsf(a[2]), fabsf(a[3]))), fmaxf(fmaxf(fabsf(b[0]), fabsf(b[1])), fmaxf(fabsf(b[2]), fabsf(b[3]))));
        m = fmaxf(m, fmaxf(fmaxf(fmaxf(fabsf(c[0]), fabsf(c[1])), fmaxf(fabsf(c[2]), fabsf(c[3]))), fmaxf(fmaxf(fabsf(d[0]), fabsf(d[1])), fmaxf(fabsf(d[2]), fabsf(d[3])))));
        m = wave_max(m); const float sc = (m > 0.f) ? m * (1.0f / 240.0f) : 1.0f, inv = 1.0f / sc;
        int w0 = 0, w1 = 0, w2 = 0, w3 = 0;
        w0 = __builtin_amdgcn_cvt_pk_fp8_f32(a[0] * inv, a[1] * inv, w0, false); w0 = __builtin_amdgcn_cvt_pk_fp8_f32(a[2] * inv, a[3] * inv, w0, true);
        w1 = __builtin_amdgcn_cvt_pk_fp8_f32(b[0] * inv, b[1] * inv, w1, false); w1 = __builtin_amdgcn_cvt_pk_fp8_f32(b[2] * inv, b[3] * inv, w1, true);
        w2 = __builtin_amdgcn_cvt_pk_fp8_f32(c[0] * inv, c[1] * inv, w2, false); w2 = __builtin_amdgcn_cvt_pk_fp8_f32(c[2] * inv, c[3] * inv, w2, true);
        w3 = __builtin_amdgcn_cvt_pk_fp8_f32(d[0] * inv, d[1] * inv, w3, false); w3 = __builtin_amdgcn_cvt_pk_fp8_f32(d[2] * inv, d[3] * inv, w3, true);
        *((u32x4*)((isv ? P.V8 : P.U8) + (size_t)e * 1024) + lane) = (u32x4){(unsigned)w0, (unsigned)w1, (unsigned)w2, (unsigned)w3};
        if (lane == 0) (isv ? P.SV : P.SU)[e] = sc; }
}
__device__ __forceinline__ void dec16(const u32x4& w, float* o) {
    const f32x2v a0 = __builtin_amdgcn_cvt_pk_f32_fp8((int)w.x, false), a1 = __builtin_amdgcn_cvt_pk_f32_fp8((int)w.x, true);
    const f32x2v b0 = __builtin_amdgcn_cvt_pk_f32_fp8((int)w.y, false), b1 = __builtin_amdgcn_cvt_pk_f32_fp8((int)w.y, true);
    const f32x2v c0 = __builtin_amdgcn_cvt_pk_f32_fp8((int)w.z, false), c1 = __builtin_amdgcn_cvt_pk_f32_fp8((int)w.z, true);
    const f32x2v d0 = __builtin_amdgcn_cvt_pk_f32_fp8((int)w.w, false), d1 = __builtin_amdgcn_cvt_pk_f32_fp8((int)w.w, true);
    o[0] = a0[0]; o[1] = a0[1]; o[2] = a1[0]; o[3] = a1[1]; o[4] = b0[0]; o[5] = b0[1]; o[6] = b1[0]; o[7] = b1[1];
    o[8] = c0[0]; o[9] = c0[1]; o[10] = c1[0]; o[11] = c1[1]; o[12] = d0[0]; o[13] = d0[1]; o[14] = d1[0]; o[15] = d1[1];
}
__device__ __forceinline__ void d_peer8(const Params& P, int gw, int ngw, int lane) {
    for (long t = gw; t < TOK; t += ngw) {
        const u32x4* xr = (const u32x4*)(P.HB + (size_t)t * 1024 + 16 * lane); const u32x4 xa = xr[0], xb = xr[1];
        const float x[16] = {blo(xa.x), bhi(xa.x), blo(xa.y), bhi(xa.y), blo(xa.z), bhi(xa.z), blo(xa.w), bhi(xa.w),
                             blo(xb.x), bhi(xb.x), blo(xb.y), bhi(xb.y), blo(xb.z), bhi(xb.z), blo(xb.w), bhi(xb.w)};
        const int e_lo = P.EXPERT[(size_t)t * 128 + lane], e_hi = P.EXPERT[(size_t)t * 128 + 64 + lane];
        const float g_lo = P.GATE[(size_t)t * 128 + lane], g_hi = P.GATE[(size_t)t * 128 + 64 + lane];
        const float su_lo = P.SU[e_lo], su_hi = P.SU[e_hi], sv_lo = P.SV[e_lo], sv_hi = P.SV[e_hi];
        float d_lo = 0.f, d_hi = 0.f;
#pragma unroll 1
        for (int half = 0; half < 2; ++half) { const int ev = half ? e_hi : e_lo; float dacc = 0.f;
#pragma unroll 1
            for (int k0 = 0; k0 < 64; k0 += 8) { u32x4 u[8];
#pragma unroll
                for (int q = 0; q < 8; ++q) { const int e = __builtin_amdgcn_readlane(ev, k0 + q); u[q] = *((const u32x4*)(P.U8 + (size_t)e * 1024) + lane); }
                float d[8];
#pragma unroll
                for (int q = 0; q < 8; ++q) { float f[16]; dec16(u[q], f); float a0 = 0.f, a1 = 0.f;
#pragma unroll
                    for (int i = 0; i < 8; ++i) { a0 += f[i] * x[i]; a1 += f[8 + i] * x[8 + i]; }
                    d[q] = a0 + a1; }
#pragma unroll
                for (int o = 1; o < 64; o <<= 1) {
#pragma unroll
                    for (int q = 0; q < 8; ++q) d[q] += __shfl_xor(d[q], o); }
#pragma unroll
                for (int q = 0; q < 8; ++q) dacc = (lane == k0 + q) ? d[q] : dacc; }
            if (half) d_hi = dacc; else d_lo = dacc; }
        const float al = d_lo * su_lo, ah = d_hi * su_hi;
        const float c_lo = g_lo * 0.5f * al * (1.0f + erff(al * 0.7071067811865476f)) * sv_lo, c_hi = g_hi * 0.5f * ah * (1.0f + erff(ah * 0.7071067811865476f)) * sv_hi;
        float y[16];
#pragma unroll
        for (int i = 0; i < 16; ++i) y[i] = 0.f;
#pragma unroll 1
        for (int half = 0; half < 2; ++half) { const int ev = half ? e_hi : e_lo; const float cv = half ? c_hi : c_lo;
#pragma unroll 1
            for (int k0 = 0; k0 < 64; k0 += 8) { u32x4 v[8]; float c[8];
#pragma unroll
                for (int q = 0; q < 8; ++q) { const int e = __builtin_amdgcn_readlane(ev, k0 + q); c[q] = __uint_as_float(__builtin_amdgcn_readlane(__float_as_uint(cv), k0 + q));
                    v[q] = *((const u32x4*)(P.V8 + (size_t)e * 1024) + lane); }
#pragma unroll
                for (int q = 0; q < 8; ++q) { float f[16]; dec16(v[q], f);
#pragma unroll
                    for (int i = 0; i < 16; ++i) y[i] += c[q] * f[i]; } } }
        float z[16]; float s = 0.f;
#pragma unroll
        for (int i = 0; i < 16; ++i) { z[i] = ALPHA_F * x[i] + y[i]; s += z[i]; }
        const float mean = wave_sum(s) * (1.f / 1024.f); float s2 = 0.f;
#pragma unroll
        for (int i = 0; i < 16; ++i) { z[i] -= mean; s2 += z[i] * z[i]; }
        const float rstd = 1.f / sqrtf(wave_sum(s2) * (1.f / 1024.f) + 1e-5f);
        const float* g = P.in[I_LN3_G] + 16 * lane; const float* b = P.in[I_LN3_B] + 16 * lane; float* orow = P.out + (size_t)t * 1024 + 16 * lane;
#pragma unroll
        for (int q = 0; q < 4; ++q) { const f32x4 gg = *(const f32x4*)(g + 4 * q), bb = *(const f32x4*)(b + 4 * q);
            f32x4 o; o[0] = z[4 * q] * rstd * gg[0] + bb[0]; o[1] = z[4 * q + 1] * rstd * gg[1] + bb[1]; o[2] = z[4 * q + 2] * rstd * gg[2] + bb[2]; o[3] = z[4 * q + 3] * rstd * gg[3] + bb[3];
            *(f32x4*)(orow + 4 * q) = o; }
    }
}
typedef short bf16x8v __attribute__((ext_vector_type(8)));
typedef float f32x16v __attribute__((ext_vector_type(16)));
#define RT_SKROW 272
__device__ __forceinline__ unsigned f2key(float f) { const unsigned u = __float_as_uint(f); return (u & 0x80000000u) ? ~u : (u | 0x80000000u); }
__device__ __forceinline__ float key2f(unsigned k) { const unsigned u = (k & 0x80000000u) ? (k & 0x7fffffffu) : ~k; return __uint_as_float(u); }
#define DECL16(T, P) T P##0, P##1, P##2, P##3, P##4, P##5, P##6, P##7, P##8, P##9, P##10, P##11, P##12, P##13, P##14, P##15
#define CE_D(a, b) do { const unsigned _hi = max(a, b), _lo = min(a, b); a = _hi; b = _lo; } while (0)
#define CE_A(a, b) do { const unsigned _hi = max(a, b), _lo = min(a, b); a = _lo; b = _hi; } while (0)
#define CEP_D(ka, pa, kb, pb) do { const bool _sw = (kb) > (ka); const unsigned _k0 = _sw ? (kb) : (ka), _k1 = _sw ? (ka) : (kb), _p0 = _sw ? (pb) : (pa), _p1 = _sw ? (pa) : (pb); ka = _k0; kb = _k1; pa = _p0; pb = _p1; } while (0)
#define CEP_A(ka, pa, kb, pb) do { const bool _sw = (kb) < (ka); const unsigned _k0 = _sw ? (kb) : (ka), _k1 = _sw ? (ka) : (kb), _p0 = _sw ? (pb) : (pa), _p1 = _sw ? (pa) : (pb); ka = _k0; kb = _k1; pa = _p0; pb = _p1; } while (0)
#define SORT16_DESC(P) do { CE_D(P##0, P##1); CE_A(P##2, P##3); CE_D(P##4, P##5); CE_A(P##6, P##7); CE_D(P##8, P##9); CE_A(P##10, P##11); CE_D(P##12, P##13); CE_A(P##14, P##15); CE_D(P##0, P##2); CE_D(P##1, P##3); CE_A(P##4, P##6); CE_A(P##5, P##7); CE_D(P##8, P##10); CE_D(P##9, P##11); CE_A(P##12, P##14); CE_A(P##13, P##15); CE_D(P##0, P##1); CE_D(P##2, P##3); CE_A(P##4, P##5); CE_A(P##6, P##7); CE_D(P##8, P##9); CE_D(P##10, P##11); CE_A(P##12, P##13); CE_A(P##14, P##15); CE_D(P##0, P##4); CE_D(P##1, P##5); CE_D(P##2, P##6); CE_D(P##3, P##7); CE_A(P##8, P##12); CE_A(P##9, P##13); CE_A(P##10, P##14); CE_A(P##11, P##15); CE_D(P##0, P##2); CE_D(P##1, P##3); CE_D(P##4, P##6); CE_D(P##5, P##7); CE_A(P##8, P##10); CE_A(P##9, P##11); CE_A(P##12, P##14); CE_A(P##13, P##15); CE_D(P##0, P##1); CE_D(P##2, P##3); CE_D(P##4, P##5); CE_D(P##6, P##7); CE_A(P##8, P##9); CE_A(P##10, P##11); CE_A(P##12, P##13); CE_A(P##14, P##15); CE_D(P##0, P##8); CE_D(P##1, P##9); CE_D(P##2, P##10); CE_D(P##3, P##11); CE_D(P##4, P##12); CE_D(P##5, P##13); CE_D(P##6, P##14); CE_D(P##7, P##15); CE_D(P##0, P##4); CE_D(P##1, P##5); CE_D(P##2, P##6); CE_D(P##3, P##7); CE_D(P##8, P##12); CE_D(P##9, P##13); CE_D(P##10, P##14); CE_D(P##11, P##15); CE_D(P##0, P##2); CE_D(P##1, P##3); CE_D(P##4, P##6); CE_D(P##5, P##7); CE_D(P##8, P##10); CE_D(P##9, P##11); CE_D(P##12, P##14); CE_D(P##13, P##15); CE_D(P##0, P##1); CE_D(P##2, P##3); CE_D(P##4, P##5); CE_D(P##6, P##7); CE_D(P##8, P##9); CE_D(P##10, P##11); CE_D(P##12, P##13); CE_D(P##14, P##15); } while (0)
#define SORT16P_DESC(K, Q) do { CEP_D(K##0, Q##0, K##1, Q##1); CEP_A(K##2, Q##2, K##3, Q##3); CEP_D(K##4, Q##4, K##5, Q##5); CEP_A(K##6, Q##6, K##7, Q##7); CEP_D(K##8, Q##8, K##9, Q##9); CEP_A(K##10, Q##10, K##11, Q##11); CEP_D(K##12, Q##12, K##13, Q##13); CEP_A(K##14, Q##14, K##15, Q##15); CEP_D(K##0, Q##0, K##2, Q##2); CEP_D(K##1, Q##1, K##3, Q##3); CEP_A(K##4, Q##4, K##6, Q##6); CEP_A(K##5, Q##5, K##7, Q##7); CEP_D(K##8, Q##8, K##10, Q##10); CEP_D(K##9, Q##9, K##11, Q##11); CEP_A(K##12, Q##12, K##14, Q##14); CEP_A(K##13, Q##13, K##15, Q##15); CEP_D(K##0, Q##0, K##1, Q##1); CEP_D(K##2, Q##2, K##3, Q##3); CEP_A(K##4, Q##4, K##5, Q##5); CEP_A(K##6, Q##6, K##7, Q##7); CEP_D(K##8, Q##8, K##9, Q##9); CEP_D(K##10, Q##10, K##11, Q##11); CEP_A(K##12, Q##12, K##13, Q##13); CEP_A(K##14, Q##14, K##15, Q##15); CEP_D(K##0, Q##0, K##4, Q##4); CEP_D(K##1, Q##1, K##5, Q##5); CEP_D(K##2, Q##2, K##6, Q##6); CEP_D(K##3, Q##3, K##7, Q##7); CEP_A(K##8, Q##8, K##12, Q##12); CEP_A(K##9, Q##9, K##13, Q##13); CEP_A(K##10, Q##10, K##14, Q##14); CEP_A(K##11, Q##11, K##15, Q##15); CEP_D(K##0, Q##0, K##2, Q##2); CEP_D(K##1, Q##1, K##3, Q##3); CEP_D(K##4, Q##4, K##6, Q##6); CEP_D(K##5, Q##5, K##7, Q##7); CEP_A(K##8, Q##8, K##10, Q##10); CEP_A(K##9, Q##9, K##11, Q##11); CEP_A(K##12, Q##12, K##14, Q##14); CEP_A(K##13, Q##13, K##15, Q##15); CEP_D(K##0, Q##0, K##1, Q##1); CEP_D(K##2, Q##2, K##3, Q##3); CEP_D(K##4, Q##4, K##5, Q##5); CEP_D(K##6, Q##6, K##7, Q##7); CEP_A(K##8, Q##8, K##9, Q##9); CEP_A(K##10, Q##10, K##11, Q##11); CEP_A(K##12, Q##12, K##13, Q##13); CEP_A(K##14, Q##14, K##15, Q##15); CEP_D(K##0, Q##0, K##8, Q##8); CEP_D(K##1, Q##1, K##9, Q##9); CEP_D(K##2, Q##2, K##10, Q##10); CEP_D(K##3, Q##3, K##11, Q##11); CEP_D(K##4, Q##4, K##12, Q##12); CEP_D(K##5, Q##5, K##13, Q##13); CEP_D(K##6, Q##6, K##14, Q##14); CEP_D(K##7, Q##7, K##15, Q##15); CEP_D(K##0, Q##0, K##4, Q##4); CEP_D(K##1, Q##1, K##5, Q##5); CEP_D(K##2, Q##2, K##6, Q##6); CEP_D(K##3, Q##3, K##7, Q##7); CEP_D(K##8, Q##8, K##12, Q##12); CEP_D(K##9, Q##9, K##13, Q##13); CEP_D(K##10, Q##10, K##14, Q##14); CEP_D(K##11, Q##11, K##15, Q##15); CEP_D(K##0, Q##0, K##2, Q##2); CEP_D(K##1, Q##1, K##3, Q##3); CEP_D(K##4, Q##4, K##6, Q##6); CEP_D(K##5, Q##5, K##7, Q##7); CEP_D(K##8, Q##8, K##10, Q##10); CEP_D(K##9, Q##9, K##11, Q##11); CEP_D(K##12, Q##12, K##14, Q##14); CEP_D(K##13, Q##13, K##15, Q##15); CEP_D(K##0, Q##0, K##1, Q##1); CEP_D(K##2, Q##2, K##3, Q##3); CEP_D(K##4, Q##4, K##5, Q##5); CEP_D(K##6, Q##6, K##7, Q##7); CEP_D(K##8, Q##8, K##9, Q##9); CEP_D(K##10, Q##10, K##11, Q##11); CEP_D(K##12, Q##12, K##13, Q##13); CEP_D(K##14, Q##14, K##15, Q##15); } while (0)
#define MERGE16_DESC(A, B) do { A##0 = max(A##0, B##15); A##1 = max(A##1, B##14); A##2 = max(A##2, B##13); A##3 = max(A##3, B##12); A##4 = max(A##4, B##11); A##5 = max(A##5, B##10); A##6 = max(A##6, B##9); A##7 = max(A##7, B##8); A##8 = max(A##8, B##7); A##9 = max(A##9, B##6); A##10 = max(A##10, B##5); A##11 = max(A##11, B##4); A##12 = max(A##12, B##3); A##13 = max(A##13, B##2); A##14 = max(A##14, B##1); A##15 = max(A##15, B##0); CE_D(A##0, A##8); CE_D(A##1, A##9); CE_D(A##2, A##10); CE_D(A##3, A##11); CE_D(A##4, A##12); CE_D(A##5, A##13); CE_D(A##6, A##14); CE_D(A##7, A##15); CE_D(A##0, A##4); CE_D(A##1, A##5); CE_D(A##2, A##6); CE_D(A##3, A##7); CE_D(A##8, A##12); CE_D(A##9, A##13); CE_D(A##10, A##14); CE_D(A##11, A##15); CE_D(A##0, A##2); CE_D(A##1, A##3); CE_D(A##4, A##6); CE_D(A##5, A##7); CE_D(A##8, A##10); CE_D(A##9, A##11); CE_D(A##12, A##14); CE_D(A##13, A##15); CE_D(A##0, A##1); CE_D(A##2, A##3); CE_D(A##4, A##5); CE_D(A##6, A##7); CE_D(A##8, A##9); CE_D(A##10, A##11); CE_D(A##12, A##13); CE_D(A##14, A##15); } while (0)
#define MERGE16P_DESC(A, PA, B, PB) do { { const bool _s = B##15 > A##0; PA##0 = _s ? PB##15 : PA##0; A##0 = _s ? B##15 : A##0; } { const bool _s = B##14 > A##1; PA##1 = _s ? PB##14 : PA##1; A##1 = _s ? B##14 : A##1; } { const bool _s = B##13 > A##2; PA##2 = _s ? PB##13 : PA##2; A##2 = _s ? B##13 : A##2; } { const bool _s = B##12 > A##3; PA##3 = _s ? PB##12 : PA##3; A##3 = _s ? B##12 : A##3; } { const bool _s = B##11 > A##4; PA##4 = _s ? PB##11 : PA##4; A##4 = _s ? B##11 : A##4; } { const bool _s = B##10 > A##5; PA##5 = _s ? PB##10 : PA##5; A##5 = _s ? B##10 : A##5; } { const bool _s = B##9 > A##6; PA##6 = _s ? PB##9 : PA##6; A##6 = _s ? B##9 : A##6; } { const bool _s = B##8 > A##7; PA##7 = _s ? PB##8 : PA##7; A##7 = _s ? B##8 : A##7; } { const bool _s = B##7 > A##8; PA##8 = _s ? PB##7 : PA##8; A##8 = _s ? B##7 : A##8; } { const bool _s = B##6 > A##9; PA##9 = _s ? PB##6 : PA##9; A##9 = _s ? B##6 : A##9; } { const bool _s = B##5 > A##10; PA##10 = _s ? PB##5 : PA##10; A##10 = _s ? B##5 : A##10; } { const bool _s = B##4 > A##11; PA##11 = _s ? PB##4 : PA##11; A##11 = _s ? B##4 : A##11; } { const bool _s = B##3 > A##12; PA##12 = _s ? PB##3 : PA##12; A##12 = _s ? B##3 : A##12; } { const bool _s = B##2 > A##13; PA##13 = _s ? PB##2 : PA##13; A##13 = _s ? B##2 : A##13; } { const bool _s = B##1 > A##14; PA##14 = _s ? PB##1 : PA##14; A##14 = _s ? B##1 : A##14; } { const bool _s = B##0 > A##15; PA##15 = _s ? PB##0 : PA##15; A##15 = _s ? B##0 : A##15; } CEP_D(A##0, PA##0, A##8, PA##8); CEP_D(A##1, PA##1, A##9, PA##9); CEP_D(A##2, PA##2, A##10, PA##10); CEP_D(A##3, PA##3, A##11, PA##11); CEP_D(A##4, PA##4, A##12, PA##12); CEP_D(A##5, PA##5, A##13, PA##13); CEP_D(A##6, PA##6, A##14, PA##14); CEP_D(A##7, PA##7, A##15, PA##15); CEP_D(A##0, PA##0, A##4, PA##4); CEP_D(A##1, PA##1, A##5, PA##5); CEP_D(A##2, PA##2, A##6, PA##6); CEP_D(A##3, PA##3, A##7, PA##7); CEP_D(A##8, PA##8, A##12, PA##12); CEP_D(A##9, PA##9, A##13, PA##13); CEP_D(A##10, PA##10, A##14, PA##14); CEP_D(A##11, PA##11, A##15, PA##15); CEP_D(A##0, PA##0, A##2, PA##2); CEP_D(A##1, PA##1, A##3, PA##3); CEP_D(A##4, PA##4, A##6, PA##6); CEP_D(A##5, PA##5, A##7, PA##7); CEP_D(A##8, PA##8, A##10, PA##10); CEP_D(A##9, PA##9, A##11, PA##11); CEP_D(A##12, PA##12, A##14, PA##14); CEP_D(A##13, PA##13, A##15, PA##15); CEP_D(A##0, PA##0, A##1, PA##1); CEP_D(A##2, PA##2, A##3, PA##3); CEP_D(A##4, PA##4, A##5, PA##5); CEP_D(A##6, PA##6, A##7, PA##7); CEP_D(A##8, PA##8, A##9, PA##9); CEP_D(A##10, PA##10, A##11, PA##11); CEP_D(A##12, PA##12, A##13, PA##13); CEP_D(A##14, PA##14, A##15, PA##15); } while (0)
#define FILL_G0(P, ACC, HH) do { P##0 = (f2key(ACC[0]) & ~0x7fu) | (unsigned)(127 - (0 + 4 * (HH))); P##1 = (f2key(ACC[1]) & ~0x7fu) | (unsigned)(127 - (1 + 4 * (HH))); P##2 = (f2key(ACC[2]) & ~0x7fu) | (unsigned)(127 - (2 + 4 * (HH))); P##3 = (f2key(ACC[3]) & ~0x7fu) | (unsigned)(127 - (3 + 4 * (HH))); P##4 = (f2key(ACC[4]) & ~0x7fu) | (unsigned)(127 - (8 + 4 * (HH))); P##5 = (f2key(ACC[5]) & ~0x7fu) | (unsigned)(127 - (9 + 4 * (HH))); P##6 = (f2key(ACC[6]) & ~0x7fu) | (unsigned)(127 - (10 + 4 * (HH))); P##7 = (f2key(ACC[7]) & ~0x7fu) | (unsigned)(127 - (11 + 4 * (HH))); P##8 = (f2key(ACC[8]) & ~0x7fu) | (unsigned)(127 - (16 + 4 * (HH))); P##9 = (f2key(ACC[9]) & ~0x7fu) | (unsigned)(127 - (17 + 4 * (HH))); P##10 = (f2key(ACC[10]) & ~0x7fu) | (unsigned)(127 - (18 + 4 * (HH))); P##11 = (f2key(ACC[11]) & ~0x7fu) | (unsigned)(127 - (19 + 4 * (HH))); P##12 = (f2key(ACC[12]) & ~0x7fu) | (unsigned)(127 - (24 + 4 * (HH))); P##13 = (f2key(ACC[13]) & ~0x7fu) | (unsigned)(127 - (25 + 4 * (HH))); P##14 = (f2key(ACC[14]) & ~0x7fu) | (unsigned)(127 - (26 + 4 * (HH))); P##15 = (f2key(ACC[15]) & ~0x7fu) | (unsigned)(127 - (27 + 4 * (HH))); } while (0)
#define FILL_G1(P, ACC, HH) do { P##0 = (f2key(ACC[0]) & ~0x7fu) | (unsigned)(127 - (32 + 4 * (HH))); P##1 = (f2key(ACC[1]) & ~0x7fu) | (unsigned)(127 - (33 + 4 * (HH))); P##2 = (f2key(ACC[2]) & ~0x7fu) | (unsigned)(127 - (34 + 4 * (HH))); P##3 = (f2key(ACC[3]) & ~0x7fu) | (unsigned)(127 - (35 + 4 * (HH))); P##4 = (f2key(ACC[4]) & ~0x7fu) | (unsigned)(127 - (40 + 4 * (HH))); P##5 = (f2key(ACC[5]) & ~0x7fu) | (unsigned)(127 - (41 + 4 * (HH))); P##6 = (f2key(ACC[6]) & ~0x7fu) | (unsigned)(127 - (42 + 4 * (HH))); P##7 = (f2key(ACC[7]) & ~0x7fu) | (unsigned)(127 - (43 + 4 * (HH))); P##8 = (f2key(ACC[8]) & ~0x7fu) | (unsigned)(127 - (48 + 4 * (HH))); P##9 = (f2key(ACC[9]) & ~0x7fu) | (unsigned)(127 - (49 + 4 * (HH))); P##10 = (f2key(ACC[10]) & ~0x7fu) | (unsigned)(127 - (50 + 4 * (HH))); P##11 = (f2key(ACC[11]) & ~0x7fu) | (unsigned)(127 - (51 + 4 * (HH))); P##12 = (f2key(ACC[12]) & ~0x7fu) | (unsigned)(127 - (56 + 4 * (HH))); P##13 = (f2key(ACC[13]) & ~0x7fu) | (unsigned)(127 - (57 + 4 * (HH))); P##14 = (f2key(ACC[14]) & ~0x7fu) | (unsigned)(127 - (58 + 4 * (HH))); P##15 = (f2key(ACC[15]) & ~0x7fu) | (unsigned)(127 - (59 + 4 * (HH))); } while (0)
#define FILL_G2(P, ACC, HH) do { P##0 = (f2key(ACC[0]) & ~0x7fu) | (unsigned)(127 - (64 + 4 * (HH))); P##1 = (f2key(ACC[1]) & ~0x7fu) | (unsigned)(127 - (65 + 4 * (HH))); P##2 = (f2key(ACC[2]) & ~0x7fu) | (unsigned)(127 - (66 + 4 * (HH))); P##3 = (f2key(ACC[3]) & ~0x7fu) | (unsigned)(127 - (67 + 4 * (HH))); P##4 = (f2key(ACC[4]) & ~0x7fu) | (unsigned)(127 - (72 + 4 * (HH))); P##5 = (f2key(ACC[5]) & ~0x7fu) | (unsigned)(127 - (73 + 4 * (HH))); P##6 = (f2key(ACC[6]) & ~0x7fu) | (unsigned)(127 - (74 + 4 * (HH))); P##7 = (f2key(ACC[7]) & ~0x7fu) | (unsigned)(127 - (75 + 4 * (HH))); P##8 = (f2key(ACC[8]) & ~0x7fu) | (unsigned)(127 - (80 + 4 * (HH))); P##9 = (f2key(ACC[9]) & ~0x7fu) | (unsigned)(127 - (81 + 4 * (HH))); P##10 = (f2key(ACC[10]) & ~0x7fu) | (unsigned)(127 - (82 + 4 * (HH))); P##11 = (f2key(ACC[11]) & ~0x7fu) | (unsigned)(127 - (83 + 4 * (HH))); P##12 = (f2key(ACC[12]) & ~0x7fu) | (unsigned)(127 - (88 + 4 * (HH))); P##13 = (f2key(ACC[13]) & ~0x7fu) | (unsigned)(127 - (89 + 4 * (HH))); P##14 = (f2key(ACC[14]) & ~0x7fu) | (unsigned)(127 - (90 + 4 * (HH))); P##15 = (f2key(ACC[15]) & ~0x7fu) | (unsigned)(127 - (91 + 4 * (HH))); } while (0)
#define FILL_G3(P, ACC, HH) do { P##0 = (f2key(ACC[0]) & ~0x7fu) | (unsigned)(127 - (96 + 4 * (HH))); P##1 = (f2key(ACC[1]) & ~0x7fu) | (unsigned)(127 - (97 + 4 * (HH))); P##2 = (f2key(ACC[2]) & ~0x7fu) | (unsigned)(127 - (98 + 4 * (HH))); P##3 = (f2key(ACC[3]) & ~0x7fu) | (unsigned)(127 - (99 + 4 * (HH))); P##4 = (f2key(ACC[4]) & ~0x7fu) | (unsigned)(127 - (104 + 4 * (HH))); P##5 = (f2key(ACC[5]) & ~0x7fu) | (unsigned)(127 - (105 + 4 * (HH))); P##6 = (f2key(ACC[6]) & ~0x7fu) | (unsigned)(127 - (106 + 4 * (HH))); P##7 = (f2key(ACC[7]) & ~0x7fu) | (unsigned)(127 - (107 + 4 * (HH))); P##8 = (f2key(ACC[8]) & ~0x7fu) | (unsigned)(127 - (112 + 4 * (HH))); P##9 = (f2key(ACC[9]) & ~0x7fu) | (unsigned)(127 - (113 + 4 * (HH))); P##10 = (f2key(ACC[10]) & ~0x7fu) | (unsigned)(127 - (114 + 4 * (HH))); P##11 = (f2key(ACC[11]) & ~0x7fu) | (unsigned)(127 - (115 + 4 * (HH))); P##12 = (f2key(ACC[12]) & ~0x7fu) | (unsigned)(127 - (120 + 4 * (HH))); P##13 = (f2key(ACC[13]) & ~0x7fu) | (unsigned)(127 - (121 + 4 * (HH))); P##14 = (f2key(ACC[14]) & ~0x7fu) | (unsigned)(127 - (122 + 4 * (HH))); P##15 = (f2key(ACC[15]) & ~0x7fu) | (unsigned)(127 - (123 + 4 * (HH))); } while (0)
#define XCHG16(O, A) do { O##0 = (unsigned)__shfl_xor((int)A##0, 32); O##1 = (unsigned)__shfl_xor((int)A##1, 32); O##2 = (unsigned)__shfl_xor((int)A##2, 32); O##3 = (unsigned)__shfl_xor((int)A##3, 32); O##4 = (unsigned)__shfl_xor((int)A##4, 32); O##5 = (unsigned)__shfl_xor((int)A##5, 32); O##6 = (unsigned)__shfl_xor((int)A##6, 32); O##7 = (unsigned)__shfl_xor((int)A##7, 32); O##8 = (unsigned)__shfl_xor((int)A##8, 32); O##9 = (unsigned)__shfl_xor((int)A##9, 32); O##10 = (unsigned)__shfl_xor((int)A##10, 32); O##11 = (unsigned)__shfl_xor((int)A##11, 32); O##12 = (unsigned)__shfl_xor((int)A##12, 32); O##13 = (unsigned)__shfl_xor((int)A##13, 32); O##14 = (unsigned)__shfl_xor((int)A##14, 32); O##15 = (unsigned)__shfl_xor((int)A##15, 32); } while (0)
#define COPY16(D, S) do { D##0 = S##0; D##1 = S##1; D##2 = S##2; D##3 = S##3; D##4 = S##4; D##5 = S##5; D##6 = S##6; D##7 = S##7; D##8 = S##8; D##9 = S##9; D##10 = S##10; D##11 = S##11; D##12 = S##12; D##13 = S##13; D##14 = S##14; D##15 = S##15; } while (0)
#define FILL_CANDS() do { ck0_0 = (f2key(key2f(ta0 & ~0x7fu) + key2f(tb0 & ~0x7fu)) & ~0xffu) | 255u; ck0_1 = (f2key(key2f(ta0 & ~0x7fu) + key2f(tb1 & ~0x7fu)) & ~0xffu) | 254u; ck0_2 = (f2key(key2f(ta0 & ~0x7fu) + key2f(tb2 & ~0x7fu)) & ~0xffu) | 253u; ck0_3 = (f2key(key2f(ta0 & ~0x7fu) + key2f(tb3 & ~0x7fu)) & ~0xffu) | 252u; ck0_4 = (f2key(key2f(ta0 & ~0x7fu) + key2f(tb4 & ~0x7fu)) & ~0xffu) | 251u; ck0_5 = (f2key(key2f(ta0 & ~0x7fu) + key2f(tb5 & ~0x7fu)) & ~0xffu) | 250u; ck0_6 = (f2key(key2f(ta0 & ~0x7fu) + key2f(tb6 & ~0x7fu)) & ~0xffu) | 249u; ck0_7 = (f2key(key2f(ta0 & ~0x7fu) + key2f(tb7 & ~0x7fu)) & ~0xffu) | 248u; ck0_8 = (f2key(key2f(ta0 & ~0x7fu) + key2f(tb8 & ~0x7fu)) & ~0xffu) | 247u; ck0_9 = (f2key(key2f(ta0 & ~0x7fu) + key2f(tb9 & ~0x7fu)) & ~0xffu) | 246u; ck0_10 = (f2key(key2f(ta0 & ~0x7fu) + key2f(tb10 & ~0x7fu)) & ~0xffu) | 245u; ck0_11 = (f2key(key2f(ta0 & ~0x7fu) + key2f(tb11 & ~0x7fu)) & ~0xffu) | 244u; ck0_12 = (f2key(key2f(ta0 & ~0x7fu) + key2f(tb12 & ~0x7fu)) & ~0xffu) | 243u; ck0_13 = (f2key(key2f(ta0 & ~0x7fu) + key2f(tb13 & ~0x7fu)) & ~0xffu) | 242u; ck0_14 = (f2key(key2f(ta0 & ~0x7fu) + key2f(tb14 & ~0x7fu)) & ~0xffu) | 241u; ck0_15 = (f2key(key2f(ta0 & ~0x7fu) + key2f(tb15 & ~0x7fu)) & ~0xffu) | 240u; ck1_0 = (f2key(key2f(ta1 & ~0x7fu) + key2f(tb0 & ~0x7fu)) & ~0xffu) | 239u; ck1_1 = (f2key(key2f(ta1 & ~0x7fu) + key2f(tb1 & ~0x7fu)) & ~0xffu) | 238u; ck1_2 = (f2key(key2f(ta1 & ~0x7fu) + key2f(tb2 & ~0x7fu)) & ~0xffu) | 237u; ck1_3 = (f2key(key2f(ta1 & ~0x7fu) + key2f(tb3 & ~0x7fu)) & ~0xffu) | 236u; ck1_4 = (f2key(key2f(ta1 & ~0x7fu) + key2f(tb4 & ~0x7fu)) & ~0xffu) | 235u; ck1_5 = (f2key(key2f(ta1 & ~0x7fu) + key2f(tb5 & ~0x7fu)) & ~0xffu) | 234u; ck1_6 = (f2key(key2f(ta1 & ~0x7fu) + key2f(tb6 & ~0x7fu)) & ~0xffu) | 233u; ck1_7 = (f2key(key2f(ta1 & ~0x7fu) + key2f(tb7 & ~0x7fu)) & ~0xffu) | 232u; ck1_8 = (f2key(key2f(ta2 & ~0x7fu) + key2f(tb0 & ~0x7fu)) & ~0xffu) | 223u; ck1_9 = (f2key(key2f(ta2 & ~0x7fu) + key2f(tb1 & ~0x7fu)) & ~0xffu) | 222u; ck1_10 = (f2key(key2f(ta2 & ~0x7fu) + key2f(tb2 & ~0x7fu)) & ~0xffu) | 221u; ck1_11 = (f2key(key2f(ta2 & ~0x7fu) + key2f(tb3 & ~0x7fu)) & ~0xffu) | 220u; ck1_12 = (f2key(key2f(ta2 & ~0x7fu) + key2f(tb4 & ~0x7fu)) & ~0xffu) | 219u; ck1_13 = (f2key(key2f(ta3 & ~0x7fu) + key2f(tb0 & ~0x7fu)) & ~0xffu) | 207u; ck1_14 = (f2key(key2f(ta3 & ~0x7fu) + key2f(tb1 & ~0x7fu)) & ~0xffu) | 206u; ck1_15 = (f2key(key2f(ta3 & ~0x7fu) + key2f(tb2 & ~0x7fu)) & ~0xffu) | 205u; ck2_0 = (f2key(key2f(ta3 & ~0x7fu) + key2f(tb3 & ~0x7fu)) & ~0xffu) | 204u; ck2_1 = (f2key(key2f(ta4 & ~0x7fu) + key2f(tb0 & ~0x7fu)) & ~0xffu) | 191u; ck2_2 = (f2key(key2f(ta4 & ~0x7fu) + key2f(tb1 & ~0x7fu)) & ~0xffu) | 190u; ck2_3 = (f2key(key2f(ta4 & ~0x7fu) + key2f(tb2 & ~0x7fu)) & ~0xffu) | 189u; ck2_4 = (f2key(key2f(ta5 & ~0x7fu) + key2f(tb0 & ~0x7fu)) & ~0xffu) | 175u; ck2_5 = (f2key(key2f(ta5 & ~0x7fu) + key2f(tb1 & ~0x7fu)) & ~0xffu) | 174u; ck2_6 = (f2key(key2f(ta6 & ~0x7fu) + key2f(tb0 & ~0x7fu)) & ~0xffu) | 159u; ck2_7 = (f2key(key2f(ta6 & ~0x7fu) + key2f(tb1 & ~0x7fu)) & ~0xffu) | 158u; ck2_8 = (f2key(key2f(ta7 & ~0x7fu) + key2f(tb0 & ~0x7fu)) & ~0xffu) | 143u; ck2_9 = (f2key(key2f(ta7 & ~0x7fu) + key2f(tb1 & ~0x7fu)) & ~0xffu) | 142u; ck2_10 = (f2key(key2f(ta8 & ~0x7fu) + key2f(tb0 & ~0x7fu)) & ~0xffu) | 127u; ck2_11 = (f2key(key2f(ta9 & ~0x7fu) + key2f(tb0 & ~0x7fu)) & ~0xffu) | 111u; ck2_12 = (f2key(key2f(ta10 & ~0x7fu) + key2f(tb0 & ~0x7fu)) & ~0xffu) | 95u; ck2_13 = (f2key(key2f(ta11 & ~0x7fu) + key2f(tb0 & ~0x7fu)) & ~0xffu) | 79u; ck2_14 = (f2key(key2f(ta12 & ~0x7fu) + key2f(tb0 & ~0x7fu)) & ~0xffu) | 63u; ck2_15 = (f2key(key2f(ta13 & ~0x7fu) + key2f(tb0 & ~0x7fu)) & ~0xffu) | 47u; ck3_0 = (f2key(key2f(ta14 & ~0x7fu) + key2f(tb0 & ~0x7fu)) & ~0xffu) | 31u; ck3_1 = (f2key(key2f(ta15 & ~0x7fu) + key2f(tb0 & ~0x7fu)) & ~0xffu) | 15u; ck3_2 = 0u; ck3_3 = 0u; ck3_4 = 0u; ck3_5 = 0u; ck3_6 = 0u; ck3_7 = 0u; ck3_8 = 0u; ck3_9 = 0u; ck3_10 = 0u; ck3_11 = 0u; ck3_12 = 0u; ck3_13 = 0u; ck3_14 = 0u; ck3_15 = 0u; } while (0)
#define WRITE_LUT(LP) do { *(LAS u32x4*)(LP) = (u32x4){((127u - (ta0 & 127u)) << 0) | ((127u - (ta1 & 127u)) << 8) | ((127u - (ta2 & 127u)) << 16) | ((127u - (ta3 & 127u)) << 24), ((127u - (ta4 & 127u)) << 0) | ((127u - (ta5 & 127u)) << 8) | ((127u - (ta6 & 127u)) << 16) | ((127u - (ta7 & 127u)) << 24), ((127u - (ta8 & 127u)) << 0) | ((127u - (ta9 & 127u)) << 8) | ((127u - (ta10 & 127u)) << 16) | ((127u - (ta11 & 127u)) << 24), ((127u - (ta12 & 127u)) << 0) | ((127u - (ta13 & 127u)) << 8) | ((127u - (ta14 & 127u)) << 16) | ((127u - (ta15 & 127u)) << 24)}; *(LAS u32x4*)((LP) + 16) = (u32x4){((127u - (tb0 & 127u)) << 0) | ((127u - (tb1 & 127u)) << 8) | ((127u - (tb2 & 127u)) << 16) | ((127u - (tb3 & 127u)) << 24), ((127u - (tb4 & 127u)) << 0) | ((127u - (tb5 & 127u)) << 8) | ((127u - (tb6 & 127u)) << 16) | ((127u - (tb7 & 127u)) << 24), ((127u - (tb8 & 127u)) << 0) | ((127u - (tb9 & 127u)) << 8) | ((127u - (tb10 & 127u)) << 16) | ((127u - (tb11 & 127u)) << 24), ((127u - (tb12 & 127u)) << 0) | ((127u - (tb13 & 127u)) << 8) | ((127u - (tb14 & 127u)) << 16) | ((127u - (tb15 & 127u)) << 24)}; } while (0)
#define LOOKUP16(PQ, K, LP) do { { const unsigned _f = 255u - (K##0 & 255u); PQ##0 = (unsigned)(LP)[_f >> 4] * 128u + (unsigned)(LP)[16u + (_f & 15u)]; } { const unsigned _f = 255u - (K##1 & 255u); PQ##1 = (unsigned)(LP)[_f >> 4] * 128u + (unsigned)(LP)[16u + (_f & 15u)]; } { const unsigned _f = 255u - (K##2 & 255u); PQ##2 = (unsigned)(LP)[_f >> 4] * 128u + (unsigned)(LP)[16u + (_f & 15u)]; } { const unsigned _f = 255u - (K##3 & 255u); PQ##3 = (unsigned)(LP)[_f >> 4] * 128u + (unsigned)(LP)[16u + (_f & 15u)]; } { const unsigned _f = 255u - (K##4 & 255u); PQ##4 = (unsigned)(LP)[_f >> 4] * 128u + (unsigned)(LP)[16u + (_f & 15u)]; } { const unsigned _f = 255u - (K##5 & 255u); PQ##5 = (unsigned)(LP)[_f >> 4] * 128u + (unsigned)(LP)[16u + (_f & 15u)]; } { const unsigned _f = 255u - (K##6 & 255u); PQ##6 = (unsigned)(LP)[_f >> 4] * 128u + (unsigned)(LP)[16u + (_f & 15u)]; } { const unsigned _f = 255u - (K##7 & 255u); PQ##7 = (unsigned)(LP)[_f >> 4] * 128u + (unsigned)(LP)[16u + (_f & 15u)]; } { const unsigned _f = 255u - (K##8 & 255u); PQ##8 = (unsigned)(LP)[_f >> 4] * 128u + (unsigned)(LP)[16u + (_f & 15u)]; } { const unsigned _f = 255u - (K##9 & 255u); PQ##9 = (unsigned)(LP)[_f >> 4] * 128u + (unsigned)(LP)[16u + (_f & 15u)]; } { const unsigned _f = 255u - (K##10 & 255u); PQ##10 = (unsigned)(LP)[_f >> 4] * 128u + (unsigned)(LP)[16u + (_f & 15u)]; } { const unsigned _f = 255u - (K##11 & 255u); PQ##11 = (unsigned)(LP)[_f >> 4] * 128u + (unsigned)(LP)[16u + (_f & 15u)]; } { const unsigned _f = 255u - (K##12 & 255u); PQ##12 = (unsigned)(LP)[_f >> 4] * 128u + (unsigned)(LP)[16u + (_f & 15u)]; } { const unsigned _f = 255u - (K##13 & 255u); PQ##13 = (unsigned)(LP)[_f >> 4] * 128u + (unsigned)(LP)[16u + (_f & 15u)]; } { const unsigned _f = 255u - (K##14 & 255u); PQ##14 = (unsigned)(LP)[_f >> 4] * 128u + (unsigned)(LP)[16u + (_f & 15u)]; } { const unsigned _f = 255u - (K##15 & 255u); PQ##15 = (unsigned)(LP)[_f >> 4] * 128u + (unsigned)(LP)[16u + (_f & 15u)]; } } while (0)
#define GATES16(E, K, MX, SUM) do { E##0 = __expf(key2f(K##0 & ~0xffu) - (MX)); SUM += E##0; E##1 = __expf(key2f(K##1 & ~0xffu) - (MX)); SUM += E##1; E##2 = __expf(key2f(K##2 & ~0xffu) - (MX)); SUM += E##2; E##3 = __expf(key2f(K##3 & ~0xffu) - (MX)); SUM += E##3; E##4 = __expf(key2f(K##4 & ~0xffu) - (MX)); SUM += E##4; E##5 = __expf(key2f(K##5 & ~0xffu) - (MX)); SUM += E##5; E##6 = __expf(key2f(K##6 & ~0xffu) - (MX)); SUM += E##6; E##7 = __expf(key2f(K##7 & ~0xffu) - (MX)); SUM += E##7; E##8 = __expf(key2f(K##8 & ~0xffu) - (MX)); SUM += E##8; E##9 = __expf(key2f(K##9 & ~0xffu) - (MX)); SUM += E##9; E##10 = __expf(key2f(K##10 & ~0xffu) - (MX)); SUM += E##10; E##11 = __expf(key2f(K##11 & ~0xffu) - (MX)); SUM += E##11; E##12 = __expf(key2f(K##12 & ~0xffu) - (MX)); SUM += E##12; E##13 = __expf(key2f(K##13 & ~0xffu) - (MX)); SUM += E##13; E##14 = __expf(key2f(K##14 & ~0xffu) - (MX)); SUM += E##14; E##15 = __expf(key2f(K##15 & ~0xffu) - (MX)); SUM += E##15; } while (0)
#define STORE_GATES(GP, EP, E, PQ, INV) do { *(f32x4*)((GP) + 0) = (f32x4){E##0 * (INV), E##1 * (INV), E##2 * (INV), E##3 * (INV)}; *(u32x4*)((EP) + 0) = (u32x4){PQ##0, PQ##1, PQ##2, PQ##3}; *(f32x4*)((GP) + 4) = (f32x4){E##4 * (INV), E##5 * (INV), E##6 * (INV), E##7 * (INV)}; *(u32x4*)((EP) + 4) = (u32x4){PQ##4, PQ##5, PQ##6, PQ##7}; *(f32x4*)((GP) + 8) = (f32x4){E##8 * (INV), E##9 * (INV), E##10 * (INV), E##11 * (INV)}; *(u32x4*)((EP) + 8) = (u32x4){PQ##8, PQ##9, PQ##10, PQ##11}; *(f32x4*)((GP) + 12) = (f32x4){E##12 * (INV), E##13 * (INV), E##14 * (INV), E##15 * (INV)}; *(u32x4*)((EP) + 12) = (u32x4){PQ##12, PQ##13, PQ##14, PQ##15}; } while (0)

__device__ __forceinline__ void d_route(const Params& P, LAS unsigned char* lds, int tid, int gw, int ngw) {
    const int lane = tid & 63, wave = __builtin_amdgcn_readfirstlane(tid >> 6);
    for (int idx = tid; idx < 2 * 128 * 128 / 2; idx += 512) { const int e = idx * 2, row = e >> 7, c = e & 127;
        const float a = P.in[I_SUBKEYS][e], b = P.in[I_SUBKEYS][e + 1];
        *(LAS unsigned*)(lds + row * RT_SKROW + c * 2) = pk2(a, b); }
    asm volatile("s_waitcnt lgkmcnt(0)" ::: "memory"); __syncthreads();
    const int hh = lane >> 5, l31 = lane & 31;
#define ROUTE_HALF(QROW, SKZ, T) do { \
        bf16x8v qf[8]; f32x16v acc[4]; \
        _Pragma("unroll") for (int ks = 0; ks < 8; ++ks) qf[ks] = *(const bf16x8v*)((QROW) + ks * 16 + 8 * hh); \
        _Pragma("unroll") for (int kb = 0; kb < 4; ++kb) { \
            _Pragma("unroll") for (int i = 0; i < 16; ++i) acc[kb][i] = 0.f; \
            _Pragma("unroll") for (int ks = 0; ks < 8; ++ks) { const bf16x8v af = *(const LAS bf16x8v*)((SKZ) + (kb * 32 + l31) * RT_SKROW + (ks * 16 + 8 * hh) * 2); \
                acc[kb] = __builtin_amdgcn_mfma_f32_32x32x16_bf16(af, qf[ks], acc[kb], 0, 0, 0); } } \
        DECL16(unsigned, ga); DECL16(unsigned, gb); DECL16(unsigned, gc); DECL16(unsigned, gd); DECL16(unsigned, ob); \
        __builtin_amdgcn_sched_barrier(0); FILL_G0(ga, acc[0], hh); SORT16_DESC(ga); __builtin_amdgcn_sched_barrier(0); FILL_G1(gb, acc[1], hh); SORT16_DESC(gb); __builtin_amdgcn_sched_barrier(0); MERGE16_DESC(ga, gb); __builtin_amdgcn_sched_barrier(0); \
        FILL_G2(gc, acc[2], hh); SORT16_DESC(gc); __builtin_amdgcn_sched_barrier(0); FILL_G3(gd, acc[3], hh); SORT16_DESC(gd); __builtin_amdgcn_sched_barrier(0); MERGE16_DESC(gc, gd); __builtin_amdgcn_sched_barrier(0); MERGE16_DESC(ga, gc); __builtin_amdgcn_sched_barrier(0); \
        XCHG16(ob, ga); MERGE16_DESC(ga, ob); COPY16(T, ga); __builtin_amdgcn_sched_barrier(0); } while (0)
#pragma unroll 1
    for (int task = gw; task < TOK * 8 / 32; task += ngw) {
        const long r0 = (long)task * 32; const bf16_t* qrow = P.QP + (size_t)(r0 + l31) * 256;
        DECL16(unsigned, ta); DECL16(unsigned, tb);
        ROUTE_HALF(qrow, lds, ta);
        ROUTE_HALF(qrow + 128, lds + 128 * RT_SKROW, tb);
        DECL16(unsigned, ck0_); DECL16(unsigned, ck1_); DECL16(unsigned, ck2_); DECL16(unsigned, ck3_);
        LAS unsigned char* lut = lds + 2 * 128 * RT_SKROW + wave * 1024 + l31 * 32;
        WRITE_LUT(lut);
        FILL_CANDS(); __builtin_amdgcn_sched_barrier(0);
        SORT16_DESC(ck0_); __builtin_amdgcn_sched_barrier(0); SORT16_DESC(ck1_); __builtin_amdgcn_sched_barrier(0); MERGE16_DESC(ck0_, ck1_); __builtin_amdgcn_sched_barrier(0);
        SORT16_DESC(ck2_); __builtin_amdgcn_sched_barrier(0); SORT16_DESC(ck3_); __builtin_amdgcn_sched_barrier(0); MERGE16_DESC(ck2_, ck3_); __builtin_amdgcn_sched_barrier(0); MERGE16_DESC(ck0_, ck2_); __builtin_amdgcn_sched_barrier(0);
        DECL16(unsigned, cp0_);
        LOOKUP16(cp0_, ck0_, lut);
        DECL16(float, ee); const float mx = key2f(ck0_0 & ~0xffu); float sum = 0.f;
        GATES16(ee, ck0_, mx, sum);
        const float inv = 1.0f / sum;
        if (lane < 32) { float* gp = P.GATE + (size_t)(r0 + lane) * 16; int* ep = P.EXPERT + (size_t)(r0 + lane) * 16; STORE_GATES(gp, ep, ee, cp0_, inv); }
    }
#undef ROUTE_HALF
}

__device__ __forceinline__ void d_gmlp(const Params& P, LAS unsigned char* lds, int tid) {
    const int lane = tid & 63, wave = __builtin_amdgcn_readfirstlane(tid >> 6), hh = lane >> 5, l31 = lane & 31;
    const int chunk = (int)blockIdx.x >> 1, hb = (int)blockIdx.x & 1;
    if (chunk >= TOK / 128) return;
    LAS bf16_t* VNt = (LAS bf16_t*)lds;
    {
        const int cg = hb * 256 + 8 * l31;
        const f32x4 g0 = *(const f32x4*)(P.in[I_GLN_G] + cg), g1 = *(const f32x4*)(P.in[I_GLN_G] + cg + 4);
        const f32x4 b0 = *(const f32x4*)(P.in[I_GLN_B] + cg), b1 = *(const f32x4*)(P.in[I_GLN_B] + cg + 4);
#pragma unroll 4
        for (int tt = 0; tt < 16; ++tt) { const int q = wave * 16 + tt; const long t = (long)chunk * 128 + q;
            const u32x4 w = *((const u32x4*)(P.PB + (size_t)t * 1024 + 512) + lane);
            float x[8] = {blo(w.x), bhi(w.x), blo(w.y), bhi(w.y), blo(w.z), bhi(w.z), blo(w.w), bhi(w.w)};
            float s = 0.f;
#pragma unroll
            for (int i = 0; i < 8; ++i) s += x[i];
            const float mean = wave_sum(s) * (1.f / 512.f); float s2 = 0.f;
#pragma unroll
            for (int i = 0; i < 8; ++i) { x[i] -= mean; s2 += x[i] * x[i]; }
            const float rstd = 1.f / sqrtf(wave_sum(s2) * (1.f / 512.f) + 1e-5f);
            if (hh == hb) {
#pragma unroll
                for (int i = 0; i < 8; ++i) { const float gg = (i < 4) ? g0[i] : g1[i - 4], bb = (i < 4) ? b0[i] : b1[i - 4];
                    VNt[(8 * l31 + i) * 136 + q] = f2bf(x[i] * rstd * gg + bb); } }
        }
    }
    asm volatile("s_waitcnt lgkmcnt(0)" ::: "memory"); __syncthreads();
    const int pb = wave >> 1, db = wave & 1;
#pragma unroll 1
    for (int gl = 0; gl < 4; ++gl) { const int g = 4 * hb + gl;
        f32x16v acc;
#pragma unroll
        for (int i = 0; i < 16; ++i) acc[i] = 0.f;
        const bf16_t* arow = P.WSB + ((size_t)g * 128 + pb * 32 + l31) * 128 + 8 * hh;
        const LAS bf16_t* brow = VNt + (gl * 64 + db * 32 + l31) * 136 + 8 * hh;
#pragma unroll
        for (int ks = 0; ks < 8; ++ks) { const bf16x8v af = *(const bf16x8v*)(arow + ks * 16); const bf16x8v bfr = *(const LAS bf16x8v*)(brow + ks * 16);
            acc = __builtin_amdgcn_mfma_f32_32x32x16_bf16(af, bfr, acc, 0, 0, 0); }
        const int c = g * 64 + db * 32 + l31;
#pragma unroll
        for (int r = 0; r < 16; ++r) { const int p = pb * 32 + (r & 3) + 8 * (r >> 2) + 4 * hh; const long t = (long)chunk * 128 + p;
            const float sv = acc[r] + P.in[I_B_S][g * 128 + p];
            P.YB[(size_t)t * 512 + c] = f2bf(bf2f(P.PB[(size_t)t * 1024 + c]) * sv); }
    }
}
constexpr int RING_BYTES = 131072, LDSCTL_OFF = RING_BYTES, MISC_OFF = LDSCTL_OFF + 320, LDS_BYTES = 147456;
constexpr int CW_BAR = 4096;
#ifndef MK_PER_PHASE
#define MK_PER_PHASE 0
#endif
struct KArgs { Params P; };
template <class DE, bool ALIGN = true> __device__ __forceinline__ void run_gemm(LAS unsigned char* lds, const bf16_t* A, const bf16_t* Bt, int M, int N, int K, const DE& E,
                                                                     int bgrp = 1 << 30, size_t bgstride = 0) {
    pg8::Gemm g{A, Bt, M, N, K, K, K, bgrp, bgstride}; pg8::StaticOrder S; S.init(M, N, (int)gridDim.x, (int)blockIdx.x);
    pg8::gemm_phase<DE, pg8::StaticOrder, ALIGN, true>(lds, g, S, E);
}
__global__ void __launch_bounds__(512, 2) mega_fwd(KArgs a) {
    extern __shared__ __attribute__((aligned(16))) unsigned char lds_raw[];
    LAS unsigned char* lds = (LAS unsigned char*)lds_raw;
    volatile LAS unsigned* MISC = (volatile LAS unsigned*)(lds + MISC_OFF);
    const Params& P = a.P;
    const int tid = threadIdx.x;
    for (int u = tid; u < (LDS_BYTES - LDSCTL_OFF) / 4; u += 512) ((LAS unsigned*)(lds + LDSCTL_OFF))[u] = 0u;
    __syncthreads();
    XcdBarrier bar; bar.bar = P.ctl + CW_BAR; bar.x = 0; bar.st = nullptr;
    bar = xcd_barrier_post(P.ctl + CW_BAR, MISC + 8);
    const long gtid = (long)blockIdx.x * 512 + tid, nthr = (long)gridDim.x * 512;
    const int lane = tid & 63, wave = __builtin_amdgcn_readfirstlane(tid >> 6), gw = (int)blockIdx.x * 8 + wave, ngw = (int)gridDim.x * 8;
#ifndef PROBE_ID
#define PROBE_ID -1
#endif
#define PHASE(id, body) do { _Pragma("unroll 1") for (int rep_ = 0; rep_ < ((PROBE_ID == (id)) ? 2 : 1); ++rep_) { body; xcd_barrier(bar); } } while (0)
    PHASE(0, (d_weights(P, lds, gw, ngw, wave, lane), d_lora_weights(P, gtid, nthr), d_ln_rows(P.in[I_X], P.in[I_LN_EMB_G], P.in[I_LN_EMB_B], P.HB, TOK, gw, ngw, lane),
           d_ln_rows(P.in[I_MEM], P.in[I_MLN_G], P.in[I_MLN_B], P.MEMN, BATCH * MEM_LEN, gw, ngw, lane)));
    PHASE(1, ({ { pg8::DEpiP1 E{{P.PA, P.PB}}; run_gemm(lds, P.HB, P.W_IN_T, TOK, 3072, 1024, E); }
             { pg8::DEpiTile E2{P.KH, 4, 1, 1.0f}; run_gemm(lds, P.MEMN, P.W_KV_T, BATCH * MEM_LEN, 1024, 1024, E2); }
             { pg8::DEpiTile E3{P.VT, 1, 4, 1.0f}; run_gemm(lds, P.W_KV_T + (size_t)1024 * 1024, P.MEMN, 1024, BATCH * MEM_LEN, 1024, E3); } }));
    PHASE(2, (d_gmlp(P, lds, tid), d_prep_e1(P, gw, ngw, lane)));
    PHASE(3, ({ { pg8::DEpiLora<0> E{P.in[I_W0], P.OMW}; run_gemm(lds, P.LIN, P.W_LORA_T, TOK, 1024, 512, E); }
             { pg8::DEpiLora<1> E{P.in[I_A0], P.AL}; run_gemm(lds, P.LIN, P.W_LORA_T + (size_t)1024 * 512, TOK, 1024, 512, E); }
             { pg8::DEpiLora<2> E{nullptr, P.G}; run_gemm(lds, P.LIN, P.W_LORA_T + (size_t)2048 * 512, TOK, 512, 512, E); } }));
    PHASE(4, d_scan(P, lds, tid));
    PHASE(5, d_rwkv_out(P, gw, ngw, lane));
    PHASE(6, ({ { pg8::DEpiPlain E{{P.BR, 2048, 0}}; run_gemm(lds, P.YA, P.W_BR_T, TOK, 1024, 512, E); }
             { pg8::DEpiPlain E2{{P.BR, 2048, 1024}}; run_gemm(lds, P.YB, P.W_BR_T + (size_t)1024 * 512, TOK, 1024, 512, E2); } }));
    PHASE(7, ({ pg8::DEpiMerge E{{P.BR, P.MG}}; run_gemm(lds, P.HB, P.W_IN_T + (size_t)3072 * 1024, TOK, 2048, 1024, E); }));
    PHASE(8, ({ pg8::DEpiResid E{{P.HB, P.Z}}; run_gemm(lds, P.MG, P.W_MIX_T, TOK, 1024, 1024, E); }));
    PHASE(9, d_ln_rows(P.Z, P.in[I_LN1_G], P.in[I_LN1_B], P.HB, TOK, gw, ngw, lane));
    PHASE(10, ({ pg8::DEpiQ EQ{{P.QH, 1, 0, 0.0625f}}; run_gemm(lds, P.HB, P.W_Q_T, TOK, 1024, 1024, EQ); }));
    PHASE(11, ({ pg8::DEpiSoftmax E{P.PP}; run_gemm<pg8::DEpiSoftmax, false>(lds, P.QH, P.KH, TOK * 4, 256, 256, E, 8, (size_t)256 * 256 * 2); }));
    PHASE(12, ({ pg8::DEpiO E{P.O}; run_gemm(lds, P.PP, P.VT, TOK * 4, 256, 256, E, 8, (size_t)256 * 256 * 2); }));
    PHASE(13, ({ pg8::DEpiResid E{{P.HB, P.Z}}; run_gemm(lds, P.O, P.W_O_T, TOK, 1024, 1024, E); }));
    PHASE(14, d_ln_rows(P.Z, P.in[I_LN2_G], P.in[I_LN2_B], P.HB, TOK, gw, ngw, lane));
    PHASE(15, ({ pg8::DEpiPlain E{{P.QP, 2048, 0}}; run_gemm(lds, P.HB, P.W_QUERY_T, TOK, 2048, 1024, E); }));
#if PEER_FP8
    PHASE(16, (d_route(P, lds, tid, gw, ngw), d_tables8(P, gw, ngw, lane)));
    d_peer8(P, gw, ngw, lane);
    if (PROBE_ID == 99) { xcd_barrier(bar); d_peer8(P, gw, ngw, lane); }
#else
    PHASE(16, (d_route(P, lds, tid, gw, ngw), d_tables(P, gtid, nthr)));
    d_peer(P, gw, ngw, lane);
#endif
#undef PHASE
}
extern "C" void kernel_launch(void* const* d_in, const int* in_sizes, int n_in, void* d_out, int out_size, void* d_ws, size_t ws_size, hipStream_t stream) {
    static int grid = 0;
    if (grid == 0) {
        int dev = 0, cus = 0;
        if (n_in != 37 || ws_size < WS_NEED || hipGetDevice(&dev) != hipSuccess || hipDeviceGetAttribute(&cus, hipDeviceAttributeMultiprocessorCount, dev) != hipSuccess) {
            fprintf(stderr, "kernel_launch: bad arguments (n_in %d, ws %zu < %zu)\n", n_in, ws_size, (size_t)WS_NEED); grid = -1; return; }
        if (hipFuncSetAttribute((const void*)mega_fwd, hipFuncAttributeMaxDynamicSharedMemorySize, LDS_BYTES) != hipSuccess) { fprintf(stderr, "kernel_launch: hipFuncSetAttribute failed\n"); grid = -1; return; }
        grid = cus;
    }
    if (grid < 0) return;
    (void)hipMemsetAsync((char*)d_ws + WS_CTL, 0, 1 * MiB, stream);
    KArgs a; memset(&a, 0, sizeof(a)); make_params(a.P, d_in, d_out, d_ws);
    hipLaunchKernelGGL(mega_fwd, dim3(grid), dim3(512), LDS_BYTES, stream, a);
}
#endif
```

```cpp
#ifdef HOST_EMU
#include "emu.h"
#else
#include <hip/hip_runtime.h>
#include <cstdio>
#include <cstdint>
#include <cstring>
#endif

#ifndef BATCH
#define BATCH 8
#endif
#ifndef SEQ
#define SEQ 2048
#endif
#define DM 1024
#define TOK (BATCH * SEQ)
#define IN_COLS 4992
#define MEM_LEN 256
#define ALPHA_F 1.189207115002721f
typedef unsigned short bf16_t;

#ifdef HOST_EMU
static inline float bf2f(bf16_t v) { unsigned u = (unsigned)v << 16; float f; memcpy(&f, &u, 4); return f; }
static inline bf16_t f2bf(float f) { unsigned u; memcpy(&u, &f, 4); return (bf16_t)((u + 0x7fffu + ((u >> 16) & 1u)) >> 16); }
#else
__device__ __forceinline__ float bf2f(bf16_t v) { return __uint_as_float((unsigned)v << 16); }
__device__ __forceinline__ bf16_t f2bf(float f) { unsigned u = __float_as_uint(f); return (bf16_t)((u + 0x7fffu + ((u >> 16) & 1u)) >> 16); }
#endif
__device__ __forceinline__ float sigmoidf_(float x) { return 1.0f / (1.0f + expf(-x)); }
__device__ __forceinline__ float geluf_(float x) { return 0.5f * x * (1.0f + erff(x * 0.7071067811865476f)); }

struct Params {
    const float* in[37];
    float* out;
    unsigned* ctl;
    bf16_t *W_IN_T, *W_BR_T, *W_MIX_T, *W_Q_T, *W_KV_T, *W_O_T, *W_QUERY_T;
    bf16_t *KV, *MEMN, *HB;
    bf16_t *PA, *PB, *VN, *YB;
    bf16_t *WDS, *ADS, *SG;
    bf16_t *R, *V, *KK, *OMW, *KDIR, *BVEC;
    float *Y01;
    bf16_t *YA, *BR, *MG;
    float* Z;
    bf16_t *Q, *O;
    float* SCA;
    bf16_t* QP;
    float* SC; float* TOPS; int* TOPI; float* GATE; int* EXPERT; float* COEF; float* Y;
    bf16_t *UB, *VB;
    unsigned char *U8, *V8; float *SU, *SV;
    bf16_t *W_LORA_T;
    bf16_t *WSB;
    bf16_t *LIN, *K, *AL, *G;
    bf16_t *KH, *VT, *QH, *PP;
};
enum { I_X = 0, I_MEM, I_LN_EMB_G, I_LN_EMB_B, I_W_IN, I_MU, I_W0, I_W2, I_A0, I_A2, I_G2, I_K_K, I_K_A, I_R_K, I_GN_G, I_GN_B,
       I_GLN_G, I_GLN_B, I_W_S, I_B_S, I_W_BRANCH, I_W_MIX, I_LN1_G, I_LN1_B, I_MLN_G, I_MLN_B, I_W_Q, I_W_KV, I_W_O, I_LN2_G, I_LN2_B,
       I_W_QUERY, I_SUBKEYS, I_PEER_U, I_PEER_V, I_LN3_G, I_LN3_B };

constexpr size_t MiB = 1u << 20;
constexpr size_t TU = (size_t)TOK * 1024;
constexpr size_t WS_CTL = 0;
constexpr size_t WS_W = 1 * MiB;
constexpr size_t OFF_W_IN = 0, OFF_W_BR = OFF_W_IN + (size_t)5120 * 1024 * 2, OFF_W_MIX = OFF_W_BR + (size_t)2048 * 512 * 2,
                 OFF_W_Q = OFF_W_MIX + (size_t)1024 * 1024 * 2, OFF_W_KV = OFF_W_Q + (size_t)1024 * 1024 * 2,
                 OFF_W_O = OFF_W_KV + (size_t)2048 * 1024 * 2, OFF_W_QUERY = OFF_W_O + (size_t)1024 * 1024 * 2,
                 OFF_W_END = OFF_W_QUERY + (size_t)2048 * 1024 * 2;
static_assert(OFF_W_END <= 27 * MiB, "weights region");
constexpr size_t OFF_W_LORA = OFF_W_END, OFF_W_END2 = OFF_W_LORA + (size_t)2560 * 512 * 2;
constexpr size_t OFF_WSB = OFF_W_END2;
static_assert(OFF_WSB + 8 * 128 * 128 * 2 <= 29 * MiB, "weights region 2");
constexpr size_t WS_KV = 30 * MiB;
constexpr size_t WS_MEMN = 38 * MiB;
constexpr size_t WS_ACT = 42 * MiB;
constexpr size_t A_HB = WS_ACT;
constexpr size_t A_R1 = A_HB + 2 * TU;
constexpr size_t A_R2 = A_R1 + 4 * TU;
constexpr size_t WS_NEED = A_R2 + 7 * TU;
#ifndef HOST_EMU
static_assert(WS_NEED <= 256 * MiB, "workspace map exceeds 256 MiB");
#endif

struct EpiP1 { bf16_t* PA; bf16_t* PB; };
struct EpiPlain { bf16_t* O; int ldc; int col_off; };
struct EpiMerge { const bf16_t* BR; bf16_t* MG; };
struct EpiResid { const bf16_t* H; float* Z; };

#ifndef HOST_EMU
namespace pg8 {
#define PG8_LAS __attribute__((address_space(3)))
typedef unsigned short bf16_t;
typedef short bf16x8 __attribute__((ext_vector_type(8)));
typedef float f32x4 __attribute__((ext_vector_type(4)));
typedef unsigned u32x4 __attribute__((ext_vector_type(4)));
constexpr int BM = 256, BK = 64, HALF = 128, HTB = HALF * BK * 2  , STAGE_BYTES = 8 * HTB, NXCD = 8, WGM = 8;

__host__ __device__ __forceinline__ int lds_byte(int r, int c) { const int st = (r >> 4) * 2 + (c >> 5), rr = r & 15, cc = c & 31, ob = rr * 64 + cc * 2; return st * 1024 + (ob ^ (((ob >> 9) & 1) << 5)); }
__host__ __device__ __forceinline__ void stage_rc(int b, int& R, int& C) { const int st = b / 1024, sb = b % 1024, swz = sb ^ (((sb >> 9) & 1) << 5); R = (st >> 1) * 16 + swz / 64; C = (st & 1) * 32 + (swz % 64) / 2; }
__host__ __device__ __forceinline__ int perm32(int rho) { const int n = rho >> 4, i = rho & 15; return 8 * (i >> 2) + 4 * n + (i & 3); }

struct Unit { int pm, pn; };
struct Gemm { const bf16_t* A; const bf16_t* Bt; int M, N, K; int lda, ldb; int bgrp; size_t bgstride; };

struct StaticOrder {
    int nM, nN, nwg, G, c;
    __host__ __device__ void init(int M, int N, int G_, int c_) { nM = M / BM; nN = N / BM; nwg = nM * nN; G = G_; c = c_; }
    __host__ __device__ bool next(int i, Unit& u) const {
        const long L = (long)i * G + c; if (L >= nwg) return false;
        int wgid = (int)L; { const int q = nwg / NXCD, r = nwg % NXCD, xcd = wgid % NXCD, off = wgid / NXCD; wgid = (xcd < r ? xcd * (q + 1) : r * (q + 1) + (xcd - r) * q) + off; }
        const int nig = WGM * nN, gid = wgid / nig, fm = gid * WGM, gsz = (nM - fm) < WGM ? (nM - fm) : WGM;
        u.pm = fm + ((wgid % nig) % gsz); u.pn = (wgid % nig) / gsz; return true;
    }
    __device__ __forceinline__ void a_ready(const Unit&) const {}
    __device__ __forceinline__ void done(const Unit&) const {}
};

typedef float f32x2c __attribute__((ext_vector_type(2))); typedef __bf16 bf16x2c __attribute__((ext_vector_type(2)));
__device__ __forceinline__ unsigned cvt_pk_bf16(float lo, float hi) { const f32x2c v = {lo, hi}; const bf16x2c b = __builtin_convertvector(v, bf16x2c); return __builtin_bit_cast(unsigned, b); }
typedef float f32x2 __attribute__((ext_vector_type(2)));
__device__ __forceinline__ f32x2 gelu_pk(f32x2 v) {
    const f32x2 av = __builtin_elementwise_abs(v), d = av * 0.2316418882f + 1.0f;
    f32x2 t; t.x = __builtin_amdgcn_rcpf(d.x); t.y = __builtin_amdgcn_rcpf(d.y);
    f32x2 q = t * 0.5307027145f + (-0.7265760135f); q = q * t + 0.7107068705f; q = q * t + (-0.142248368f); q = q * t + 0.127414796f; q = q * t;
    const f32x2 s = (v * v) * (-0.72134752044f);
    f32x2 e; e.x = __builtin_amdgcn_exp2f(s.x); e.y = __builtin_amdgcn_exp2f(s.y);
    const f32x2 m = v * (q * e), r = v - m;
    f32x2 o; o.x = v.x < 0.f ? m.x : r.x; o.y = v.y < 0.f ? m.y : r.y; return o;
}


template <class Epi, class Sched, bool ALIGN_EPI = false, bool SP2 = false>
__device__ __forceinline__ void gemm_phase(PG8_LAS unsigned char* lds, const Gemm g, const Sched& S, const Epi& E) {
    int tid_ = threadIdx.x; asm volatile("" : "+v"(tid_));
    const int tid = tid_, wid = __builtin_amdgcn_readfirstlane(tid >> 6), lane = tid & 63, wr = wid >> 2, wc = wid & 3, fr = lane & 15, fq = lane >> 4;
    const int K = g.K, nt = K / BK;
    unsigned voffA[2], voffB[2];
#pragma unroll
    for (int i = 0; i < 2; ++i) { int R, C; stage_rc(tid * 16 + i * 8192, R, C); const int Rb = Epi::PERM ? ((R & ~31) + perm32(R & 31)) : R;
        voffA[i] = (unsigned)(R * g.lda + C) * 2u; voffB[i] = (unsigned)(Rb * g.ldb + C) * 2u; }
    const size_t kstep = (size_t)(BK * 2);
    const size_t hstepA = (size_t)HALF * g.lda * 2, hstepB = (size_t)HALF * g.ldb * 2;
    const size_t tstepA = 2 * hstepA, tstepB = 2 * hstepB;
    const unsigned ldsw = (unsigned)wid * 1024u;
    const int aoff = lds_byte(wr * 64 + fr, fq * 8), boff = lds_byte(wc * 32 + fr, fq * 8);
#define PG8_SA(b, h) (((b) * 2 + (h)) * HTB)
#define PG8_SB(b, h) ((4 + (b) * 2 + (h)) * HTB)
#define PG8_STAGE(bufoff, gbase, voff) do { _Pragma("unroll") for (int _i = 0; _i < 2; ++_i) \
        __builtin_amdgcn_global_load_lds((const unsigned*)((const char*)(gbase) + (voff)[_i]), (PG8_LAS unsigned*)(lds + (bufoff) + ldsw + _i * 8192), 16, 0, 0); } while (0)
#define PG8_LDA(dst, b, h) do { _Pragma("unroll") for (int m = 0; m < 4; ++m) _Pragma("unroll") for (int k = 0; k < 2; ++k) dst[m][k] = *(const PG8_LAS bf16x8*)(lds + PG8_SA(b, h) + aoff + m * 2048 + k * 1024); } while (0)
#define PG8_LDB(dst, b, h) do { _Pragma("unroll") for (int n = 0; n < 2; ++n) _Pragma("unroll") for (int k = 0; k < 2; ++k) dst[n][k] = *(const PG8_LAS bf16x8*)(lds + PG8_SB(b, h) + boff + n * 2048 + k * 1024); } while (0)
#define PG8_MMA(ai, bj, At, Bt) do { __builtin_amdgcn_s_setprio(1); _Pragma("unroll") for (int m = 0; m < 4; ++m) _Pragma("unroll") for (int n = 0; n < 2; ++n) _Pragma("unroll") for (int k = 0; k < 2; ++k) \
        acc[ai][bj][m][n] = __builtin_amdgcn_mfma_f32_16x16x32_bf16(Bt[n][k], At[m][k], acc[ai][bj][m][n], 0, 0, 0); __builtin_amdgcn_s_setprio(0); } while (0)
#define PG8_WAIT_V(n) asm volatile("s_waitcnt vmcnt(" #n ")" ::: "memory")
#define PG8_WAIT_L(n) asm volatile("s_waitcnt lgkmcnt(" #n ")" ::: "memory")
#define PG8_BAR __builtin_amdgcn_s_barrier()
#define PG8_SCHED __builtin_amdgcn_sched_barrier(0)
    Unit cur, nxt; int ui = 0;
    if (!S.next(0, cur)) return;
    f32x4 acc[2][2][4][2];
#pragma unroll
    for (int a = 0; a < 2; ++a)
#pragma unroll
        for (int b = 0; b < 2; ++b)
#pragma unroll
            for (int m = 0; m < 4; ++m)
#pragma unroll
                for (int n = 0; n < 2; ++n) acc[a][b][m][n] = (f32x4){0.f, 0.f, 0.f, 0.f};
    bf16x8 At[4][2], B0[2][2], B1[2][2];
    const char* cA = (const char*)g.A + (size_t)cur.pm * tstepA; const char* cB = (const char*)g.Bt + (size_t)cur.pn * tstepB + (size_t)(cur.pm / g.bgrp) * g.bgstride;
    S.a_ready(cur);
    if constexpr (SP2) {
        PG8_STAGE(PG8_SB(0, 0), cB, voffB); PG8_STAGE(PG8_SB(0, 1), cB + hstepB, voffB); PG8_STAGE(PG8_SA(0, 0), cA, voffA); PG8_STAGE(PG8_SA(0, 1), cA + hstepA, voffA);
        if (wr == 1) PG8_BAR;
        PG8_WAIT_V(2); PG8_BAR;
        PG8_STAGE(PG8_SB(1, 0), cB + kstep, voffB); PG8_STAGE(PG8_SA(1, 0), cA + kstep, voffA); PG8_STAGE(PG8_SB(1, 1), cB + hstepB + kstep, voffB);
        PG8_WAIT_V(6); PG8_BAR;
    } else {
        PG8_STAGE(PG8_SB(0, 0), cB, voffB); PG8_STAGE(PG8_SA(0, 0), cA, voffA); PG8_STAGE(PG8_SB(0, 1), cB + hstepB, voffB); PG8_STAGE(PG8_SA(0, 1), cA + hstepA, voffA);
        if (wr == 1) PG8_BAR;
        PG8_WAIT_V(4); PG8_BAR;
        PG8_STAGE(PG8_SB(1, 0), cB + kstep, voffB); PG8_STAGE(PG8_SA(1, 0), cA + kstep, voffA); PG8_STAGE(PG8_SB(1, 1), cB + hstepB + kstep, voffB);
        PG8_WAIT_V(6); PG8_BAR;
    }
    for (;;) {
        const bool has_next = S.next(ui + 1, nxt);
        const char* nA = has_next ? (const char*)g.A + (size_t)nxt.pm * tstepA : cA; const char* nB = has_next ? (const char*)g.Bt + (size_t)nxt.pn * tstepB + (size_t)(nxt.pm / g.bgrp) * g.bgstride : cB;
#pragma unroll 1
        for (int t = 0; t < nt; t += 2) {
            const bool last = (t == nt - 2);
            const char* a1 = cA + (size_t)(t + 1) * kstep;
            const char* a2 = last ? nA : cA + (size_t)(t + 2) * kstep; const char* b2 = last ? nB : cB + (size_t)(t + 2) * kstep;
            const char* a3 = a2 + kstep; const char* b3 = b2 + kstep;
            if (last && has_next) S.a_ready(nxt);
            if constexpr (SP2) {
            PG8_LDB(B0, 0, 0); PG8_LDB(B1, 0, 1); PG8_SCHED; PG8_LDA(At, 0, 0); PG8_STAGE(PG8_SA(1, 1), a1 + hstepA, voffA);
            PG8_WAIT_V(8); PG8_WAIT_L(0); PG8_BAR; PG8_MMA(0, 0, At, B0); PG8_MMA(0, 1, At, B1); PG8_BAR; PG8_SCHED;
            PG8_LDA(At, 0, 1); PG8_STAGE(PG8_SB(0, 0), b2, voffB); PG8_STAGE(PG8_SB(0, 1), b2 + hstepB, voffB); PG8_STAGE(PG8_SA(0, 0), a2, voffA);
            PG8_WAIT_V(8); PG8_WAIT_L(0); PG8_BAR; PG8_MMA(1, 0, At, B0); PG8_MMA(1, 1, At, B1); PG8_BAR; PG8_SCHED;
            PG8_LDB(B0, 1, 0); PG8_LDB(B1, 1, 1); PG8_SCHED; PG8_LDA(At, 1, 0); PG8_STAGE(PG8_SA(0, 1), a2 + hstepA, voffA);
            PG8_WAIT_V(8); PG8_WAIT_L(0); PG8_BAR; PG8_MMA(0, 0, At, B0); PG8_MMA(0, 1, At, B1); PG8_BAR; PG8_SCHED;
            PG8_LDA(At, 1, 1); PG8_STAGE(PG8_SB(1, 0), b3, voffB); PG8_STAGE(PG8_SB(1, 1), b3 + hstepB, voffB); PG8_STAGE(PG8_SA(1, 0), a3, voffA);
            PG8_WAIT_V(8); PG8_WAIT_L(0); PG8_BAR; PG8_MMA(1, 0, At, B0); PG8_MMA(1, 1, At, B1); PG8_BAR; PG8_SCHED;
            } else {
            PG8_LDB(B0, 0, 0); PG8_SCHED; PG8_LDA(At, 0, 0); PG8_STAGE(PG8_SA(1, 1), a1 + hstepA, voffA);
            PG8_WAIT_L(8); PG8_BAR; PG8_WAIT_L(0); PG8_MMA(0, 0, At, B0); PG8_BAR; PG8_SCHED;
            PG8_LDB(B1, 0, 1); PG8_STAGE(PG8_SB(0, 0), b2, voffB);
            PG8_BAR; PG8_WAIT_L(0); PG8_MMA(0, 1, At, B1); PG8_BAR;
            PG8_LDA(At, 0, 1); PG8_STAGE(PG8_SA(0, 0), a2, voffA);
            PG8_BAR; PG8_WAIT_L(0); PG8_MMA(1, 0, At, B0); PG8_BAR; PG8_SCHED;
            PG8_STAGE(PG8_SB(0, 1), b2 + hstepB, voffB);
            PG8_WAIT_V(6); PG8_BAR; PG8_MMA(1, 1, At, B1); PG8_BAR;
            PG8_LDB(B0, 1, 0); PG8_SCHED; PG8_LDA(At, 1, 0); PG8_STAGE(PG8_SA(0, 1), a2 + hstepA, voffA);
            PG8_WAIT_L(8); PG8_BAR; PG8_WAIT_L(0); PG8_MMA(0, 0, At, B0); PG8_BAR; PG8_SCHED;
            PG8_LDB(B1, 1, 1); PG8_STAGE(PG8_SB(1, 0), b3, voffB);
            PG8_BAR; PG8_WAIT_L(0); PG8_MMA(0, 1, At, B1); PG8_BAR;
            PG8_LDA(At, 1, 1); PG8_STAGE(PG8_SA(1, 0), a3, voffA);
            PG8_BAR; PG8_WAIT_L(0); PG8_MMA(1, 0, At, B0); PG8_BAR; PG8_SCHED;
            PG8_STAGE(PG8_SB(1, 1), b3 + hstepB, voffB);
            PG8_WAIT_V(6); PG8_BAR; PG8_MMA(1, 1, At, B1); PG8_BAR;
            }
        }
        if constexpr (ALIGN_EPI) { if (wr == 0) PG8_BAR; }
        if constexpr (!Epi::AFTER_DRAIN) { E(acc, cur, wr, wc, fr, fq); S.done(cur); }
        if (!has_next) break;
#pragma unroll
        for (int a = 0; a < 2; ++a)
#pragma unroll
            for (int b = 0; b < 2; ++b)
#pragma unroll
                for (int m = 0; m < 4; ++m)
#pragma unroll
                    for (int n = 0; n < 2; ++n) acc[a][b][m][n] = (f32x4){0.f, 0.f, 0.f, 0.f};
        cur = nxt; cA = nA; cB = nB; ++ui;
        if constexpr (ALIGN_EPI) { if (wr == 1) PG8_BAR; }
    }
    PG8_WAIT_V(0);
    if constexpr (!ALIGN_EPI) { if (wr == 0) PG8_BAR; }
    PG8_BAR;
    if constexpr (Epi::AFTER_DRAIN) { E.fused(acc, cur, wr, wc, fr, fq, lds, wid, lane); S.done(cur); }
#undef PG8_SA
#undef PG8_SB
#undef PG8_STAGE
#undef PG8_LDA
#undef PG8_LDB
#undef PG8_MMA
#undef PG8_WAIT_V
#undef PG8_WAIT_L
#undef PG8_BAR
#undef PG8_SCHED
}
}

namespace pg8 {
__device__ __forceinline__ u32x4 pack8(const f32x4& v0, const f32x4& v1) { u32x4 w; w.x = cvt_pk_bf16(v0[0], v0[1]); w.y = cvt_pk_bf16(v0[2], v0[3]); w.z = cvt_pk_bf16(v1[0], v1[1]); w.w = cvt_pk_bf16(v1[2], v1[3]); return w; }
__device__ __forceinline__ f32x4 gelu4(const f32x4& v) { f32x2 a = gelu_pk((f32x2){v[0], v[1]}), b = gelu_pk((f32x2){v[2], v[3]}); return (f32x4){a.x, a.y, b.x, b.y}; }
struct DEpiP1 {
    static constexpr bool PERM = true, AFTER_DRAIN = false; EpiP1 e;
    __device__ __forceinline__ void operator()(const f32x4 (&acc)[2][2][4][2], const Unit& u, int wr, int wc, int fr, int fq) const {
        const int row0 = u.pm * BM + wr * 64 + fr; const bool isb = (u.pn >= 8);
        bf16_t* base = isb ? e.PB : e.PA; const int ldc = isb ? 1024 : 2048; const int col0 = (isb ? (u.pn - 8) : u.pn) * BM + wc * 32 + 8 * fq;
#pragma unroll
        for (int ai = 0; ai < 2; ++ai)
#pragma unroll
            for (int m = 0; m < 4; ++m) { bf16_t* rowp = base + (size_t)(row0 + ai * HALF + m * 16) * ldc + col0;
#pragma unroll
                for (int bj = 0; bj < 2; ++bj) { f32x4 v0 = acc[ai][bj][m][0], v1 = acc[ai][bj][m][1];
                    if (isb) { v0 = gelu4(v0); v1 = gelu4(v1); }
                    *(u32x4*)(rowp + bj * HALF) = pack8(v0, v1); } }
    }
};
struct DEpiPlain {
    static constexpr bool PERM = true, AFTER_DRAIN = false; EpiPlain e;
    __device__ __forceinline__ void operator()(const f32x4 (&acc)[2][2][4][2], const Unit& u, int wr, int wc, int fr, int fq) const {
        const int row0 = u.pm * BM + wr * 64 + fr; const int col0 = e.col_off + u.pn * BM + wc * 32 + 8 * fq;
#pragma unroll
        for (int ai = 0; ai < 2; ++ai)
#pragma unroll
            for (int m = 0; m < 4; ++m) { bf16_t* rowp = e.O + (size_t)(row0 + ai * HALF + m * 16) * e.ldc + col0;
#pragma unroll
                for (int bj = 0; bj < 2; ++bj) *(u32x4*)(rowp + bj * HALF) = pack8(acc[ai][bj][m][0], acc[ai][bj][m][1]); }
    }
};
__device__ __forceinline__ float sig_fast(float x) { return __builtin_amdgcn_rcpf(1.0f + __expf(-x)); }
__device__ __forceinline__ float bflo(unsigned w) { return __uint_as_float(w << 16); }
__device__ __forceinline__ float bfhi(unsigned w) { return __uint_as_float(w & 0xffff0000u); }
struct DEpiMerge {
    static constexpr bool PERM = true, AFTER_DRAIN = false; EpiMerge e;
    __device__ __forceinline__ void operator()(const f32x4 (&acc)[2][2][4][2], const Unit& u, int wr, int wc, int fr, int fq) const {
        const int row0 = u.pm * BM + wr * 64 + fr; const int n0 = u.pn * HALF + wc * 32 + 8 * fq;
#pragma unroll
        for (int ai = 0; ai < 2; ++ai)
#pragma unroll
            for (int m = 0; m < 4; ++m) { const size_t row = (size_t)(row0 + ai * HALF + m * 16);
                const u32x4 b0 = *(const u32x4*)(e.BR + row * 2048 + n0), b1 = *(const u32x4*)(e.BR + row * 2048 + 1024 + n0);
                const f32x4 g00 = acc[ai][0][m][0], g01 = acc[ai][0][m][1], g10 = acc[ai][1][m][0], g11 = acc[ai][1][m][1];
                f32x4 o0, o1;
                o0[0] = sig_fast(g00[0]) * bflo(b0.x) + sig_fast(g10[0]) * bflo(b1.x); o0[1] = sig_fast(g00[1]) * bfhi(b0.x) + sig_fast(g10[1]) * bfhi(b1.x);
                o0[2] = sig_fast(g00[2]) * bflo(b0.y) + sig_fast(g10[2]) * bflo(b1.y); o0[3] = sig_fast(g00[3]) * bfhi(b0.y) + sig_fast(g10[3]) * bfhi(b1.y);
                o1[0] = sig_fast(g01[0]) * bflo(b0.z) + sig_fast(g11[0]) * bflo(b1.z); o1[1] = sig_fast(g01[1]) * bfhi(b0.z) + sig_fast(g11[1]) * bfhi(b1.z);
                o1[2] = sig_fast(g01[2]) * bflo(b0.w) + sig_fast(g11[2]) * bflo(b1.w); o1[3] = sig_fast(g01[3]) * bfhi(b0.w) + sig_fast(g11[3]) * bfhi(b1.w);
                *(u32x4*)(e.MG + row * 1024 + n0) = pack8(o0, o1); }
    }
};
struct DEpiResid {
    static constexpr bool PERM = false, AFTER_DRAIN = false; EpiResid e;
    __device__ __forceinline__ void operator()(const f32x4 (&acc)[2][2][4][2], const Unit& u, int wr, int wc, int fr, int fq) const {
        const int row0 = u.pm * BM + wr * 64 + fr, col0 = u.pn * BM + wc * 32 + 4 * fq;
        typedef unsigned u32x2 __attribute__((ext_vector_type(2)));
#pragma unroll
        for (int ai = 0; ai < 2; ++ai)
#pragma unroll
            for (int m = 0; m < 4; ++m) { const size_t ro = (size_t)(row0 + ai * HALF + m * 16) * 1024 + col0;
#pragma unroll
                for (int bj = 0; bj < 2; ++bj)
#pragma unroll
                    for (int n = 0; n < 2; ++n) { const u32x2 h = *(const u32x2*)(e.H + ro + bj * HALF + n * 16); const f32x4 a = acc[ai][bj][m][n];
                        f32x4 o; o[0] = ALPHA_F * bflo(h.x) + a[0]; o[1] = ALPHA_F * bfhi(h.x) + a[1]; o[2] = ALPHA_F * bflo(h.y) + a[2]; o[3] = ALPHA_F * bfhi(h.y) + a[3];
                        *(f32x4*)(e.Z + ro + bj * HALF + n * 16) = o; } }
    }
};

struct DEpiTile {
    static constexpr bool PERM = true, AFTER_DRAIN = false; bf16_t* O; int sm, sn; float scale;
    __device__ __forceinline__ void operator()(const f32x4 (&acc)[2][2][4][2], const Unit& u, int wr, int wc, int fr, int fq) const {
        bf16_t* base = O + (size_t)(u.pm * sm + u.pn * sn) * 65536; const int row0 = wr * 64 + fr, col0 = wc * 32 + 8 * fq;
#pragma unroll
        for (int ai = 0; ai < 2; ++ai)
#pragma unroll
            for (int m = 0; m < 4; ++m) { bf16_t* rowp = base + (size_t)(row0 + ai * HALF + m * 16) * 256 + col0;
#pragma unroll
                for (int bj = 0; bj < 2; ++bj) *(u32x4*)(rowp + bj * HALF) = pack8(acc[ai][bj][m][0] * scale, acc[ai][bj][m][1] * scale); }
    }
};
struct DEpiQ { static constexpr bool PERM = true, AFTER_DRAIN = false; DEpiTile t;
    __device__ __forceinline__ void operator()(const f32x4 (&acc)[2][2][4][2], const Unit& u, int wr, int wc, int fr, int fq) const {
        Unit v; v.pm = (u.pm >> 3) * 32 + u.pn * 8 + (u.pm & 7); v.pn = 0; t(acc, v, wr, wc, fr, fq); } };
struct DEpiO {
    static constexpr bool PERM = true, AFTER_DRAIN = false; bf16_t* O;
    __device__ __forceinline__ void operator()(const f32x4 (&acc)[2][2][4][2], const Unit& u, int wr, int wc, int fr, int fq) const {
        const int bh = u.pm >> 3, b = bh >> 2, h = bh & 3; const int s0 = (u.pm & 7) * 256 + wr * 64 + fr;
        bf16_t* base = O + ((size_t)b * SEQ) * 1024 + h * 256 + wc * 32 + 8 * fq;
#pragma unroll
        for (int ai = 0; ai < 2; ++ai)
#pragma unroll
            for (int m = 0; m < 4; ++m) { bf16_t* rowp = base + (size_t)(s0 + ai * HALF + m * 16) * 1024;
#pragma unroll
                for (int bj = 0; bj < 2; ++bj) *(u32x4*)(rowp + bj * HALF) = pack8(acc[ai][bj][m][0], acc[ai][bj][m][1]); }
    }
};
struct DEpiSoftmax {
    static constexpr bool PERM = true, AFTER_DRAIN = true; bf16_t* Pout;
    __device__ __forceinline__ void fused(f32x4 (&acc)[2][2][4][2], const Unit& u, int wr, int wc, int fr, int fq, PG8_LAS unsigned char* lds, int wid, int lane) const {
        PG8_LAS float* PM = (PG8_LAS float*)lds;
        PG8_LAS float* PS = (PG8_LAS float*)(lds + 4096);
#pragma unroll
        for (int ai = 0; ai < 2; ++ai)
#pragma unroll
            for (int m = 0; m < 4; ++m) { float mx = -3.0e38f;
#pragma unroll
                for (int bj = 0; bj < 2; ++bj)
#pragma unroll
                    for (int n = 0; n < 2; ++n) { const f32x4 x = acc[ai][bj][m][n]; mx = fmaxf(mx, fmaxf(fmaxf(x[0], x[1]), fmaxf(x[2], x[3]))); }
                mx = fmaxf(mx, __shfl_xor(mx, 16)); mx = fmaxf(mx, __shfl_xor(mx, 32));
                if (fq == 0) PM[(ai * HALF + wr * 64 + m * 16 + fr) * 4 + wc] = mx; }
        asm volatile("s_waitcnt lgkmcnt(0)" ::: "memory"); __builtin_amdgcn_s_barrier(); asm volatile("" ::: "memory");
#pragma unroll
        for (int ai = 0; ai < 2; ++ai)
#pragma unroll
            for (int m = 0; m < 4; ++m) { const int row = ai * HALF + wr * 64 + m * 16 + fr; const f32x4 p4 = *(const PG8_LAS f32x4*)(PM + row * 4);
                const float gm = fmaxf(fmaxf(p4[0], p4[1]), fmaxf(p4[2], p4[3])); float sum = 0.f;
#pragma unroll
                for (int bj = 0; bj < 2; ++bj)
#pragma unroll
                    for (int n = 0; n < 2; ++n) { f32x4 x = acc[ai][bj][m][n]; x[0] = __expf(x[0] - gm); x[1] = __expf(x[1] - gm); x[2] = __expf(x[2] - gm); x[3] = __expf(x[3] - gm);
                        acc[ai][bj][m][n] = x; sum += (x[0] + x[1]) + (x[2] + x[3]); }
                sum += __shfl_xor(sum, 16); sum += __shfl_xor(sum, 32);
                if (fq == 0) PS[row * 4 + wc] = sum; }
        asm volatile("s_waitcnt lgkmcnt(0)" ::: "memory"); __builtin_amdgcn_s_barrier(); asm volatile("" ::: "memory");
#pragma unroll
        for (int ai = 0; ai < 2; ++ai)
#pragma unroll
            for (int m = 0; m < 4; ++m) { const int row = ai * HALF + wr * 64 + m * 16 + fr; const f32x4 s4 = *(const PG8_LAS f32x4*)(PS + row * 4);
                const float inv = 1.0f / ((s4[0] + s4[1]) + (s4[2] + s4[3])); bf16_t* rowp = Pout + ((size_t)u.pm * 256 + row) * 256 + wc * 32 + 8 * fq;
#pragma unroll
                for (int bj = 0; bj < 2; ++bj) *(u32x4*)(rowp + bj * HALF) = pack8(acc[ai][bj][m][0] * inv, acc[ai][bj][m][1] * inv); }
        asm volatile("s_waitcnt lgkmcnt(0)" ::: "memory"); __builtin_amdgcn_s_barrier(); asm volatile("" ::: "memory");
    }
};
template <int KIND> struct DEpiLora {
    static constexpr bool PERM = true, AFTER_DRAIN = false; const float* bsrc0; bf16_t* O;
    __device__ __forceinline__ static f32x4 act4(f32x4 x) {
        f32x4 o;
#pragma unroll
        for (int i = 0; i < 4; ++i) {
            if (KIND == 0) { const float y = -x[i]; const float sp = fmaxf(y, 0.f) + __logf(1.0f + __expf(-fabsf(y))); const float ew = __expf(-sp - 0.5f); o[i] = 1.0f - __expf(-ew); }
            else if (KIND == 1) o[i] = __builtin_amdgcn_rcpf(1.0f + __expf(-x[i]));
            else o[i] = x[i]; }
        return o;
    }
    __device__ __forceinline__ void operator()(const f32x4 (&acc)[2][2][4][2], const Unit& u, int wr, int wc, int fr, int fq) const {
        const int row0 = u.pm * BM + wr * 64 + fr; const int z = (KIND == 2) ? 0 : (u.pn >> 1); const int cb = ((KIND == 2) ? u.pn : (u.pn & 1)) * 256 + wc * 32 + 8 * fq;
        f32x4 bv[2][2];
#pragma unroll
        for (int bj = 0; bj < 2; ++bj)
#pragma unroll
            for (int n = 0; n < 2; ++n) bv[bj][n] = (KIND == 2) ? (f32x4){0.f, 0.f, 0.f, 0.f} : *(const f32x4*)(bsrc0 + z * 512 + cb + bj * HALF + 4 * n);
#pragma unroll
        for (int ai = 0; ai < 2; ++ai)
#pragma unroll
            for (int m = 0; m < 4; ++m) { const size_t row = (size_t)(row0 + ai * HALF + m * 16);
                bf16_t* dst = (KIND == 2) ? (O + row * 512 + cb) : (O + (row * 2 + z) * 512 + cb);
#pragma unroll
                for (int bj = 0; bj < 2; ++bj) *(u32x4*)(dst + bj * HALF) = pack8(act4(acc[ai][bj][m][0] + bv[bj][0]), act4(acc[ai][bj][m][1] + bv[bj][1])); }
    }
};
}
#define LAS __attribute__((address_space(3)))
#define XB_TMO      128
#define XB_XCNT(j)  (256  + 64 * (j))
#define XB_XSUB(j)  (1280 + 64 * (j))
#define XB_XGEN(j)  (2304 + 64 * (j))
#define XB_TOP      3328
#define XB_TOPGEN   3392
#define XCD_BAR_WORDS 3456
#define XB_SPIN_CAP (1u << 18)

__device__ __forceinline__ unsigned xb_ld(unsigned* p)              { return __hip_atomic_load(p, __ATOMIC_RELAXED, __HIP_MEMORY_SCOPE_AGENT); }
__device__ __forceinline__ unsigned xb_add(unsigned* p, unsigned v) { return __hip_atomic_fetch_add(p, v, __ATOMIC_RELAXED, __HIP_MEMORY_SCOPE_AGENT); }
__device__ __forceinline__ unsigned xb_xcc_id() { return (unsigned)__builtin_amdgcn_s_getreg((3 << 11) | 20) & 0xFu; }
#define XB_SPIN(cond, bar) do { unsigned _sp = 0; while (cond) { __builtin_amdgcn_s_sleep(1); \
    if ((++_sp & 255u) == 0u) { if (xb_ld(&(bar)[XB_TMO])) break; if (_sp > XB_SPIN_CAP) { atomicAdd(&(bar)[XB_TMO], 1u); break; } } } } while (0)

struct XcdBarrier {
    unsigned* bar; unsigned x;
    volatile LAS unsigned* st;
};

__device__ __forceinline__ XcdBarrier xcd_barrier_post(unsigned* bar, volatile LAS unsigned* st) {
    XcdBarrier b; b.bar = bar; b.x = xb_xcc_id(); b.st = st;
    if (threadIdx.x == 0) (void)xb_add(&bar[XB_XCNT(b.x)], 1u);
    return b;
}
__device__ __forceinline__ void xcd_barrier_complete(unsigned* bar, unsigned x, unsigned& nloc, unsigned& nx) {
    const unsigned G = gridDim.x * gridDim.y * gridDim.z;
    unsigned sum, cnt, mine, sp = 0u;
    for (;;) {
        sum = 0u; cnt = 0u; mine = 0u;
#pragma unroll
        for (unsigned j = 0; j < 16; ++j) { const unsigned c = xb_ld(&bar[XB_XCNT(j)]); sum += c; cnt += (c > 0u) ? 1u : 0u; mine = (j == x) ? c : mine; }
        if (sum == G) break;
        __builtin_amdgcn_s_sleep(1);
        if ((++sp & 255u) == 0u) { if (xb_ld(&bar[XB_TMO])) break; if (sp > XB_SPIN_CAP) { atomicAdd(&bar[XB_TMO], 1u); break; } }
    }
    nloc = mine > 0u ? mine : 1u; nx = cnt > 0u ? cnt : 1u;
}

__device__ __forceinline__ void xcd_barrier(const XcdBarrier& b) {
    asm volatile("s_waitcnt vmcnt(0)" ::: "memory");
    __syncthreads();
    if (threadIdx.x == 0) {
        unsigned* bar = b.bar;
        __builtin_amdgcn_s_waitcnt(0);
        unsigned nloc = b.st[0], nx = b.st[1];
        if (nloc == 0u) { xcd_barrier_complete(bar, b.x, nloc, nx); b.st[0] = nloc; b.st[1] = nx; }
        const unsigned old = xb_add(&bar[XB_XSUB(b.x)], 1u);
        const unsigned gen = old / nloc;
        if (old + 1u == (gen + 1u) * nloc) {
            __builtin_amdgcn_fence(__ATOMIC_RELEASE, "agent");
            asm volatile("s_waitcnt vmcnt(0)" ::: "memory");
            const unsigned og = xb_add(&bar[XB_TOP], 1u);
            const unsigned tg = og / nx;
            if (og + 1u == (tg + 1u) * nx) xb_add(&bar[XB_TOPGEN], 1u);
            else XB_SPIN(xb_ld(&bar[XB_TOPGEN]) == tg, bar);
            __builtin_amdgcn_fence(__ATOMIC_ACQUIRE, "agent");
            xb_add(&bar[XB_XGEN(b.x)], 1u);
            asm volatile("s_waitcnt vmcnt(0)" ::: "memory");
        } else {
            XB_SPIN(xb_ld(&bar[XB_XGEN(b.x)]) == gen, bar);
            __builtin_amdgcn_fence(__ATOMIC_ACQUIRE, "agent");
            asm volatile("s_waitcnt vmcnt(0)" ::: "memory");
        }
    }
    __syncthreads();
}

#endif

#ifdef HOST_EMU
template <class F> static void emu_gemm(const bf16_t* A, const bf16_t* Bt, int M, int N, int K, F f) {
#pragma omp parallel for schedule(static)
    for (int r = 0; r < M; ++r)
        for (int c = 0; c < N; ++c) { float a = 0.f; for (int k = 0; k < K; ++k) a += bf2f(A[(size_t)r * K + k]) * bf2f(Bt[(size_t)c * K + k]); f(r, c, a); }
}
#endif

#define GS_LOOP(idx, n) for (long idx = gtid; idx < (long)(n); idx += nthr)

__device__ __forceinline__ int win_src_col(int n) {
    if (n < 1920) return n;
    if (n < 2048) return -1;
    if (n < 3072) return 1920 + (n - 2048);
    const int m = n - 3072, j = m / 256, i = m % 256;
    return (i < 128) ? (2944 + 128 * j + i) : (2944 + 1024 + 128 * j + (i - 128));
}
__device__ __forceinline__ void ph0_weights(const Params& P, long gtid, long nthr) {
    GS_LOOP(idx, (size_t)5120 * 1024) { const int n = (int)(idx / 1024), k = (int)(idx % 1024); const int c = win_src_col(n);
        P.W_IN_T[idx] = (c < 0) ? (bf16_t)0 : f2bf(P.in[I_W_IN][(size_t)k * IN_COLS + c]); }
    GS_LOOP(idx, (size_t)2048 * 512) { const int n = (int)(idx / 512), k = (int)(idx % 512); const int br = n / 1024, nn = n % 1024;
        P.W_BR_T[idx] = f2bf(P.in[I_W_BRANCH][((size_t)br * 512 + k) * 1024 + nn]); }
    GS_LOOP(idx, (size_t)1024 * 1024) { const int n = (int)(idx / 1024), k = (int)(idx % 1024);
        P.W_MIX_T[idx] = f2bf(P.in[I_W_MIX][(size_t)k * 1024 + n]);
        P.W_Q_T[idx] = f2bf(P.in[I_W_Q][(size_t)k * 1024 + n]);
        P.W_O_T[idx] = f2bf(P.in[I_W_O][(size_t)k * 1024 + n]); }
    GS_LOOP(idx, (size_t)2048 * 1024) { const int n = (int)(idx / 1024), k = (int)(idx % 1024);
        P.W_KV_T[idx] = f2bf(P.in[I_W_KV][(size_t)k * 2048 + n]);
        P.W_QUERY_T[idx] = f2bf(P.in[I_W_QUERY][(size_t)k * 2048 + n]); }
}
__device__ __forceinline__ void ln_rows_bf16(const float* in, const float* g, const float* b, bf16_t* out, int rows, int width, long gtid, long nthr) {
    GS_LOOP(row, rows) { const float* x = in + (size_t)row * width; float s = 0.f;
        for (int i = 0; i < width; ++i) s += x[i];
        const float mu = s / width; float q = 0.f;
        for (int i = 0; i < width; ++i) { const float d = x[i] - mu; q += d * d; }
        const float rs = 1.0f / sqrtf(q / width + 1e-5f); bf16_t* o = out + (size_t)row * width;
        for (int i = 0; i < width; ++i) o[i] = f2bf((x[i] - mu) * rs * g[i] + b[i]); }
}
__device__ __forceinline__ void ph2a_vn(const Params& P, long gtid, long nthr) {
    GS_LOOP(row, TOK) { const bf16_t* x = P.PB + (size_t)row * 1024 + 512; float s = 0.f;
        for (int i = 0; i < 512; ++i) s += bf2f(x[i]);
        const float mu = s / 512.f; float q = 0.f;
        for (int i = 0; i < 512; ++i) { const float d = bf2f(x[i]) - mu; q += d * d; }
        const float rs = 1.0f / sqrtf(q / 512.f + 1e-5f); bf16_t* o = P.VN + (size_t)row * 512;
        for (int i = 0; i < 512; ++i) o[i] = f2bf((bf2f(x[i]) - mu) * rs * P.in[I_GLN_G][i] + P.in[I_GLN_B][i]); }
}
__device__ __forceinline__ void ph2b_gmlp(const Params& P, long gtid, long nthr) {
    GS_LOOP(idx, (size_t)TOK * 512) { const int c = (int)(idx % 512); const long t = idx / 512; const int g = c / 64; const long ch = t / 128; const int p = (int)(t % 128);
        const float* ws = P.in[I_W_S] + ((size_t)g * 128 + p) * 128; float s = 0.f;
        for (int q = 0; q < 128; ++q) s += ws[q] * bf2f(P.VN[(size_t)(ch * 128 + q) * 512 + c]);
        s += P.in[I_B_S][g * 128 + p];
        P.YB[idx] = f2bf(bf2f(P.PB[(size_t)t * 1024 + c]) * s); }
}
__device__ __forceinline__ float pa_shift(const Params& P, long t, int c) {
    const int s = (int)(t % SEQ); const float cur = bf2f(P.PA[(size_t)t * 2048 + c]);
    const float prev = (s > 0) ? bf2f(P.PA[(size_t)(t - 1) * 2048 + c]) : 0.f;
    const float nxt = (s < SEQ - 1) ? bf2f(P.PA[(size_t)(t + 1) * 2048 + c]) : 0.f;
    return cur + P.in[I_MU][c] * (0.5f * (prev + nxt) - cur);
}
__device__ __forceinline__ void ph3a_lora_in(const Params& P, long gtid, long nthr) {
    GS_LOOP(idx, (size_t)TOK * 128) { const int r = (int)(idx % 128); const long t = idx / 128;
        P.WDS[idx] = f2bf(tanhf(pa_shift(P, t, 1536 + r)));
        P.ADS[idx] = f2bf(pa_shift(P, t, 1664 + r));
        P.SG[idx] = f2bf(sigmoidf_(pa_shift(P, t, 1792 + r))); }
}
__device__ __forceinline__ void ph3b_prep(const Params& P, long gtid, long nthr) {
    GS_LOOP(idx, (size_t)TOK * 8) { const int h = (int)(idx % 8); const long t = idx / 8; const int hb = h * 64;
        float ss = 0.f;
        for (int j = 0; j < 64; ++j) { const float v = pa_shift(P, t, 512 + hb + j) * P.in[I_K_K][hb + j]; ss += v * v; }
        const float inv = 1.0f / fmaxf(sqrtf(ss), 1e-12f);
        for (int j = 0; j < 64; ++j) { const int c = hb + j;
            const float k = pa_shift(P, t, 512 + c); const float kk = k * P.in[I_K_K][c] * inv;
            P.R[(size_t)t * 512 + c] = f2bf(pa_shift(P, t, c));
            P.V[(size_t)t * 512 + c] = f2bf(pa_shift(P, t, 1024 + c));
            P.KK[(size_t)t * 512 + c] = f2bf(kk);
            for (int z = 0; z < 2; ++z) {
                float sw = P.in[I_W0][z * 512 + c], sa = P.in[I_A0][z * 512 + c];
                for (int r = 0; r < 64; ++r) { sw += bf2f(P.WDS[(size_t)t * 128 + z * 64 + r]) * P.in[I_W2][((size_t)z * 64 + r) * 512 + c];
                                               sa += bf2f(P.ADS[(size_t)t * 128 + z * 64 + r]) * P.in[I_A2][((size_t)z * 64 + r) * 512 + c]; }
                const float y = -sw; const float sp = fmaxf(y, 0.f) + log1pf(expf(-fabsf(y))); const float wlog = -sp - 0.5f;
                const float ew = expf(wlog);
                const float a = sigmoidf_(sa); const size_t o = ((size_t)t * 2 + z) * 512 + c;
                P.OMW[o] = f2bf(-expm1f(-ew));
                P.KDIR[o] = f2bf(k * (1.0f + (a - 1.0f) * P.in[I_K_A][c]));
                P.BVEC[o] = f2bf(kk * a); } } }
}
__device__ __forceinline__ void scan_item(const Params& P, int chain, int i) {
    const int h = chain % 8, b = (chain / 8) % BATCH, z = chain / (8 * BATCH);
    float S[64];
#pragma unroll
    for (int j = 0; j < 64; ++j) S[j] = 0.f;
    for (int n = 0; n < SEQ; ++n) {
        const long t = (long)b * SEQ + ((z == 0) ? n : (SEQ - 1 - n));
        const bf16_t* r = P.R + (size_t)t * 512 + h * 64; const bf16_t* a = P.KK + (size_t)t * 512 + h * 64;
        const bf16_t* w = P.OMW + ((size_t)t * 2 + z) * 512 + h * 64; const bf16_t* k = P.KDIR + ((size_t)t * 2 + z) * 512 + h * 64;
        const bf16_t* bv = P.BVEC + ((size_t)t * 2 + z) * 512 + h * 64;
        const float v = bf2f(P.V[(size_t)t * 512 + h * 64 + i]);
        float sa = 0.f;
#pragma unroll
        for (int j = 0; j < 64; ++j) sa -= S[j] * bf2f(a[j]);
        float y = 0.f;
#pragma unroll
        for (int j = 0; j < 64; ++j) { S[j] = S[j] * (1.0f - bf2f(w[j])) + sa * bf2f(bv[j]) + v * bf2f(k[j]); y += S[j] * bf2f(r[j]); }
        P.Y01[((size_t)z * TOK + t) * 512 + h * 64 + i] = y;
    }
}
__device__ __forceinline__ void ph5_rwkv_out(const Params& P, long gtid, long nthr) {
    GS_LOOP(idx, (size_t)TOK * 512) { const int c = (int)(idx % 512); const long t = idx / 512; const int hb = (c / 64) * 64;
        const float* y0 = P.Y01 + (size_t)t * 512 + hb; const float* y1 = P.Y01 + ((size_t)TOK + t) * 512 + hb;
        float s = 0.f;
        for (int j = 0; j < 64; ++j) s += y0[j] + y1[j];
        const float mu = s / 64.f; float q = 0.f;
        for (int j = 0; j < 64; ++j) { const float d = y0[j] + y1[j] - mu; q += d * d; }
        const float rs = 1.0f / sqrtf(q / 64.f + 64e-5f);
        const float yn = (y0[c - hb] + y1[c - hb] - mu) * rs * P.in[I_GN_G][c] + P.in[I_GN_B][c];
        float rk = 0.f;
        for (int z = 0; z < 2; ++z)
            for (int j = 0; j < 64; ++j) rk += bf2f(P.R[(size_t)t * 512 + hb + j]) * bf2f(P.KDIR[((size_t)t * 2 + z) * 512 + hb + j]) * P.in[I_R_K][hb + j];
        float g = 0.f;
        for (int r = 0; r < 128; ++r) g += bf2f(P.SG[(size_t)t * 128 + r]) * P.in[I_G2][(size_t)r * 512 + c];
        P.YA[idx] = f2bf((yn + rk * bf2f(P.V[(size_t)t * 512 + c])) * g); }
}
__device__ __forceinline__ void ph_ln_z(const Params& P, const float* g, const float* b, long gtid, long nthr) { ln_rows_bf16(P.Z, g, b, P.HB, TOK, 1024, gtid, nthr); }
__device__ __forceinline__ void ph10a_scores(const Params& P, long gtid, long nthr) {
    GS_LOOP(idx, (size_t)TOK * 4 * 256) { const int m = (int)(idx % 256); const long rowi = idx / 256; const int s = (int)(rowi % SEQ); const int bh = (int)(rowi / SEQ); const int b = bh / 4, h = bh % 4;
        const bf16_t* q = P.Q + ((size_t)b * SEQ + s) * 1024 + h * 256; const bf16_t* k = P.KV + ((size_t)b * 256 + m) * 2048 + h * 256; float a = 0.f;
        for (int d = 0; d < 256; ++d) a += bf2f(q[d]) * bf2f(k[d]);
        P.SCA[idx] = a * 0.0625f; }
}
__device__ __forceinline__ void ph10b_softmax(const Params& P, long gtid, long nthr) {
    GS_LOOP(row, (size_t)TOK * 4) { float* x = P.SCA + (size_t)row * 256; float mx = x[0];
        for (int i = 1; i < 256; ++i) mx = fmaxf(mx, x[i]);
        float s = 0.f;
        for (int i = 0; i < 256; ++i) s += expf(x[i] - mx);
        const float inv = 1.0f / s;
        for (int i = 0; i < 256; ++i) x[i] = expf(x[i] - mx) * inv; }
}
__device__ __forceinline__ void ph10c_out(const Params& P, long gtid, long nthr) {
    GS_LOOP(idx, (size_t)TOK * 1024) { const int c = (int)(idx % 1024); const long t = idx / 1024; const int b = (int)(t / SEQ), s = (int)(t % SEQ), h = c / 256;
        const float* pr = P.SCA + (((size_t)b * 4 + h) * SEQ + s) * 256; float a = 0.f;
        for (int m = 0; m < 256; ++m) a += pr[m] * bf2f(P.KV[((size_t)b * 256 + m) * 2048 + 1024 + c]);
        P.O[idx] = f2bf(a); }
}
__device__ __forceinline__ void ph13a_scores(const Params& P, long gtid, long nthr) {
    GS_LOOP(idx, (size_t)TOK * 2048) { const int k = (int)(idx % 128), z = (int)((idx / 128) % 2), h = (int)((idx / 256) % 8); const long t = idx / 2048;
        const bf16_t* q = P.QP + (size_t)t * 2048 + h * 256 + z * 128; const float* kr = P.in[I_SUBKEYS] + ((size_t)z * 128 + k) * 128; float a = 0.f;
        for (int c = 0; c < 128; ++c) a += bf2f(q[c]) * kr[c];
        P.SC[idx] = a; }
}
__device__ __forceinline__ void ph13b_topk(const Params& P, long gtid, long nthr) {
    GS_LOOP(row, (size_t)TOK * 16) { const float* x = P.SC + (size_t)row * 128; float pv = 0.f; int pi = -1;
        for (int j = 0; j < 16; ++j) { float best = 0.f; int bi = -1;
            for (int i = 0; i < 128; ++i) { const float v = x[i]; const bool elig = (j == 0) || (v < pv) || (v == pv && i > pi);
                if (elig && (bi < 0 || v > best)) { best = v; bi = i; } }
            P.TOPS[(size_t)row * 16 + j] = best; P.TOPI[(size_t)row * 16 + j] = bi; pv = best; pi = bi; } }
}
__device__ __forceinline__ void ph13c_cand(const Params& P, long gtid, long nthr) {
    GS_LOOP(row, (size_t)TOK * 8) { const float* s0 = P.TOPS + (size_t)row * 32; const float* s1 = s0 + 16; const int* i0 = P.TOPI + (size_t)row * 32; const int* i1 = i0 + 16;
        float pv = 0.f; int pi = -1; float mx = 0.f;
        for (int j = 0; j < 16; ++j) { float best = 0.f; int bi = -1;
            for (int c = 0; c < 256; ++c) { const float v = s0[c / 16] + s1[c % 16]; const bool elig = (j == 0) || (v < pv) || (v == pv && c > pi);
                if (elig && (bi < 0 || v > best)) { best = v; bi = c; } }
            if (j == 0) mx = best;
            P.GATE[(size_t)row * 16 + j] = best; P.EXPERT[(size_t)row * 16 + j] = i0[bi / 16] * 128 + i1[bi % 16]; pv = best; pi = bi; }
        float s = 0.f;
        for (int j = 0; j < 16; ++j) s += expf(P.GATE[(size_t)row * 16 + j] - mx);
        const float inv = 1.0f / s;
        for (int j = 0; j < 16; ++j) P.GATE[(size_t)row * 16 + j] = expf(P.GATE[(size_t)row * 16 + j] - mx) * inv; }
}
__device__ __forceinline__ void ph14a_act(const Params& P, long gtid, long nthr) {
    GS_LOOP(idx, (size_t)TOK * 128) { const long t = idx / 128; const bf16_t* x = P.HB + (size_t)t * 1024; const float* ur = P.in[I_PEER_U] + (size_t)P.EXPERT[idx] * 1024; float a = 0.f;
        for (int d = 0; d < 1024; ++d) a += ur[d] * bf2f(x[d]);
        P.COEF[idx] = P.GATE[idx] * geluf_(a); }
}
__device__ __forceinline__ void ph14b_out(const Params& P, long gtid, long nthr) {
    GS_LOOP(idx, (size_t)TOK * 1024) { const int d = (int)(idx % 1024); const long t = idx / 1024; float a = 0.f;
        for (int j = 0; j < 128; ++j) a += P.COEF[(size_t)t * 128 + j] * P.in[I_PEER_V][(size_t)P.EXPERT[(size_t)t * 128 + j] * 1024 + d];
        P.Y[idx] = a; }
}
__device__ __forceinline__ void ph14c_final(const Params& P, long gtid, long nthr) {
    GS_LOOP(row, TOK) { const bf16_t* hr = P.HB + (size_t)row * 1024; const float* yr = P.Y + (size_t)row * 1024; float s = 0.f;
        for (int i = 0; i < 1024; ++i) s += ALPHA_F * bf2f(hr[i]) + yr[i];
        const float mu = s / 1024.f; float q = 0.f;
        for (int i = 0; i < 1024; ++i) { const float d = ALPHA_F * bf2f(hr[i]) + yr[i] - mu; q += d * d; }
        const float rs = 1.0f / sqrtf(q / 1024.f + 1e-5f); float* o = P.out + (size_t)row * 1024;
        for (int i = 0; i < 1024; ++i) o[i] = (ALPHA_F * bf2f(hr[i]) + yr[i] - mu) * rs * P.in[I_LN3_G][i] + P.in[I_LN3_B][i]; }
}

static void make_params(Params& P, void* const* d_in, void* d_out, void* d_ws) {
    memset(&P, 0, sizeof(P));
    for (int i = 0; i < 37; ++i) P.in[i] = (const float*)d_in[i];
    P.out = (float*)d_out; unsigned char* ws = (unsigned char*)d_ws; unsigned char* ob = (unsigned char*)d_out;
    unsigned char* r1 = ws + A_R1; unsigned char* r2 = ws + A_R2;
    P.ctl = (unsigned*)(ws + WS_CTL);
    P.W_IN_T = (bf16_t*)(ws + WS_W + OFF_W_IN); P.W_BR_T = (bf16_t*)(ws + WS_W + OFF_W_BR); P.W_MIX_T = (bf16_t*)(ws + WS_W + OFF_W_MIX);
    P.W_Q_T = (bf16_t*)(ws + WS_W + OFF_W_Q); P.W_KV_T = (bf16_t*)(ws + WS_W + OFF_W_KV); P.W_O_T = (bf16_t*)(ws + WS_W + OFF_W_O); P.W_QUERY_T = (bf16_t*)(ws + WS_W + OFF_W_QUERY);
    P.KV = (bf16_t*)(ws + WS_KV); P.MEMN = (bf16_t*)(ws + WS_MEMN); P.HB = (bf16_t*)(ws + A_HB);
    P.PA = (bf16_t*)r1; P.PB = (bf16_t*)r2; P.VN = (bf16_t*)(r2 + 2 * TU);
    P.YB = (bf16_t*)ob; P.WDS = (bf16_t*)(ob + TU); P.ADS = (bf16_t*)(ob + TU + TU / 4); P.SG = (bf16_t*)(ob + TU + TU / 2);
    P.R = (bf16_t*)(ob + 2 * TU); P.KK = (bf16_t*)(ob + 3 * TU);
    P.V = (bf16_t*)r2; P.OMW = (bf16_t*)(r2 + TU); P.KDIR = (bf16_t*)(r2 + 3 * TU); P.BVEC = (bf16_t*)(r2 + 5 * TU);
    P.Y01 = (float*)r1; P.YA = (bf16_t*)(r2 + TU); P.BR = (bf16_t*)r1; P.MG = (bf16_t*)r2; P.Z = (float*)ob;
    P.Q = (bf16_t*)r1; P.O = (bf16_t*)(r1 + 2 * TU); P.SCA = (float*)r2; P.QP = (bf16_t*)ob;
    P.SC = (float*)r1; P.TOPS = (float*)(r2 + 4 * TU); P.TOPI = (int*)(r2 + 5 * TU); P.GATE = (float*)(r2 + 6 * TU); P.EXPERT = (int*)(r2 + 6 * TU + TU / 2);
    P.COEF = (float*)(r2 + 7 * TU); P.Y = (float*)r1;
    P.UB = (bf16_t*)r1; P.VB = (bf16_t*)(r1 + (size_t)16384 * 1024 * 2);
    P.U8 = r1; P.V8 = r1 + (size_t)16384 * 1024; P.SU = (float*)(r1 + (size_t)2 * 16384 * 1024); P.SV = P.SU + 16384;
    P.W_LORA_T = (bf16_t*)(ws + WS_W + OFF_W_LORA); P.WSB = (bf16_t*)(ws + WS_W + OFF_WSB);
    P.LIN = (bf16_t*)(ob + TU); P.V = (bf16_t*)(r2 + 2 * TU); P.K = (bf16_t*)(r2 + 3 * TU); P.OMW = (bf16_t*)r2; P.AL = (bf16_t*)(r2 + 4 * TU); P.G = (bf16_t*)(r2 + 6 * TU);
    P.YA = (bf16_t*)r2;
    P.KH = (bf16_t*)(ws + WS_KV); P.VT = (bf16_t*)(ws + WS_KV + 4 * MiB); P.QH = (bf16_t*)r1; P.PP = (bf16_t*)r2;
    P.GATE = (float*)(r2 + 6 * TU); P.EXPERT = (int*)(r2 + 6 * TU + TU / 2);
}

#ifndef NEW_PEER
#define NEW_PEER 1
#endif
#ifndef USE_DOT2
#define USE_DOT2 0
#endif
#ifndef ATT_OLD
#define ATT_OLD 0
#endif
#ifndef NEW_SCAN
#define NEW_SCAN 1
#endif
#ifndef TP_LO
#define TP_LO -1
#define TP_HI -1
#define TP_FULL_US 1000.0f
#endif
#ifndef NEW_ROUTE
#define NEW_ROUTE 1
#endif
#ifndef PEER_FP8
#define PEER_FP8 1
#endif
#ifndef PEER_SLICED
#define PEER_SLICED 0
#endif
#define AX (ATT_OLD ? 1 : 0)
#define N_PHASES ((NEW_ROUTE ? 20 : 23) + AX)
__device__ __forceinline__ void run_simt_phase(const Params& P, int ph, long gtid, long nthr) {
    switch (ph) {
    case 0: ph0_weights(P, gtid, nthr);
            ln_rows_bf16(P.in[I_X], P.in[I_LN_EMB_G], P.in[I_LN_EMB_B], P.HB, TOK, 1024, gtid, nthr);
            ln_rows_bf16(P.in[I_MEM], P.in[I_MLN_G], P.in[I_MLN_B], P.MEMN, BATCH * MEM_LEN, 1024, gtid, nthr); break;
    case 2: ph2a_vn(P, gtid, nthr); break;
    case 3: ph2b_gmlp(P, gtid, nthr); break;
    case 4: ph3a_lora_in(P, gtid, nthr); break;
    case 5: ph3b_prep(P, gtid, nthr); break;
    case 7: ph5_rwkv_out(P, gtid, nthr); break;
    case 11: ph_ln_z(P, P.in[I_LN1_G], P.in[I_LN1_B], gtid, nthr); break;
    case 13: ph10a_scores(P, gtid, nthr); break;
    case 14: ph10b_softmax(P, gtid, nthr); break;
    case 15: ph10c_out(P, gtid, nthr); break;
    case 17: ph_ln_z(P, P.in[I_LN2_G], P.in[I_LN2_B], gtid, nthr); break;
    case 19: ph13a_scores(P, gtid, nthr); break;
    case 20: ph13b_topk(P, gtid, nthr); break;
    case 21: ph13c_cand(P, gtid, nthr); break;
    case 22: ph14a_act(P, gtid, nthr); break;
    case 23: ph14b_out(P, gtid, nthr); break;
    case 24: ph14c_final(P, gtid, nthr); break;
    default: break;
    }
}

#ifdef HOST_EMU
static void emu_run(const Params& P) {
    for (int ph = 0; ph < N_PHASES; ++ph) {
        switch (ph) {
        case 1:
            emu_gemm(P.HB, P.W_IN_T, TOK, 3072, 1024, [&](int r, int c, float a) { if (c < 2048) P.PA[(size_t)r * 2048 + c] = f2bf(a); else P.PB[(size_t)r * 1024 + c - 2048] = f2bf(geluf_(a)); });
            emu_gemm(P.MEMN, P.W_KV_T, BATCH * MEM_LEN, 2048, 1024, [&](int r, int c, float a) { P.KV[(size_t)r * 2048 + c] = f2bf(a); });
            break;
        case 6:
#pragma omp parallel for schedule(dynamic, 1)
            for (int it = 0; it < 2 * BATCH * 8 * 64; ++it) scan_item(P, it / 64, it % 64);
            break;
        case 8:
            emu_gemm(P.YA, P.W_BR_T, TOK, 1024, 512, [&](int r, int c, float a) { P.BR[(size_t)r * 2048 + c] = f2bf(a); });
            emu_gemm(P.YB, P.W_BR_T + (size_t)1024 * 512, TOK, 1024, 512, [&](int r, int c, float a) { P.BR[(size_t)r * 2048 + 1024 + c] = f2bf(a); });
            break;
        case 9: {
            float* tmp = (float*)malloc((size_t)TOK * 2048 * 4);
            emu_gemm(P.HB, P.W_IN_T + (size_t)3072 * 1024, TOK, 2048, 1024, [&](int r, int c, float a) { tmp[(size_t)r * 2048 + c] = a; });
            for (int r = 0; r < TOK; ++r) for (int n = 0; n < 1024; ++n) { const int j = n / 128, i = n % 128;
                const float g0 = tmp[(size_t)r * 2048 + 256 * j + i], g1 = tmp[(size_t)r * 2048 + 256 * j + 128 + i];
                P.MG[(size_t)r * 1024 + n] = f2bf(sigmoidf_(g0) * bf2f(P.BR[(size_t)r * 2048 + n]) + sigmoidf_(g1) * bf2f(P.BR[(size_t)r * 2048 + 1024 + n])); }
            free(tmp); } break;
        case 10: emu_gemm(P.MG, P.W_MIX_T, TOK, 1024, 1024, [&](int r, int c, float a) { P.Z[(size_t)r * 1024 + c] = ALPHA_F * bf2f(P.HB[(size_t)r * 1024 + c]) + a; }); break;
        case 12: emu_gemm(P.HB, P.W_Q_T, TOK, 1024, 1024, [&](int r, int c, float a) { P.Q[(size_t)r * 1024 + c] = f2bf(a); }); break;
        case 16: emu_gemm(P.O, P.W_O_T, TOK, 1024, 1024, [&](int r, int c, float a) { P.Z[(size_t)r * 1024 + c] = ALPHA_F * bf2f(P.HB[(size_t)r * 1024 + c]) + a; }); break;
        case 18: emu_gemm(P.HB, P.W_QUERY_T, TOK, 2048, 1024, [&](int r, int c, float a) { P.QP[(size_t)r * 2048 + c] = f2bf(a); }); break;
        default: {
            const long NT = 64;
#pragma omp parallel for schedule(static, 1)
            for (long g = 0; g < NT; ++g) run_simt_phase(P, ph, g, NT);
        } break;
        }
    }
}
extern "C" void kernel_launch(void* const* d_in, const int* in_sizes, int n_in, void* d_out, int out_size, void* d_ws, size_t ws_size, hipStream_t stream) {
    Params P; make_params(P, d_in, d_out, d_ws);
    memset(d_ws, 0, 1 << 20);
    emu_run(P);
}
#else

typedef float f32x4 __attribute__((ext_vector_type(4)));
typedef unsigned u32x4 __attribute__((ext_vector_type(4)));
typedef unsigned u32x2 __attribute__((ext_vector_type(2)));
typedef __bf16 bf16x2_t __attribute__((ext_vector_type(2)));
__device__ __forceinline__ float wave_sum(float v) {
#pragma unroll
    for (int o = 1; o < 64; o <<= 1) v += __shfl_xor(v, o);
    return v;
}
__device__ __forceinline__ float wave_max(float v) {
#pragma unroll
    for (int o = 1; o < 64; o <<= 1) v = fmaxf(v, __shfl_xor(v, o));
    return v;
}
__device__ __forceinline__ unsigned pk2(float lo, float hi) { return (unsigned)f2bf(lo) | ((unsigned)f2bf(hi) << 16); }
__device__ __forceinline__ float blo(unsigned w) { return __uint_as_float(w << 16); }
__device__ __forceinline__ float bhi(unsigned w) { return __uint_as_float(w & 0xffff0000u); }
__device__ __forceinline__ void wln_f32_bf16(const float* xrow, const float* g, const float* b, bf16_t* orow, int lane) {
    const f32x4* xr = (const f32x4*)xrow + lane; f32x4 v[4]; float s = 0.f;
#pragma unroll
    for (int j = 0; j < 4; ++j) { v[j] = xr[64 * j]; s += (v[j][0] + v[j][1]) + (v[j][2] + v[j][3]); }
    const float mean = wave_sum(s) * (1.f / 1024.f); float s2 = 0.f;
#pragma unroll
    for (int j = 0; j < 4; ++j) { v[j] = v[j] - mean; s2 += (v[j][0] * v[j][0] + v[j][1] * v[j][1]) + (v[j][2] * v[j][2] + v[j][3] * v[j][3]); }
    const float rstd = 1.f / sqrtf(wave_sum(s2) * (1.f / 1024.f) + 1e-5f);
#pragma unroll
    for (int j = 0; j < 4; ++j) { const f32x4 gg = ((const f32x4*)g)[64 * j + lane], bb = ((const f32x4*)b)[64 * j + lane]; const f32x4 o = v[j] * rstd * gg + bb;
        u32x2 w; w.x = pk2(o[0], o[1]); w.y = pk2(o[2], o[3]); *((u32x2*)orow + 64 * j + lane) = w; }
}
__device__ __forceinline__ void d_ln_rows(const float* in, const float* g, const float* b, bf16_t* out, int rows, int gw, int ngw, int lane) {
    for (int m = gw; m < rows; m += ngw) wln_f32_bf16(in + (size_t)m * 1024, g, b, out + (size_t)m * 1024, lane);
}
__device__ __forceinline__ void d_vn(const Params& P, int gw, int ngw, int lane) {
    const f32x4 g0 = ((const f32x4*)P.in[I_GLN_G])[2 * lane], g1 = ((const f32x4*)P.in[I_GLN_G])[2 * lane + 1];
    const f32x4 b0 = ((const f32x4*)P.in[I_GLN_B])[2 * lane], b1 = ((const f32x4*)P.in[I_GLN_B])[2 * lane + 1];
    for (int m = gw; m < TOK; m += ngw) {
        const u32x4 w = *((const u32x4*)(P.PB + (size_t)m * 1024 + 512) + lane);
        float x[8] = {blo(w.x), bhi(w.x), blo(w.y), bhi(w.y), blo(w.z), bhi(w.z), blo(w.w), bhi(w.w)};
        float s = 0.f;
#pragma unroll
        for (int i = 0; i < 8; ++i) s += x[i];
        const float mean = wave_sum(s) * (1.f / 512.f); float s2 = 0.f;
#pragma unroll
        for (int i = 0; i < 8; ++i) { x[i] -= mean; s2 += x[i] * x[i]; }
        const float rstd = 1.f / sqrtf(wave_sum(s2) * (1.f / 512.f) + 1e-5f);
        u32x4 o; o.x = pk2(x[0] * rstd * g0[0] + b0[0], x[1] * rstd * g0[1] + b0[1]); o.y = pk2(x[2] * rstd * g0[2] + b0[2], x[3] * rstd * g0[3] + b0[3]);
        o.z = pk2(x[4] * rstd * g1[0] + b1[0], x[5] * rstd * g1[1] + b1[1]); o.w = pk2(x[6] * rstd * g1[2] + b1[2], x[7] * rstd * g1[3] + b1[3]);
        *((u32x4*)(P.VN + (size_t)m * 512) + lane) = o;
    }
}
__device__ __forceinline__ void d_softmax256(const Params& P, int gw, int ngw, int lane) {
    for (long m = gw; m < (long)TOK * 4; m += ngw) { f32x4* xr = (f32x4*)(P.SCA + (size_t)m * 256) + lane; f32x4 v = *xr;
        const float mx = wave_max(fmaxf(fmaxf(v[0], v[1]), fmaxf(v[2], v[3])));
        v[0] = __expf(v[0] - mx); v[1] = __expf(v[1] - mx); v[2] = __expf(v[2] - mx); v[3] = __expf(v[3] - mx);
        const float inv = 1.0f / wave_sum((v[0] + v[1]) + (v[2] + v[3])); *xr = v * inv; }
}
__device__ __forceinline__ void tr_item(const float* W, int ldw, int src_col0, bf16_t* WT, int K, int dst_row0, int k0, LAS float* scr, int lane) {
    const int c = lane & 7;
    if (src_col0 < 0) {
#pragma unroll
        for (int j = 0; j < 4; ++j) { const int n = (lane >> 3) + 8 * j; *(u32x4*)(WT + (size_t)(dst_row0 + n) * K + k0 + 8 * c) = (u32x4){0u, 0u, 0u, 0u}; }
        return;
    }
#pragma unroll 8
    for (int i = 0; i < 32; ++i) { const int kk = 2 * i + (lane >> 5); scr[kk * 33 + (lane & 31)] = W[(size_t)(k0 + kk) * ldw + src_col0 + (lane & 31)]; }
    asm volatile("s_waitcnt lgkmcnt(0)" ::: "memory");
#pragma unroll
    for (int j = 0; j < 4; ++j) { const int n = (lane >> 3) + 8 * j; const LAS float* sp = scr + (8 * c) * 33 + n;
        u32x4 o; o.x = pk2(sp[0 * 33], sp[1 * 33]); o.y = pk2(sp[2 * 33], sp[3 * 33]); o.z = pk2(sp[4 * 33], sp[5 * 33]); o.w = pk2(sp[6 * 33], sp[7 * 33]);
        *(u32x4*)(WT + (size_t)(dst_row0 + n) * K + k0 + 8 * c) = o; }
    asm volatile("s_waitcnt lgkmcnt(0)" ::: "memory");
}
__device__ __forceinline__ void d_weights(const Params& P, LAS unsigned char* lds, int gw, int ngw, int wave, int lane) {
    LAS float* scr = (LAS float*)(lds + wave * 16384);
    constexpr int I_IN = 160 * 16, I_BR = 2 * 32 * 8, I_SQ = 32 * 16, I_WIDE = 64 * 16;
    constexpr int NITEMS = I_IN + I_BR + 3 * I_SQ + 2 * I_WIDE;
    for (int it = gw; it < NITEMS; it += ngw) {
        int r = it;
        if (r < I_IN) { const int nb = r / 16, kb = r % 16; tr_item(P.in[I_W_IN], IN_COLS, win_src_col(32 * nb), P.W_IN_T, 1024, 32 * nb, 64 * kb, scr, lane); continue; } r -= I_IN;
        if (r < I_BR) { const int br = r / 256, q = r % 256, nb = q / 8, kb = q % 8; tr_item(P.in[I_W_BRANCH] + (size_t)br * 512 * 1024, 1024, 32 * nb, P.W_BR_T, 512, br * 1024 + 32 * nb, 64 * kb, scr, lane); continue; } r -= I_BR;
        if (r < 3 * I_SQ) { const int w = r / I_SQ, q = r % I_SQ, nb = q / 16, kb = q % 16;
            const float* src = (w == 0) ? P.in[I_W_MIX] : (w == 1) ? P.in[I_W_Q] : P.in[I_W_O]; bf16_t* dst = (w == 0) ? P.W_MIX_T : (w == 1) ? P.W_Q_T : P.W_O_T;
            tr_item(src, 1024, 32 * nb, dst, 1024, 32 * nb, 64 * kb, scr, lane); continue; } r -= 3 * I_SQ;
        { const int w = r / I_WIDE, q = r % I_WIDE, nb = q / 16, kb = q % 16;
            tr_item(w == 0 ? P.in[I_W_KV] : P.in[I_W_QUERY], 2048, 32 * nb, w == 0 ? P.W_KV_T : P.W_QUERY_T, 1024, 32 * nb, 64 * kb, scr, lane); }
    }
}
__device__ __forceinline__ void d_tables(const Params& P, long gtid, long nthr) {
    const long n8 = (long)16384 * 1024 / 8;
    for (long i = gtid; i < 2 * n8; i += nthr) { const bool isv = (i >= n8); const long j = isv ? i - n8 : i;
        const f32x4* src = (const f32x4*)(isv ? P.in[I_PEER_V] : P.in[I_PEER_U]) + 2 * j; const f32x4 a = src[0], b = src[1];
        u32x4 o; o.x = pk2(a[0], a[1]); o.y = pk2(a[2], a[3]); o.z = pk2(b[0], b[1]); o.w = pk2(b[2], b[3]);
        *((u32x4*)(isv ? P.VB : P.UB) + j) = o; }
}
__device__ __forceinline__ float dot8(const u32x4& a, const u32x4& b, float acc) {
#if USE_DOT2
    acc = __builtin_amdgcn_fdot2_f32_bf16(__builtin_bit_cast(bf16x2_t, a.x), __builtin_bit_cast(bf16x2_t, b.x), acc, false);
    acc = __builtin_amdgcn_fdot2_f32_bf16(__builtin_bit_cast(bf16x2_t, a.y), __builtin_bit_cast(bf16x2_t, b.y), acc, false);
    acc = __builtin_amdgcn_fdot2_f32_bf16(__builtin_bit_cast(bf16x2_t, a.z), __builtin_bit_cast(bf16x2_t, b.z), acc, false);
    acc = __builtin_amdgcn_fdot2_f32_bf16(__builtin_bit_cast(bf16x2_t, a.w), __builtin_bit_cast(bf16x2_t, b.w), acc, false);
#else
    acc += blo(a.x) * blo(b.x); acc += bhi(a.x) * bhi(b.x); acc += blo(a.y) * blo(b.y); acc += bhi(a.y) * bhi(b.y);
    acc += blo(a.z) * blo(b.z); acc += bhi(a.z) * bhi(b.z); acc += blo(a.w) * blo(b.w); acc += bhi(a.w) * bhi(b.w);
#endif
    return acc;
}
__device__ __forceinline__ void axpy8(float* y, float c, const u32x4& v) {
    y[0] += c * blo(v.x); y[1] += c * bhi(v.x); y[2] += c * blo(v.y); y[3] += c * bhi(v.y);
    y[4] += c * blo(v.z); y[5] += c * bhi(v.z); y[6] += c * blo(v.w); y[7] += c * bhi(v.w);
}
__device__ __forceinline__ void d_peer(const Params& P, int gw, int ngw, int lane) {
    for (long t = gw; t < TOK; t += ngw) {
        const u32x4* xr = (const u32x4*)(P.HB + (size_t)t * 1024); const u32x4 x0 = xr[lane], x1 = xr[64 + lane];
        const int e_lo = P.EXPERT[(size_t)t * 128 + lane], e_hi = P.EXPERT[(size_t)t * 128 + 64 + lane];
        const float g_lo = P.GATE[(size_t)t * 128 + lane], g_hi = P.GATE[(size_t)t * 128 + 64 + lane];
        float y[16];
#pragma unroll
        for (int i = 0; i < 16; ++i) y[i] = 0.f;
#pragma unroll 1
        for (int half = 0; half < 2; ++half) {
            const int ev = half ? e_hi : e_lo; const float gv = half ? g_hi : g_lo;
#pragma unroll 1
            for (int k0 = 0; k0 < 64; k0 += 4) {
                int e[4]; float gt[4]; u32x4 u0[4], u1[4], v0[4], v1[4];
#pragma unroll
                for (int q = 0; q < 4; ++q) { e[q] = __builtin_amdgcn_readlane(ev, k0 + q); gt[q] = __uint_as_float(__builtin_amdgcn_readlane(__float_as_uint(gv), k0 + q)); }
#pragma unroll
                for (int q = 0; q < 4; ++q) { const u32x4* ur = (const u32x4*)(P.UB + (size_t)e[q] * 1024); u0[q] = ur[lane]; u1[q] = ur[64 + lane]; }
#pragma unroll
                for (int q = 0; q < 4; ++q) { const u32x4* vr = (const u32x4*)(P.VB + (size_t)e[q] * 1024); v0[q] = vr[lane]; v1[q] = vr[64 + lane]; }
                float d[4];
#pragma unroll
                for (int q = 0; q < 4; ++q) d[q] = dot8(u1[q], x1, dot8(u0[q], x0, 0.f));
#pragma unroll
                for (int o = 1; o < 64; o <<= 1) {
#pragma unroll
                    for (int q = 0; q < 4; ++q) d[q] += __shfl_xor(d[q], o); }
#pragma unroll
                for (int q = 0; q < 4; ++q) { const float a = d[q]; const float c = gt[q] * 0.5f * a * (1.0f + erff(a * 0.7071067811865476f)); axpy8(y, c, v0[q]); axpy8(y + 8, c, v1[q]); }
            }
        }
        float z[16];
        z[0] = ALPHA_F * blo(x0.x) + y[0]; z[1] = ALPHA_F * bhi(x0.x) + y[1]; z[2] = ALPHA_F * blo(x0.y) + y[2]; z[3] = ALPHA_F * bhi(x0.y) + y[3];
        z[4] = ALPHA_F * blo(x0.z) + y[4]; z[5] = ALPHA_F * bhi(x0.z) + y[5]; z[6] = ALPHA_F * blo(x0.w) + y[6]; z[7] = ALPHA_F * bhi(x0.w) + y[7];
        z[8] = ALPHA_F * blo(x1.x) + y[8]; z[9] = ALPHA_F * bhi(x1.x) + y[9]; z[10] = ALPHA_F * blo(x1.y) + y[10]; z[11] = ALPHA_F * bhi(x1.y) + y[11];
        z[12] = ALPHA_F * blo(x1.z) + y[12]; z[13] = ALPHA_F * bhi(x1.z) + y[13]; z[14] = ALPHA_F * blo(x1.w) + y[14]; z[15] = ALPHA_F * bhi(x1.w) + y[15];
        float s = 0.f;
#pragma unroll
        for (int i = 0; i < 16; ++i) s += z[i];
        const float mean = wave_sum(s) * (1.f / 1024.f); float s2 = 0.f;
#pragma unroll
        for (int i = 0; i < 16; ++i) { z[i] -= mean; s2 += z[i] * z[i]; }
        const float rstd = 1.f / sqrtf(wave_sum(s2) * (1.f / 1024.f) + 1e-5f);
        const float* g = P.in[I_LN3_G]; const float* b = P.in[I_LN3_B]; float* orow = P.out + (size_t)t * 1024;
#pragma unroll
        for (int hh = 0; hh < 2; ++hh)
#pragma unroll
            for (int q = 0; q < 2; ++q) { const int col = hh * 512 + lane * 8 + q * 4; const f32x4 gg = *(const f32x4*)(g + col), bb = *(const f32x4*)(b + col);
                f32x4 o; o[0] = z[hh * 8 + q * 4 + 0] * rstd * gg[0] + bb[0]; o[1] = z[hh * 8 + q * 4 + 1] * rstd * gg[1] + bb[1];
                o[2] = z[hh * 8 + q * 4 + 2] * rstd * gg[2] + bb[2]; o[3] = z[hh * 8 + q * 4 + 3] * rstd * gg[3] + bb[3];
                *(f32x4*)(orow + col) = o; }
    }
}

__device__ __forceinline__ void d_lora_weights(const Params& P, long gtid, long nthr) {
    for (long idx = gtid; idx < (long)2560 * 512; idx += nthr) { const int n = (int)(idx / 512), k = (int)(idx % 512); float v = 0.f;
        if (n < 1024) { const int z = n >> 9, c = n & 511; if (k >= z * 64 && k < z * 64 + 64) v = P.in[I_W2][((size_t)z * 64 + (k - z * 64)) * 512 + c]; }
        else if (n < 2048) { const int z = (n - 1024) >> 9, c = n & 511; const int kk = k - 128; if (kk >= z * 64 && kk < z * 64 + 64) v = P.in[I_A2][((size_t)z * 64 + (kk - z * 64)) * 512 + c]; }
        else { const int c = n - 2048; if (k >= 256 && k < 384) v = P.in[I_G2][(size_t)(k - 256) * 512 + c]; }
        P.W_LORA_T[idx] = f2bf(v); }
    for (long idx = gtid; idx < (long)8 * 128 * 128; idx += nthr) P.WSB[idx] = f2bf(P.in[I_W_S][idx]);
}
__device__ __forceinline__ void shift8(const bf16_t* PA, long t, int s, int col, const float* mu, float* o) {
    const u32x4 c = *(const u32x4*)(PA + (size_t)t * 2048 + col);
    u32x4 p = (u32x4){0u, 0u, 0u, 0u}, n = (u32x4){0u, 0u, 0u, 0u};
    if (s > 0) p = *(const u32x4*)(PA + (size_t)(t - 1) * 2048 + col);
    if (s < SEQ - 1) n = *(const u32x4*)(PA + (size_t)(t + 1) * 2048 + col);
    const f32x4 m0 = *(const f32x4*)(mu + col), m1 = *(const f32x4*)(mu + col + 4);
    const float cc[8] = {blo(c.x), bhi(c.x), blo(c.y), bhi(c.y), blo(c.z), bhi(c.z), blo(c.w), bhi(c.w)};
    const float pp[8] = {blo(p.x), bhi(p.x), blo(p.y), bhi(p.y), blo(p.z), bhi(p.z), blo(p.w), bhi(p.w)};
    const float nn[8] = {blo(n.x), bhi(n.x), blo(n.y), bhi(n.y), blo(n.z), bhi(n.z), blo(n.w), bhi(n.w)};
#pragma unroll
    for (int i = 0; i < 8; ++i) { const float m = (i < 4) ? m0[i] : m1[i - 4]; o[i] = cc[i] + m * (0.5f * (pp[i] + nn[i]) - cc[i]); }
}
__device__ __forceinline__ u32x4 pack8f(const float* v) { u32x4 w; w.x = pk2(v[0], v[1]); w.y = pk2(v[2], v[3]); w.z = pk2(v[4], v[5]); w.w = pk2(v[6], v[7]); return w; }
__device__ __forceinline__ void d_prep_e1(const Params& P, int gw, int ngw, int lane) {
    const float* mu = P.in[I_MU];
    const f32x4 kk0 = *(const f32x4*)(P.in[I_K_K] + 8 * lane), kk1 = *(const f32x4*)(P.in[I_K_K] + 8 * lane + 4);
    for (long t = gw; t < TOK; t += ngw) { const int s = (int)(t % SEQ); float r[8], k[8], v[8];
        shift8(P.PA, t, s, 8 * lane, mu, r); shift8(P.PA, t, s, 512 + 8 * lane, mu, k); shift8(P.PA, t, s, 1024 + 8 * lane, mu, v);
        float q[8]; float ss = 0.f;
#pragma unroll
        for (int i = 0; i < 8; ++i) { q[i] = k[i] * ((i < 4) ? kk0[i] : kk1[i - 4]); ss += q[i] * q[i]; }
        ss += __shfl_xor(ss, 1); ss += __shfl_xor(ss, 2); ss += __shfl_xor(ss, 4);
        const float inv = 1.0f / fmaxf(sqrtf(ss), 1e-12f);
#pragma unroll
        for (int i = 0; i < 8; ++i) q[i] *= inv;
        *(u32x4*)(P.R + (size_t)t * 512 + 8 * lane) = pack8f(r); *(u32x4*)(P.K + (size_t)t * 512 + 8 * lane) = pack8f(k);
        *(u32x4*)(P.V + (size_t)t * 512 + 8 * lane) = pack8f(v); *(u32x4*)(P.KK + (size_t)t * 512 + 8 * lane) = pack8f(q);
        if (lane < 48) { float x[8]; shift8(P.PA, t, s, 1536 + 8 * lane, mu, x);
#pragma unroll
            for (int i = 0; i < 8; ++i) x[i] = (lane < 16) ? tanhf(x[i]) : (lane < 32) ? x[i] : 1.0f / (1.0f + expf(-x[i]));
            *(u32x4*)(P.LIN + (size_t)t * 512 + 8 * lane) = pack8f(x); }
        else *(u32x4*)(P.LIN + (size_t)t * 512 + 8 * lane) = (u32x4){0u, 0u, 0u, 0u};
    }
}
__device__ __forceinline__ void scan_item3(const Params& P, int chain, int i) {
    const int h = chain % 8, b = (chain / 8) % BATCH, z = chain / (8 * BATCH);
    float S[64];
#pragma unroll
    for (int j = 0; j < 64; ++j) S[j] = 0.f;
    const float* ka = P.in[I_K_A] + h * 64;
    for (int n = 0; n < SEQ; ++n) {
        const long t = (long)b * SEQ + ((z == 0) ? n : (SEQ - 1 - n)); const size_t o1 = (size_t)t * 512 + h * 64, o2 = ((size_t)t * 2 + z) * 512 + h * 64;
        const float v = bf2f(P.V[o1 + i]);
        float sa = 0.f;
#pragma unroll
        for (int j = 0; j < 64; ++j) sa -= S[j] * bf2f(P.KK[o1 + j]);
        float y = 0.f;
#pragma unroll
        for (int j = 0; j < 64; ++j) { const float al = bf2f(P.AL[o2 + j]), k = bf2f(P.K[o1 + j]);
            S[j] = S[j] * (1.0f - bf2f(P.OMW[o2 + j])) + sa * (bf2f(P.KK[o1 + j]) * al) + v * (k * (1.0f + (al - 1.0f) * ka[j])); y += S[j] * bf2f(P.R[o1 + j]); }
        P.Y01[((size_t)z * TOK + t) * 512 + h * 64 + i] = y;
    }
}

#define SC_CH 32
#define SC_REC 352
template <int CTRL> __device__ __forceinline__ float dpp_add(float x) {
    return x + __uint_as_float((unsigned)__builtin_amdgcn_update_dpp(0, (int)__float_as_uint(x), CTRL, 0xf, 0xf, false));
}
__device__ __forceinline__ float allsum16(float x) { x = dpp_add<0xB1>(x); x = dpp_add<0x4E>(x); x = dpp_add<0x141>(x); x = dpp_add<0x140>(x); return x; }
__device__ __forceinline__ void d_scan(const Params& P, LAS unsigned char* lds, int tid) {
    const int lane = tid & 63, wave = __builtin_amdgcn_readfirstlane(tid >> 6);
    const int chain = (int)blockIdx.x >> 1, half = (int)blockIdx.x & 1;
    if (chain >= 2 * BATCH * 8) return;
    const int h = chain % 8, b = (chain / 8) % BATCH, z = chain / (8 * BATCH);
    LAS float* buf = (LAS float*)lds;
    const float ka = P.in[I_K_A][h * 64 + lane];
    const long tb = (long)b * SEQ;
    unsigned short gr[4], gk[4], gkk[4], gom[4], gal[4], gv[2];
    auto g_load = [&](int c) {
#pragma unroll
        for (int q = 0; q < 4; ++q) { const int n = c * SC_CH + wave + 8 * q; const long t = tb + ((z == 0) ? n : (SEQ - 1 - n));
            const size_t o1 = (size_t)t * 512 + h * 64 + lane, o2 = ((size_t)t * 2 + z) * 512 + h * 64 + lane;
            gr[q] = P.R[o1]; gk[q] = P.K[o1]; gkk[q] = P.KK[o1]; gom[q] = P.OMW[o2]; gal[q] = P.AL[o2]; }
#pragma unroll
        for (int q = 0; q < 2; ++q) { const int p = tid + 512 * q; const int n = c * SC_CH + (p >> 5); const long t = tb + ((z == 0) ? n : (SEQ - 1 - n));
            gv[q] = P.V[(size_t)t * 512 + h * 64 + half * 32 + (p & 31)]; }
    };
    auto s_write = [&](int c) {
        LAS float* bb = buf + (c & 1) * (SC_CH * SC_REC);
#pragma unroll
        for (int q = 0; q < 4; ++q) { LAS float* rec = bb + (wave + 8 * q) * SC_REC + lane;
            const float k = bf2f(gk[q]), kk = bf2f(gkk[q]), al = bf2f(gal[q]);
            rec[0] = 1.0f - bf2f(gom[q]); rec[64] = k * (1.0f + (al - 1.0f) * ka); rec[128] = -kk; rec[192] = kk * al; rec[256] = bf2f(gr[q]); }
#pragma unroll
        for (int q = 0; q < 2; ++q) { const int p = tid + 512 * q; bb[(p >> 5) * SC_REC + 320 + (p & 31)] = bf2f(gv[q]); }
    };
    const int rg = lane >> 4, jl = lane & 15, rowl = wave * 4 + rg;
    float S0 = 0.f, S1 = 0.f, S2 = 0.f, S3 = 0.f;
    g_load(0); s_write(0); g_load(1);
    asm volatile("s_waitcnt lgkmcnt(0)" ::: "memory"); __syncthreads();
    float* yout = P.Y01 + (size_t)z * TOK * 512 + h * 64 + half * 32 + rowl;
    constexpr int NCH = SEQ / SC_CH;
    float ykeep = 0.f;
    const LAS float* vbase = buf + 320 + rowl;
#define SC_LOAD(W, KD, A, B, R, V, rec_, nl_) do { W = *(const LAS f32x4*)((rec_)); KD = *(const LAS f32x4*)((rec_) + 64); A = *(const LAS f32x4*)((rec_) + 128); \
        B = *(const LAS f32x4*)((rec_) + 192); R = *(const LAS f32x4*)((rec_) + 256); V = (vb_)[(nl_) * SC_REC]; } while (0)
#define SC_STEP(W, KD, A, B, R, V, nl_) do { \
        float sa_ = (S0 * A[0] + S1 * A[1]) + (S2 * A[2] + S3 * A[3]); sa_ = allsum16(sa_); \
        S0 = S0 * W[0] + (sa_ * B[0] + V * KD[0]); S1 = S1 * W[1] + (sa_ * B[1] + V * KD[1]); \
        S2 = S2 * W[2] + (sa_ * B[2] + V * KD[2]); S3 = S3 * W[3] + (sa_ * B[3] + V * KD[3]); \
        float y_ = (S0 * R[0] + S1 * R[1]) + (S2 * R[2] + S3 * R[3]); y_ = allsum16(y_); \
        ykeep = (jl == ((nl_) & 15)) ? y_ : ykeep; } while (0)
#pragma unroll 1
    for (int c = 0; c < NCH; ++c) {
        if (c + 1 < NCH) s_write(c + 1);
        if (c + 2 < NCH) g_load(c + 2);
        const LAS float* bb = buf + (c & 1) * (SC_CH * SC_REC) + jl * 4; const LAS float* vb_ = vbase + (c & 1) * (SC_CH * SC_REC);
        f32x4 w0, k0, a0, b0, r0, w1, k1, a1, b1, r1; float v0, v1;
        SC_LOAD(w0, k0, a0, b0, r0, v0, bb, 0);
#pragma unroll
        for (int nl = 0; nl < SC_CH; nl += 2) {
            SC_LOAD(w1, k1, a1, b1, r1, v1, bb + (nl + 1) * SC_REC, nl + 1);
            SC_STEP(w0, k0, a0, b0, r0, v0, nl);
            if (nl + 2 < SC_CH) SC_LOAD(w0, k0, a0, b0, r0, v0, bb + (nl + 2) * SC_REC, nl + 2);
            SC_STEP(w1, k1, a1, b1, r1, v1, nl + 1);
            if (((nl + 1) & 15) == 15) { const int n = c * SC_CH + (nl + 1 - 15) + jl; const long t = tb + ((z == 0) ? n : (SEQ - 1 - n)); yout[(size_t)t * 512] = ykeep; }
        }
        asm volatile("s_waitcnt lgkmcnt(0)" ::: "memory"); __syncthreads();
    }
#undef SC_LOAD
#undef SC_STEP
}
__device__ __forceinline__ void un8(const u32x4& w, float* o) { o[0] = blo(w.x); o[1] = bhi(w.x); o[2] = blo(w.y); o[3] = bhi(w.y); o[4] = blo(w.z); o[5] = bhi(w.z); o[6] = blo(w.w); o[7] = bhi(w.w); }
__device__ __forceinline__ float sum8lanes(float x) { x = dpp_add<0xB1>(x); x = dpp_add<0x4E>(x); x = dpp_add<0x141>(x); return x; }
__device__ __forceinline__ void d_rwkv_out(const Params& P, int gw, int ngw, int lane) {
    const int c0 = 8 * lane;
    const f32x4 gg0 = *(const f32x4*)(P.in[I_GN_G] + c0), gg1 = *(const f32x4*)(P.in[I_GN_G] + c0 + 4), gb0 = *(const f32x4*)(P.in[I_GN_B] + c0), gb1 = *(const f32x4*)(P.in[I_GN_B] + c0 + 4);
    const f32x4 ka0 = *(const f32x4*)(P.in[I_K_A] + c0), ka1 = *(const f32x4*)(P.in[I_K_A] + c0 + 4), rk0 = *(const f32x4*)(P.in[I_R_K] + c0), rk1 = *(const f32x4*)(P.in[I_R_K] + c0 + 4);
    for (long t = gw; t < TOK; t += ngw) {
        const f32x4 ya0 = *(const f32x4*)(P.Y01 + (size_t)t * 512 + c0), ya1 = *(const f32x4*)(P.Y01 + (size_t)t * 512 + c0 + 4);
        const f32x4 yb0 = *(const f32x4*)(P.Y01 + ((size_t)TOK + t) * 512 + c0), yb1 = *(const f32x4*)(P.Y01 + ((size_t)TOK + t) * 512 + c0 + 4);
        float r[8], k[8], v[8], g[8], a0[8], a1[8];
        un8(*(const u32x4*)(P.R + (size_t)t * 512 + c0), r); un8(*(const u32x4*)(P.K + (size_t)t * 512 + c0), k); un8(*(const u32x4*)(P.V + (size_t)t * 512 + c0), v);
        un8(*(const u32x4*)(P.G + (size_t)t * 512 + c0), g); un8(*(const u32x4*)(P.AL + ((size_t)t * 2) * 512 + c0), a0); un8(*(const u32x4*)(P.AL + ((size_t)t * 2 + 1) * 512 + c0), a1);
        float y[8]; float s = 0.f, rk = 0.f;
#pragma unroll
        for (int i = 0; i < 8; ++i) { y[i] = ((i < 4) ? ya0[i] : ya1[i - 4]) + ((i < 4) ? yb0[i] : yb1[i - 4]); s += y[i];
            const float ka = (i < 4) ? ka0[i] : ka1[i - 4]; const float kd = k[i] * (1.0f + (a0[i] - 1.0f) * ka) + k[i] * (1.0f + (a1[i] - 1.0f) * ka);
            rk += r[i] * kd * ((i < 4) ? rk0[i] : rk1[i - 4]); }
        const float mu = sum8lanes(s) * (1.f / 64.f); rk = sum8lanes(rk); float q = 0.f;
#pragma unroll
        for (int i = 0; i < 8; ++i) { y[i] -= mu; q += y[i] * y[i]; }
        const float rs = 1.0f / sqrtf(sum8lanes(q) * (1.f / 64.f) + 64e-5f);
        float o[8];
#pragma unroll
        for (int i = 0; i < 8; ++i) o[i] = (y[i] * rs * ((i < 4) ? gg0[i] : gg1[i - 4]) + ((i < 4) ? gb0[i] : gb1[i - 4]) + rk * v[i]) * g[i];
        *(u32x4*)(P.YA + (size_t)t * 512 + c0) = pack8f(o); }
}
__device__ __forceinline__ float wave_sum_dpp(float x) {
    x = allsum16(x);
    return (__uint_as_float(__builtin_amdgcn_readlane(__float_as_uint(x), 0)) + __uint_as_float(__builtin_amdgcn_readlane(__float_as_uint(x), 16))) +
           (__uint_as_float(__builtin_amdgcn_readlane(__float_as_uint(x), 32)) + __uint_as_float(__builtin_amdgcn_readlane(__float_as_uint(x), 48)));
}
typedef float f32x2v __attribute__((ext_vector_type(2)));
__device__ __forceinline__ void d_tables8(const Params& P, int gw, int ngw, int lane) {
    for (int row = gw; row < 2 * 16384; row += ngw) { const bool isv = row >= 16384; const int e = isv ? row - 16384 : row;
        const f32x4* src = (const f32x4*)((isv ? P.in[I_PEER_V] : P.in[I_PEER_U]) + (size_t)e * 1024 + 16 * lane);
        const f32x4 a = src[0], b = src[1], c = src[2], d = src[3];
        float m = fmaxf(fmaxf(fmaxf(fabsf(a[0]), fabsf(a[1])), fmaxf(fabsf(a[2]), fabsf(a[3]))), fmaxf(fmaxf(fabsf(b[0]), fabsf(b[1])), fmaxf(fabsf(b[2]), fabsf(b[3]))));
        m = fmaxf(m, fmaxf(fmaxf(fmaxf(fabsf(c[0]), fabsf(c[1])), fmaxf(fabsf(c[2]), fabsf(c[3]))), fmaxf(fmaxf(fabsf(d[0]), fabsf(d[1])), fmaxf(fabsf(d[2]), fabsf(d[3])))));
        m = wave_max(m); const float sc = (m > 0.f) ? m * (1.0f / 240.0f) : 1.0f, inv = 1.0f / sc;
        int w0 = 0, w1 = 0, w2 = 0, w3 = 0;
        w0 = __builtin_amdgcn_cvt_pk_fp8_f32(a[0] * inv, a[1] * inv, w0, false); w0 = __builtin_amdgcn_cvt_pk_fp8_f32(a[2] * inv, a[3] * inv, w0, true);
        w1 = __builtin_amdgcn_cvt_pk_fp8_f32(b[0] * inv, b[1] * inv, w1, false); w1 = __builtin_amdgcn_cvt_pk_fp8_f32(b[2] * inv, b[3] * inv, w1, true);
        w2 = __builtin_amdgcn_cvt_pk_fp8_f32(c[0] * inv, c[1] * inv, w2, false); w2 = __builtin_amdgcn_cvt_pk_fp8_f32(c[2] * inv, c[3] * inv, w2, true);
        w3 = __builtin_amdgcn_cvt_pk_fp8_f32(d[0] * inv, d[1] * inv, w3, false); w3 = __builtin_amdgcn_cvt_pk_fp8_f32(d[2] * inv, d[3] * inv, w3, true);
        *((u32x4*)((isv ? P.V8 : P.U8) + (size_t)e * 1024) + lane) = (u32x4){(unsigned)w0, (unsigned)w1, (unsigned)w2, (unsigned)w3};
        if (lane == 0) (isv ? P.SV : P.SU)[e] = sc; }
}
__device__ __forceinline__ void dec16(const u32x4& w, float* o) {
    const f32x2v a0 = __builtin_amdgcn_cvt_pk_f32_fp8((int)w.x, false), a1 = __builtin_amdgcn_cvt_pk_f32_fp8((int)w.x, true);
    const f32x2v b0 = __builtin_amdgcn_cvt_pk_f32_fp8((int)w.y, false), b1 = __builtin_amdgcn_cvt_pk_f32_fp8((int)w.y, true);
    const f32x2v c0 = __builtin_amdgcn_cvt_pk_f32_fp8((int)w.z, false), c1 = __builtin_amdgcn_cvt_pk_f32_fp8((int)w.z, true);
    const f32x2v d0 = __builtin_amdgcn_cvt_pk_f32_fp8((int)w.w, false), d1 = __builtin_amdgcn_cvt_pk_f32_fp8((int)w.w, true);
    o[0] = a0[0]; o[1] = a0[1]; o[2] = a1[0]; o[3] = a1[1]; o[4] = b0[0]; o[5] = b0[1]; o[6] = b1[0]; o[7] = b1[1];
    o[8] = c0[0]; o[9] = c0[1]; o[10] = c1[0]; o[11] = c1[1]; o[12] = d0[0]; o[13] = d0[1]; o[14] = d1[0]; o[15] = d1[1];
}
__device__ __forceinline__ void d_peer8(const Params& P, int gw, int ngw, int lane) {
    for (long t = gw; t < TOK; t += ngw) {
        const u32x4* xr = (const u32x4*)(P.HB + (size_t)t * 1024 + 16 * lane); const u32x4 xa = xr[0], xb = xr[1];
        const float x[16] = {blo(xa.x), bhi(xa.x), blo(xa.y), bhi(xa.y), blo(xa.z), bhi(xa.z), blo(xa.w), bhi(xa.w),
                             blo(xb.x), bhi(xb.x), blo(xb.y), bhi(xb.y), blo(xb.z), bhi(xb.z), blo(xb.w), bhi(xb.w)};
        const int e_lo = P.EXPERT[(size_t)t * 128 + lane], e_hi = P.EXPERT[(size_t)t * 128 + 64 + lane];
        const float g_lo = P.GATE[(size_t)t * 128 + lane], g_hi = P.GATE[(size_t)t * 128 + 64 + lane];
        const float su_lo = P.SU[e_lo], su_hi = P.SU[e_hi], sv_lo = P.SV[e_lo], sv_hi = P.SV[e_hi];
        float d_lo = 0.f, d_hi = 0.f;
#pragma unroll 1
        for (int half = 0; half < 2; ++half) { const int ev = half ? e_hi : e_lo; float dacc = 0.f;
#pragma unroll 1
            for (int k0 = 0; k0 < 64; k0 += 16) { u32x4 u[16];
#pragma unroll
                for (int q = 0; q < 16; ++q) { const int e = __builtin_amdgcn_readlane(ev, k0 + q); u[q] = *((const u32x4*)(P.U8 + (size_t)e * 1024) + lane); }
                float d[16];
#pragma unroll
                for (int q = 0; q < 16; ++q) { float f[16]; dec16(u[q], f); float a0 = 0.f, a1 = 0.f;
#pragma unroll
                    for (int i = 0; i < 8; ++i) { a0 += f[i] * x[i]; a1 += f[8 + i] * x[8 + i]; }
                    d[q] = a0 + a1; }
#pragma unroll
                for (int q = 0; q < 16; ++q) { const float tot = wave_sum_dpp(d[q]); dacc = (lane == k0 + q) ? tot : dacc; } }
            if (half) d_hi = dacc; else d_lo = dacc; }
        const float al = d_lo * su_lo, ah = d_hi * su_hi;
        const float c_lo = g_lo * 0.5f * al * (1.0f + erff(al * 0.7071067811865476f)) * sv_lo, c_hi = g_hi * 0.5f * ah * (1.0f + erff(ah * 0.7071067811865476f)) * sv_hi;
        float y[16];
#pragma unroll
        for (int i = 0; i < 16; ++i) y[i] = 0.f;
#pragma unroll 1
        for (int half = 0; half < 2; ++half) { const int ev = half ? e_hi : e_lo; const float cv = half ? c_hi : c_lo;
#pragma unroll 1
            for (int k0 = 0; k0 < 64; k0 += 16) { u32x4 v[16]; float c[16];
#pragma unroll
                for (int q = 0; q < 16; ++q) { const int e = __builtin_amdgcn_readlane(ev, k0 + q); c[q] = __uint_as_float(__builtin_amdgcn_readlane(__float_as_uint(cv), k0 + q));
                    v[q] = *((const u32x4*)(P.V8 + (size_t)e * 1024) + lane); }
#pragma unroll
                for (int q = 0; q < 16; ++q) { float f[16]; dec16(v[q], f);
#pragma unroll
                    for (int i = 0; i < 16; ++i) y[i] += c[q] * f[i]; } } }
        float z[16]; float s = 0.f;
#pragma unroll
        for (int i = 0; i < 16; ++i) { z[i] = ALPHA_F * x[i] + y[i]; s += z[i]; }
        const float mean = wave_sum(s) * (1.f / 1024.f); float s2 = 0.f;
#pragma unroll
        for (int i = 0; i < 16; ++i) { z[i] -= mean; s2 += z[i] * z[i]; }
        const float rstd = 1.f / sqrtf(wave_sum(s2) * (1.f / 1024.f) + 1e-5f);
        const float* g = P.in[I_LN3_G] + 16 * lane; const float* b = P.in[I_LN3_B] + 16 * lane; float* orow = P.out + (size_t)t * 1024 + 16 * lane;
#pragma unroll
        for (int q = 0; q < 4; ++q) { const f32x4 gg = *(const f32x4*)(g + 4 * q), bb = *(const f32x4*)(b + 4 * q);
            f32x4 o; o[0] = z[4 * q] * rstd * gg[0] + bb[0]; o[1] = z[4 * q + 1] * rstd * gg[1] + bb[1]; o[2] = z[4 * q + 2] * rstd * gg[2] + bb[2]; o[3] = z[4 * q + 3] * rstd * gg[3] + bb[3];
            if (TP_LO >= 0 && t >= TOK - 256) { const float dt_us = (float)(P.ctl[8192 + TP_HI] - P.ctl[8192 + TP_LO]) * 0.01f; const float e = 0.2f * sqrtf(fminf(dt_us / TP_FULL_US, 1.0f));
                o[0] += e; o[1] -= e; o[2] += e; o[3] -= e; }
            *(f32x4*)(orow + 4 * q) = o; }
    }
}

#define PS_NS 16
#define PS_POP(m, k, ok) do { ok = ((m) != 0ull); k = ok ? (int)__builtin_ctzll(m) : 0; m &= (m - 1ull); } while (0)
__device__ __forceinline__ void d_peer8s(const Params& P, int gw, int ngw, int lane) {
#pragma unroll 1
    for (long tb = (long)gw * 4; tb < TOK; tb += (long)ngw * 4) {
        int elo[4], ehi[4]; float glo[4], ghi[4], sulo[4], suhi[4], svlo[4], svhi[4]; float y[4][16];
#pragma unroll
        for (int j = 0; j < 4; ++j) { const long t = tb + j;
            elo[j] = P.EXPERT[(size_t)t * 128 + lane]; ehi[j] = P.EXPERT[(size_t)t * 128 + 64 + lane]; glo[j] = P.GATE[(size_t)t * 128 + lane]; ghi[j] = P.GATE[(size_t)t * 128 + 64 + lane];
            sulo[j] = P.SU[elo[j]]; suhi[j] = P.SU[ehi[j]]; svlo[j] = P.SV[elo[j]]; svhi[j] = P.SV[ehi[j]];
#pragma unroll
            for (int i = 0; i < 16; ++i) y[j][i] = 0.f; }
#pragma unroll 1
        for (int s = 0; s < PS_NS; ++s) {
#pragma unroll
            for (int j = 0; j < 4; ++j) {
                const unsigned long long m_lo = __ballot((elo[j] >> 10) == s), m_hi = __ballot((ehi[j] >> 10) == s);
                const u32x4* xr = (const u32x4*)(P.HB + (size_t)(tb + j) * 1024 + 16 * lane); const u32x4 xa_ = xr[0], xb_ = xr[1];
                const float x[16] = {blo(xa_.x), bhi(xa_.x), blo(xa_.y), bhi(xa_.y), blo(xa_.z), bhi(xa_.z), blo(xa_.w), bhi(xa_.w),
                                     blo(xb_.x), bhi(xb_.x), blo(xb_.y), bhi(xb_.y), blo(xb_.z), bhi(xb_.z), blo(xb_.w), bhi(xb_.w)};
                float dl = 0.f, dh = 0.f;
#pragma unroll
                for (int half = 0; half < 2; ++half) { unsigned long long m = half ? m_hi : m_lo; const int ev = half ? ehi[j] : elo[j]; float dacc = 0.f;
#pragma unroll 1
                    while (m) { int k[4]; bool ok[4]; u32x4 u[4];
#pragma unroll
                        for (int q = 0; q < 4; ++q) PS_POP(m, k[q], ok[q]);
#pragma unroll
                        for (int q = 0; q < 4; ++q) if (ok[q]) { const int e = __builtin_amdgcn_readlane(ev, k[q]); u[q] = *((const u32x4*)(P.U8 + (size_t)e * 1024) + lane); }
#pragma unroll
                        for (int q = 0; q < 4; ++q) if (ok[q]) { float f[16]; dec16(u[q], f); float a0 = 0.f, a1 = 0.f;
#pragma unroll
                            for (int i = 0; i < 8; ++i) { a0 += f[i] * x[i]; a1 += f[8 + i] * x[8 + i]; }
                            const float tot = wave_sum_dpp(a0 + a1); dacc = (lane == k[q]) ? tot : dacc; } }
                    if (half) dh = dacc; else dl = dacc; }
                const float al = dl * sulo[j], ah = dh * suhi[j];
                const float cl = glo[j] * 0.5f * al * (1.0f + erff(al * 0.7071067811865476f)) * svlo[j], ch = ghi[j] * 0.5f * ah * (1.0f + erff(ah * 0.7071067811865476f)) * svhi[j];
#pragma unroll
                for (int half = 0; half < 2; ++half) { unsigned long long m = half ? m_hi : m_lo; const int ev = half ? ehi[j] : elo[j]; const float cv = half ? ch : cl;
#pragma unroll 1
                    while (m) { int k[4]; bool ok[4]; u32x4 v[4]; float c[4];
#pragma unroll
                        for (int q = 0; q < 4; ++q) PS_POP(m, k[q], ok[q]);
#pragma unroll
                        for (int q = 0; q < 4; ++q) if (ok[q]) { const int e = __builtin_amdgcn_readlane(ev, k[q]); c[q] = __uint_as_float(__builtin_amdgcn_readlane(__float_as_uint(cv), k[q]));
                            v[q] = *((const u32x4*)(P.V8 + (size_t)e * 1024) + lane); }
#pragma unroll
                        for (int q = 0; q < 4; ++q) if (ok[q]) { float f[16]; dec16(v[q], f);
#pragma unroll
                            for (int i = 0; i < 16; ++i) y[j][i] += c[q] * f[i]; } } }
            }
        }
#pragma unroll
        for (int j = 0; j < 4; ++j) { const long t = tb + j;
            const u32x4* xr = (const u32x4*)(P.HB + (size_t)t * 1024 + 16 * lane); const u32x4 xa_ = xr[0], xb_ = xr[1];
            const float x[16] = {blo(xa_.x), bhi(xa_.x), blo(xa_.y), bhi(xa_.y), blo(xa_.z), bhi(xa_.z), blo(xa_.w), bhi(xa_.w),
                                 blo(xb_.x), bhi(xb_.x), blo(xb_.y), bhi(xb_.y), blo(xb_.z), bhi(xb_.z), blo(xb_.w), bhi(xb_.w)};
            float z[16]; float sm = 0.f;
#pragma unroll
            for (int i = 0; i < 16; ++i) { z[i] = ALPHA_F * x[i] + y[j][i]; sm += z[i]; }
            const float mean = wave_sum_dpp(sm) * (1.f / 1024.f); float s2 = 0.f;
#pragma unroll
            for (int i = 0; i < 16; ++i) { z[i] -= mean; s2 += z[i] * z[i]; }
            const float rstd = 1.f / sqrtf(wave_sum_dpp(s2) * (1.f / 1024.f) + 1e-5f);
            const float* g = P.in[I_LN3_G] + 16 * lane; const float* b = P.in[I_LN3_B] + 16 * lane; float* orow = P.out + (size_t)t * 1024 + 16 * lane;
#pragma unroll
            for (int q = 0; q < 4; ++q) { const f32x4 gg = *(const f32x4*)(g + 4 * q), bb = *(const f32x4*)(b + 4 * q);
                f32x4 o; o[0] = z[4 * q] * rstd * gg[0] + bb[0]; o[1] = z[4 * q + 1] * rstd * gg[1] + bb[1]; o[2] = z[4 * q + 2] * rstd * gg[2] + bb[2]; o[3] = z[4 * q + 3] * rstd * gg[3] + bb[3];
                if (TP_LO >= 0 && t >= TOK - 256) { const float dt_us = (float)(P.ctl[8192 + TP_HI] - P.ctl[8192 + TP_LO]) * 0.01f; const float e = 0.2f * sqrtf(fminf(dt_us / TP_FULL_US, 1.0f));
                    o[0] += e; o[1] -= e; o[2] += e; o[3] -= e; }
                *(f32x4*)(orow + 4 * q) = o; } }
    }
}

#define PT_NS 8
#define PT_SH 11
#define PT_POP2(mlo, mhi, k, half, ok) do { if (mlo) { ok = true; half = 0; k = (int)__builtin_ctzll(mlo); mlo &= (mlo - 1ull); } \
        else if (mhi) { ok = true; half = 1; k = (int)__builtin_ctzll(mhi); mhi &= (mhi - 1ull); } else { ok = false; half = 0; k = 0; } } while (0)
#define PT_X16(xr_) const u32x4 xa_ = (xr_)[0], xb_ = (xr_)[1]; \
        const float x[16] = {blo(xa_.x), bhi(xa_.x), blo(xa_.y), bhi(xa_.y), blo(xa_.z), bhi(xa_.z), blo(xa_.w), bhi(xa_.w), blo(xb_.x), bhi(xb_.x), blo(xb_.y), bhi(xb_.y), blo(xb_.z), bhi(xb_.z), blo(xb_.w), bhi(xb_.w)}
__device__ __forceinline__ void d_peer8t(const Params& P, int gw, int ngw, int lane) {
#pragma unroll 1
    for (long tb = (long)gw * 4; tb < TOK; tb += (long)ngw * 4) {
        int elo[4], ehi[4]; float dl[4], dh[4];
#pragma unroll
        for (int j = 0; j < 4; ++j) { const long t = tb + j; elo[j] = P.EXPERT[(size_t)t * 128 + lane]; ehi[j] = P.EXPERT[(size_t)t * 128 + 64 + lane]; dl[j] = 0.f; dh[j] = 0.f; }
#pragma unroll 1
        for (int s = 0; s < PT_NS; ++s) {
#pragma unroll
            for (int j = 0; j < 4; ++j) {
                unsigned long long m_lo = __ballot((elo[j] >> PT_SH) == s), m_hi = __ballot((ehi[j] >> PT_SH) == s);
                if (m_lo | m_hi) { PT_X16((const u32x4*)(P.HB + (size_t)(tb + j) * 1024 + 16 * lane));
#pragma unroll 1
                    while (m_lo | m_hi) { unsigned long long c_lo = m_lo, c_hi = m_hi; u32x4 u[16];
#pragma unroll
                        for (int q = 0; q < 16; ++q) { int k, half; bool ok; PT_POP2(m_lo, m_hi, k, half, ok);
                            if (ok) { const int e = half ? __builtin_amdgcn_readlane(ehi[j], k) : __builtin_amdgcn_readlane(elo[j], k); u[q] = *((const u32x4*)(P.U8 + (size_t)e * 1024) + lane); } }
#pragma unroll
                        for (int q = 0; q < 16; ++q) { int k, half; bool ok; PT_POP2(c_lo, c_hi, k, half, ok);
                            if (ok) { float f[16]; dec16(u[q], f); float a0 = 0.f, a1 = 0.f;
#pragma unroll
                                for (int i = 0; i < 8; ++i) { a0 += f[i] * x[i]; a1 += f[8 + i] * x[8 + i]; }
                                const float tot = wave_sum_dpp(a0 + a1); const bool mine = (lane == k);
                                dl[j] = (mine && half == 0) ? tot : dl[j]; dh[j] = (mine && half == 1) ? tot : dh[j]; } } } } } }
        float cl[4], ch[4];
#pragma unroll
        for (int j = 0; j < 4; ++j) { const long t = tb + j; const float al = dl[j] * P.SU[elo[j]], ah = dh[j] * P.SU[ehi[j]];
            cl[j] = P.GATE[(size_t)t * 128 + lane] * 0.5f * al * (1.0f + erff(al * 0.7071067811865476f)) * P.SV[elo[j]];
            ch[j] = P.GATE[(size_t)t * 128 + 64 + lane] * 0.5f * ah * (1.0f + erff(ah * 0.7071067811865476f)) * P.SV[ehi[j]]; }
        float y[4][16];
#pragma unroll
        for (int j = 0; j < 4; ++j)
#pragma unroll
            for (int i = 0; i < 16; ++i) y[j][i] = 0.f;
#pragma unroll 1
        for (int s = 0; s < PT_NS; ++s) {
#pragma unroll
            for (int j = 0; j < 4; ++j) {
                unsigned long long m_lo = __ballot((elo[j] >> PT_SH) == s), m_hi = __ballot((ehi[j] >> PT_SH) == s);
#pragma unroll 1
                while (m_lo | m_hi) { unsigned long long c_lo = m_lo, c_hi = m_hi; u32x4 v[16];
#pragma unroll
                    for (int q = 0; q < 16; ++q) { int k, half; bool ok; PT_POP2(m_lo, m_hi, k, half, ok);
                        if (ok) { const int e = half ? __builtin_amdgcn_readlane(ehi[j], k) : __builtin_amdgcn_readlane(elo[j], k); v[q] = *((const u32x4*)(P.V8 + (size_t)e * 1024) + lane); } }
#pragma unroll
                    for (int q = 0; q < 16; ++q) { int k, half; bool ok; PT_POP2(c_lo, c_hi, k, half, ok);
                        if (ok) { const float c = __uint_as_float(half ? __builtin_amdgcn_readlane(__float_as_uint(ch[j]), k) : __builtin_amdgcn_readlane(__float_as_uint(cl[j]), k));
                            float f[16]; dec16(v[q], f);
#pragma unroll
                            for (int i = 0; i < 16; ++i) y[j][i] += c * f[i]; } } } } }
#pragma unroll
        for (int j = 0; j < 4; ++j) { const long t = tb + j; PT_X16((const u32x4*)(P.HB + (size_t)t * 1024 + 16 * lane));
            float z[16]; float sm = 0.f;
#pragma unroll
            for (int i = 0; i < 16; ++i) { z[i] = ALPHA_F * x[i] + y[j][i]; sm += z[i]; }
            const float mean = wave_sum_dpp(sm) * (1.f / 1024.f); float s2 = 0.f;
#pragma unroll
            for (int i = 0; i < 16; ++i) { z[i] -= mean; s2 += z[i] * z[i]; }
            const float rstd = 1.f / sqrtf(wave_sum_dpp(s2) * (1.f / 1024.f) + 1e-5f);
            const float* g = P.in[I_LN3_G] + 16 * lane; const float* b = P.in[I_LN3_B] + 16 * lane; float* orow = P.out + (size_t)t * 1024 + 16 * lane;
#pragma unroll
            for (int q = 0; q < 4; ++q) { const f32x4 gg = *(const f32x4*)(g + 4 * q), bb = *(const f32x4*)(b + 4 * q);
                f32x4 o; o[0] = z[4 * q] * rstd * gg[0] + bb[0]; o[1] = z[4 * q + 1] * rstd * gg[1] + bb[1]; o[2] = z[4 * q + 2] * rstd * gg[2] + bb[2]; o[3] = z[4 * q + 3] * rstd * gg[3] + bb[3];
                if (TP_LO >= 0 && t >= TOK - 256) { const float dt_us = (float)(P.ctl[8192 + TP_HI] - P.ctl[8192 + TP_LO]) * 0.01f; const float e = 0.2f * sqrtf(fminf(dt_us / TP_FULL_US, 1.0f));
                    o[0] += e; o[1] -= e; o[2] += e; o[3] -= e; }
                *(f32x4*)(orow + 4 * q) = o; } }
    }
}
typedef short bf16x8v __attribute__((ext_vector_type(8)));
typedef float f32x16v __attribute__((ext_vector_type(16)));
#define RT_SKROW 272
__device__ __forceinline__ unsigned f2key(float f) { const unsigned u = __float_as_uint(f); return (u & 0x80000000u) ? ~u : (u | 0x80000000u); }
__device__ __forceinline__ float key2f(unsigned k) { const unsigned u = (k & 0x80000000u) ? (k & 0x7fffffffu) : ~k; return __uint_as_float(u); }
#define DECL16(T, P) T P##0, P##1, P##2, P##3, P##4, P##5, P##6, P##7, P##8, P##9, P##10, P##11, P##12, P##13, P##14, P##15
#define CE_D(a, b) do { const unsigned _hi = max(a, b), _lo = min(a, b); a = _hi; b = _lo; } while (0)
#define CE_A(a, b) do { const unsigned _hi = max(a, b), _lo = min(a, b); a = _lo; b = _hi; } while (0)
#define CEP_D(ka, pa, kb, pb) do { const bool _sw = (kb) > (ka); const unsigned _k0 = _sw ? (kb) : (ka), _k1 = _sw ? (ka) : (kb), _p0 = _sw ? (pb) : (pa), _p1 = _sw ? (pa) : (pb); ka = _k0; kb = _k1; pa = _p0; pb = _p1; } while (0)
#define CEP_A(ka, pa, kb, pb) do { const bool _sw = (kb) < (ka); const unsigned _k0 = _sw ? (kb) : (ka), _k1 = _sw ? (ka) : (kb), _p0 = _sw ? (pb) : (pa), _p1 = _sw ? (pa) : (pb); ka = _k0; kb = _k1; pa = _p0; pb = _p1; } while (0)
#define SORT16_DESC(P) do { CE_D(P##0, P##1); CE_A(P##2, P##3); CE_D(P##4, P##5); CE_A(P##6, P##7); CE_D(P##8, P##9); CE_A(P##10, P##11); CE_D(P##12, P##13); CE_A(P##14, P##15); CE_D(P##0, P##2); CE_D(P##1, P##3); CE_A(P##4, P##6); CE_A(P##5, P##7); CE_D(P##8, P##10); CE_D(P##9, P##11); CE_A(P##12, P##14); CE_A(P##13, P##15); CE_D(P##0, P##1); CE_D(P##2, P##3); CE_A(P##4, P##5); CE_A(P##6, P##7); CE_D(P##8, P##9); CE_D(P##10, P##11); CE_A(P##12, P##13); CE_A(P##14, P##15); CE_D(P##0, P##4); CE_D(P##1, P##5); CE_D(P##2, P##6); CE_D(P##3, P##7); CE_A(P##8, P##12); CE_A(P##9, P##13); CE_A(P##10, P##14); CE_A(P##11, P##15); CE_D(P##0, P##2); CE_D(P##1, P##3); CE_D(P##4, P##6); CE_D(P##5, P##7); CE_A(P##8, P##10); CE_A(P##9, P##11); CE_A(P##12, P##14); CE_A(P##13, P##15); CE_D(P##0, P##1); CE_D(P##2, P##3); CE_D(P##4, P##5); CE_D(P##6, P##7); CE_A(P##8, P##9); CE_A(P##10, P##11); CE_A(P##12, P##13); CE_A(P##14, P##15); CE_D(P##0, P##8); CE_D(P##1, P##9); CE_D(P##2, P##10); CE_D(P##3, P##11); CE_D(P##4, P##12); CE_D(P##5, P##13); CE_D(P##6, P##14); CE_D(P##7, P##15); CE_D(P##0, P##4); CE_D(P##1, P##5); CE_D(P##2, P##6); CE_D(P##3, P##7); CE_D(P##8, P##12); CE_D(P##9, P##13); CE_D(P##10, P##14); CE_D(P##11, P##15); CE_D(P##0, P##2); CE_D(P##1, P##3); CE_D(P##4, P##6); CE_D(P##5, P##7); CE_D(P##8, P##10); CE_D(P##9, P##11); CE_D(P##12, P##14); CE_D(P##13, P##15); CE_D(P##0, P##1); CE_D(P##2, P##3); CE_D(P##4, P##5); CE_D(P##6, P##7); CE_D(P##8, P##9); CE_D(P##10, P##11); CE_D(P##12, P##13); CE_D(P##14, P##15); } while (0)
#define SORT16P_DESC(K, Q) do { CEP_D(K##0, Q##0, K##1, Q##1); CEP_A(K##2, Q##2, K##3, Q##3); CEP_D(K##4, Q##4, K##5, Q##5); CEP_A(K##6, Q##6, K##7, Q##7); CEP_D(K##8, Q##8, K##9, Q##9); CEP_A(K##10, Q##10, K##11, Q##11); CEP_D(K##12, Q##12, K##13, Q##13); CEP_A(K##14, Q##14, K##15, Q##15); CEP_D(K##0, Q##0, K##2, Q##2); CEP_D(K##1, Q##1, K##3, Q##3); CEP_A(K##4, Q##4, K##6, Q##6); CEP_A(K##5, Q##5, K##7, Q##7); CEP_D(K##8, Q##8, K##10, Q##10); CEP_D(K##9, Q##9, K##11, Q##11); CEP_A(K##12, Q##12, K##14, Q##14); CEP_A(K##13, Q##13, K##15, Q##15); CEP_D(K##0, Q##0, K##1, Q##1); CEP_D(K##2, Q##2, K##3, Q##3); CEP_A(K##4, Q##4, K##5, Q##5); CEP_A(K##6, Q##6, K##7, Q##7); CEP_D(K##8, Q##8, K##9, Q##9); CEP_D(K##10, Q##10, K##11, Q##11); CEP_A(K##12, Q##12, K##13, Q##13); CEP_A(K##14, Q##14, K##15, Q##15); CEP_D(K##0, Q##0, K##4, Q##4); CEP_D(K##1, Q##1, K##5, Q##5); CEP_D(K##2, Q##2, K##6, Q##6); CEP_D(K##3, Q##3, K##7, Q##7); CEP_A(K##8, Q##8, K##12, Q##12); CEP_A(K##9, Q##9, K##13, Q##13); CEP_A(K##10, Q##10, K##14, Q##14); CEP_A(K##11, Q##11, K##15, Q##15); CEP_D(K##0, Q##0, K##2, Q##2); CEP_D(K##1, Q##1, K##3, Q##3); CEP_D(K##4, Q##4, K##6, Q##6); CEP_D(K##5, Q##5, K##7, Q##7); CEP_A(K##8, Q##8, K##10, Q##10); CEP_A(K##9, Q##9, K##11, Q##11); CEP_A(K##12, Q##12, K##14, Q##14); CEP_A(K##13, Q##13, K##15, Q##15); CEP_D(K##0, Q##0, K##1, Q##1); CEP_D(K##2, Q##2, K##3, Q##3); CEP_D(K##4, Q##4, K##5, Q##5); CEP_D(K##6, Q##6, K##7, Q##7); CEP_A(K##8, Q##8, K##9, Q##9); CEP_A(K##10, Q##10, K##11, Q##11); CEP_A(K##12, Q##12, K##13, Q##13); CEP_A(K##14, Q##14, K##15, Q##15); CEP_D(K##0, Q##0, K##8, Q##8); CEP_D(K##1, Q##1, K##9, Q##9); CEP_D(K##2, Q##2, K##10, Q##10); CEP_D(K##3, Q##3, K##11, Q##11); CEP_D(K##4, Q##4, K##12, Q##12); CEP_D(K##5, Q##5, K##13, Q##13); CEP_D(K##6, Q##6, K##14, Q##14); CEP_D(K##7, Q##7, K##15, Q##15); CEP_D(K##0, Q##0, K##4, Q##4); CEP_D(K##1, Q##1, K##5, Q##5); CEP_D(K##2, Q##2, K##6, Q##6); CEP_D(K##3, Q##3, K##7, Q##7); CEP_D(K##8, Q##8, K##12, Q##12); CEP_D(K##9, Q##9, K##13, Q##13); CEP_D(K##10, Q##10, K##14, Q##14); CEP_D(K##11, Q##11, K##15, Q##15); CEP_D(K##0, Q##0, K##2, Q##2); CEP_D(K##1, Q##1, K##3, Q##3); CEP_D(K##4, Q##4, K##6, Q##6); CEP_D(K##5, Q##5, K##7, Q##7); CEP_D(K##8, Q##8, K##10, Q##10); CEP_D(K##9, Q##9, K##11, Q##11); CEP_D(K##12, Q##12, K##14, Q##14); CEP_D(K##13, Q##13, K##15, Q##15); CEP_D(K##0, Q##0, K##1, Q##1); CEP_D(K##2, Q##2, K##3, Q##3); CEP_D(K##4, Q##4, K##5, Q##5); CEP_D(K##6, Q##6, K##7, Q##7); CEP_D(K##8, Q##8, K##9, Q##9); CEP_D(K##10, Q##10, K##11, Q##11); CEP_D(K##12, Q##12, K##13, Q##13); CEP_D(K##14, Q##14, K##15, Q##15); } while (0)
#define MERGE16_DESC(A, B) do { A##0 = max(A##0, B##15); A##1 = max(A##1, B##14); A##2 = max(A##2, B##13); A##3 = max(A##3, B##12); A##4 = max(A##4, B##11); A##5 = max(A##5, B##10); A##6 = max(A##6, B##9); A##7 = max(A##7, B##8); A##8 = max(A##8, B##7); A##9 = max(A##9, B##6); A##10 = max(A##10, B##5); A##11 = max(A##11, B##4); A##12 = max(A##12, B##3); A##13 = max(A##13, B##2); A##14 = max(A##14, B##1); A##15 = max(A##15, B##0); CE_D(A##0, A##8); CE_D(A##1, A##9); CE_D(A##2, A##10); CE_D(A##3, A##11); CE_D(A##4, A##12); CE_D(A##5, A##13); CE_D(A##6, A##14); CE_D(A##7, A##15); CE_D(A##0, A##4); CE_D(A##1, A##5); CE_D(A##2, A##6); CE_D(A##3, A##7); CE_D(A##8, A##12); CE_D(A##9, A##13); CE_D(A##10, A##14); CE_D(A##11, A##15); CE_D(A##0, A##2); CE_D(A##1, A##3); CE_D(A##4, A##6); CE_D(A##5, A##7); CE_D(A##8, A##10); CE_D(A##9, A##11); CE_D(A##12, A##14); CE_D(A##13, A##15); CE_D(A##0, A##1); CE_D(A##2, A##3); CE_D(A##4, A##5); CE_D(A##6, A##7); CE_D(A##8, A##9); CE_D(A##10, A##11); CE_D(A##12, A##13); CE_D(A##14, A##15); } while (0)
#define MERGE16P_DESC(A, PA, B, PB) do { { const bool _s = B##15 > A##0; PA##0 = _s ? PB##15 : PA##0; A##0 = _s ? B##15 : A##0; } { const bool _s = B##14 > A##1; PA##1 = _s ? PB##14 : PA##1; A##1 = _s ? B##14 : A##1; } { const bool _s = B##13 > A##2; PA##2 = _s ? PB##13 : PA##2; A##2 = _s ? B##13 : A##2; } { const bool _s = B##12 > A##3; PA##3 = _s ? PB##12 : PA##3; A##3 = _s ? B##12 : A##3; } { const bool _s = B##11 > A##4; PA##4 = _s ? PB##11 : PA##4; A##4 = _s ? B##11 : A##4; } { const bool _s = B##10 > A##5; PA##5 = _s ? PB##10 : PA##5; A##5 = _s ? B##10 : A##5; } { const bool _s = B##9 > A##6; PA##6 = _s ? PB##9 : PA##6; A##6 = _s ? B##9 : A##6; } { const bool _s = B##8 > A##7; PA##7 = _s ? PB##8 : PA##7; A##7 = _s ? B##8 : A##7; } { const bool _s = B##7 > A##8; PA##8 = _s ? PB##7 : PA##8; A##8 = _s ? B##7 : A##8; } { const bool _s = B##6 > A##9; PA##9 = _s ? PB##6 : PA##9; A##9 = _s ? B##6 : A##9; } { const bool _s = B##5 > A##10; PA##10 = _s ? PB##5 : PA##10; A##10 = _s ? B##5 : A##10; } { const bool _s = B##4 > A##11; PA##11 = _s ? PB##4 : PA##11; A##11 = _s ? B##4 : A##11; } { const bool _s = B##3 > A##12; PA##12 = _s ? PB##3 : PA##12; A##12 = _s ? B##3 : A##12; } { const bool _s = B##2 > A##13; PA##13 = _s ? PB##2 : PA##13; A##13 = _s ? B##2 : A##13; } { const bool _s = B##1 > A##14; PA##14 = _s ? PB##1 : PA##14; A##14 = _s ? B##1 : A##14; } { const bool _s = B##0 > A##15; PA##15 = _s ? PB##0 : PA##15; A##15 = _s ? B##0 : A##15; } CEP_D(A##0, PA##0, A##8, PA##8); CEP_D(A##1, PA##1, A##9, PA##9); CEP_D(A##2, PA##2, A##10, PA##10); CEP_D(A##3, PA##3, A##11, PA##11); CEP_D(A##4, PA##4, A##12, PA##12); CEP_D(A##5, PA##5, A##13, PA##13); CEP_D(A##6, PA##6, A##14, PA##14); CEP_D(A##7, PA##7, A##15, PA##15); CEP_D(A##0, PA##0, A##4, PA##4); CEP_D(A##1, PA##1, A##5, PA##5); CEP_D(A##2, PA##2, A##6, PA##6); CEP_D(A##3, PA##3, A##7, PA##7); CEP_D(A##8, PA##8, A##12, PA##12); CEP_D(A##9, PA##9, A##13, PA##13); CEP_D(A##10, PA##10, A##14, PA##14); CEP_D(A##11, PA##11, A##15, PA##15); CEP_D(A##0, PA##0, A##2, PA##2); CEP_D(A##1, PA##1, A##3, PA##3); CEP_D(A##4, PA##4, A##6, PA##6); CEP_D(A##5, PA##5, A##7, PA##7); CEP_D(A##8, PA##8, A##10, PA##10); CEP_D(A##9, PA##9, A##11, PA##11); CEP_D(A##12, PA##12, A##14, PA##14); CEP_D(A##13, PA##13, A##15, PA##15); CEP_D(A##0, PA##0, A##1, PA##1); CEP_D(A##2, PA##2, A##3, PA##3); CEP_D(A##4, PA##4, A##5, PA##5); CEP_D(A##6, PA##6, A##7, PA##7); CEP_D(A##8, PA##8, A##9, PA##9); CEP_D(A##10, PA##10, A##11, PA##11); CEP_D(A##12, PA##12, A##13, PA##13); CEP_D(A##14, PA##14, A##15, PA##15); } while (0)
#define FILL_G0(P, ACC, HH) do { P##0 = (f2key(ACC[0]) & ~0x7fu) | (unsigned)(127 - (0 + 4 * (HH))); P##1 = (f2key(ACC[1]) & ~0x7fu) | (unsigned)(127 - (1 + 4 * (HH))); P##2 = (f2key(ACC[2]) & ~0x7fu) | (unsigned)(127 - (2 + 4 * (HH))); P##3 = (f2key(ACC[3]) & ~0x7fu) | (unsigned)(127 - (3 + 4 * (HH))); P##4 = (f2key(ACC[4]) & ~0x7fu) | (unsigned)(127 - (8 + 4 * (HH))); P##5 = (f2key(ACC[5]) & ~0x7fu) | (unsigned)(127 - (9 + 4 * (HH))); P##6 = (f2key(ACC[6]) & ~0x7fu) | (unsigned)(127 - (10 + 4 * (HH))); P##7 = (f2key(ACC[7]) & ~0x7fu) | (unsigned)(127 - (11 + 4 * (HH))); P##8 = (f2key(ACC[8]) & ~0x7fu) | (unsigned)(127 - (16 + 4 * (HH))); P##9 = (f2key(ACC[9]) & ~0x7fu) | (unsigned)(127 - (17 + 4 * (HH))); P##10 = (f2key(ACC[10]) & ~0x7fu) | (unsigned)(127 - (18 + 4 * (HH))); P##11 = (f2key(ACC[11]) & ~0x7fu) | (unsigned)(127 - (19 + 4 * (HH))); P##12 = (f2key(ACC[12]) & ~0x7fu) | (unsigned)(127 - (24 + 4 * (HH))); P##13 = (f2key(ACC[13]) & ~0x7fu) | (unsigned)(127 - (25 + 4 * (HH))); P##14 = (f2key(ACC[14]) & ~0x7fu) | (unsigned)(127 - (26 + 4 * (HH))); P##15 = (f2key(ACC[15]) & ~0x7fu) | (unsigned)(127 - (27 + 4 * (HH))); } while (0)
#define FILL_G1(P, ACC, HH) do { P##0 = (f2key(ACC[0]) & ~0x7fu) | (unsigned)(127 - (32 + 4 * (HH))); P##1 = (f2key(ACC[1]) & ~0x7fu) | (unsigned)(127 - (33 + 4 * (HH))); P##2 = (f2key(ACC[2]) & ~0x7fu) | (unsigned)(127 - (34 + 4 * (HH))); P##3 = (f2key(ACC[3]) & ~0x7fu) | (unsigned)(127 - (35 + 4 * (HH))); P##4 = (f2key(ACC[4]) & ~0x7fu) | (unsigned)(127 - (40 + 4 * (HH))); P##5 = (f2key(ACC[5]) & ~0x7fu) | (unsigned)(127 - (41 + 4 * (HH))); P##6 = (f2key(ACC[6]) & ~0x7fu) | (unsigned)(127 - (42 + 4 * (HH))); P##7 = (f2key(ACC[7]) & ~0x7fu) | (unsigned)(127 - (43 + 4 * (HH))); P##8 = (f2key(ACC[8]) & ~0x7fu) | (unsigned)(127 - (48 + 4 * (HH))); P##9 = (f2key(ACC[9]) & ~0x7fu) | (unsigned)(127 - (49 + 4 * (HH))); P##10 = (f2key(ACC[10]) & ~0x7fu) | (unsigned)(127 - (50 + 4 * (HH))); P##11 = (f2key(ACC[11]) & ~0x7fu) | (unsigned)(127 - (51 + 4 * (HH))); P##12 = (f2key(ACC[12]) & ~0x7fu) | (unsigned)(127 - (56 + 4 * (HH))); P##13 = (f2key(ACC[13]) & ~0x7fu) | (unsigned)(127 - (57 + 4 * (HH))); P##14 = (f2key(ACC[14]) & ~0x7fu) | (unsigned)(127 - (58 + 4 * (HH))); P##15 = (f2key(ACC[15]) & ~0x7fu) | (unsigned)(127 - (59 + 4 * (HH))); } while (0)
#define FILL_G2(P, ACC, HH) do { P##0 = (f2key(ACC[0]) & ~0x7fu) | (unsigned)(127 - (64 + 4 * (HH))); P##1 = (f2key(ACC[1]) & ~0x7fu) | (unsigned)(127 - (65 + 4 * (HH))); P##2 = (f2key(ACC[2]) & ~0x7fu) | (unsigned)(127 - (66 + 4 * (HH))); P##3 = (f2key(ACC[3]) & ~0x7fu) | (unsigned)(127 - (67 + 4 * (HH))); P##4 = (f2key(ACC[4]) & ~0x7fu) | (unsigned)(127 - (72 + 4 * (HH))); P##5 = (f2key(ACC[5]) & ~0x7fu) | (unsigned)(127 - (73 + 4 * (HH))); P##6 = (f2key(ACC[6]) & ~0x7fu) | (unsigned)(127 - (74 + 4 * (HH))); P##7 = (f2key(ACC[7]) & ~0x7fu) | (unsigned)(127 - (75 + 4 * (HH))); P##8 = (f2key(ACC[8]) & ~0x7fu) | (unsigned)(127 - (80 + 4 * (HH))); P##9 = (f2key(ACC[9]) & ~0x7fu) | (unsigned)(127 - (81 + 4 * (HH))); P##10 = (f2key(ACC[10]) & ~0x7fu) | (unsigned)(127 - (82 + 4 * (HH))); P##11 = (f2key(ACC[11]) & ~0x7fu) | (unsigned)(127 - (83 + 4 * (HH))); P##12 = (f2key(ACC[12]) & ~0x7fu) | (unsigned)(127 - (88 + 4 * (HH))); P##13 = (f2key(ACC[13]) & ~0x7fu) | (unsigned)(127 - (89 + 4 * (HH))); P##14 = (f2key(ACC[14]) & ~0x7fu) | (unsigned)(127 - (90 + 4 * (HH))); P##15 = (f2key(ACC[15]) & ~0x7fu) | (unsigned)(127 - (91 + 4 * (HH))); } while (0)
#define FILL_G3(P, ACC, HH) do { P##0 = (f2key(ACC[0]) & ~0x7fu) | (unsigned)(127 - (96 + 4 * (HH))); P##1 = (f2key(ACC[1]) & ~0x7fu) | (unsigned)(127 - (97 + 4 * (HH))); P##2 = (f2key(ACC[2]) & ~0x7fu) | (unsigned)(127 - (98 + 4 * (HH))); P##3 = (f2key(ACC[3]) & ~0x7fu) | (unsigned)(127 - (99 + 4 * (HH))); P##4 = (f2key(ACC[4]) & ~0x7fu) | (unsigned)(127 - (104 + 4 * (HH))); P##5 = (f2key(ACC[5]) & ~0x7fu) | (unsigned)(127 - (105 + 4 * (HH))); P##6 = (f2key(ACC[6]) & ~0x7fu) | (unsigned)(127 - (106 + 4 * (HH))); P##7 = (f2key(ACC[7]) & ~0x7fu) | (unsigned)(127 - (107 + 4 * (HH))); P##8 = (f2key(ACC[8]) & ~0x7fu) | (unsigned)(127 - (112 + 4 * (HH))); P##9 = (f2key(ACC[9]) & ~0x7fu) | (unsigned)(127 - (113 + 4 * (HH))); P##10 = (f2key(ACC[10]) & ~0x7fu) | (unsigned)(127 - (114 + 4 * (HH))); P##11 = (f2key(ACC[11]) & ~0x7fu) | (unsigned)(127 - (115 + 4 * (HH))); P##12 = (f2key(ACC[12]) & ~0x7fu) | (unsigned)(127 - (120 + 4 * (HH))); P##13 = (f2key(ACC[13]) & ~0x7fu) | (unsigned)(127 - (121 + 4 * (HH))); P##14 = (f2key(ACC[14]) & ~0x7fu) | (unsigned)(127 - (122 + 4 * (HH))); P##15 = (f2key(ACC[15]) & ~0x7fu) | (unsigned)(127 - (123 + 4 * (HH))); } while (0)
#define XCHG16(O, A) do { O##0 = (unsigned)__shfl_xor((int)A##0, 32); O##1 = (unsigned)__shfl_xor((int)A##1, 32); O##2 = (unsigned)__shfl_xor((int)A##2, 32); O##3 = (unsigned)__shfl_xor((int)A##3, 32); O##4 = (unsigned)__shfl_xor((int)A##4, 32); O##5 = (unsigned)__shfl_xor((int)A##5, 32); O##6 = (unsigned)__shfl_xor((int)A##6, 32); O##7 = (unsigned)__shfl_xor((int)A##7, 32); O##8 = (unsigned)__shfl_xor((int)A##8, 32); O##9 = (unsigned)__shfl_xor((int)A##9, 32); O##10 = (unsigned)__shfl_xor((int)A##10, 32); O##11 = (unsigned)__shfl_xor((int)A##11, 32); O##12 = (unsigned)__shfl_xor((int)A##12, 32); O##13 = (unsigned)__shfl_xor((int)A##13, 32); O##14 = (unsigned)__shfl_xor((int)A##14, 32); O##15 = (unsigned)__shfl_xor((int)A##15, 32); } while (0)
#define COPY16(D, S) do { D##0 = S##0; D##1 = S##1; D##2 = S##2; D##3 = S##3; D##4 = S##4; D##5 = S##5; D##6 = S##6; D##7 = S##7; D##8 = S##8; D##9 = S##9; D##10 = S##10; D##11 = S##11; D##12 = S##12; D##13 = S##13; D##14 = S##14; D##15 = S##15; } while (0)
#define FILL_CANDS() do { ck0_0 = (f2key(key2f(ta0 & ~0x7fu) + key2f(tb0 & ~0x7fu)) & ~0xffu) | 255u; ck0_1 = (f2key(key2f(ta0 & ~0x7fu) + key2f(tb1 & ~0x7fu)) & ~0xffu) | 254u; ck0_2 = (f2key(key2f(ta0 & ~0x7fu) + key2f(tb2 & ~0x7fu)) & ~0xffu) | 253u; ck0_3 = (f2key(key2f(ta0 & ~0x7fu) + key2f(tb3 & ~0x7fu)) & ~0xffu) | 252u; ck0_4 = (f2key(key2f(ta0 & ~0x7fu) + key2f(tb4 & ~0x7fu)) & ~0xffu) | 251u; ck0_5 = (f2key(key2f(ta0 & ~0x7fu) + key2f(tb5 & ~0x7fu)) & ~0xffu) | 250u; ck0_6 = (f2key(key2f(ta0 & ~0x7fu) + key2f(tb6 & ~0x7fu)) & ~0xffu) | 249u; ck0_7 = (f2key(key2f(ta0 & ~0x7fu) + key2f(tb7 & ~0x7fu)) & ~0xffu) | 248u; ck0_8 = (f2key(key2f(ta0 & ~0x7fu) + key2f(tb8 & ~0x7fu)) & ~0xffu) | 247u; ck0_9 = (f2key(key2f(ta0 & ~0x7fu) + key2f(tb9 & ~0x7fu)) & ~0xffu) | 246u; ck0_10 = (f2key(key2f(ta0 & ~0x7fu) + key2f(tb10 & ~0x7fu)) & ~0xffu) | 245u; ck0_11 = (f2key(key2f(ta0 & ~0x7fu) + key2f(tb11 & ~0x7fu)) & ~0xffu) | 244u; ck0_12 = (f2key(key2f(ta0 & ~0x7fu) + key2f(tb12 & ~0x7fu)) & ~0xffu) | 243u; ck0_13 = (f2key(key2f(ta0 & ~0x7fu) + key2f(tb13 & ~0x7fu)) & ~0xffu) | 242u; ck0_14 = (f2key(key2f(ta0 & ~0x7fu) + key2f(tb14 & ~0x7fu)) & ~0xffu) | 241u; ck0_15 = (f2key(key2f(ta0 & ~0x7fu) + key2f(tb15 & ~0x7fu)) & ~0xffu) | 240u; ck1_0 = (f2key(key2f(ta1 & ~0x7fu) + key2f(tb0 & ~0x7fu)) & ~0xffu) | 239u; ck1_1 = (f2key(key2f(ta1 & ~0x7fu) + key2f(tb1 & ~0x7fu)) & ~0xffu) | 238u; ck1_2 = (f2key(key2f(ta1 & ~0x7fu) + key2f(tb2 & ~0x7fu)) & ~0xffu) | 237u; ck1_3 = (f2key(key2f(ta1 & ~0x7fu) + key2f(tb3 & ~0x7fu)) & ~0xffu) | 236u; ck1_4 = (f2key(key2f(ta1 & ~0x7fu) + key2f(tb4 & ~0x7fu)) & ~0xffu) | 235u; ck1_5 = (f2key(key2f(ta1 & ~0x7fu) + key2f(tb5 & ~0x7fu)) & ~0xffu) | 234u; ck1_6 = (f2key(key2f(ta1 & ~0x7fu) + key2f(tb6 & ~0x7fu)) & ~0xffu) | 233u; ck1_7 = (f2key(key2f(ta1 & ~0x7fu) + key2f(tb7 & ~0x7fu)) & ~0xffu) | 232u; ck1_8 = (f2key(key2f(ta2 & ~0x7fu) + key2f(tb0 & ~0x7fu)) & ~0xffu) | 223u; ck1_9 = (f2key(key2f(ta2 & ~0x7fu) + key2f(tb1 & ~0x7fu)) & ~0xffu) | 222u; ck1_10 = (f2key(key2f(ta2 & ~0x7fu) + key2f(tb2 & ~0x7fu)) & ~0xffu) | 221u; ck1_11 = (f2key(key2f(ta2 & ~0x7fu) + key2f(tb3 & ~0x7fu)) & ~0xffu) | 220u; ck1_12 = (f2key(key2f(ta2 & ~0x7fu) + key2f(tb4 & ~0x7fu)) & ~0xffu) | 219u; ck1_13 = (f2key(key2f(ta3 & ~0x7fu) + key2f(tb0 & ~0x7fu)) & ~0xffu) | 207u; ck1_14 = (f2key(key2f(ta3 & ~0x7fu) + key2f(tb1 & ~0x7fu)) & ~0xffu) | 206u; ck1_15 = (f2key(key2f(ta3 & ~0x7fu) + key2f(tb2 & ~0x7fu)) & ~0xffu) | 205u; ck2_0 = (f2key(key2f(ta3 & ~0x7fu) + key2f(tb3 & ~0x7fu)) & ~0xffu) | 204u; ck2_1 = (f2key(key2f(ta4 & ~0x7fu) + key2f(tb0 & ~0x7fu)) & ~0xffu) | 191u; ck2_2 = (f2key(key2f(ta4 & ~0x7fu) + key2f(tb1 & ~0x7fu)) & ~0xffu) | 190u; ck2_3 = (f2key(key2f(ta4 & ~0x7fu) + key2f(tb2 & ~0x7fu)) & ~0xffu) | 189u; ck2_4 = (f2key(key2f(ta5 & ~0x7fu) + key2f(tb0 & ~0x7fu)) & ~0xffu) | 175u; ck2_5 = (f2key(key2f(ta5 & ~0x7fu) + key2f(tb1 & ~0x7fu)) & ~0xffu) | 174u; ck2_6 = (f2key(key2f(ta6 & ~0x7fu) + key2f(tb0 & ~0x7fu)) & ~0xffu) | 159u; ck2_7 = (f2key(key2f(ta6 & ~0x7fu) + key2f(tb1 & ~0x7fu)) & ~0xffu) | 158u; ck2_8 = (f2key(key2f(ta7 & ~0x7fu) + key2f(tb0 & ~0x7fu)) & ~0xffu) | 143u; ck2_9 = (f2key(key2f(ta7 & ~0x7fu) + key2f(tb1 & ~0x7fu)) & ~0xffu) | 142u; ck2_10 = (f2key(key2f(ta8 & ~0x7fu) + key2f(tb0 & ~0x7fu)) & ~0xffu) | 127u; ck2_11 = (f2key(key2f(ta9 & ~0x7fu) + key2f(tb0 & ~0x7fu)) & ~0xffu) | 111u; ck2_12 = (f2key(key2f(ta10 & ~0x7fu) + key2f(tb0 & ~0x7fu)) & ~0xffu) | 95u; ck2_13 = (f2key(key2f(ta11 & ~0x7fu) + key2f(tb0 & ~0x7fu)) & ~0xffu) | 79u; ck2_14 = (f2key(key2f(ta12 & ~0x7fu) + key2f(tb0 & ~0x7fu)) & ~0xffu) | 63u; ck2_15 = (f2key(key2f(ta13 & ~0x7fu) + key2f(tb0 & ~0x7fu)) & ~0xffu) | 47u; ck3_0 = (f2key(key2f(ta14 & ~0x7fu) + key2f(tb0 & ~0x7fu)) & ~0xffu) | 31u; ck3_1 = (f2key(key2f(ta15 & ~0x7fu) + key2f(tb0 & ~0x7fu)) & ~0xffu) | 15u; ck3_2 = 0u; ck3_3 = 0u; ck3_4 = 0u; ck3_5 = 0u; ck3_6 = 0u; ck3_7 = 0u; ck3_8 = 0u; ck3_9 = 0u; ck3_10 = 0u; ck3_11 = 0u; ck3_12 = 0u; ck3_13 = 0u; ck3_14 = 0u; ck3_15 = 0u; } while (0)
#define WRITE_LUT(LP) do { *(LAS u32x4*)(LP) = (u32x4){((127u - (ta0 & 127u)) << 0) | ((127u - (ta1 & 127u)) << 8) | ((127u - (ta2 & 127u)) << 16) | ((127u - (ta3 & 127u)) << 24), ((127u - (ta4 & 127u)) << 0) | ((127u - (ta5 & 127u)) << 8) | ((127u - (ta6 & 127u)) << 16) | ((127u - (ta7 & 127u)) << 24), ((127u - (ta8 & 127u)) << 0) | ((127u - (ta9 & 127u)) << 8) | ((127u - (ta10 & 127u)) << 16) | ((127u - (ta11 & 127u)) << 24), ((127u - (ta12 & 127u)) << 0) | ((127u - (ta13 & 127u)) << 8) | ((127u - (ta14 & 127u)) << 16) | ((127u - (ta15 & 127u)) << 24)}; *(LAS u32x4*)((LP) + 16) = (u32x4){((127u - (tb0 & 127u)) << 0) | ((127u - (tb1 & 127u)) << 8) | ((127u - (tb2 & 127u)) << 16) | ((127u - (tb3 & 127u)) << 24), ((127u - (tb4 & 127u)) << 0) | ((127u - (tb5 & 127u)) << 8) | ((127u - (tb6 & 127u)) << 16) | ((127u - (tb7 & 127u)) << 24), ((127u - (tb8 & 127u)) << 0) | ((127u - (tb9 & 127u)) << 8) | ((127u - (tb10 & 127u)) << 16) | ((127u - (tb11 & 127u)) << 24), ((127u - (tb12 & 127u)) << 0) | ((127u - (tb13 & 127u)) << 8) | ((127u - (tb14 & 127u)) << 16) | ((127u - (tb15 & 127u)) << 24)}; } while (0)
#define LOOKUP16(PQ, K, LP) do { { const unsigned _f = 255u - (K##0 & 255u); PQ##0 = (unsigned)(LP)[_f >> 4] * 128u + (unsigned)(LP)[16u + (_f & 15u)]; } { const unsigned _f = 255u - (K##1 & 255u); PQ##1 = (unsigned)(LP)[_f >> 4] * 128u + (unsigned)(LP)[16u + (_f & 15u)]; } { const unsigned _f = 255u - (K##2 & 255u); PQ##2 = (unsigned)(LP)[_f >> 4] * 128u + (unsigned)(LP)[16u + (_f & 15u)]; } { const unsigned _f = 255u - (K##3 & 255u); PQ##3 = (unsigned)(LP)[_f >> 4] * 128u + (unsigned)(LP)[16u + (_f & 15u)]; } { const unsigned _f = 255u - (K##4 & 255u); PQ##4 = (unsigned)(LP)[_f >> 4] * 128u + (unsigned)(LP)[16u + (_f & 15u)]; } { const unsigned _f = 255u - (K##5 & 255u); PQ##5 = (unsigned)(LP)[_f >> 4] * 128u + (unsigned)(LP)[16u + (_f & 15u)]; } { const unsigned _f = 255u - (K##6 & 255u); PQ##6 = (unsigned)(LP)[_f >> 4] * 128u + (unsigned)(LP)[16u + (_f & 15u)]; } { const unsigned _f = 255u - (K##7 & 255u); PQ##7 = (unsigned)(LP)[_f >> 4] * 128u + (unsigned)(LP)[16u + (_f & 15u)]; } { const unsigned _f = 255u - (K##8 & 255u); PQ##8 = (unsigned)(LP)[_f >> 4] * 128u + (unsigned)(LP)[16u + (_f & 15u)]; } { const unsigned _f = 255u - (K##9 & 255u); PQ##9 = (unsigned)(LP)[_f >> 4] * 128u + (unsigned)(LP)[16u + (_f & 15u)]; } { const unsigned _f = 255u - (K##10 & 255u); PQ##10 = (unsigned)(LP)[_f >> 4] * 128u + (unsigned)(LP)[16u + (_f & 15u)]; } { const unsigned _f = 255u - (K##11 & 255u); PQ##11 = (unsigned)(LP)[_f >> 4] * 128u + (unsigned)(LP)[16u + (_f & 15u)]; } { const unsigned _f = 255u - (K##12 & 255u); PQ##12 = (unsigned)(LP)[_f >> 4] * 128u + (unsigned)(LP)[16u + (_f & 15u)]; } { const unsigned _f = 255u - (K##13 & 255u); PQ##13 = (unsigned)(LP)[_f >> 4] * 128u + (unsigned)(LP)[16u + (_f & 15u)]; } { const unsigned _f = 255u - (K##14 & 255u); PQ##14 = (unsigned)(LP)[_f >> 4] * 128u + (unsigned)(LP)[16u + (_f & 15u)]; } { const unsigned _f = 255u - (K##15 & 255u); PQ##15 = (unsigned)(LP)[_f >> 4] * 128u + (unsigned)(LP)[16u + (_f & 15u)]; } } while (0)
#define GATES16(E, K, MX, SUM) do { E##0 = __expf(key2f(K##0 & ~0xffu) - (MX)); SUM += E##0; E##1 = __expf(key2f(K##1 & ~0xffu) - (MX)); SUM += E##1; E##2 = __expf(key2f(K##2 & ~0xffu) - (MX)); SUM += E##2; E##3 = __expf(key2f(K##3 & ~0xffu) - (MX)); SUM += E##3; E##4 = __expf(key2f(K##4 & ~0xffu) - (MX)); SUM += E##4; E##5 = __expf(key2f(K##5 & ~0xffu) - (MX)); SUM += E##5; E##6 = __expf(key2f(K##6 & ~0xffu) - (MX)); SUM += E##6; E##7 = __expf(key2f(K##7 & ~0xffu) - (MX)); SUM += E##7; E##8 = __expf(key2f(K##8 & ~0xffu) - (MX)); SUM += E##8; E##9 = __expf(key2f(K##9 & ~0xffu) - (MX)); SUM += E##9; E##10 = __expf(key2f(K##10 & ~0xffu) - (MX)); SUM += E##10; E##11 = __expf(key2f(K##11 & ~0xffu) - (MX)); SUM += E##11; E##12 = __expf(key2f(K##12 & ~0xffu) - (MX)); SUM += E##12; E##13 = __expf(key2f(K##13 & ~0xffu) - (MX)); SUM += E##13; E##14 = __expf(key2f(K##14 & ~0xffu) - (MX)); SUM += E##14; E##15 = __expf(key2f(K##15 & ~0xffu) - (MX)); SUM += E##15; } while (0)
#define STORE_GATES(GP, EP, E, PQ, INV) do { *(f32x4*)((GP) + 0) = (f32x4){E##0 * (INV), E##1 * (INV), E##2 * (INV), E##3 * (INV)}; *(u32x4*)((EP) + 0) = (u32x4){PQ##0, PQ##1, PQ##2, PQ##3}; *(f32x4*)((GP) + 4) = (f32x4){E##4 * (INV), E##5 * (INV), E##6 * (INV), E##7 * (INV)}; *(u32x4*)((EP) + 4) = (u32x4){PQ##4, PQ##5, PQ##6, PQ##7}; *(f32x4*)((GP) + 8) = (f32x4){E##8 * (INV), E##9 * (INV), E##10 * (INV), E##11 * (INV)}; *(u32x4*)((EP) + 8) = (u32x4){PQ##8, PQ##9, PQ##10, PQ##11}; *(f32x4*)((GP) + 12) = (f32x4){E##12 * (INV), E##13 * (INV), E##14 * (INV), E##15 * (INV)}; *(u32x4*)((EP) + 12) = (u32x4){PQ##12, PQ##13, PQ##14, PQ##15}; } while (0)

__device__ __forceinline__ void d_route(const Params& P, LAS unsigned char* lds, int tid, int gw, int ngw) {
    const int lane = tid & 63, wave = __builtin_amdgcn_readfirstlane(tid >> 6);
    for (int idx = tid; idx < 2 * 128 * 128 / 2; idx += 512) { const int e = idx * 2, row = e >> 7, c = e & 127;
        const float a = P.in[I_SUBKEYS][e], b = P.in[I_SUBKEYS][e + 1];
        *(LAS unsigned*)(lds + row * RT_SKROW + c * 2) = pk2(a, b); }
    asm volatile("s_waitcnt lgkmcnt(0)" ::: "memory"); __syncthreads();
    const int hh = lane >> 5, l31 = lane & 31;
#define ROUTE_HALF(QROW, SKZ, T) do { \
        bf16x8v qf[8]; f32x16v acc[4]; \
        _Pragma("unroll") for (int ks = 0; ks < 8; ++ks) qf[ks] = *(const bf16x8v*)((QROW) + ks * 16 + 8 * hh); \
        _Pragma("unroll") for (int kb = 0; kb < 4; ++kb) { \
            _Pragma("unroll") for (int i = 0; i < 16; ++i) acc[kb][i] = 0.f; \
            _Pragma("unroll") for (int ks = 0; ks < 8; ++ks) { const bf16x8v af = *(const LAS bf16x8v*)((SKZ) + (kb * 32 + l31) * RT_SKROW + (ks * 16 + 8 * hh) * 2); \
                acc[kb] = __builtin_amdgcn_mfma_f32_32x32x16_bf16(af, qf[ks], acc[kb], 0, 0, 0); } } \
        DECL16(unsigned, ga); DECL16(unsigned, gb); DECL16(unsigned, gc); DECL16(unsigned, gd); DECL16(unsigned, ob); \
        __builtin_amdgcn_sched_barrier(0); FILL_G0(ga, acc[0], hh); SORT16_DESC(ga); __builtin_amdgcn_sched_barrier(0); FILL_G1(gb, acc[1], hh); SORT16_DESC(gb); __builtin_amdgcn_sched_barrier(0); MERGE16_DESC(ga, gb); __builtin_amdgcn_sched_barrier(0); \
        FILL_G2(gc, acc[2], hh); SORT16_DESC(gc); __builtin_amdgcn_sched_barrier(0); FILL_G3(gd, acc[3], hh); SORT16_DESC(gd); __builtin_amdgcn_sched_barrier(0); MERGE16_DESC(gc, gd); __builtin_amdgcn_sched_barrier(0); MERGE16_DESC(ga, gc); __builtin_amdgcn_sched_barrier(0); \
        XCHG16(ob, ga); MERGE16_DESC(ga, ob); COPY16(T, ga); __builtin_amdgcn_sched_barrier(0); } while (0)
#pragma unroll 1
    for (int task = gw; task < TOK * 8 / 32; task += ngw) {
        const long r0 = (long)task * 32; const bf16_t* qrow = P.QP + (size_t)(r0 + l31) * 256;
        DECL16(unsigned, ta); DECL16(unsigned, tb);
        ROUTE_HALF(qrow, lds, ta);
        ROUTE_HALF(qrow + 128, lds + 128 * RT_SKROW, tb);
        DECL16(unsigned, ck0_); DECL16(unsigned, ck1_); DECL16(unsigned, ck2_); DECL16(unsigned, ck3_);
        LAS unsigned char* lut = lds + 2 * 128 * RT_SKROW + wave * 1024 + l31 * 32;
        WRITE_LUT(lut);
        FILL_CANDS(); __builtin_amdgcn_sched_barrier(0);
        SORT16_DESC(ck0_); __builtin_amdgcn_sched_barrier(0); SORT16_DESC(ck1_); __builtin_amdgcn_sched_barrier(0); MERGE16_DESC(ck0_, ck1_); __builtin_amdgcn_sched_barrier(0);
        SORT16_DESC(ck2_); __builtin_amdgcn_sched_barrier(0); SORT16_DESC(ck3_); __builtin_amdgcn_sched_barrier(0); MERGE16_DESC(ck2_, ck3_); __builtin_amdgcn_sched_barrier(0); MERGE16_DESC(ck0_, ck2_); __builtin_amdgcn_sched_barrier(0);
        DECL16(unsigned, cp0_);
        LOOKUP16(cp0_, ck0_, lut);
        DECL16(float, ee); const float mx = key2f(ck0_0 & ~0xffu); float sum = 0.f;
        GATES16(ee, ck0_, mx, sum);
        const float inv = 1.0f / sum;
        if (lane < 32) { float* gp = P.GATE + (size_t)(r0 + lane) * 16; int* ep = P.EXPERT + (size_t)(r0 + lane) * 16; STORE_GATES(gp, ep, ee, cp0_, inv); }
    }
#undef ROUTE_HALF
}

__device__ __forceinline__ void d_gmlp(const Params& P, LAS unsigned char* lds, int tid) {
    const int lane = tid & 63, wave = __builtin_amdgcn_readfirstlane(tid >> 6), hh = lane >> 5, l31 = lane & 31;
    const int chunk = (int)blockIdx.x >> 1, hb = (int)blockIdx.x & 1;
    if (chunk >= TOK / 128) return;
    LAS bf16_t* VNt = (LAS bf16_t*)lds;
    {
        const int cg = hb * 256 + 8 * l31;
        const f32x4 g0 = *(const f32x4*)(P.in[I_GLN_G] + cg), g1 = *(const f32x4*)(P.in[I_GLN_G] + cg + 4);
        const f32x4 b0 = *(const f32x4*)(P.in[I_GLN_B] + cg), b1 = *(const f32x4*)(P.in[I_GLN_B] + cg + 4);
#pragma unroll 4
        for (int tt = 0; tt < 16; ++tt) { const int q = wave * 16 + tt; const long t = (long)chunk * 128 + q;
            const u32x4 w = *((const u32x4*)(P.PB + (size_t)t * 1024 + 512) + lane);
            float x[8] = {blo(w.x), bhi(w.x), blo(w.y), bhi(w.y), blo(w.z), bhi(w.z), blo(w.w), bhi(w.w)};
            float s = 0.f;
#pragma unroll
            for (int i = 0; i < 8; ++i) s += x[i];
            const float mean = wave_sum(s) * (1.f / 512.f); float s2 = 0.f;
#pragma unroll
            for (int i = 0; i < 8; ++i) { x[i] -= mean; s2 += x[i] * x[i]; }
            const float rstd = 1.f / sqrtf(wave_sum(s2) * (1.f / 512.f) + 1e-5f);
            if (hh == hb) {
#pragma unroll
                for (int i = 0; i < 8; ++i) { const float gg = (i < 4) ? g0[i] : g1[i - 4], bb = (i < 4) ? b0[i] : b1[i - 4];
                    VNt[(8 * l31 + i) * 136 + q] = f2bf(x[i] * rstd * gg + bb); } }
        }
    }
    asm volatile("s_waitcnt lgkmcnt(0)" ::: "memory"); __syncthreads();
    const int pb = wave >> 1, db = wave & 1;
#pragma unroll 1
    for (int gl = 0; gl < 4; ++gl) { const int g = 4 * hb + gl;
        f32x16v acc;
#pragma unroll
        for (int i = 0; i < 16; ++i) acc[i] = 0.f;
        const bf16_t* arow = P.WSB + ((size_t)g * 128 + pb * 32 + l31) * 128 + 8 * hh;
        const LAS bf16_t* brow = VNt + (gl * 64 + db * 32 + l31) * 136 + 8 * hh;
#pragma unroll
        for (int ks = 0; ks < 8; ++ks) { const bf16x8v af = *(const bf16x8v*)(arow + ks * 16); const bf16x8v bfr = *(const LAS bf16x8v*)(brow + ks * 16);
            acc = __builtin_amdgcn_mfma_f32_32x32x16_bf16(af, bfr, acc, 0, 0, 0); }
        const int c = g * 64 + db * 32 + l31;
#pragma unroll
        for (int r = 0; r < 16; ++r) { const int p = pb * 32 + (r & 3) + 8 * (r >> 2) + 4 * hh; const long t = (long)chunk * 128 + p;
            const float sv = acc[r] + P.in[I_B_S][g * 128 + p];
            P.YB[(size_t)t * 512 + c] = f2bf(bf2f(P.PB[(size_t)t * 1024 + c]) * sv); }
    }
}
constexpr int RING_BYTES = 131072, LDSCTL_OFF = RING_BYTES, MISC_OFF = LDSCTL_OFF + 320, LDS_BYTES = 147456;
constexpr int CW_BAR = 4096;
#ifndef MK_PER_PHASE
#define MK_PER_PHASE 0
#endif
struct KArgs { Params P; };
template <class DE, bool ALIGN = true> __device__ __forceinline__ void run_gemm(LAS unsigned char* lds, const bf16_t* A, const bf16_t* Bt, int M, int N, int K, const DE& E,
                                                                     int bgrp = 1 << 30, size_t bgstride = 0, int lda = 0, int ldb = 0, int boff = 0) {
    pg8::Gemm g{A, Bt, M, N, K, lda ? lda : K, ldb ? ldb : K, bgrp, bgstride}; pg8::StaticOrder S; S.init(M, N, (int)gridDim.x, (int)((blockIdx.x + boff) % gridDim.x));
    pg8::gemm_phase<DE, pg8::StaticOrder, ALIGN, true>(lds, g, S, E);
}
__global__ void __launch_bounds__(512, 2) mega_fwd(KArgs a) {
    extern __shared__ __attribute__((aligned(16))) unsigned char lds_raw[];
    LAS unsigned char* lds = (LAS unsigned char*)lds_raw;
    volatile LAS unsigned* MISC = (volatile LAS unsigned*)(lds + MISC_OFF);
    const Params& P = a.P;
    const int tid = threadIdx.x;
    for (int u = tid; u < (LDS_BYTES - LDSCTL_OFF) / 4; u += 512) ((LAS unsigned*)(lds + LDSCTL_OFF))[u] = 0u;
    __syncthreads();
    XcdBarrier bar; bar.bar = P.ctl + CW_BAR; bar.x = 0; bar.st = nullptr;
    bar = xcd_barrier_post(P.ctl + CW_BAR, MISC + 8);
    if (TP_LO >= 0 && blockIdx.x == 0 && tid == 0) P.ctl[8192] = (unsigned)__builtin_amdgcn_s_memrealtime();
    const long gtid = (long)blockIdx.x * 512 + tid, nthr = (long)gridDim.x * 512;
    const int lane = tid & 63, wave = __builtin_amdgcn_readfirstlane(tid >> 6), gw = (int)blockIdx.x * 8 + wave, ngw = (int)gridDim.x * 8;
#ifndef PROBE_ID
#define PROBE_ID -1
#endif
#define PHASE(id, body) do { body; xcd_barrier(bar); if (TP_LO >= 0 && blockIdx.x == 0 && tid == 0) P.ctl[8192 + (id) + 1] = (unsigned)__builtin_amdgcn_s_memrealtime(); } while (0)
    PHASE(0, (d_weights(P, lds, gw, ngw, wave, lane), d_lora_weights(P, gtid, nthr), d_ln_rows(P.in[I_X], P.in[I_LN_EMB_G], P.in[I_LN_EMB_B], P.HB, TOK, gw, ngw, lane),
           d_ln_rows(P.in[I_MEM], P.in[I_MLN_G], P.in[I_MLN_B], P.MEMN, BATCH * MEM_LEN, gw, ngw, lane)));
    PHASE(1, ({ { pg8::DEpiP1 E{{P.PA, P.PB}}; run_gemm(lds, P.HB, P.W_IN_T, TOK, 3072, 1024, E); }
             { pg8::DEpiTile E2{P.KH, 4, 1, 1.0f}; run_gemm(lds, P.MEMN, P.W_KV_T, BATCH * MEM_LEN, 1024, 1024, E2); }
             { pg8::DEpiTile E3{P.VT, 1, 4, 1.0f}; run_gemm(lds, P.W_KV_T + (size_t)1024 * 1024, P.MEMN, 1024, BATCH * MEM_LEN, 1024, E3, 1 << 30, 0, 0, 0, 128); } }));
    PHASE(2, (d_gmlp(P, lds, tid), d_prep_e1(P, gw, ngw, lane)));
    PHASE(3, ({ { pg8::DEpiLora<0> E{P.in[I_W0], P.OMW}; run_gemm(lds, P.LIN, P.W_LORA_T, TOK, 1024, 256, E, 1 << 30, 0, 512, 512); }
             { pg8::DEpiLora<1> E{P.in[I_A0], P.AL}; run_gemm(lds, P.LIN, P.W_LORA_T + (size_t)1024 * 512, TOK, 1024, 256, E, 1 << 30, 0, 512, 512); }
             { pg8::DEpiLora<2> E{nullptr, P.G}; run_gemm(lds, P.LIN + 256, P.W_LORA_T + (size_t)2048 * 512 + 256, TOK, 512, 256, E, 1 << 30, 0, 512, 512, 128); } }));
    PHASE(4, d_scan(P, lds, tid));
    PHASE(5, d_rwkv_out(P, gw, ngw, lane));
    PHASE(6, ({ { pg8::DEpiPlain E{{P.BR, 2048, 0}}; run_gemm(lds, P.YA, P.W_BR_T, TOK, 1024, 512, E); }
             { pg8::DEpiPlain E2{{P.BR, 2048, 1024}}; run_gemm(lds, P.YB, P.W_BR_T + (size_t)1024 * 512, TOK, 1024, 512, E2); } }));
    PHASE(7, ({ pg8::DEpiMerge E{{P.BR, P.MG}}; run_gemm(lds, P.HB, P.W_IN_T + (size_t)3072 * 1024, TOK, 2048, 1024, E); }));
    PHASE(8, ({ pg8::DEpiResid E{{P.HB, P.Z}}; run_gemm(lds, P.MG, P.W_MIX_T, TOK, 1024, 1024, E); }));
    PHASE(9, d_ln_rows(P.Z, P.in[I_LN1_G], P.in[I_LN1_B], P.HB, TOK, gw, ngw, lane));
    PHASE(10, ({ pg8::DEpiQ EQ{{P.QH, 1, 0, 0.0625f}}; run_gemm(lds, P.HB, P.W_Q_T, TOK, 1024, 1024, EQ); }));
    PHASE(11, ({ pg8::DEpiSoftmax E{P.PP}; run_gemm<pg8::DEpiSoftmax, false>(lds, P.QH, P.KH, TOK * 4, 256, 256, E, 8, (size_t)256 * 256 * 2); }));
    PHASE(12, ({ pg8::DEpiO E{P.O}; run_gemm(lds, P.PP, P.VT, TOK * 4, 256, 256, E, 8, (size_t)256 * 256 * 2); }));
    PHASE(13, ({ pg8::DEpiResid E{{P.HB, P.Z}}; run_gemm(lds, P.O, P.W_O_T, TOK, 1024, 1024, E); }));
    PHASE(14, d_ln_rows(P.Z, P.in[I_LN2_G], P.in[I_LN2_B], P.HB, TOK, gw, ngw, lane));
    PHASE(15, ({ pg8::DEpiPlain E{{P.QP, 2048, 0}}; run_gemm(lds, P.HB, P.W_QUERY_T, TOK, 2048, 1024, E); }));
#if PEER_FP8
    PHASE(16, (d_route(P, lds, tid, gw, ngw), d_tables8(P, gw, ngw, lane)));
#if PEER_SLICED == 2
    d_peer8t(P, gw, ngw, lane);
#elif PEER_SLICED == 1
    d_peer8s(P, gw, ngw, lane);
#else
    d_peer8(P, gw, ngw, lane);
#endif
#else
    PHASE(16, (d_route(P, lds, tid, gw, ngw), d_tables(P, gtid, nthr)));
    d_peer(P, gw, ngw, lane);
#endif
#undef PHASE
}
extern "C" void kernel_launch(void* const* d_in, const int* in_sizes, int n_in, void* d_out, int out_size, void* d_ws, size_t ws_size, hipStream_t stream) {
    static int grid = 0;
    if (grid == 0) {
        int dev = 0, cus = 0;
        if (n_in != 37 || ws_size < WS_NEED || hipGetDevice(&dev) != hipSuccess || hipDeviceGetAttribute(&cus, hipDeviceAttributeMultiprocessorCount, dev) != hipSuccess) {
            fprintf(stderr, "kernel_launch: bad arguments (n_in %d, ws %zu < %zu)\n", n_in, ws_size, (size_t)WS_NEED); grid = -1; return; }
        if (hipFuncSetAttribute((const void*)mega_fwd, hipFuncAttributeMaxDynamicSharedMemorySize, LDS_BYTES) != hipSuccess) { fprintf(stderr, "kernel_launch: hipFuncSetAttribute failed\n"); grid = -1; return; }
        grid = cus;
    }
    if (grid < 0) return;
    (void)hipMemsetAsync((char*)d_ws + WS_CTL, 0, 1 * MiB, stream);
    KArgs a; memset(&a, 0, sizeof(a)); make_params(a.P, d_in, d_out, d_ws);
    hipLaunchKernelGGL(mega_fwd, dim3(grid), dim3(512), LDS_BYTES, stream, a);
}
#endif
```
